# Optimizing an MI355X kernel written in HIP

```python
import jax, jax.numpy as jnp
from jax import lax
import numpy as np

D_MODEL = 1024
BATCH = 8
SEQ = 2048
DEPTH = 2

N_META = 16
D_FF = (11 * D_MODEL) // 4
LRU_WIDTH = D_MODEL // 4
LRU_BLOCKS = 4
LRU_BLOCK = LRU_WIDTH // LRU_BLOCKS
LRU_CONV = 4
LRU_C = 8.0
SC_WIDTH = D_MODEL // 4
SC_GROUPS = 4
SC_CONV = 3
RWKV_WIDTH = D_MODEL // 2
RWKV_HEAD = 64
RWKV_HEADS = RWKV_WIDTH // RWKV_HEAD
DECAY_LORA = 32
ICL_LORA = 32
GATE_LORA = 64
MIX_WIDTH = LRU_WIDTH + SC_WIDTH + RWKV_WIDTH
RWKV_IN = 3 * RWKV_WIDTH + DECAY_LORA + ICL_LORA + GATE_LORA
N_IN = 2 * LRU_WIDTH + 3 * SC_WIDTH + RWKV_IN
IN_SPLIT_IDX = (LRU_WIDTH, 2 * LRU_WIDTH, 2 * LRU_WIDTH + SC_WIDTH,
                2 * LRU_WIDTH + 2 * SC_WIDTH, 2 * LRU_WIDTH + 3 * SC_WIDTH)
RWKV_SPLIT_IDX = (RWKV_WIDTH, 2 * RWKV_WIDTH, 3 * RWKV_WIDTH,
                  3 * RWKV_WIDTH + DECAY_LORA, 3 * RWKV_WIDTH + DECAY_LORA + ICL_LORA)
RMS_EPS = 1e-6
LNX_EPS = 64e-5

kernel_name = "hybrid_rglru_shortconv_rwkv7_macaron"


def rms_norm(x, g):
    xf = x.astype(jnp.float32)
    y = xf * lax.rsqrt(jnp.mean(xf * xf, axis=-1, keepdims=True) + RMS_EPS)
    return (y * g).astype(x.dtype)


def group_rms_norm(x, g, n_groups):
    shp = x.shape
    xf = x.astype(jnp.float32).reshape(shp[:-1] + (n_groups, shp[-1] // n_groups))
    y = xf * lax.rsqrt(jnp.mean(xf * xf, axis=-1, keepdims=True) + RMS_EPS)
    return (y.reshape(shp) * g).astype(x.dtype)


def causal_dwconv(x, w):
    k_w, t = w.shape[0], x.shape[1]
    xp = jnp.pad(x, ((0, 0), (k_w - 1, 0), (0, 0)))
    y = xp[:, 0:t] * w[0]
    for k in range(1, k_w):
        y = y + xp[:, k:k + t] * w[k]
    return y


def token_shift(x):
    return jnp.pad(x, ((0, 0), (1, 0), (0, 0)))[:, :-1]


def swiglu(x, w_in, w_out):
    gate, up = jnp.split(x @ w_in, 2, axis=-1)
    return (jax.nn.silu(gate) * up) @ w_out


def _linear_rec_combine(c1, c2):
    a1, b1 = c1
    a2, b2 = c2
    return a1 * a2, a2 * b1 + b2


def rg_lru_mixer(xb, gb, conv_w, conv_b, wa, ba, wx, bx, lam):
    bsz, t, _ = xb.shape
    u = (causal_dwconv(xb, conv_w) + conv_b).astype(jnp.float32)
    ub = u.reshape(bsz, t, LRU_BLOCKS, LRU_BLOCK)
    r = jax.nn.sigmoid(jnp.einsum('btgi,gij->btgj', ub, wa).reshape(bsz, t, LRU_WIDTH) + ba)
    i = jax.nn.sigmoid(jnp.einsum('btgi,gij->btgj', ub, wx).reshape(bsz, t, LRU_WIDTH) + bx)
    log_a = -LRU_C * r * jax.nn.softplus(-lam)
    a = jnp.exp(log_a)
    b = jnp.sqrt(-jnp.expm1(2.0 * log_a)) * (i * u)
    _, h = lax.associative_scan(_linear_rec_combine, (a, b), axis=1)
    return jax.nn.gelu(gb.astype(jnp.float32)) * h


def short_conv_mixer(sc_b, sc_c, sc_x, conv_w):
    return sc_b * causal_dwconv(sc_c * sc_x, conv_w)


def rwkv7_mixer(z, mu, w0, w2, a0, a2, g2, k_k, k_a, r_k, lnx_w, lnx_b):
    bsz, t, _ = z.shape
    z = (z + (token_shift(z) - z) * mu).astype(jnp.float32)
    r, k, v, w_lo, a_lo, g_lo = jnp.split(z, RWKV_SPLIT_IDX, axis=-1)
    w_log = -jax.nn.softplus(-(w0 + jnp.tanh(w_lo) @ w2)) - 0.5
    decay = jnp.exp(-jnp.exp(w_log))
    a = jax.nn.sigmoid(a0 + a_lo @ a2)
    g = jax.nn.sigmoid(g_lo) @ g2
    kk = k * k_k
    k = k * (1.0 + (a - 1.0) * k_a)

    def heads(q):
        return q.reshape(bsz, t, RWKV_HEADS, RWKV_HEAD)

    r, k, v, kk, a, decay = (heads(q) for q in (r, k, v, kk, a, decay))
    kk = kk * lax.rsqrt(jnp.maximum(jnp.sum(kk * kk, axis=-1, keepdims=True), 1e-24))

    def step(s, inp):
        r_t, w_t, k_t, v_t, kk_t, a_t = inp
        sa = jnp.einsum('bhvk,bhk->bhv', s, -kk_t)
        s = (s * w_t[:, :, None, :] + sa[..., None] * (kk_t * a_t)[:, :, None, :]
             + v_t[..., None] * k_t[:, :, None, :])
        return s, jnp.einsum('bhvk,bhk->bhv', s, r_t)

    seq = tuple(jnp.moveaxis(q, 1, 0) for q in (r, decay, k, v, kk, a))
    s0 = jnp.zeros((bsz, RWKV_HEADS, RWKV_HEAD, RWKV_HEAD), jnp.float32)
    _, y = lax.scan(step, s0, seq)
    y = jnp.moveaxis(y, 0, 1)
    mean = jnp.mean(y, axis=-1, keepdims=True)
    var = jnp.mean(jnp.square(y - mean), axis=-1, keepdims=True)
    y = ((y - mean) * lax.rsqrt(var + LNX_EPS)).reshape(bsz, t, RWKV_WIDTH) * lnx_w + lnx_b
    bonus = jnp.sum(r * k * r_k.reshape(RWKV_HEADS, RWKV_HEAD), axis=-1, keepdims=True) * v
    y = y + bonus.reshape(bsz, t, RWKV_WIDTH)
    return y * g


def hybrid_mixer(u, w_in, w_out, lru_conv_w, lru_conv_b, lru_wa, lru_ba, lru_wx, lru_bx,
                 lru_lambda, lru_norm_g, sc_conv_w, sc_norm_g, rwkv_mu, rwkv_w0, rwkv_w2,
                 rwkv_a0, rwkv_a2, rwkv_g2, rwkv_k_k, rwkv_k_a, rwkv_r_k, rwkv_lnx_w, rwkv_lnx_b):
    p = u @ w_in
    lru_x, lru_g, sc_b, sc_c, sc_x, rw = jnp.split(p, IN_SPLIT_IDX, axis=-1)
    y_lru = group_rms_norm(
        rg_lru_mixer(lru_x, lru_g, lru_conv_w, lru_conv_b, lru_wa, lru_ba, lru_wx, lru_bx, lru_lambda),
        lru_norm_g, LRU_BLOCKS)
    y_sc = group_rms_norm(short_conv_mixer(sc_b, sc_c, sc_x, sc_conv_w), sc_norm_g, SC_GROUPS)
    y_rw = rwkv7_mixer(rw, rwkv_mu, rwkv_w0, rwkv_w2, rwkv_a0, rwkv_a2, rwkv_g2,
                       rwkv_k_k, rwkv_k_a, rwkv_r_k, rwkv_lnx_w, rwkv_lnx_b)
    y = jnp.concatenate([y_lru.astype(u.dtype), y_sc.astype(u.dtype), y_rw.astype(u.dtype)], axis=-1)
    return y @ w_out


def setup_inputs(seed: int = 0) -> dict:
    key = jax.random.key(seed)
    ks = jax.random.split(key, 32)
    L, D = DEPTH, D_MODEL
    nrm = jax.random.normal
    u01 = jax.random.uniform(ks[14], (L, LRU_WIDTH), minval=0.9, maxval=0.999)
    a_base = u01 ** (1.0 / LRU_C)
    return {
        'x': nrm(ks[0], (BATCH, SEQ, D), jnp.float32),
        'meta_tokens': nrm(ks[1], (N_META, D), jnp.float32),
        'norm_g': 1.0 + 0.02 * nrm(ks[2], (L, 6, D), jnp.float32),
        'ffn1_w_in': nrm(ks[3], (L, D, 2 * D_FF), jnp.float32) * D ** -0.5,
        'ffn1_w_out': nrm(ks[4], (L, D_FF, D), jnp.float32) * D_FF ** -0.5,
        'ffn2_w_in': nrm(ks[5], (L, D, 2 * D_FF), jnp.float32) * D ** -0.5,
        'ffn2_w_out': nrm(ks[6], (L, D_FF, D), jnp.float32) * D_FF ** -0.5,
        'mix_w_in': nrm(ks[7], (L, D, N_IN), jnp.float32) * D ** -0.5,
        'mix_w_out': nrm(ks[8], (L, MIX_WIDTH, D), jnp.float32) * MIX_WIDTH ** -0.5,
        'lru_conv_w': nrm(ks[9], (L, LRU_CONV, LRU_WIDTH), jnp.float32) * LRU_CONV ** -0.5,
        'lru_conv_b': 0.02 * nrm(ks[10], (L, LRU_WIDTH), jnp.float32),
        'lru_wa': nrm(ks[11], (L, LRU_BLOCKS, LRU_BLOCK, LRU_BLOCK), jnp.float32) * LRU_BLOCK ** -0.5,
        'lru_ba': 0.1 * nrm(ks[12], (L, LRU_WIDTH), jnp.float32),
        'lru_wx': nrm(ks[13], (L, LRU_BLOCKS, LRU_BLOCK, LRU_BLOCK), jnp.float32) * LRU_BLOCK ** -0.5,
        'lru_bx': 0.1 * nrm(ks[15], (L, LRU_WIDTH), jnp.float32),
        'lru_lambda': jnp.log(a_base) - jnp.log1p(-a_base),
        'lru_norm_g': 1.0 + 0.02 * nrm(ks[16], (L, LRU_WIDTH), jnp.float32),
        'sc_conv_w': nrm(ks[17], (L, SC_CONV, SC_WIDTH), jnp.float32) * SC_CONV ** -0.5,
        'sc_norm_g': 1.0 + 0.02 * nrm(ks[18], (L, SC_WIDTH), jnp.float32),
        'rwkv_mu': jax.random.uniform(ks[19], (L, RWKV_IN), jnp.float32),
        'rwkv_w0': jnp.linspace(-6.0, -1.0, RWKV_WIDTH, dtype=jnp.float32)[None, :]
                   + 0.1 * nrm(ks[20], (L, RWKV_WIDTH), jnp.float32),
        'rwkv_w2': nrm(ks[21], (L, DECAY_LORA, RWKV_WIDTH), jnp.float32) * DECAY_LORA ** -0.5,
        'rwkv_a0': 0.1 * nrm(ks[22], (L, RWKV_WIDTH), jnp.float32),
        'rwkv_a2': nrm(ks[23], (L, ICL_LORA, RWKV_WIDTH), jnp.float32) * ICL_LORA ** -0.5,
        'rwkv_g2': nrm(ks[24], (L, GATE_LORA, RWKV_WIDTH), jnp.float32) * GATE_LORA ** -0.5,
        'rwkv_k_k': 0.85 + 0.02 * nrm(ks[25], (L, RWKV_WIDTH), jnp.float32),
        'rwkv_k_a': 1.0 + 0.02 * nrm(ks[26], (L, RWKV_WIDTH), jnp.float32),
        'rwkv_r_k': 0.1 * nrm(ks[27], (L, RWKV_WIDTH), jnp.float32),
        'rwkv_lnx_w': 1.0 + 0.02 * nrm(ks[28], (L, RWKV_WIDTH), jnp.float32),
        'rwkv_lnx_b': 0.02 * nrm(ks[29], (L, RWKV_WIDTH), jnp.float32),
    }


def reference(x, meta_tokens, norm_g, ffn1_w_in, ffn1_w_out, ffn2_w_in, ffn2_w_out,
              mix_w_in, mix_w_out, lru_conv_w, lru_conv_b, lru_wa, lru_ba, lru_wx, lru_bx,
              lru_lambda, lru_norm_g, sc_conv_w, sc_norm_g, rwkv_mu, rwkv_w0, rwkv_w2,
              rwkv_a0, rwkv_a2, rwkv_g2, rwkv_k_k, rwkv_k_a, rwkv_r_k, rwkv_lnx_w, rwkv_lnx_b):
    bsz = x.shape[0]
    meta = jnp.broadcast_to(meta_tokens.astype(x.dtype)[None], (bsz, N_META, x.shape[-1]))
    h = jnp.concatenate([meta, x], axis=1)
    for l in range(DEPTH):
        g = norm_g[l]
        h = h + 0.5 * rms_norm(swiglu(rms_norm(h, g[0]), ffn1_w_in[l], ffn1_w_out[l]), g[1])
        m = hybrid_mixer(rms_norm(h, g[2]), mix_w_in[l], mix_w_out[l],
                         lru_conv_w[l], lru_conv_b[l], lru_wa[l], lru_ba[l], lru_wx[l], lru_bx[l],
                         lru_lambda[l], lru_norm_g[l], sc_conv_w[l], sc_norm_g[l],
                         rwkv_mu[l], rwkv_w0[l], rwkv_w2[l], rwkv_a0[l], rwkv_a2[l], rwkv_g2[l],
                         rwkv_k_k[l], rwkv_k_a[l], rwkv_r_k[l], rwkv_lnx_w[l], rwkv_lnx_b[l])
        h = h + rms_norm(m, g[3])
        h = h + 0.5 * rms_norm(swiglu(rms_norm(h, g[4]), ffn2_w_in[l], ffn2_w_out[l]), g[5])
    return h[:, N_META:]
```

```cpp
#include <hip/hip_runtime.h>
#include <cstdio>
#include <cstdint>
namespace pg8 {
#define PG8_LAS __attribute__((address_space(3)))
typedef unsigned short bf16_t;
typedef short bf16x8 __attribute__((ext_vector_type(8)));
typedef float f32x4 __attribute__((ext_vector_type(4)));
typedef unsigned u32x4 __attribute__((ext_vector_type(4)));
constexpr int BM = 256, BK = 64, HALF = 128, HTB = HALF * BK * 2  , STAGE_BYTES = 8 * HTB, NXCD = 8, WGM = 8;

__host__ __device__ __forceinline__ int lds_byte(int r, int c) { const int st = (r >> 4) * 2 + (c >> 5), rr = r & 15, cc = c & 31, ob = rr * 64 + cc * 2; return st * 1024 + (ob ^ (((ob >> 9) & 1) << 5)); }
__host__ __device__ __forceinline__ void stage_rc(int b, int& R, int& C) { const int st = b / 1024, sb = b % 1024, swz = sb ^ (((sb >> 9) & 1) << 5); R = (st >> 1) * 16 + swz / 64; C = (st & 1) * 32 + (swz % 64) / 2; }
__host__ __device__ __forceinline__ int perm32(int rho) { const int n = rho >> 4, i = rho & 15; return 8 * (i >> 2) + 4 * n + (i & 3); }

struct Unit { int pm, pn; };
struct Gemm { const bf16_t* A; const bf16_t* Bt; int M, N, K; };

struct StaticOrder {
    int nM, nN, nwg, G, c;
    __host__ __device__ void init(int M, int N, int G_, int c_) { nM = M / BM; nN = N / BM; nwg = nM * nN; G = G_; c = c_; }
    __host__ __device__ bool next(int i, Unit& u) const {
        const long L = (long)i * G + c; if (L >= nwg) return false;
        int wgid = (int)L; { const int q = nwg / NXCD, r = nwg % NXCD, xcd = wgid % NXCD, off = wgid / NXCD; wgid = (xcd < r ? xcd * (q + 1) : r * (q + 1) + (xcd - r) * q) + off; }
        const int nig = WGM * nN, gid = wgid / nig, fm = gid * WGM, gsz = (nM - fm) < WGM ? (nM - fm) : WGM;
        u.pm = fm + ((wgid % nig) % gsz); u.pn = (wgid % nig) / gsz; return true;
    }
    __device__ __forceinline__ void a_ready(const Unit&) const {}
    __device__ __forceinline__ void done(const Unit&) const {}
};
__device__ __forceinline__ unsigned cvt_pk_bf16(float lo, float hi) { unsigned r; asm volatile("v_cvt_pk_bf16_f32 %0, %1, %2" : "=v"(r) : "v"(lo), "v"(hi)); return r; }
typedef float f32x2 __attribute__((ext_vector_type(2)));
struct EpiSwiGLU {
    static constexpr bool PERM = true, AFTER_DRAIN = false;
    bf16_t* O; int ldo;
    __device__ __forceinline__ void operator()(const f32x4 (&acc)[2][2][4][2], const Unit& u, int wr, int wc, int fr, int fq) const {
        const int row0 = u.pm * BM + wr * 64 + fr, col0 = u.pn * HALF + wc * 32 + 8 * fq;
#pragma unroll
        for (int ai = 0; ai < 2; ++ai)
#pragma unroll
            for (int m = 0; m < 4; ++m) { bf16_t* rowp = O + (size_t)(row0 + ai * HALF + m * 16) * ldo + col0;
                float hv[8];
#pragma unroll
                for (int n = 0; n < 2; ++n)
#pragma unroll
                    for (int j = 0; j < 4; ++j) { const float g = acc[ai][0][m][n][j], up = acc[ai][1][m][n][j]; hv[n * 4 + j] = g * __builtin_amdgcn_rcpf(1.0f + __expf(-g)) * up; }
                u32x4 w; w.x = cvt_pk_bf16(hv[0], hv[1]); w.y = cvt_pk_bf16(hv[2], hv[3]); w.z = cvt_pk_bf16(hv[4], hv[5]); w.w = cvt_pk_bf16(hv[6], hv[7]);
                *(u32x4*)rowp = w; }
    }
};
struct EpiStoreBf16 {
    static constexpr bool PERM = true, AFTER_DRAIN = false;
    bf16_t* O; int ldc;
    __device__ __forceinline__ void operator()(const f32x4 (&acc)[2][2][4][2], const Unit& u, int wr, int wc, int fr, int fq) const {
        const int row0 = u.pm * BM + wr * 64 + fr, col0 = u.pn * BM + wc * 32 + 8 * fq;
#pragma unroll
        for (int ai = 0; ai < 2; ++ai)
#pragma unroll
            for (int m = 0; m < 4; ++m) { bf16_t* rowp = O + (size_t)(row0 + ai * HALF + m * 16) * ldc + col0;
#pragma unroll
                for (int bj = 0; bj < 2; ++bj) { const f32x4 v0 = acc[ai][bj][m][0], v1 = acc[ai][bj][m][1];
                    u32x4 w; w.x = cvt_pk_bf16(v0[0], v0[1]); w.y = cvt_pk_bf16(v0[2], v0[3]); w.z = cvt_pk_bf16(v1[0], v1[1]); w.w = cvt_pk_bf16(v1[2], v1[3]);
                    *(u32x4*)(rowp + bj * HALF) = w; } }
    }
};
struct EpiF32 {
    static constexpr bool PERM = false, AFTER_DRAIN = false;
    float* C; int ldc;
    __device__ __forceinline__ void operator()(const f32x4 (&acc)[2][2][4][2], const Unit& u, int wr, int wc, int fr, int fq) const {
        const int row0 = u.pm * BM + wr * 64 + fr, col0 = u.pn * BM + wc * 32 + 4 * fq;
#pragma unroll
        for (int ai = 0; ai < 2; ++ai)
#pragma unroll
            for (int m = 0; m < 4; ++m) { float* rowp = C + (size_t)(row0 + ai * HALF + m * 16) * ldc + col0;
#pragma unroll
                for (int bj = 0; bj < 2; ++bj)
#pragma unroll
                    for (int n = 0; n < 2; ++n) *(f32x4*)(rowp + bj * HALF + n * 16) = acc[ai][bj][m][n]; }
    }
};
template <class Epi, class Sched, bool ALIGN_EPI = false, bool SP2 = false>
__device__ __forceinline__ void gemm_phase(PG8_LAS unsigned char* lds, const Gemm g, const Sched& S, const Epi& E) {
    int tid_ = threadIdx.x; asm volatile("" : "+v"(tid_));
    const int tid = tid_, wid = __builtin_amdgcn_readfirstlane(tid >> 6), lane = tid & 63, wr = wid >> 2, wc = wid & 3, fr = lane & 15, fq = lane >> 4;
    const int K = g.K, nt = K / BK;
    unsigned voffA[2], voffB[2];
#pragma unroll
    for (int i = 0; i < 2; ++i) { int R, C; stage_rc(tid * 16 + i * 8192, R, C); const int Rb = Epi::PERM ? ((R & ~31) + perm32(R & 31)) : R;
        voffA[i] = (unsigned)(R * K + C) * 2u; voffB[i] = (unsigned)(Rb * K + C) * 2u; }
    const size_t kstep = (size_t)(BK * 2);
    const size_t hstep = (size_t)HALF * K * 2;
    const size_t tstep = 2 * hstep;
    const unsigned ldsw = (unsigned)wid * 1024u;
    const int aoff = lds_byte(wr * 64 + fr, fq * 8), boff = lds_byte(wc * 32 + fr, fq * 8);
#define PG8_SA(b, h) (((b) * 2 + (h)) * HTB)
#define PG8_SB(b, h) ((4 + (b) * 2 + (h)) * HTB)
#define PG8_STAGE(bufoff, gbase, voff) do { _Pragma("unroll") for (int _i = 0; _i < 2; ++_i) \
        __builtin_amdgcn_global_load_lds((const unsigned*)((const char*)(gbase) + (voff)[_i]), (PG8_LAS unsigned*)(lds + (bufoff) + ldsw + _i * 8192), 16, 0, 0); } while (0)
#define PG8_LDA(dst, b, h) do { _Pragma("unroll") for (int m = 0; m < 4; ++m) _Pragma("unroll") for (int k = 0; k < 2; ++k) dst[m][k] = *(const PG8_LAS bf16x8*)(lds + PG8_SA(b, h) + aoff + m * 2048 + k * 1024); } while (0)
#define PG8_LDB(dst, b, h) do { _Pragma("unroll") for (int n = 0; n < 2; ++n) _Pragma("unroll") for (int k = 0; k < 2; ++k) dst[n][k] = *(const PG8_LAS bf16x8*)(lds + PG8_SB(b, h) + boff + n * 2048 + k * 1024); } while (0)
#define PG8_MMA(ai, bj, At, Bt) do { __builtin_amdgcn_s_setprio(1); _Pragma("unroll") for (int m = 0; m < 4; ++m) _Pragma("unroll") for (int n = 0; n < 2; ++n) _Pragma("unroll") for (int k = 0; k < 2; ++k) \
        acc[ai][bj][m][n] = __builtin_amdgcn_mfma_f32_16x16x32_bf16(Bt[n][k], At[m][k], acc[ai][bj][m][n], 0, 0, 0); __builtin_amdgcn_s_setprio(0); } while (0)
#define PG8_WAIT_V(n) asm volatile("s_waitcnt vmcnt(" #n ")" ::: "memory")
#define PG8_WAIT_L(n) asm volatile("s_waitcnt lgkmcnt(" #n ")" ::: "memory")
#define PG8_BAR __builtin_amdgcn_s_barrier()
#define PG8_SCHED __builtin_amdgcn_sched_barrier(0)
    Unit cur, nxt; int ui = 0;
    if (!S.next(0, cur)) return;
    f32x4 acc[2][2][4][2];
#pragma unroll
    for (int a = 0; a < 2; ++a)
#pragma unroll
        for (int b = 0; b < 2; ++b)
#pragma unroll
            for (int m = 0; m < 4; ++m)
#pragma unroll
                for (int n = 0; n < 2; ++n) acc[a][b][m][n] = (f32x4){0.f, 0.f, 0.f, 0.f};
    bf16x8 At[4][2], B0[2][2], B1[2][2];
    const char* cA = (const char*)g.A + (size_t)cur.pm * tstep; const char* cB = (const char*)g.Bt + (size_t)cur.pn * tstep;
    S.a_ready(cur);
    if constexpr (SP2) {
        PG8_STAGE(PG8_SB(0, 0), cB, voffB); PG8_STAGE(PG8_SB(0, 1), cB + hstep, voffB); PG8_STAGE(PG8_SA(0, 0), cA, voffA); PG8_STAGE(PG8_SA(0, 1), cA + hstep, voffA);
        if (wr == 1) PG8_BAR;
        PG8_WAIT_V(2); PG8_BAR;
        PG8_STAGE(PG8_SB(1, 0), cB + kstep, voffB); PG8_STAGE(PG8_SA(1, 0), cA + kstep, voffA); PG8_STAGE(PG8_SB(1, 1), cB + hstep + kstep, voffB);
        PG8_WAIT_V(6); PG8_BAR;
    } else {
        PG8_STAGE(PG8_SB(0, 0), cB, voffB); PG8_STAGE(PG8_SA(0, 0), cA, voffA); PG8_STAGE(PG8_SB(0, 1), cB + hstep, voffB); PG8_STAGE(PG8_SA(0, 1), cA + hstep, voffA);
        if (wr == 1) PG8_BAR;
        PG8_WAIT_V(4); PG8_BAR;
        PG8_STAGE(PG8_SB(1, 0), cB + kstep, voffB); PG8_STAGE(PG8_SA(1, 0), cA + kstep, voffA); PG8_STAGE(PG8_SB(1, 1), cB + hstep + kstep, voffB);
        PG8_WAIT_V(6); PG8_BAR;
    }
    for (;;) {
        const bool has_next = S.next(ui + 1, nxt);
        const char* nA = has_next ? (const char*)g.A + (size_t)nxt.pm * tstep : cA; const char* nB = has_next ? (const char*)g.Bt + (size_t)nxt.pn * tstep : cB;
        for (int t = 0; t < nt; t += 2) {
            const bool last = (t == nt - 2);
            const char* a1 = cA + (size_t)(t + 1) * kstep;
            const char* a2 = last ? nA : cA + (size_t)(t + 2) * kstep; const char* b2 = last ? nB : cB + (size_t)(t + 2) * kstep;
            const char* a3 = a2 + kstep; const char* b3 = b2 + kstep;
            if (last && has_next) S.a_ready(nxt);
            if constexpr (SP2) {
            PG8_LDB(B0, 0, 0); PG8_LDB(B1, 0, 1); PG8_SCHED; PG8_LDA(At, 0, 0); PG8_STAGE(PG8_SA(1, 1), a1 + hstep, voffA);
            PG8_WAIT_V(8); PG8_WAIT_L(0); PG8_BAR; PG8_MMA(0, 0, At, B0); PG8_MMA(0, 1, At, B1); PG8_BAR; PG8_SCHED;
            PG8_LDA(At, 0, 1); PG8_STAGE(PG8_SB(0, 0), b2, voffB); PG8_STAGE(PG8_SB(0, 1), b2 + hstep, voffB); PG8_STAGE(PG8_SA(0, 0), a2, voffA);
            PG8_WAIT_V(8); PG8_WAIT_L(0); PG8_BAR; PG8_MMA(1, 0, At, B0); PG8_MMA(1, 1, At, B1); PG8_BAR; PG8_SCHED;
            PG8_LDB(B0, 1, 0); PG8_LDB(B1, 1, 1); PG8_SCHED; PG8_LDA(At, 1, 0); PG8_STAGE(PG8_SA(0, 1), a2 + hstep, voffA);
            PG8_WAIT_V(8); PG8_WAIT_L(0); PG8_BAR; PG8_MMA(0, 0, At, B0); PG8_MMA(0, 1, At, B1); PG8_BAR; PG8_SCHED;
            PG8_LDA(At, 1, 1); PG8_STAGE(PG8_SB(1, 0), b3, voffB); PG8_STAGE(PG8_SB(1, 1), b3 + hstep, voffB); PG8_STAGE(PG8_SA(1, 0), a3, voffA);
            PG8_WAIT_V(8); PG8_WAIT_L(0); PG8_BAR; PG8_MMA(1, 0, At, B0); PG8_MMA(1, 1, At, B1); PG8_BAR; PG8_SCHED;
            } else {
            PG8_LDB(B0, 0, 0); PG8_SCHED; PG8_LDA(At, 0, 0); PG8_STAGE(PG8_SA(1, 1), a1 + hstep, voffA);
            PG8_WAIT_L(8); PG8_BAR; PG8_WAIT_L(0); PG8_MMA(0, 0, At, B0); PG8_BAR; PG8_SCHED;
            PG8_LDB(B1, 0, 1); PG8_STAGE(PG8_SB(0, 0), b2, voffB);
            PG8_BAR; PG8_WAIT_L(0); PG8_MMA(0, 1, At, B1); PG8_BAR;
            PG8_LDA(At, 0, 1); PG8_STAGE(PG8_SA(0, 0), a2, voffA);
            PG8_BAR; PG8_WAIT_L(0); PG8_MMA(1, 0, At, B0); PG8_BAR; PG8_SCHED;
            PG8_STAGE(PG8_SB(0, 1), b2 + hstep, voffB);
            PG8_WAIT_V(6); PG8_BAR; PG8_MMA(1, 1, At, B1); PG8_BAR;
            PG8_LDB(B0, 1, 0); PG8_SCHED; PG8_LDA(At, 1, 0); PG8_STAGE(PG8_SA(0, 1), a2 + hstep, voffA);
            PG8_WAIT_L(8); PG8_BAR; PG8_WAIT_L(0); PG8_MMA(0, 0, At, B0); PG8_BAR; PG8_SCHED;
            PG8_LDB(B1, 1, 1); PG8_STAGE(PG8_SB(1, 0), b3, voffB);
            PG8_BAR; PG8_WAIT_L(0); PG8_MMA(0, 1, At, B1); PG8_BAR;
            PG8_LDA(At, 1, 1); PG8_STAGE(PG8_SA(1, 0), a3, voffA);
            PG8_BAR; PG8_WAIT_L(0); PG8_MMA(1, 0, At, B0); PG8_BAR; PG8_SCHED;
            PG8_STAGE(PG8_SB(1, 1), b3 + hstep, voffB);
            PG8_WAIT_V(6); PG8_BAR; PG8_MMA(1, 1, At, B1); PG8_BAR;
            }
        }
        if constexpr (ALIGN_EPI) { if (wr == 0) PG8_BAR; }
        if constexpr (!Epi::AFTER_DRAIN) { E(acc, cur, wr, wc, fr, fq); S.done(cur); }
        if (!has_next) break;
#pragma unroll
        for (int a = 0; a < 2; ++a)
#pragma unroll
            for (int b = 0; b < 2; ++b)
#pragma unroll
                for (int m = 0; m < 4; ++m)
#pragma unroll
                    for (int n = 0; n < 2; ++n) acc[a][b][m][n] = (f32x4){0.f, 0.f, 0.f, 0.f};
        cur = nxt; cA = nA; cB = nB; ++ui;
        if constexpr (ALIGN_EPI) { if (wr == 1) PG8_BAR; }
    }
    PG8_WAIT_V(0);
    if constexpr (!ALIGN_EPI) { if (wr == 0) PG8_BAR; }
    PG8_BAR;
    if constexpr (Epi::AFTER_DRAIN) { E.fused(acc, cur, wr, wc, fr, fq, lds, wid, lane); S.done(cur); }
#undef PG8_SA
#undef PG8_SB
#undef PG8_STAGE
#undef PG8_LDA
#undef PG8_LDB
#undef PG8_MMA
#undef PG8_WAIT_V
#undef PG8_WAIT_L
#undef PG8_BAR
#undef PG8_SCHED
}
}
constexpr int NWAVES = 8;
constexpr int D = 1024, FF = 2816, NIN = 2944, NINP = 3072, NLAYER = 2;
constexpr int NB = 8, SEQ = 2048, NMETA = 16, TT = SEQ + NMETA;
constexpr int MX = NB * SEQ, MREAL = NB * TT, MP = 16640;
constexpr float RMS_EPS = 1e-6f, LNX_EPS = 64e-5f;
constexpr int PC_LRUX = 0, PC_LRUG = 256, PC_SCB = 512, PC_SCC = 768, PC_SCX = 1024, PC_R = 1280, PC_K = 1792, PC_V = 2304, PC_LO = 2816;

constexpr size_t MiB = 1u << 20;
constexpr size_t WS_CTL = 0, CTL_ZERO_BYTES = 1 * MiB;
constexpr size_t WS_HMETA = 1 * MiB;
constexpr size_t WS_AGG = 2 * MiB;
constexpr size_t WS_WB = 3 * MiB;
constexpr size_t WB_W1IN = 0, WB_W1OUT = 11 * MiB, WB_W2IN = WB_W1OUT + 5632 * 1024, WB_W2OUT = WB_W2IN + 11 * MiB, WB_WIN = WB_W2OUT + 5632 * 1024, WB_WOUT = WB_WIN + 6 * MiB, WB_END = WB_WOUT + 2 * MiB;
static_assert(WB_END == 41 * MiB, "weight map");
constexpr size_t WS_XN = 44 * MiB;
constexpr size_t WS_OV = 77 * MiB;
constexpr size_t OV_HID = 0, OV_RAWF = 90 * MiB;
constexpr size_t OV_P = 0, OV_WDEC = OV_P + (size_t)MP * NINP * 2, OV_ABUF = OV_WDEC + (size_t)MP * 512 * 4, OV_HL = OV_ABUF + (size_t)MP * 512 * 2, OV_CA = OV_HL + (size_t)MP * 256 * 4, OV_MIXEND = OV_CA + (size_t)MP * 256 * 4;
constexpr size_t OV_RAWM = 0;
constexpr size_t WS_END = 256 * MiB;
static_assert(WS_XN + (size_t)MP * D * 2 <= WS_OV && WS_OV + OV_MIXEND <= WS_END && WS_OV + OV_RAWF + (size_t)MP * D * 4 <= WS_END && (size_t)MP * FF * 2 <= OV_RAWF && (size_t)MP * 512 * 2 <= WB_W2IN, "d_ws map");
constexpr int CW_BAR = 4096;

constexpr int RING_BYTES = 131072, LDSCTL_OFF = RING_BYTES, MISC_OFF = LDSCTL_OFF + 320, LDS_BYTES = 147456;

#define GAS __attribute__((address_space(1)))
#define LAS __attribute__((address_space(3)))
typedef unsigned short bf16;
typedef unsigned v4u __attribute__((ext_vector_type(4)));
typedef float f32x4 __attribute__((ext_vector_type(4)));
typedef GAS unsigned gu32;
#define LDS_WAIT() asm volatile("s_waitcnt lgkmcnt(0)" ::: "memory")
__device__ __forceinline__ unsigned f2bf(float f) { unsigned u = __builtin_bit_cast(unsigned, f); return (u + 0x7fffu + ((u >> 16) & 1u)) >> 16; }
__device__ __forceinline__ unsigned pk2(float lo, float hi) { return f2bf(lo) | (f2bf(hi) << 16); }
__device__ __forceinline__ float bf2f(unsigned b) { return __builtin_bit_cast(float, b << 16); }
__device__ __forceinline__ float wave_sum(float v) {
#pragma unroll
    for (int o = 1; o < 64; o <<= 1) v += __shfl_xor(v, o);
    return v;
}
__device__ __forceinline__ float sigmoidf_(float x) { return 1.0f / (1.0f + __expf(-x)); }
__device__ __forceinline__ float softplusf_(float x) { return fmaxf(x, 0.f) + log1pf(__expf(-fabsf(x))); }
__device__ __forceinline__ float gelu_tanh(float x) { const float u = 0.7978845608028654f * (x + 0.044715f * x * x * x); return 0.5f * x * (1.0f + tanhf(u)); }
__device__ __forceinline__ int row_of(int b, int s) { return s < NMETA ? (MX + b * NMETA + s) : (b * SEQ + s - NMETA); }
#define XB_TMO      128
#define XB_XCNT(j)  (256  + 64 * (j))
#define XB_XSUB(j)  (1280 + 64 * (j))
#define XB_XGEN(j)  (2304 + 64 * (j))
#define XB_TOP      3328
#define XB_TOPGEN   3392
#define XCD_BAR_WORDS 3456
#define XB_SPIN_CAP (1u << 18)

__device__ __forceinline__ unsigned xb_ld(unsigned* p)              { return __hip_atomic_load(p, __ATOMIC_RELAXED, __HIP_MEMORY_SCOPE_AGENT); }
__device__ __forceinline__ unsigned xb_add(unsigned* p, unsigned v) { return __hip_atomic_fetch_add(p, v, __ATOMIC_RELAXED, __HIP_MEMORY_SCOPE_AGENT); }
__device__ __forceinline__ unsigned xb_xcc_id() { return (unsigned)__builtin_amdgcn_s_getreg((3 << 11) | 20) & 0xFu; }
#define XB_SPIN(cond, bar) do { unsigned _sp = 0; while (cond) { __builtin_amdgcn_s_sleep(1); \
    if ((++_sp & 255u) == 0u) { if (xb_ld(&(bar)[XB_TMO])) break; if (_sp > XB_SPIN_CAP) { atomicAdd(&(bar)[XB_TMO], 1u); break; } } } } while (0)

struct XcdBarrier {
    unsigned* bar; unsigned x;
    volatile LAS unsigned* st;
};

__device__ __forceinline__ XcdBarrier xcd_barrier_post(unsigned* bar, volatile LAS unsigned* st) {
    XcdBarrier b; b.bar = bar; b.x = xb_xcc_id(); b.st = st;
    if (threadIdx.x == 0) (void)xb_add(&bar[XB_XCNT(b.x)], 1u);
    return b;
}
__device__ __forceinline__ void xcd_barrier_complete(unsigned* bar, unsigned x, unsigned& nloc, unsigned& nx) {
    const unsigned G = gridDim.x * gridDim.y * gridDim.z;
    unsigned sum, cnt, mine, sp = 0u;
    for (;;) {
        sum = 0u; cnt = 0u; mine = 0u;
#pragma unroll
        for (unsigned j = 0; j < 16; ++j) { const unsigned c = xb_ld(&bar[XB_XCNT(j)]); sum += c; cnt += (c > 0u) ? 1u : 0u; mine = (j == x) ? c : mine; }
        if (sum == G) break;
        __builtin_amdgcn_s_sleep(1);
        if ((++sp & 255u) == 0u) { if (xb_ld(&bar[XB_TMO])) break; if (sp > XB_SPIN_CAP) { atomicAdd(&bar[XB_TMO], 1u); break; } }
    }
    nloc = mine > 0u ? mine : 1u; nx = cnt > 0u ? cnt : 1u;
}

__device__ __forceinline__ void xcd_barrier(const XcdBarrier& b) {
    asm volatile("s_waitcnt vmcnt(0)" ::: "memory");
    __syncthreads();
    if (threadIdx.x == 0) {
        unsigned* bar = b.bar;
        __builtin_amdgcn_s_waitcnt(0);
        unsigned nloc = b.st[0], nx = b.st[1];
        if (nloc == 0u) { xcd_barrier_complete(bar, b.x, nloc, nx); b.st[0] = nloc; b.st[1] = nx; }
        const unsigned old = xb_add(&bar[XB_XSUB(b.x)], 1u);
        const unsigned gen = old / nloc;
        if (old + 1u == (gen + 1u) * nloc) {
            __builtin_amdgcn_fence(__ATOMIC_RELEASE, "agent");
            asm volatile("s_waitcnt vmcnt(0)" ::: "memory");
            const unsigned og = xb_add(&bar[XB_TOP], 1u);
            const unsigned tg = og / nx;
            if (og + 1u == (tg + 1u) * nx) xb_add(&bar[XB_TOPGEN], 1u);
            else XB_SPIN(xb_ld(&bar[XB_TOPGEN]) == tg, bar);
            __builtin_amdgcn_fence(__ATOMIC_ACQUIRE, "agent");
            xb_add(&bar[XB_XGEN(b.x)], 1u);
            asm volatile("s_waitcnt vmcnt(0)" ::: "memory");
        } else {
            XB_SPIN(xb_ld(&bar[XB_XGEN(b.x)]) == gen, bar);
            __builtin_amdgcn_fence(__ATOMIC_ACQUIRE, "agent");
            asm volatile("s_waitcnt vmcnt(0)" ::: "memory");
        }
    }
    __syncthreads();
}
struct Frame {
    LAS unsigned char* lds;
    int tid, lane, wave, vcu, G;
    unsigned char* ws;
    const float* x; const float* meta; float* out;
};

constexpr int PK_CONVW = 0, PK_CONVB = 1024, PK_WA = 1280, PK_BA = 17664, PK_WX = 17920, PK_BX = 34304, PK_LAM = 34560, PK_LNG = 34816, PK_SCW = 35072, PK_SCG = 35840, PK_MU = 36096, PK_W0 = 37760,
              PK_W2 = 38272, PK_A0 = 54656, PK_A2 = 55168, PK_G2 = 71552, PK_KK = 104320, PK_KA = 104832, PK_RK = 105344, PK_LNW = 105856, PK_LNB = 106368, PK_SIZE = 106880;
constexpr size_t WS_PACK = 64 * 1024;
static_assert(WS_PACK + (size_t)NLAYER * PK_SIZE * 4 <= CTL_ZERO_BYTES && (CW_BAR + 3456) * 4 <= (int)WS_PACK, "pack inside CTL, above the barrier words");
__device__ __forceinline__ const float* pack_of(const Frame& F, int l) { return (const float*)(F.ws + WS_PACK) + (size_t)l * PK_SIZE; }
__device__ __forceinline__ void pack_copy(Frame& F, const float* src, int per_layer, int off) {
    const int gt = F.vcu * (NWAVES * 64) + F.tid, NT = F.G * NWAVES * 64;
    for (int i = gt; i < NLAYER * per_layer; i += NT) { const int l = i / per_layer, j = i - l * per_layer; ((float*)(F.ws + WS_PACK))[(size_t)l * PK_SIZE + off + j] = src[i]; }
}
__device__ __forceinline__ void phase_pack(Frame& F, const float* const* in) {
    pack_copy(F, in[9], 1024, PK_CONVW); pack_copy(F, in[10], 256, PK_CONVB); pack_copy(F, in[11], 16384, PK_WA); pack_copy(F, in[12], 256, PK_BA); pack_copy(F, in[13], 16384, PK_WX); pack_copy(F, in[14], 256, PK_BX);
    pack_copy(F, in[15], 256, PK_LAM); pack_copy(F, in[16], 256, PK_LNG); pack_copy(F, in[17], 768, PK_SCW); pack_copy(F, in[18], 256, PK_SCG); pack_copy(F, in[19], 1664, PK_MU); pack_copy(F, in[20], 512, PK_W0);
    pack_copy(F, in[21], 16384, PK_W2); pack_copy(F, in[22], 512, PK_A0); pack_copy(F, in[23], 16384, PK_A2); pack_copy(F, in[24], 32768, PK_G2); pack_copy(F, in[25], 512, PK_KK); pack_copy(F, in[26], 512, PK_KA);
    pack_copy(F, in[27], 512, PK_RK); pack_copy(F, in[28], 512, PK_LNW); pack_copy(F, in[29], 512, PK_LNB);
}

__device__ __forceinline__ void transpose_item(const float* W, int K, int N, bf16* WT, int k0, int n0, int drow0, LAS float* scr, int lane) {
#pragma unroll 8
    for (int i = 0; i < 32; ++i) { const int kk = 2 * i + (lane >> 5); scr[kk * 33 + (lane & 31)] = W[(size_t)(k0 + kk) * N + n0 + (lane & 31)]; }
    LDS_WAIT(); asm volatile("" ::: "memory");
    const int c = lane & 7;
#pragma unroll
    for (int j = 0; j < 4; ++j) { const int n = (lane >> 3) + 8 * j; const LAS float* s = scr + (8 * c) * 33 + n;
        v4u o; o.x = pk2(s[0 * 33], s[1 * 33]); o.y = pk2(s[2 * 33], s[3 * 33]); o.z = pk2(s[4 * 33], s[5 * 33]); o.w = pk2(s[6 * 33], s[7 * 33]);
        *(GAS v4u*)(WT + (size_t)(drow0 + n) * K + k0 + 8 * c) = o; }
    LDS_WAIT(); asm volatile("" ::: "memory");
}
__device__ __forceinline__ int swiglu_row(int n0) { return n0 < FF ? ((n0 >> 7) * 256 + (n0 & 127)) : (((n0 - FF) >> 7) * 256 + 128 + ((n0 - FF) & 127)); }
__device__ __forceinline__ void phase_convert(Frame& F, const float* const* in, int l) {
    const float* ffn1_in = in[3] + (size_t)l * D * 2 * FF; const float* ffn1_out = in[4] + (size_t)l * FF * D; const float* ffn2_in = in[5] + (size_t)l * D * 2 * FF; const float* ffn2_out = in[6] + (size_t)l * FF * D;
    const float* mix_in = in[7] + (size_t)l * D * NIN; const float* mix_out = in[8] + (size_t)l * D * D;
    LAS float* scr = (LAS float*)(F.lds + F.wave * 16384);
    const int gw = F.vcu * NWAVES + F.wave, NGW = F.G * NWAVES;
    constexpr int I_IN = (D / 64) * (2 * FF / 32), I_OUT = (FF / 64) * (D / 32), I_MI = (D / 64) * (NIN / 32), I_MO = (D / 64) * (D / 32);
    constexpr int NITEMS = 2 * I_IN + 2 * I_OUT + I_MI + I_MO;
    for (int it = gw; it < NITEMS; it += NGW) {
        int r = it;
        if (r < 2 * I_IN) { const bool second = r >= I_IN; if (second) r -= I_IN; const int nblk = 2 * FF / 32, kb = r / nblk, nb = r % nblk;
            transpose_item(second ? ffn2_in : ffn1_in, D, 2 * FF, second ? ((bf16*)(F.ws + WS_WB + WB_W2IN)) : ((bf16*)(F.ws + WS_WB + WB_W1IN)), 64 * kb, 32 * nb, swiglu_row(32 * nb), scr, F.lane); continue; }
        r -= 2 * I_IN;
        if (r < 2 * I_OUT) { const bool second = r >= I_OUT; if (second) r -= I_OUT; const int nblk = D / 32, kb = r / nblk, nb = r % nblk;
            transpose_item(second ? ffn2_out : ffn1_out, FF, D, second ? ((bf16*)(F.ws + WS_WB + WB_W2OUT)) : ((bf16*)(F.ws + WS_WB + WB_W1OUT)), 64 * kb, 32 * nb, 32 * nb, scr, F.lane); continue; }
        r -= 2 * I_OUT;
        if (r < I_MI) { const int nblk = NIN / 32, kb = r / nblk, nb = r % nblk; transpose_item(mix_in, D, NIN, ((bf16*)(F.ws + WS_WB + WB_WIN)), 64 * kb, 32 * nb, 32 * nb, scr, F.lane); continue; }
        r -= I_MI;
        { const int nblk = D / 32, kb = r / nblk, nb = r % nblk; transpose_item(mix_out, D, D, ((bf16*)(F.ws + WS_WB + WB_WOUT)), 64 * kb, 32 * nb, 32 * nb, scr, F.lane); }
    }
    for (int i = gw * 64 + F.lane; i < (NINP - NIN) * D / 8; i += NGW * 64) *(GAS v4u*)(((bf16*)(F.ws + WS_WB + WB_WIN)) + (size_t)NIN * D + (size_t)i * 8) = (v4u){0u, 0u, 0u, 0u};
}

__device__ __forceinline__ const float* hrow_c(const Frame& F, const float* xrows, int r) { return r < MX ? xrows + (size_t)r * D : ((float*)(F.ws + WS_HMETA)) + (size_t)(r - MX) * D; }
__device__ __forceinline__ void store_xn_row(bf16* XN, int r, int lane, const f32x4 (&v)[4], float rstd, const float* g) {
    GAS unsigned long long* o8 = (GAS unsigned long long*)(XN + (size_t)r * D) + lane;
#pragma unroll
    for (int j = 0; j < 4; ++j) { const f32x4 gv = ((const GAS f32x4*)g)[lane + 64 * j];
        o8[64 * j] = (unsigned long long)pk2(v[j].x * rstd * gv.x, v[j].y * rstd * gv.y) | ((unsigned long long)pk2(v[j].z * rstd * gv.z, v[j].w * rstd * gv.w) << 32); }
}
__device__ __forceinline__ float sumsq4(const f32x4 (&v)[4]) { float s = 0.f;
#pragma unroll
    for (int j = 0; j < 4; ++j) s += (v[j].x * v[j].x + v[j].y * v[j].y) + (v[j].z * v[j].z + v[j].w * v[j].w);
    return s; }
__device__ __forceinline__ void phase_init(Frame& F, const float* g_pre) {
    const int gw = F.vcu * NWAVES + F.wave, NGW = F.G * NWAVES;
    for (int r = gw; r < MP; r += NGW) {
        if (r >= MREAL) { GAS unsigned long long* o8 = (GAS unsigned long long*)(((bf16*)(F.ws + WS_XN)) + (size_t)r * D) + F.lane;
#pragma unroll
            for (int j = 0; j < 4; ++j) o8[64 * j] = 0ull;
            continue; }
        const float* src = r < MX ? F.x + (size_t)r * D : F.meta + (size_t)((r - MX) & (NMETA - 1)) * D;
        f32x4 v[4];
#pragma unroll
        for (int j = 0; j < 4; ++j) v[j] = ((const GAS f32x4*)src)[F.lane + 64 * j];
        if (r >= MX) { GAS f32x4* hm = (GAS f32x4*)(((float*)(F.ws + WS_HMETA)) + (size_t)(r - MX) * D);
#pragma unroll
            for (int j = 0; j < 4; ++j) hm[F.lane + 64 * j] = v[j]; }
        const float rstd = rsqrtf(wave_sum(sumsq4(v)) * (1.0f / D) + RMS_EPS);
        store_xn_row(((bf16*)(F.ws + WS_XN)), r, F.lane, v, rstd, g_pre);
    }
}
__device__ __forceinline__ void phase_post(Frame& F, const float* raw, const float* base_x, float scale, const float* g_post, const float* g_pre) {
    const int gw = F.vcu * NWAVES + F.wave, NGW = F.G * NWAVES;
    for (int r = gw; r < MREAL; r += NGW) {
        f32x4 y[4], hb[4];
        const float* bp = hrow_c(F, base_x, r);
#pragma unroll
        for (int j = 0; j < 4; ++j) { y[j] = ((const GAS f32x4*)(raw + (size_t)r * D))[F.lane + 64 * j]; hb[j] = ((const GAS f32x4*)bp)[F.lane + 64 * j]; }
        const float rs = scale * rsqrtf(wave_sum(sumsq4(y)) * (1.0f / D) + RMS_EPS);
        float* dst = r < MX ? F.out + (size_t)r * D : ((float*)(F.ws + WS_HMETA)) + (size_t)(r - MX) * D;
#pragma unroll
        for (int j = 0; j < 4; ++j) { const f32x4 gv = ((const GAS f32x4*)g_post)[F.lane + 64 * j]; hb[j] = hb[j] + y[j] * rs * gv; ((GAS f32x4*)dst)[F.lane + 64 * j] = hb[j]; }
        if (g_pre) { const float rstd = rsqrtf(wave_sum(sumsq4(hb)) * (1.0f / D) + RMS_EPS); store_xn_row(((bf16*)(F.ws + WS_XN)), r, F.lane, hb, rstd, g_pre); }
    }
}
__device__ __forceinline__ void phase_mix_prep(Frame& F, const float* pk) {
    LAS float* U = (LAS float*)F.lds;
    LAS float* ZL = U + 16 * 256;
    LAS float* GT = ZL + 16 * 128;
    const int tid = F.tid;
    const bf16* P = ((bf16*)(F.ws + WS_OV + OV_P)); bf16* Y = ((bf16*)(F.ws + WS_XN));
    for (int tile = blockIdx.x; tile < 256; tile += gridDim.x) {
        const int b = tile >> 5, c = tile & 31;
        const int s_begin = c == 0 ? 0 : NMETA + 64 * c, nsub = c == 0 ? 5 : 4;
        float hloc = 0.f, caloc = 1.f;
        const float spl = tid < 256 ? softplusf_(-pk[PK_LAM + tid]) : 0.f;
        for (int sub = 0; sub < nsub; ++sub) {
            const int s0 = s_begin + 16 * sub;
            for (int idx = tid; idx < 16 * 256; idx += NWAVES * 64) { const int t = idx >> 8, ch = idx & 255, s = s0 + t;
                float u = pk[PK_CONVB + ch];
#pragma unroll
                for (int k = 0; k < 4; ++k) { const int sp = s - 3 + k; if (sp >= 0) u += bf2f(P[(size_t)row_of(b, sp) * NINP + PC_LRUX + ch]) * pk[PK_CONVW + k * 256 + ch]; }
                U[idx] = u; }
            for (int idx = tid; idx < 16 * 128; idx += NWAVES * 64) { const int t = idx >> 7, i = idx & 127, s = s0 + t;
                const float cur = bf2f(P[(size_t)row_of(b, s) * NINP + PC_LO + i]); const float prev = s > 0 ? bf2f(P[(size_t)row_of(b, s - 1) * NINP + PC_LO + i]) : 0.f;
                const float z = cur + (prev - cur) * pk[PK_MU + 1536 + i];
                ZL[idx] = i < 32 ? tanhf(z) : (i < 64 ? z : sigmoidf_(z)); }
            __syncthreads();
            { const int j = tid & 255, gt = tid >> 8, g = j >> 6, jp = j & 63; const float* W = pk + (gt ? PK_WX : PK_WA) + g * 4096 + jp;
                float acc[16];
#pragma unroll
                for (int t = 0; t < 16; ++t) acc[t] = 0.f;
                for (int i4 = 0; i4 < 16; ++i4) { const float w0 = W[(4 * i4 + 0) * 64], w1 = W[(4 * i4 + 1) * 64], w2 = W[(4 * i4 + 2) * 64], w3 = W[(4 * i4 + 3) * 64];
#pragma unroll
                    for (int t = 0; t < 16; ++t) { const f32x4 u4 = *(const LAS f32x4*)(U + t * 256 + g * 64 + 4 * i4); acc[t] += (u4.x * w0 + u4.y * w1) + (u4.z * w2 + u4.w * w3); } }
                const float bias = pk[(gt ? PK_BX : PK_BA) + j];
#pragma unroll
                for (int t = 0; t < 16; ++t) GT[(gt * 16 + t) * 256 + j] = sigmoidf_(acc[t] + bias); }
            { const int n = tid; float aw[16], aa[16], ag[16];
#pragma unroll
                for (int t = 0; t < 16; ++t) { aw[t] = 0.f; aa[t] = 0.f; ag[t] = 0.f; }
                for (int i4 = 0; i4 < 8; ++i4) { float wv[4], av[4];
#pragma unroll
                    for (int q = 0; q < 4; ++q) { wv[q] = pk[PK_W2 + (4 * i4 + q) * 512 + n]; av[q] = pk[PK_A2 + (4 * i4 + q) * 512 + n]; }
#pragma unroll
                    for (int t = 0; t < 16; ++t) { const f32x4 zw = *(const LAS f32x4*)(ZL + t * 128 + 4 * i4), za = *(const LAS f32x4*)(ZL + t * 128 + 32 + 4 * i4);
                        aw[t] += (zw.x * wv[0] + zw.y * wv[1]) + (zw.z * wv[2] + zw.w * wv[3]); aa[t] += (za.x * av[0] + za.y * av[1]) + (za.z * av[2] + za.w * av[3]); } }
                for (int i4 = 0; i4 < 16; ++i4) { float gv[4];
#pragma unroll
                    for (int q = 0; q < 4; ++q) gv[q] = pk[PK_G2 + (4 * i4 + q) * 512 + n];
#pragma unroll
                    for (int t = 0; t < 16; ++t) { const f32x4 zg = *(const LAS f32x4*)(ZL + t * 128 + 64 + 4 * i4); ag[t] += (zg.x * gv[0] + zg.y * gv[1]) + (zg.z * gv[2] + zg.w * gv[3]); } }
                const float w0n = pk[PK_W0 + n], a0n = pk[PK_A0 + n];
#pragma unroll
                for (int t = 0; t < 16; ++t) { const size_t ro = (size_t)row_of(b, s0 + t) * 512 + n;
                    const float wl = -softplusf_(-(w0n + aw[t])) - 0.5f;
                    ((float*)(F.ws + WS_OV + OV_WDEC))[ro] = __expf(-__expf(wl)); ((bf16*)(F.ws + WS_OV + OV_ABUF))[ro] = (bf16)f2bf(sigmoidf_(a0n + aa[t])); ((bf16*)(F.ws + WS_WB))[ro] = (bf16)f2bf(ag[t]); } }
            { float yv[8];
#pragma unroll
                for (int it = 0; it < 8; ++it) { const int idx = it * (NWAVES * 64) + tid, t = idx >> 8, ch = idx & 255, s = s0 + t; const size_t ro = (size_t)row_of(b, s);
                    float conv = 0.f;
#pragma unroll
                    for (int k = 0; k < 3; ++k) { const int sp = s - 2 + k; if (sp >= 0) { const size_t rr = (size_t)row_of(b, sp) * NINP; conv += bf2f(P[rr + PC_SCC + ch]) * bf2f(P[rr + PC_SCX + ch]) * pk[PK_SCW + k * 256 + ch]; } }
                    yv[it] = bf2f(P[ro * NINP + PC_SCB + ch]) * conv; }
#pragma unroll
                for (int it = 0; it < 8; ++it) { const int idx = it * (NWAVES * 64) + tid, t = idx >> 8, ch = idx & 255, s = s0 + t; const size_t ro = (size_t)row_of(b, s);
                    const float ss = wave_sum(yv[it] * yv[it]);
                    Y[ro * D + 256 + ch] = (bf16)f2bf(yv[it] * rsqrtf(ss * (1.0f / 64.0f) + RMS_EPS) * pk[PK_SCG + ch]); } }
            __syncthreads();
            if (tid < 256) { const int j = tid;
#pragma unroll 4
                for (int t = 0; t < 16; ++t) { const float r = GT[t * 256 + j], ig = GT[(16 + t) * 256 + j], u = U[t * 256 + j];
                    const float la = -8.0f * r * spl, a = __expf(la), bt = sqrtf(-expm1f(2.0f * la)) * (ig * u);
                    hloc = a * hloc + bt; caloc *= a;
                    const size_t ro = (size_t)row_of(b, s0 + t) * 256 + j; ((float*)(F.ws + WS_OV + OV_HL))[ro] = hloc; ((float*)(F.ws + WS_OV + OV_CA))[ro] = caloc; } }
            __syncthreads();
        }
        if (tid < 256) { ((float*)(F.ws + WS_AGG))[((size_t)(b * 32 + c) * 256 + tid) * 2 + 0] = caloc; ((float*)(F.ws + WS_AGG))[((size_t)(b * 32 + c) * 256 + tid) * 2 + 1] = hloc; }
    }
}

constexpr int SC_CH = 24, SC_NCH = TT / SC_CH, SC_STEPF = 336, SC_BUFF = SC_CH * SC_STEPF;
static_assert(SC_NCH * SC_CH == TT && 2 * SC_BUFF * 4 <= RING_BYTES, "scan geometry");
struct ScanRegs { unsigned rr[7], kk[7], aa[6]; float ww[6]; unsigned vc[2], vp[2]; };
template <int CTRL> __device__ __forceinline__ float dppf(float x) { return __builtin_bit_cast(float, __builtin_amdgcn_mov_dpp(__builtin_bit_cast(int, x), CTRL, 0xf, 0xf, true)); }
__device__ __forceinline__ float red16(float x) { x += dppf<0xB1>(x); x += dppf<0x4E>(x); x += dppf<0x141>(x); x += dppf<0x128>(x); return x; }
__device__ __forceinline__ void scan_load(const Frame& F, ScanRegs& R, int b, int h, int q, int lw, int chunk, int lane) {
    const int t0 = chunk * SC_CH + 6 * lw;
    const bf16* P = ((bf16*)(F.ws + WS_OV + OV_P));
#pragma unroll
    for (int m = 0; m < 7; ++m) { const int s = t0 - 1 + m;
        if (s >= 0) { const size_t ro = (size_t)row_of(b, s) * NINP + h * 64 + lane; R.rr[m] = P[ro + PC_R]; R.kk[m] = P[ro + PC_K]; } else { R.rr[m] = 0u; R.kk[m] = 0u; } }
#pragma unroll
    for (int i = 0; i < 6; ++i) { const size_t ro = (size_t)row_of(b, t0 + i) * 512 + h * 64 + lane; R.aa[i] = ((bf16*)(F.ws + WS_OV + OV_ABUF))[ro]; R.ww[i] = ((float*)(F.ws + WS_OV + OV_WDEC))[ro]; }
#pragma unroll
    for (int j = 0; j < 2; ++j) { const int idx = lane + 64 * j, st = idx >> 4, rw = idx & 15; R.vc[j] = 0u; R.vp[j] = 0u;
        if (st < 6) { const int s = t0 + st; const int col = PC_V + h * 64 + 16 * q + rw; R.vc[j] = P[(size_t)row_of(b, s) * NINP + col]; if (s > 0) R.vp[j] = P[(size_t)row_of(b, s - 1) * NINP + col]; } }
}
__device__ __forceinline__ void scan_emit(const ScanRegs& R, LAS float* buf, int lw, int lane, float mu_r, float mu_k, float kk_n, float ka_n, float mu_v0, float mu_v1) {
#pragma unroll
    for (int i = 0; i < 6; ++i) { LAS float* sp = buf + (6 * lw + i) * SC_STEPF;
        const float rc = bf2f(R.rr[i + 1]), rp = bf2f(R.rr[i]), kc = bf2f(R.kk[i + 1]), kp = bf2f(R.kk[i]);
        const float zr = rc + (rp - rc) * mu_r, zk = kc + (kp - kc) * mu_k, a = bf2f(R.aa[i]);
        const float kv = zk * kk_n; const float ss = wave_sum(kv * kv); const float kn = kv * rsqrtf(fmaxf(ss, 1e-24f));
        sp[lane] = zr; sp[64 + lane] = R.ww[i]; sp[128 + lane] = zk * (1.0f + (a - 1.0f) * ka_n); sp[192 + lane] = -kn; sp[256 + lane] = kn * a; }
#pragma unroll
    for (int j = 0; j < 2; ++j) { const int idx = lane + 64 * j, st = idx >> 4, rw = idx & 15;
        if (st < 6) { const float vc = bf2f(R.vc[j]), vp = bf2f(R.vp[j]); buf[(6 * lw + st) * SC_STEPF + 320 + rw] = vc + (vp - vc) * (j ? mu_v1 : mu_v0); } }
}
__device__ __forceinline__ void phase_scan(Frame& F, const float* pk) {
    LAS float* buf0 = (LAS float*)F.lds; LAS float* buf1 = buf0 + SC_BUFF;
    const int lane = F.lane, wave = F.wave;
    bf16* Y = ((bf16*)(F.ws + WS_XN));
    for (int item = blockIdx.x; item < 256; item += gridDim.x) {
        const int b = item >> 5, h = (item >> 2) & 7, q = item & 3;
        if (wave >= 4) {
            const int lw = wave - 4, n = h * 64 + lane;
            const float mu_r = pk[PK_MU + n], mu_k = pk[PK_MU + 512 + n], kk_n = pk[PK_KK + n], ka_n = pk[PK_KA + n];
            const float mu_v0 = pk[PK_MU + 1024 + h * 64 + 16 * q + (lane & 15)], mu_v1 = mu_v0;
            ScanRegs A, B;
            scan_load(F, A, b, h, q, lw, 0, lane); B = A; scan_emit(A, buf0, lw, lane, mu_r, mu_k, kk_n, ka_n, mu_v0, mu_v1);
            scan_load(F, A, b, h, q, lw, 1, lane);
            __syncthreads();
            for (int c = 0; c < SC_NCH; ++c) {
                if (c + 2 < SC_NCH) scan_load(F, B, b, h, q, lw, c + 2, lane);
                if (c + 1 < SC_NCH) scan_emit(A, ((c + 1) & 1) ? buf1 : buf0, lw, lane, mu_r, mu_k, kk_n, ka_n, mu_v0, mu_v1);
                A = B;
                __syncthreads();
            }
        } else {
            const int kq = lane & 15, rowl = 4 * wave + (lane >> 4);
            f32x4 S = (f32x4){0.f, 0.f, 0.f, 0.f};
            const int ycol = 512 + h * 64 + 16 * q + rowl;
            __syncthreads();
            for (int c = 0; c < SC_NCH; ++c) {
                const LAS float* bp = (c & 1) ? buf1 : buf0;
#pragma unroll 4
                for (int i = 0; i < SC_CH; ++i) { const LAS float* sp = bp + i * SC_STEPF;
                    const f32x4 r4 = *(const LAS f32x4*)(sp + 4 * kq), w4 = *(const LAS f32x4*)(sp + 64 + 4 * kq), k4 = *(const LAS f32x4*)(sp + 128 + 4 * kq);
                    const f32x4 n4 = *(const LAS f32x4*)(sp + 192 + 4 * kq), b4 = *(const LAS f32x4*)(sp + 256 + 4 * kq); const float vv = sp[320 + rowl];
                    const float sa = red16((S.x * n4.x + S.y * n4.y) + (S.z * n4.z + S.w * n4.w));
                    S = (S * w4 + k4 * vv) + b4 * sa;
                    const float y = red16((S.x * r4.x + S.y * r4.y) + (S.z * r4.z + S.w * r4.w));
                    if (kq == 0) Y[(size_t)row_of(b, c * SC_CH + i) * D + ycol] = (bf16)f2bf(y); }
                __syncthreads();
            }
        }
    }
}

__device__ __forceinline__ void phase_mix_final(Frame& F, const float* pk) {
    LAS float* carry = (LAS float*)F.lds;
    const int tid = F.tid, lane = F.lane, w = F.wave;
    const bf16* P = ((bf16*)(F.ws + WS_OV + OV_P)); bf16* Y = ((bf16*)(F.ws + WS_XN));
    const int n = w * 64 + lane;
    const float mu_r = pk[PK_MU + n], mu_k = pk[PK_MU + 512 + n], mu_v = pk[PK_MU + 1024 + n], ka_n = pk[PK_KA + n], rk_n = pk[PK_RK + n], lw_n = pk[PK_LNW + n], lb_n = pk[PK_LNB + n];
    const float ng = w < 4 ? pk[PK_LNG + n] : 0.f;
    for (int tile = blockIdx.x; tile < 256; tile += gridDim.x) {
        const int b = tile >> 5, c = tile & 31;
        const int s_begin = c == 0 ? 0 : NMETA + 64 * c, ntok = c == 0 ? 80 : 64;
        if (tid < 256) { float hc = 0.f; for (int c2 = 0; c2 < c; ++c2) { const size_t o = ((size_t)(b * 32 + c2) * 256 + tid) * 2; hc = ((float*)(F.ws + WS_AGG))[o] * hc + ((float*)(F.ws + WS_AGG))[o + 1]; } carry[tid] = hc; }
        __syncthreads();
        for (int tg = 0; tg < ntok; tg += 8) {
            float rc[8], kc[8], vc[8], rp[8], kp[8], vp[8], av[8], yv[8], gv[8], hl[8], cav[8], lg[8];
#pragma unroll
            for (int u = 0; u < 8; ++u) { const int s = s_begin + tg + u; const size_t ro = (size_t)row_of(b, s); const bf16* pr = P + ro * NINP;
                rc[u] = bf2f(pr[PC_R + n]); kc[u] = bf2f(pr[PC_K + n]); vc[u] = bf2f(pr[PC_V + n]); rp[u] = 0.f; kp[u] = 0.f; vp[u] = 0.f;
                if (s > 0) { const bf16* pp = P + (size_t)row_of(b, s - 1) * NINP; rp[u] = bf2f(pp[PC_R + n]); kp[u] = bf2f(pp[PC_K + n]); vp[u] = bf2f(pp[PC_V + n]); }
                av[u] = bf2f(((bf16*)(F.ws + WS_OV + OV_ABUF))[ro * 512 + n]); yv[u] = bf2f(Y[ro * D + 512 + n]); gv[u] = bf2f(((bf16*)(F.ws + WS_WB))[ro * 512 + n]);
                hl[u] = 0.f; cav[u] = 0.f; lg[u] = 0.f;
                if (w < 4) { hl[u] = ((float*)(F.ws + WS_OV + OV_HL))[ro * 256 + n]; cav[u] = ((float*)(F.ws + WS_OV + OV_CA))[ro * 256 + n]; lg[u] = bf2f(pr[PC_LRUG + n]); } }
#pragma unroll
            for (int u = 0; u < 8; ++u) { const int s = s_begin + tg + u; const size_t ro = (size_t)row_of(b, s);
                const float zr = rc[u] + (rp[u] - rc[u]) * mu_r, zk = kc[u] + (kp[u] - kc[u]) * mu_k, zv = vc[u] + (vp[u] - vc[u]) * mu_v;
                const float kmod = zk * (1.0f + (av[u] - 1.0f) * ka_n);
                const float cb = wave_sum(zr * kmod * rk_n);
                const float mean = wave_sum(yv[u]) * (1.0f / 64.0f); const float dlt = yv[u] - mean; const float var = wave_sum(dlt * dlt) * (1.0f / 64.0f);
                const float o = (dlt * rsqrtf(var + LNX_EPS) * lw_n + lb_n + cb * zv) * gv[u];
                Y[ro * D + 512 + n] = (bf16)f2bf(o);
                if (w < 4) { const float hfin = hl[u] + cav[u] * carry[n]; const float yy = gelu_tanh(lg[u]) * hfin;
                    const float ss = wave_sum(yy * yy); Y[ro * D + n] = (bf16)f2bf(yy * rsqrtf(ss * (1.0f / 64.0f) + RMS_EPS) * ng); } }
        }
        __syncthreads();
    }
}
#ifndef MK_PER_PHASE
#define MK_PER_PHASE 0
#endif
constexpr int PH_PER_LAYER = 12, N_PHASES = 1 + NLAYER * PH_PER_LAYER;
struct Args { const float* in[30]; float* out; unsigned char* ws; int ph_lo, ph_hi; };
static_assert(sizeof(Args) == 30 * 8 + 8 + 8 + 4 + 4, "Args has no padding");

__global__ void __launch_bounds__(NWAVES * 64, 2) hybrid_fwd(Args args) {
    extern __shared__ __attribute__((aligned(16))) unsigned char lds[];
    Frame F;
    F.lds = (LAS unsigned char*)lds;
    F.tid = threadIdx.x; F.lane = F.tid & 63; F.wave = __builtin_amdgcn_readfirstlane(F.tid >> 6);
    F.G = gridDim.x; { const int bx = blockIdx.x; F.vcu = (F.G % 8 == 0) ? (bx % 8) * (F.G / 8) + bx / 8 : bx; }
    unsigned char* ws = args.ws;
    F.ws = ws; F.x = args.in[0]; F.meta = args.in[1]; F.out = args.out;
    volatile LAS unsigned* MISC = (volatile LAS unsigned*)(F.lds + MISC_OFF);
    for (int u = F.tid; u < (LDS_BYTES - LDSCTL_OFF) / 4; u += NWAVES * 64) ((LAS unsigned*)(F.lds + LDSCTL_OFF))[u] = 0u;
    __syncthreads();
    XcdBarrier bar; bar.bar = (unsigned*)(ws + WS_CTL) + CW_BAR; bar.x = 0; bar.st = nullptr;
    if (!MK_PER_PHASE) bar = xcd_barrier_post((unsigned*)(ws + WS_CTL) + CW_BAR, MISC + 8);
    const int lo = args.ph_lo, hi = args.ph_hi;
#define IN(k) (lo <= (k) && (k) < hi)
#define SEAM(k) do { if (IN(k) && IN((k) + 1)) xcd_barrier(bar); } while (0)

    if (IN(0)) { phase_init(F, args.in[2]); phase_pack(F, args.in); phase_convert(F, args.in, 0); }
    SEAM(0);
#pragma unroll 1
    for (int l = 0; l < NLAYER; ++l) {
        const int p0 = 1 + l * PH_PER_LAYER;
        { GAS unsigned char* wsg = (GAS unsigned char*)F.ws; asm volatile("" : "+s"(wsg)); F.ws = (unsigned char*)wsg; }
        { int t_ = threadIdx.x; asm volatile("" : "+v"(t_)); F.tid = t_; F.lane = t_ & 63; }
        if (IN(p0 + 0)) { pg8::Gemm g{((bf16*)(F.ws + WS_XN)), ((bf16*)(F.ws + WS_WB + WB_W1IN)), MP, 2 * FF, D}; pg8::StaticOrder S; S.init(MP, 2 * FF, F.G, (int)blockIdx.x); pg8::EpiSwiGLU E{((bf16*)(F.ws + WS_OV + OV_HID)), FF};
            pg8::gemm_phase<pg8::EpiSwiGLU, pg8::StaticOrder, true, true>(F.lds, g, S, E); }
        SEAM(p0 + 0);
        if (IN(p0 + 1)) { pg8::Gemm g{((bf16*)(F.ws + WS_OV + OV_HID)), ((bf16*)(F.ws + WS_WB + WB_W1OUT)), MP, D, FF}; pg8::StaticOrder S; S.init(MP, D, F.G, (int)blockIdx.x); pg8::EpiF32 E{((float*)(F.ws + WS_OV + OV_RAWF)), D};
            pg8::gemm_phase<pg8::EpiF32, pg8::StaticOrder, true, true>(F.lds, g, S, E); }
        SEAM(p0 + 1);
        if (IN(p0 + 2)) { const float* ng = args.in[2] + (size_t)l * 6 * D; phase_post(F, ((float*)(F.ws + WS_OV + OV_RAWF)), l == 0 ? F.x : F.out, 0.5f, ng + 1 * D, ng + 2 * D); }
        SEAM(p0 + 2);
        if (IN(p0 + 3)) { pg8::Gemm g{((bf16*)(F.ws + WS_XN)), ((bf16*)(F.ws + WS_WB + WB_WIN)), MP, NINP, D}; pg8::StaticOrder S; S.init(MP, NINP, F.G, (int)blockIdx.x); pg8::EpiStoreBf16 E{((bf16*)(F.ws + WS_OV + OV_P)), NINP};
            pg8::gemm_phase<pg8::EpiStoreBf16, pg8::StaticOrder, true, true>(F.lds, g, S, E); }
        SEAM(p0 + 3);
        if (IN(p0 + 4)) phase_mix_prep(F, pack_of(F, l));
        SEAM(p0 + 4);
        if (IN(p0 + 5)) phase_scan(F, pack_of(F, l));
        SEAM(p0 + 5);
        if (IN(p0 + 6)) phase_mix_final(F, pack_of(F, l));
        SEAM(p0 + 6);
        if (IN(p0 + 7)) { pg8::Gemm g{((bf16*)(F.ws + WS_XN)), ((bf16*)(F.ws + WS_WB + WB_WOUT)), MP, D, D}; pg8::StaticOrder S; S.init(MP, D, F.G, (int)blockIdx.x); pg8::EpiF32 E{((float*)(F.ws + WS_OV + OV_RAWM)), D};
            pg8::gemm_phase<pg8::EpiF32, pg8::StaticOrder, true, true>(F.lds, g, S, E); }
        SEAM(p0 + 7);
        if (IN(p0 + 8)) { const float* ng = args.in[2] + (size_t)l * 6 * D; phase_post(F, ((float*)(F.ws + WS_OV + OV_RAWM)), F.out, 1.0f, ng + 3 * D, ng + 4 * D); }
        SEAM(p0 + 8);
        if (IN(p0 + 9)) { pg8::Gemm g{((bf16*)(F.ws + WS_XN)), ((bf16*)(F.ws + WS_WB + WB_W2IN)), MP, 2 * FF, D}; pg8::StaticOrder S; S.init(MP, 2 * FF, F.G, (int)blockIdx.x); pg8::EpiSwiGLU E{((bf16*)(F.ws + WS_OV + OV_HID)), FF};
            pg8::gemm_phase<pg8::EpiSwiGLU, pg8::StaticOrder, true, true>(F.lds, g, S, E); }
        SEAM(p0 + 9);
        if (IN(p0 + 10)) { pg8::Gemm g{((bf16*)(F.ws + WS_OV + OV_HID)), ((bf16*)(F.ws + WS_WB + WB_W2OUT)), MP, D, FF}; pg8::StaticOrder S; S.init(MP, D, F.G, (int)blockIdx.x); pg8::EpiF32 E{((float*)(F.ws + WS_OV + OV_RAWF)), D};
            pg8::gemm_phase<pg8::EpiF32, pg8::StaticOrder, true, true>(F.lds, g, S, E); }
        SEAM(p0 + 10);
        if (IN(p0 + 11)) {
            const float* g_next = (l + 1 < NLAYER) ? (args.in[2] + (size_t)(l + 1) * 6 * D) : nullptr;
            phase_post(F, ((float*)(F.ws + WS_OV + OV_RAWF)), F.out, 0.5f, args.in[2] + (size_t)l * 6 * D + 5 * D, g_next);
            if (l + 1 < NLAYER) phase_convert(F, args.in, l + 1);
        }
        SEAM(p0 + 11);
    }
#undef IN
#undef SEAM
}

extern "C" void kernel_launch(void* const* d_in, const int* in_sizes, int n_in, void* d_out, int out_size, void* d_ws, size_t ws_size, hipStream_t stream) {
    static int grid = 0;
    if (grid == 0) {
        if (n_in != 30 || in_sizes[0] != MX * D || out_size != MX * D || ws_size < WS_END) { fprintf(stderr, "kernel_launch: unexpected shapes: n_in %d in0 %d out %d ws %zu\n", n_in, n_in > 0 ? in_sizes[0] : -1, out_size, ws_size); grid = -1; return; }
        int dev = 0, cus = 0, per_cu = 0;
        if (hipGetDevice(&dev) != hipSuccess || hipDeviceGetAttribute(&cus, hipDeviceAttributeMultiprocessorCount, dev) != hipSuccess) { grid = -1; return; }
        if (hipFuncSetAttribute((const void*)hybrid_fwd, hipFuncAttributeMaxDynamicSharedMemorySize, LDS_BYTES) != hipSuccess) { fprintf(stderr, "kernel_launch: hipFuncSetAttribute failed\n"); grid = -1; return; }
        if (hipOccupancyMaxActiveBlocksPerMultiprocessor(&per_cu, (const void*)hybrid_fwd, NWAVES * 64, LDS_BYTES) != hipSuccess || per_cu < 1) { fprintf(stderr, "kernel_launch: occupancy query says %d blocks per CU\n", per_cu); grid = -1; (void)hipGetLastError(); return; }
        (void)hipGetLastError();
        grid = cus;
    }
    if (grid < 0) return;
    if (hipMemsetAsync((char*)d_ws + WS_CTL, 0, CTL_ZERO_BYTES, stream) != hipSuccess) return;
    Args a{};
    for (int i = 0; i < 30; ++i) a.in[i] = (const float*)d_in[i];
    a.out = (float*)d_out; a.ws = (unsigned char*)d_ws;
#if MK_PER_PHASE
    for (int p = 0; p < N_PHASES; ++p) { a.ph_lo = p; a.ph_hi = p + 1; hipLaunchKernelGGL(hybrid_fwd, dim3(grid), dim3(NWAVES * 64), LDS_BYTES, stream, a); }
#else
    a.ph_lo = 0; a.ph_hi = N_PHASES;
    hipLaunchKernelGGL(hybrid_fwd, dim3(grid), dim3(NWAVES * 64), LDS_BYTES, stream, a);
#endif
}
```

```cpp
#include <hip/hip_runtime.h>
#include <cstdio>
#include <cstdint>
namespace pg8 {
#define PG8_LAS __attribute__((address_space(3)))
typedef unsigned short bf16_t;
typedef short bf16x8 __attribute__((ext_vector_type(8)));
typedef float f32x4 __attribute__((ext_vector_type(4)));
typedef unsigned u32x4 __attribute__((ext_vector_type(4)));
constexpr int BM = 256, BK = 64, HALF = 128, HTB = HALF * BK * 2  , STAGE_BYTES = 8 * HTB, NXCD = 8, WGM = 8;

__host__ __device__ __forceinline__ int lds_byte(int r, int c) { const int st = (r >> 4) * 2 + (c >> 5), rr = r & 15, cc = c & 31, ob = rr * 64 + cc * 2; return st * 1024 + (ob ^ (((ob >> 9) & 1) << 5)); }
__host__ __device__ __forceinline__ void stage_rc(int b, int& R, int& C) { const int st = b / 1024, sb = b % 1024, swz = sb ^ (((sb >> 9) & 1) << 5); R = (st >> 1) * 16 + swz / 64; C = (st & 1) * 32 + (swz % 64) / 2; }
__host__ __device__ __forceinline__ int perm32(int rho) { const int n = rho >> 4, i = rho & 15; return 8 * (i >> 2) + 4 * n + (i & 3); }

struct Unit { int pm, pn; };
struct Gemm { const bf16_t* A; const bf16_t* Bt; int M, N, K, ld; };

struct StaticOrder {
    int nM, nN, nwg, G, c, one_pn;
    __host__ __device__ void init(int M, int N, int G_, int c_) { nM = M / BM; nN = N / BM; nwg = nM * nN; G = G_; c = c_; one_pn = -1; }
    __host__ __device__ bool next(int i, Unit& u) const {
        if (one_pn != -1) { if (i != 0 || one_pn < 0) return false; u.pm = 0; u.pn = one_pn; return true; }
        const long L = (long)i * G + c; if (L >= nwg) return false;
        int wgid = (int)L; { const int q = nwg / NXCD, r = nwg % NXCD, xcd = wgid % NXCD, off = wgid / NXCD; wgid = (xcd < r ? xcd * (q + 1) : r * (q + 1) + (xcd - r) * q) + off; }
        const int nig = WGM * nN, gid = wgid / nig, fm = gid * WGM, gsz = (nM - fm) < WGM ? (nM - fm) : WGM;
        u.pm = fm + ((wgid % nig) % gsz); u.pn = (wgid % nig) / gsz; return true;
    }
    __device__ __forceinline__ void a_ready(const Unit&) const {}
    __device__ __forceinline__ void done(const Unit&) const {}
};
__device__ __forceinline__ unsigned cvt_pk_bf16(float lo, float hi) { unsigned r; asm volatile("v_cvt_pk_bf16_f32 %0, %1, %2" : "=v"(r) : "v"(lo), "v"(hi)); return r; }
typedef float f32x2 __attribute__((ext_vector_type(2)));
struct EpiSwiGLU {
    static constexpr bool PERM = true, AFTER_DRAIN = false;
    bf16_t* O; int ldo;
    __device__ __forceinline__ void operator()(const f32x4 (&acc)[2][2][4][2], const Unit& u, int wr, int wc, int fr, int fq) const {
        const int row0 = u.pm * BM + wr * 64 + fr, col0 = u.pn * HALF + wc * 32 + 8 * fq;
#pragma unroll
        for (int ai = 0; ai < 2; ++ai)
#pragma unroll
            for (int m = 0; m < 4; ++m) { bf16_t* rowp = O + (size_t)(row0 + ai * HALF + m * 16) * ldo + col0;
                float hv[8];
#pragma unroll
                for (int n = 0; n < 2; ++n)
#pragma unroll
                    for (int j = 0; j < 4; ++j) { const float g = acc[ai][0][m][n][j], up = acc[ai][1][m][n][j]; hv[n * 4 + j] = g * __builtin_amdgcn_rcpf(1.0f + __expf(-g)) * up; }
                u32x4 w; w.x = cvt_pk_bf16(hv[0], hv[1]); w.y = cvt_pk_bf16(hv[2], hv[3]); w.z = cvt_pk_bf16(hv[4], hv[5]); w.w = cvt_pk_bf16(hv[6], hv[7]);
                *(u32x4*)rowp = w; }
    }
};
struct EpiStoreBf16 {
    static constexpr bool PERM = true, AFTER_DRAIN = false;
    bf16_t* O; int ldc;
    __device__ __forceinline__ void operator()(const f32x4 (&acc)[2][2][4][2], const Unit& u, int wr, int wc, int fr, int fq) const {
        const int row0 = u.pm * BM + wr * 64 + fr, col0 = u.pn * BM + wc * 32 + 8 * fq;
#pragma unroll
        for (int ai = 0; ai < 2; ++ai)
#pragma unroll
            for (int m = 0; m < 4; ++m) { bf16_t* rowp = O + (size_t)(row0 + ai * HALF + m * 16) * ldc + col0;
#pragma unroll
                for (int bj = 0; bj < 2; ++bj) { const f32x4 v0 = acc[ai][bj][m][0], v1 = acc[ai][bj][m][1];
                    u32x4 w; w.x = cvt_pk_bf16(v0[0], v0[1]); w.y = cvt_pk_bf16(v0[2], v0[3]); w.z = cvt_pk_bf16(v1[0], v1[1]); w.w = cvt_pk_bf16(v1[2], v1[3]);
                    *(u32x4*)(rowp + bj * HALF) = w; } }
    }
};
struct EpiF32 {
    static constexpr bool PERM = false, AFTER_DRAIN = false;
    float* C; int ldc;
    __device__ __forceinline__ void operator()(const f32x4 (&acc)[2][2][4][2], const Unit& u, int wr, int wc, int fr, int fq) const {
        const int row0 = u.pm * BM + wr * 64 + fr, col0 = u.pn * BM + wc * 32 + 4 * fq;
#pragma unroll
        for (int ai = 0; ai < 2; ++ai)
#pragma unroll
            for (int m = 0; m < 4; ++m) { float* rowp = C + (size_t)(row0 + ai * HALF + m * 16) * ldc + col0;
#pragma unroll
                for (int bj = 0; bj < 2; ++bj)
#pragma unroll
                    for (int n = 0; n < 2; ++n) *(f32x4*)(rowp + bj * HALF + n * 16) = acc[ai][bj][m][n]; }
    }
};
struct EpiAny {
    static constexpr bool PERM = true, AFTER_DRAIN = false;
    int mode; void* O; int ldo;
    __device__ __forceinline__ void operator()(f32x4 (&acc)[2][2][4][2], const Unit& u, int wr, int wc, int fr, int fq) const {
        if (mode == 0) { EpiSwiGLU E{(bf16_t*)O, ldo}; E(acc, u, wr, wc, fr, fq); }
        else if (mode == 1) { EpiStoreBf16 E{(bf16_t*)O, ldo}; E(acc, u, wr, wc, fr, fq); }
        else { float* C = (float*)O; const int row0 = u.pm * BM + wr * 64 + fr, col0 = u.pn * BM + wc * 32 + 8 * fq;
#pragma unroll
            for (int ai = 0; ai < 2; ++ai)
#pragma unroll
                for (int m = 0; m < 4; ++m) { float* rowp = C + (size_t)(row0 + ai * HALF + m * 16) * ldo + col0;
#pragma unroll
                    for (int bj = 0; bj < 2; ++bj)
#pragma unroll
                        for (int n = 0; n < 2; ++n) *(f32x4*)(rowp + bj * HALF + n * 4) = acc[ai][bj][m][n]; } }
    }
};
template <class Epi, class Sched, bool ALIGN_EPI = false, bool SP2 = false>
__device__ __forceinline__ void gemm_phase(PG8_LAS unsigned char* lds, const Gemm g, const Sched& S, const Epi& E, int tid_in  ) {
    int tid_ = tid_in; asm volatile("" : "+v"(tid_));
    const int tid = tid_, wid = __builtin_amdgcn_readfirstlane(tid >> 6), lane = tid & 63, wr = wid >> 2, wc = wid & 3, fr = lane & 15, fq = lane >> 4;
    const int K = g.K, LD = g.ld, nt = K / BK;
    unsigned voffA[2], voffB[2];
#pragma unroll
    for (int i = 0; i < 2; ++i) { int R, C; stage_rc(tid * 16 + i * 8192, R, C); const int Rb = Epi::PERM ? ((R & ~31) + perm32(R & 31)) : R;
        voffA[i] = (unsigned)(R * LD + C) * 2u; voffB[i] = (unsigned)(Rb * LD + C) * 2u; }
    const size_t kstep = (size_t)(BK * 2);
    const size_t hstep = (size_t)HALF * LD * 2;
    const size_t tstep = 2 * hstep;
    const unsigned ldsw = (unsigned)wid * 1024u;
    const int aoff = lds_byte(wr * 64 + fr, fq * 8), boff = lds_byte(wc * 32 + fr, fq * 8);
#define PG8_SA(b, h) (((b) * 2 + (h)) * HTB)
#define PG8_SB(b, h) ((4 + (b) * 2 + (h)) * HTB)
#define PG8_STAGE(bufoff, gbase, voff) do { _Pragma("unroll") for (int _i = 0; _i < 2; ++_i) \
        __builtin_amdgcn_global_load_lds((const unsigned*)((const char*)(gbase) + (voff)[_i]), (PG8_LAS unsigned*)(lds + (bufoff) + ldsw + _i * 8192), 16, 0, 0); } while (0)
#define PG8_LDA(dst, b, h) do { _Pragma("unroll") for (int m = 0; m < 4; ++m) _Pragma("unroll") for (int k = 0; k < 2; ++k) dst[m][k] = *(const PG8_LAS bf16x8*)(lds + PG8_SA(b, h) + aoff + m * 2048 + k * 1024); } while (0)
#define PG8_LDB(dst, b, h) do { _Pragma("unroll") for (int n = 0; n < 2; ++n) _Pragma("unroll") for (int k = 0; k < 2; ++k) dst[n][k] = *(const PG8_LAS bf16x8*)(lds + PG8_SB(b, h) + boff + n * 2048 + k * 1024); } while (0)
#define PG8_MMA(ai, bj, At, Bt) do { __builtin_amdgcn_s_setprio(1); _Pragma("unroll") for (int m = 0; m < 4; ++m) _Pragma("unroll") for (int n = 0; n < 2; ++n) _Pragma("unroll") for (int k = 0; k < 2; ++k) \
        acc[ai][bj][m][n] = __builtin_amdgcn_mfma_f32_16x16x32_bf16(Bt[n][k], At[m][k], acc[ai][bj][m][n], 0, 0, 0); __builtin_amdgcn_s_setprio(0); } while (0)
#define PG8_WAIT_V(n) asm volatile("s_waitcnt vmcnt(" #n ")" ::: "memory")
#define PG8_WAIT_L(n) asm volatile("s_waitcnt lgkmcnt(" #n ")" ::: "memory")
#define PG8_BAR __builtin_amdgcn_s_barrier()
#define PG8_SCHED __builtin_amdgcn_sched_barrier(0)
    Unit cur, nxt; int ui = 0;
    if (!S.next(0, cur)) return;
    f32x4 acc[2][2][4][2];
#pragma unroll
    for (int a = 0; a < 2; ++a)
#pragma unroll
        for (int b = 0; b < 2; ++b)
#pragma unroll
            for (int m = 0; m < 4; ++m)
#pragma unroll
                for (int n = 0; n < 2; ++n) acc[a][b][m][n] = (f32x4){0.f, 0.f, 0.f, 0.f};
    bf16x8 At[4][2], B0[2][2], B1[2][2];
    const char* cA = (const char*)g.A + (size_t)cur.pm * tstep; const char* cB = (const char*)g.Bt + (size_t)cur.pn * tstep;
    S.a_ready(cur);
    if constexpr (SP2) {
        PG8_STAGE(PG8_SB(0, 0), cB, voffB); PG8_STAGE(PG8_SB(0, 1), cB + hstep, voffB); PG8_STAGE(PG8_SA(0, 0), cA, voffA); PG8_STAGE(PG8_SA(0, 1), cA + hstep, voffA);
        if (wr == 1) PG8_BAR;
        PG8_WAIT_V(2); PG8_BAR;
        PG8_STAGE(PG8_SB(1, 0), cB + kstep, voffB); PG8_STAGE(PG8_SA(1, 0), cA + kstep, voffA); PG8_STAGE(PG8_SB(1, 1), cB + hstep + kstep, voffB);
        PG8_WAIT_V(6); PG8_BAR;
    } else {
        PG8_STAGE(PG8_SB(0, 0), cB, voffB); PG8_STAGE(PG8_SA(0, 0), cA, voffA); PG8_STAGE(PG8_SB(0, 1), cB + hstep, voffB); PG8_STAGE(PG8_SA(0, 1), cA + hstep, voffA);
        if (wr == 1) PG8_BAR;
        PG8_WAIT_V(4); PG8_BAR;
        PG8_STAGE(PG8_SB(1, 0), cB + kstep, voffB); PG8_STAGE(PG8_SA(1, 0), cA + kstep, voffA); PG8_STAGE(PG8_SB(1, 1), cB + hstep + kstep, voffB);
        PG8_WAIT_V(6); PG8_BAR;
    }
    for (;;) {
        const bool has_next = S.next(ui + 1, nxt);
        const char* nA = has_next ? (const char*)g.A + (size_t)nxt.pm * tstep : cA; const char* nB = has_next ? (const char*)g.Bt + (size_t)nxt.pn * tstep : cB;
        for (int t = 0; t < nt; t += 2) {
            const bool last = (t == nt - 2);
            const char* a1 = cA + (size_t)(t + 1) * kstep;
            const char* a2 = last ? nA : cA + (size_t)(t + 2) * kstep; const char* b2 = last ? nB : cB + (size_t)(t + 2) * kstep;
            const char* a3 = a2 + kstep; const char* b3 = b2 + kstep;
            if (last && has_next) S.a_ready(nxt);
            if constexpr (SP2) {
            PG8_LDB(B0, 0, 0); PG8_LDB(B1, 0, 1); PG8_SCHED; PG8_LDA(At, 0, 0); PG8_STAGE(PG8_SA(1, 1), a1 + hstep, voffA);
            PG8_WAIT_V(8); PG8_WAIT_L(0); PG8_BAR; PG8_MMA(0, 0, At, B0); PG8_MMA(0, 1, At, B1); PG8_BAR; PG8_SCHED;
            PG8_LDA(At, 0, 1); PG8_STAGE(PG8_SB(0, 0), b2, voffB); PG8_STAGE(PG8_SB(0, 1), b2 + hstep, voffB); PG8_STAGE(PG8_SA(0, 0), a2, voffA);
            PG8_WAIT_V(8); PG8_WAIT_L(0); PG8_BAR; PG8_MMA(1, 0, At, B0); PG8_MMA(1, 1, At, B1); PG8_BAR; PG8_SCHED;
            PG8_LDB(B0, 1, 0); PG8_LDB(B1, 1, 1); PG8_SCHED; PG8_LDA(At, 1, 0); PG8_STAGE(PG8_SA(0, 1), a2 + hstep, voffA);
            PG8_WAIT_V(8); PG8_WAIT_L(0); PG8_BAR; PG8_MMA(0, 0, At, B0); PG8_MMA(0, 1, At, B1); PG8_BAR; PG8_SCHED;
            PG8_LDA(At, 1, 1); PG8_STAGE(PG8_SB(1, 0), b3, voffB); PG8_STAGE(PG8_SB(1, 1), b3 + hstep, voffB); PG8_STAGE(PG8_SA(1, 0), a3, voffA);
            PG8_WAIT_V(8); PG8_WAIT_L(0); PG8_BAR; PG8_MMA(1, 0, At, B0); PG8_MMA(1, 1, At, B1); PG8_BAR; PG8_SCHED;
            } else {
            PG8_LDB(B0, 0, 0); PG8_SCHED; PG8_LDA(At, 0, 0); PG8_STAGE(PG8_SA(1, 1), a1 + hstep, voffA);
            PG8_WAIT_L(8); PG8_BAR; PG8_WAIT_L(0); PG8_MMA(0, 0, At, B0); PG8_BAR; PG8_SCHED;
            PG8_LDB(B1, 0, 1); PG8_STAGE(PG8_SB(0, 0), b2, voffB);
            PG8_BAR; PG8_WAIT_L(0); PG8_MMA(0, 1, At, B1); PG8_BAR;
            PG8_LDA(At, 0, 1); PG8_STAGE(PG8_SA(0, 0), a2, voffA);
            PG8_BAR; PG8_WAIT_L(0); PG8_MMA(1, 0, At, B0); PG8_BAR; PG8_SCHED;
            PG8_STAGE(PG8_SB(0, 1), b2 + hstep, voffB);
            PG8_WAIT_V(6); PG8_BAR; PG8_MMA(1, 1, At, B1); PG8_BAR;
            PG8_LDB(B0, 1, 0); PG8_SCHED; PG8_LDA(At, 1, 0); PG8_STAGE(PG8_SA(0, 1), a2 + hstep, voffA);
            PG8_WAIT_L(8); PG8_BAR; PG8_WAIT_L(0); PG8_MMA(0, 0, At, B0); PG8_BAR; PG8_SCHED;
            PG8_LDB(B1, 1, 1); PG8_STAGE(PG8_SB(1, 0), b3, voffB);
            PG8_BAR; PG8_WAIT_L(0); PG8_MMA(0, 1, At, B1); PG8_BAR;
            PG8_LDA(At, 1, 1); PG8_STAGE(PG8_SA(1, 0), a3, voffA);
            PG8_BAR; PG8_WAIT_L(0); PG8_MMA(1, 0, At, B0); PG8_BAR; PG8_SCHED;
            PG8_STAGE(PG8_SB(1, 1), b3 + hstep, voffB);
            PG8_WAIT_V(6); PG8_BAR; PG8_MMA(1, 1, At, B1); PG8_BAR;
            }
        }
        if constexpr (ALIGN_EPI) { if (wr == 0) PG8_BAR; }
        E(acc, cur, wr, wc, fr, fq); S.done(cur);
        if (!has_next) break;
#pragma unroll
        for (int a = 0; a < 2; ++a)
#pragma unroll
            for (int b = 0; b < 2; ++b)
#pragma unroll
                for (int m = 0; m < 4; ++m)
#pragma unroll
                    for (int n = 0; n < 2; ++n) acc[a][b][m][n] = (f32x4){0.f, 0.f, 0.f, 0.f};
        cur = nxt; cA = nA; cB = nB; ++ui;
        if constexpr (ALIGN_EPI) { if (wr == 1) PG8_BAR; }
    }
    PG8_WAIT_V(0);
    if constexpr (!ALIGN_EPI) { if (wr == 0) PG8_BAR; }
    PG8_BAR;
#undef PG8_SA
#undef PG8_SB
#undef PG8_STAGE
#undef PG8_LDA
#undef PG8_LDB
#undef PG8_MMA
#undef PG8_WAIT_V
#undef PG8_WAIT_L
#undef PG8_BAR
#undef PG8_SCHED
}
}
constexpr int NWAVES = 8, GRID = 256;
constexpr int D = 1024, FF = 2816, NIN = 2944, NINP = 3072, NLAYER = 2;
constexpr int NB = 8, SEQ = 2048, NMETA = 16, TT = SEQ + NMETA;
constexpr int MX = NB * SEQ, MREAL = NB * TT, MP = 16640;
constexpr float RMS_EPS = 1e-6f, LNX_EPS = 64e-5f;
constexpr int PC_LRUX = 0, PC_LRUG = 256, PC_SCB = 512, PC_SCC = 768, PC_SCX = 1024, PC_R = 1280, PC_K = 1792, PC_V = 2304, PC_LO = 2816;

constexpr size_t MiB = 1u << 20;
constexpr size_t WS_CTL = 0, CTL_ZERO_BYTES = 1 * MiB;
constexpr size_t WS_HMETA = 1 * MiB;
constexpr size_t WS_AGG = 2 * MiB;
constexpr size_t WS_WB = 3 * MiB;
constexpr size_t WB_W1IN = 0, WB_W1OUT = 11 * MiB, WB_W2IN = WB_W1OUT + 5632 * 1024, WB_W2OUT = WB_W2IN + 11 * MiB, WB_WIN = WB_W2OUT + 5632 * 1024, WB_WOUT = WB_WIN + 6 * MiB, WB_END = WB_WOUT + 2 * MiB;
static_assert(WB_END == 41 * MiB, "weight map");
constexpr size_t WS_XN = 44 * MiB;
constexpr size_t WS_OV = 77 * MiB;
constexpr size_t OV_HID = 0, OV_RAWF = 90 * MiB;
constexpr size_t OV_P = 0, OV_WDEC = OV_P + (size_t)MP * NINP * 2, OV_ABUF = OV_WDEC + (size_t)MP * 512 * 4, OV_HL = OV_ABUF + (size_t)MP * 512 * 2, OV_CA = OV_HL + (size_t)MP * 256 * 4, OV_MIXEND = OV_CA + (size_t)MP * 256 * 4;
constexpr size_t OV_RAWM = 0;
constexpr size_t WS_END = 256 * MiB;
static_assert(WS_XN + (size_t)MP * D * 2 <= WS_OV && WS_OV + OV_MIXEND <= WS_END && WS_OV + OV_RAWF + (size_t)MP * D * 4 <= WS_END && (size_t)MP * FF * 2 <= OV_RAWF && (size_t)MP * 512 * 2 <= WB_W2IN, "d_ws map");
constexpr int CW_TMO = 8, CW_CNTM = 72, CW_BAR = 4096, CW_CNTA = 8192, CW_CNTB = CW_CNTA + 65 * 64;
constexpr size_t OV_X1 = 156 * MiB, OV_SLAB = 158 * MiB;

constexpr int RING_BYTES = 143360, LDSCTL_OFF = RING_BYTES, MISC_OFF = LDSCTL_OFF + 320, LDS_BYTES = 147456;

#define GAS __attribute__((address_space(1)))
#define LAS __attribute__((address_space(3)))
typedef unsigned short bf16;
typedef unsigned v4u __attribute__((ext_vector_type(4)));
typedef float f32x4 __attribute__((ext_vector_type(4)));
typedef GAS unsigned gu32;
typedef float f32x2v_ __attribute__((ext_vector_type(2)));
#define LDS_WAIT() asm volatile("s_waitcnt lgkmcnt(0)" ::: "memory")
__device__ __forceinline__ unsigned f2bf(float f) { unsigned u = __builtin_bit_cast(unsigned, f); return (u + 0x7fffu + ((u >> 16) & 1u)) >> 16; }
__device__ __forceinline__ unsigned pk2(float lo, float hi) { return f2bf(lo) | (f2bf(hi) << 16); }
__device__ __forceinline__ float bf2f(unsigned b) { return __builtin_bit_cast(float, b << 16); }
__device__ __forceinline__ float wave_sum(float v) {
#pragma unroll
    for (int o = 1; o < 64; o <<= 1) v += __shfl_xor(v, o);
    return v;
}
__device__ __forceinline__ float sigmoidf_(float x) { return __builtin_amdgcn_rcpf(1.0f + __expf(-x)); }
__device__ __forceinline__ float tanhf_(float x) { return 1.0f - 2.0f * __builtin_amdgcn_rcpf(1.0f + __expf(2.0f * x)); }
__device__ __forceinline__ float softplusf_(float x) { return fmaxf(x, 0.f) + __logf(1.0f + __expf(-fabsf(x))); }
__device__ __forceinline__ float gelu_tanh(float x) { const float u = 0.7978845608028654f * (x + 0.044715f * x * x * x); return 0.5f * x * (1.0f + tanhf_(u)); }
template <int CTRL> __device__ __forceinline__ float dppf(float x) { return __builtin_bit_cast(float, __builtin_amdgcn_mov_dpp(__builtin_bit_cast(int, x), CTRL, 0xf, 0xf, true)); }
__device__ __forceinline__ float red16(float x) { x += dppf<0xB1>(x); x += dppf<0x4E>(x); x += dppf<0x141>(x); x += dppf<0x128>(x); return x; }
__device__ __forceinline__ float wave_sum_dpp(float x) {
    x = red16(x); x += __shfl_xor(x, 16); x += __shfl_xor(x, 32); return x; }
__device__ __forceinline__ int vlane() { return (int)__builtin_amdgcn_mbcnt_hi(~0u, __builtin_amdgcn_mbcnt_lo(~0u, 0u)); }
__device__ __forceinline__ int row_of(int b, int s) { return s < NMETA ? (MX + b * NMETA + s) : (b * SEQ + s - NMETA); }
#define XB_TMO      128
#define XB_XCNT(j)  (256  + 64 * (j))
#define XB_XSUB(j)  (1280 + 64 * (j))
#define XB_XGEN(j)  (2304 + 64 * (j))
#define XB_TOP      3328
#define XB_TOPGEN   3392
#define XCD_BAR_WORDS 3456
#define XB_SPIN_CAP (1u << 18)

__device__ __forceinline__ unsigned xb_ld(unsigned* p)              { return __hip_atomic_load(p, __ATOMIC_RELAXED, __HIP_MEMORY_SCOPE_AGENT); }
__device__ __forceinline__ unsigned xb_add(unsigned* p, unsigned v) { return __hip_atomic_fetch_add(p, v, __ATOMIC_RELAXED, __HIP_MEMORY_SCOPE_AGENT); }
__device__ __forceinline__ unsigned xb_xcc_id() { return (unsigned)__builtin_amdgcn_s_getreg((3 << 11) | 20) & 0xFu; }
#define XB_SPIN(cond, bar) do { unsigned _sp = 0; while (cond) { __builtin_amdgcn_s_sleep(1); \
    if ((++_sp & 255u) == 0u) { if (xb_ld(&(bar)[XB_TMO])) break; if (_sp > XB_SPIN_CAP) { atomicAdd(&(bar)[XB_TMO], 1u); break; } } } } while (0)

struct XcdBarrier {
    unsigned* bar; unsigned x;
    volatile LAS unsigned* st;
};

__device__ __forceinline__ XcdBarrier xcd_barrier_post(unsigned* bar, volatile LAS unsigned* st, bool leader  ) {
    XcdBarrier b; b.bar = bar; b.x = xb_xcc_id(); b.st = st;
    if (leader) (void)xb_add(&bar[XB_XCNT(b.x)], 1u);
    return b;
}
__device__ __forceinline__ void xcd_barrier_complete(unsigned* bar, unsigned x, unsigned& nloc, unsigned& nx) {
    const unsigned G = gridDim.x * gridDim.y * gridDim.z;
    unsigned sum, cnt, mine, sp = 0u;
    for (;;) {
        sum = 0u; cnt = 0u; mine = 0u;
#pragma unroll
        for (unsigned j = 0; j < 16; ++j) { const unsigned c = xb_ld(&bar[XB_XCNT(j)]); sum += c; cnt += (c > 0u) ? 1u : 0u; mine = (j == x) ? c : mine; }
        if (sum == G) break;
        __builtin_amdgcn_s_sleep(1);
        if ((++sp & 255u) == 0u) { if (xb_ld(&bar[XB_TMO])) break; if (sp > XB_SPIN_CAP) { atomicAdd(&bar[XB_TMO], 1u); break; } }
    }
    nloc = mine > 0u ? mine : 1u; nx = cnt > 0u ? cnt : 1u;
}

__device__ __forceinline__ void xcd_barrier(const XcdBarrier& b, bool leader  ) {
    asm volatile("s_waitcnt vmcnt(0)" ::: "memory");
    __syncthreads();
    if (leader) {
        unsigned* bar = b.bar;
        __builtin_amdgcn_s_waitcnt(0);
        unsigned nloc = b.st[0], nx = b.st[1];
        if (nloc == 0u) { xcd_barrier_complete(bar, b.x, nloc, nx); b.st[0] = nloc; b.st[1] = nx; }
        const unsigned old = xb_add(&bar[XB_XSUB(b.x)], 1u);
        const unsigned gen = old / nloc;
        if (old + 1u == (gen + 1u) * nloc) {
            __builtin_amdgcn_fence(__ATOMIC_RELEASE, "agent");
            asm volatile("s_waitcnt vmcnt(0)" ::: "memory");
            const unsigned og = xb_add(&bar[XB_TOP], 1u);
            const unsigned tg = og / nx;
            if (og + 1u == (tg + 1u) * nx) xb_add(&bar[XB_TOPGEN], 1u);
            else XB_SPIN(xb_ld(&bar[XB_TOPGEN]) == tg, bar);
            __builtin_amdgcn_fence(__ATOMIC_ACQUIRE, "agent");
            xb_add(&bar[XB_XGEN(b.x)], 1u);
            asm volatile("s_waitcnt vmcnt(0)" ::: "memory");
        } else {
            XB_SPIN(xb_ld(&bar[XB_XGEN(b.x)]) == gen, bar);
            __builtin_amdgcn_fence(__ATOMIC_ACQUIRE, "agent");
            asm volatile("s_waitcnt vmcnt(0)" ::: "memory");
        }
    }
    __syncthreads();
}
struct Frame {
    LAS unsigned char* lds;
    int tid, lane, wave, vcu;
    unsigned char* ws;
    const float* x; const float* meta; float* out;
};

constexpr int PK_CONVW = 0, PK_CONVB = 1024, PK_WA = 1280, PK_BA = 17664, PK_WX = 17920, PK_BX = 34304, PK_LAM = 34560, PK_LNG = 34816, PK_SCW = 35072, PK_SCG = 35840, PK_MU = 36096, PK_W0 = 37760,
              PK_W2 = 38272, PK_A0 = 54656, PK_A2 = 55168, PK_G2 = 71552, PK_KK = 104320, PK_KA = 104832, PK_RK = 105344, PK_LNW = 105856, PK_LNB = 106368, PK_SIZE = 106880;
constexpr size_t WS_PACK = 72 * 1024;
static_assert(WS_PACK + (size_t)NLAYER * PK_SIZE * 4 <= CTL_ZERO_BYTES && (CW_CNTB + 65 * 64) * 4 <= (int)WS_PACK && CW_BAR + 3456 <= CW_CNTA, "pack inside CTL, above the barrier words");
__device__ __forceinline__ const float* pack_of(const Frame& F, int l) { return (const float*)(F.ws + WS_PACK) + (size_t)l * PK_SIZE; }
__device__ __forceinline__ void pack_copy(Frame& F, const float* src, int per_layer, int off) {
    const int gt = F.vcu * (NWAVES * 64) + F.tid, NT = GRID * NWAVES * 64;
    for (int i = gt; i < NLAYER * per_layer; i += NT) { const int l = i / per_layer, j = i - l * per_layer; ((float*)(F.ws + WS_PACK))[(size_t)l * PK_SIZE + off + j] = src[i]; }
}
__device__ __forceinline__ void phase_pack(Frame& F, const float* const* in) {
    pack_copy(F, in[9], 1024, PK_CONVW); pack_copy(F, in[10], 256, PK_CONVB); pack_copy(F, in[11], 16384, PK_WA); pack_copy(F, in[12], 256, PK_BA); pack_copy(F, in[13], 16384, PK_WX); pack_copy(F, in[14], 256, PK_BX);
    pack_copy(F, in[15], 256, PK_LAM); pack_copy(F, in[16], 256, PK_LNG); pack_copy(F, in[17], 768, PK_SCW); pack_copy(F, in[18], 256, PK_SCG); pack_copy(F, in[19], 1664, PK_MU); pack_copy(F, in[20], 512, PK_W0);
    pack_copy(F, in[21], 16384, PK_W2); pack_copy(F, in[22], 512, PK_A0); pack_copy(F, in[23], 16384, PK_A2); pack_copy(F, in[24], 32768, PK_G2); pack_copy(F, in[25], 512, PK_KK); pack_copy(F, in[26], 512, PK_KA);
    pack_copy(F, in[27], 512, PK_RK); pack_copy(F, in[28], 512, PK_LNW); pack_copy(F, in[29], 512, PK_LNB);
}

__device__ __forceinline__ void transpose_item(const float* W, int K, int N, bf16* WT, int k0, int n0, int drow0, LAS float* scr, int lane) {
#pragma unroll 8
    for (int i = 0; i < 32; ++i) { const int kk = 2 * i + (lane >> 5); scr[kk * 33 + (lane & 31)] = W[(size_t)(k0 + kk) * N + n0 + (lane & 31)]; }
    LDS_WAIT(); asm volatile("" ::: "memory");
    const int c = lane & 7;
#pragma unroll
    for (int j = 0; j < 4; ++j) { const int n = (lane >> 3) + 8 * j; const LAS float* s = scr + (8 * c) * 33 + n;
        v4u o; o.x = pk2(s[0 * 33], s[1 * 33]); o.y = pk2(s[2 * 33], s[3 * 33]); o.z = pk2(s[4 * 33], s[5 * 33]); o.w = pk2(s[6 * 33], s[7 * 33]);
        *(GAS v4u*)(WT + (size_t)(drow0 + n) * K + k0 + 8 * c) = o; }
    LDS_WAIT(); asm volatile("" ::: "memory");
}
__device__ __forceinline__ int swiglu_row(int n0) { return n0 < FF ? ((n0 >> 7) * 256 + (n0 & 127)) : (((n0 - FF) >> 7) * 256 + 128 + ((n0 - FF) & 127)); }
__device__ __forceinline__ void phase_convert(Frame& F, const float* const* in, int l) {
    { int ln_ = F.tid & 63; asm volatile("" : "+v"(ln_)); F.lane = ln_; }
    const float* ffn1_in = in[3] + (size_t)l * D * 2 * FF; const float* ffn1_out = in[4] + (size_t)l * FF * D; const float* ffn2_in = in[5] + (size_t)l * D * 2 * FF; const float* ffn2_out = in[6] + (size_t)l * FF * D;
    const float* mix_in = in[7] + (size_t)l * D * NIN; const float* mix_out = in[8] + (size_t)l * D * D;
    LAS float* scr = (LAS float*)(F.lds + F.wave * 16384);
    const int gw = F.vcu * NWAVES + F.wave, NGW = GRID * NWAVES;
    constexpr int I_IN = (D / 64) * (2 * FF / 32), I_OUT = (FF / 64) * (D / 32), I_MI = (D / 64) * (NIN / 32), I_MO = (D / 64) * (D / 32);
    constexpr int NITEMS = 2 * I_IN + 2 * I_OUT + I_MI + I_MO;
    for (int it = gw; it < NITEMS; it += NGW) {
        int r = it;
        if (r < 2 * I_IN) { const bool second = r >= I_IN; if (second) r -= I_IN; const int nblk = 2 * FF / 32, kb = r / nblk, nb = r % nblk;
            transpose_item(second ? ffn2_in : ffn1_in, D, 2 * FF, second ? ((bf16*)(F.ws + WS_WB + WB_W2IN)) : ((bf16*)(F.ws + WS_WB + WB_W1IN)), 64 * kb, 32 * nb, swiglu_row(32 * nb), scr, F.lane); continue; }
        r -= 2 * I_IN;
        if (r < 2 * I_OUT) { const bool second = r >= I_OUT; if (second) r -= I_OUT; const int nblk = D / 32, kb = r / nblk, nb = r % nblk;
            transpose_item(second ? ffn2_out : ffn1_out, FF, D, second ? ((bf16*)(F.ws + WS_WB + WB_W2OUT)) : ((bf16*)(F.ws + WS_WB + WB_W1OUT)), 64 * kb, 32 * nb, 32 * nb, scr, F.lane); continue; }
        r -= 2 * I_OUT;
        if (r < I_MI) { const int nblk = NIN / 32, kb = r / nblk, nb = r % nblk; transpose_item(mix_in, D, NIN, ((bf16*)(F.ws + WS_WB + WB_WIN)), 64 * kb, 32 * nb, 32 * nb, scr, F.lane); continue; }
        r -= I_MI;
        { const int nblk = D / 32, kb = r / nblk, nb = r % nblk; transpose_item(mix_out, D, D, ((bf16*)(F.ws + WS_WB + WB_WOUT)), 64 * kb, 32 * nb, 32 * nb, scr, F.lane); }
    }
    { unsigned zz = 0u; asm volatile("" : "+v"(zz));
      for (int i = gw * 64 + F.lane; i < (NINP - NIN) * D / 8; i += NGW * 64) *(GAS v4u*)(((bf16*)(F.ws + WS_WB + WB_WIN)) + (size_t)NIN * D + (size_t)i * 8) = (v4u){zz, zz, zz, zz}; }
}

__device__ __forceinline__ const float* hrow_c(const Frame& F, const float* xrows, int r) { return r < MX ? xrows + (size_t)r * D : ((float*)(F.ws + WS_HMETA)) + (size_t)(r - MX) * D; }
__device__ __forceinline__ void store_xn_row(bf16* XN, int r, int lane, const f32x4 (&v)[4], float rstd, const float* g) {
    GAS unsigned long long* o8 = (GAS unsigned long long*)(XN + (size_t)r * D) + lane;
#pragma unroll
    for (int j = 0; j < 4; ++j) { const f32x4 gv = ((const GAS f32x4*)g)[lane + 64 * j];
        o8[64 * j] = (unsigned long long)pk2(v[j].x * rstd * gv.x, v[j].y * rstd * gv.y) | ((unsigned long long)pk2(v[j].z * rstd * gv.z, v[j].w * rstd * gv.w) << 32); }
}
__device__ __forceinline__ float sumsq4(const f32x4 (&v)[4]) { float s = 0.f;
#pragma unroll
    for (int j = 0; j < 4; ++j) s += (v[j].x * v[j].x + v[j].y * v[j].y) + (v[j].z * v[j].z + v[j].w * v[j].w);
    return s; }
__device__ __forceinline__ void phase_init(Frame& F, const float* g_pre) {
    { int ln_ = F.tid & 63; asm volatile("" : "+v"(ln_)); F.lane = ln_; }
    const int gw = F.vcu * NWAVES + F.wave, NGW = GRID * NWAVES;
    for (int r = gw; r < MP; r += NGW) {
        if (r >= MREAL) { GAS unsigned long long* o8 = (GAS unsigned long long*)(((bf16*)(F.ws + WS_XN)) + (size_t)r * D) + F.lane;
#pragma unroll
            for (int j = 0; j < 4; ++j) { unsigned zz = 0u; asm volatile("" : "+v"(zz)); o8[64 * j] = (unsigned long long)zz; }
            continue; }
        const float* src = r < MX ? F.x + (size_t)r * D : F.meta + (size_t)((r - MX) & (NMETA - 1)) * D;
        f32x4 v[4];
#pragma unroll
        for (int j = 0; j < 4; ++j) v[j] = ((const GAS f32x4*)src)[F.lane + 64 * j];
        if (r >= MX) { GAS f32x4* hm = (GAS f32x4*)(((float*)(F.ws + WS_HMETA)) + (size_t)(r - MX) * D);
#pragma unroll
            for (int j = 0; j < 4; ++j) hm[F.lane + 64 * j] = v[j]; }
        const float rstd = rsqrtf(wave_sum(sumsq4(v)) * (1.0f / D) + RMS_EPS);
        store_xn_row(((bf16*)(F.ws + WS_XN)), r, F.lane, v, rstd, g_pre);
    }
}
struct TilePost { const float* raw; const float* base_x; float* out_x; bf16* XN; const float* g_post; const float* g_pre; int half_scale; float* xbuf; unsigned* cnt; unsigned* tmo; unsigned want; };
__device__ __forceinline__ void tile_post(const Frame& F, const TilePost& T, int pm_, int pn_) {
    const int pm = __builtin_amdgcn_readfirstlane(pm_), pn = __builtin_amdgcn_readfirstlane(pn_);
    const int lane = vlane(), w = F.wave, rg = lane >> 4, kq = lane & 15;
    const float* rawp = T.raw + (size_t)pm * 256 * D + pn * 256; const float* bp = T.base_x + (size_t)pm * 256 * D + pn * 256; float* hp = T.out_x + (size_t)pm * 256 * D + pn * 256; bf16* xp = T.XN + (size_t)pm * 256 * D + pn * 256;
    f32x4 gp[4];
#pragma unroll
    for (int j = 0; j < 4; ++j) gp[j] = *(const f32x4*)(T.g_post + pn * 256 + 64 * j + 4 * kq);
#pragma unroll 2
    for (int it = 0; it < 8; ++it) { const int r = 32 * w + 4 * it + rg; const unsigned off = (unsigned)(r * D + 4 * kq);
        f32x4 y[4], b[4];
#pragma unroll
        for (int j = 0; j < 4; ++j) { y[j] = *(const f32x4*)(rawp + (off + 64u * j)); b[j] = *(const f32x4*)(bp + (off + 64u * j)); }
        float s0 = 0.f, s1 = 0.f, s2 = 0.f, s3 = 0.f;
#pragma unroll
        for (int j = 0; j < 4; ++j) { const f32x4 t = y[j] * gp[j];
            s0 += (y[j][0] * y[j][0] + y[j][1] * y[j][1]) + (y[j][2] * y[j][2] + y[j][3] * y[j][3]); s1 += (b[j][0] * b[j][0] + b[j][1] * b[j][1]) + (b[j][2] * b[j][2] + b[j][3] * b[j][3]);
            s2 += (b[j][0] * t[0] + b[j][1] * t[1]) + (b[j][2] * t[2] + b[j][3] * t[3]); s3 += (t[0] * t[0] + t[1] * t[1]) + (t[2] * t[2] + t[3] * t[3]); }
        s0 = red16(s0); s1 = red16(s1); s2 = red16(s2); s3 = red16(s3);
        if (kq == 0) { unsigned long long* slot = (unsigned long long*)(T.xbuf + ((size_t)(pm * 256 + r) * 4 + pn) * 4);
            __hip_atomic_store(slot, ((unsigned long long)__float_as_uint(s1) << 32) | __float_as_uint(s0), __ATOMIC_RELAXED, __HIP_MEMORY_SCOPE_AGENT);
            __hip_atomic_store(slot + 1, ((unsigned long long)__float_as_uint(s3) << 32) | __float_as_uint(s2), __ATOMIC_RELAXED, __HIP_MEMORY_SCOPE_AGENT); } }
    asm volatile("s_waitcnt vmcnt(0)" ::: "memory");
    if (lane == 0) __hip_atomic_fetch_add(T.cnt + 64 * pm, 1u, __ATOMIC_RELAXED, __HIP_MEMORY_SCOPE_AGENT);
    if (w == 0) {
        const unsigned long long t0 = __builtin_amdgcn_s_memrealtime();
        for (;;) {
            if ((unsigned)__builtin_amdgcn_readfirstlane(__hip_atomic_load(T.cnt + 64 * pm, __ATOMIC_RELAXED, __HIP_MEMORY_SCOPE_AGENT)) >= T.want) break;
            if (__builtin_amdgcn_s_memrealtime() - t0 > 2000000ull) { if (lane == 0) __hip_atomic_store(T.tmo, 1u, __ATOMIC_RELAXED, __HIP_MEMORY_SCOPE_AGENT); break; }
            __builtin_amdgcn_s_sleep(2);
        }
        __builtin_amdgcn_fence(__ATOMIC_ACQUIRE, "agent");
        asm volatile("s_waitcnt vmcnt(0)" ::: "memory");
    }
    __syncthreads();
    const bool has_pre = T.g_pre != nullptr;
    f32x4 gq[4];
#pragma unroll
    for (int j = 0; j < 4; ++j) gq[j] = has_pre ? *(const f32x4*)(T.g_pre + pn * 256 + 64 * j + 4 * kq) : (f32x4){0.f, 0.f, 0.f, 0.f};
#pragma unroll 2
    for (int it = 0; it < 8; ++it) { const int r = 32 * w + 4 * it + rg; const unsigned off = (unsigned)(r * D + 4 * kq);
        f32x4 y[4], b[4];
#pragma unroll
        for (int j = 0; j < 4; ++j) { y[j] = *(const f32x4*)(rawp + (off + 64u * j)); b[j] = *(const f32x4*)(bp + (off + 64u * j)); }
        f32x4 sl = (f32x4){0.f, 0.f, 0.f, 0.f};
        if (kq < 4) sl = *(const f32x4*)(T.xbuf + ((size_t)(pm * 256 + r) * 4 + kq) * 4);
        const float T0 = red16(sl[0]), T1 = red16(sl[1]), T2 = red16(sl[2]), T3 = red16(sl[3]);
        const float r1 = __builtin_amdgcn_rsqf(T0 * (1.0f / D) + RMS_EPS), alpha = T.half_scale ? 0.5f * r1 : r1, ssq = T1 + alpha * ((T2 + T2) + alpha * T3);
        const float rstd2 = __builtin_amdgcn_rsqf(fmaxf(ssq, 0.f) * (1.0f / D) + RMS_EPS);
#pragma unroll
        for (int j = 0; j < 4; ++j) { const f32x4 h = b[j] + y[j] * gp[j] * alpha; *(f32x4*)(hp + (off + 64u * j)) = h;
            if (has_pre) { const f32x4 v = h * rstd2 * gq[j]; *(GAS unsigned long long*)(xp + (off + 64u * j)) = (unsigned long long)pk2(v[0], v[1]) | ((unsigned long long)pk2(v[2], v[3]) << 32); } } }
}

__device__ __forceinline__ void phase_post(Frame& F, const float* raw, const float* base_x, float scale, const float* g_post, const float* g_pre) {
    { int ln_ = F.tid & 63; asm volatile("" : "+v"(ln_)); F.lane = ln_; }
    const int gw = F.vcu * NWAVES + F.wave, NGW = GRID * NWAVES;
    for (int r0 = gw; r0 < MREAL; r0 += 2 * NGW) {
        const int r1 = r0 + NGW; const bool two = r1 < MREAL; const int r1c = two ? r1 : r0;
        f32x4 y0[4], h0[4], y1[4], h1[4];
        const float* bp0 = hrow_c(F, base_x, r0); const float* bp1 = hrow_c(F, base_x, r1c);
#pragma unroll
        for (int j = 0; j < 4; ++j) { y0[j] = ((const GAS f32x4*)(raw + (size_t)r0 * D))[F.lane + 64 * j]; h0[j] = ((const GAS f32x4*)bp0)[F.lane + 64 * j];
                                      y1[j] = ((const GAS f32x4*)(raw + (size_t)r1c * D))[F.lane + 64 * j]; h1[j] = ((const GAS f32x4*)bp1)[F.lane + 64 * j]; }
        const float rs0 = scale * rsqrtf(wave_sum_dpp(sumsq4(y0)) * (1.0f / D) + RMS_EPS), rs1 = scale * rsqrtf(wave_sum_dpp(sumsq4(y1)) * (1.0f / D) + RMS_EPS);
        float* d0 = r0 < MX ? F.out + (size_t)r0 * D : ((float*)(F.ws + WS_HMETA)) + (size_t)(r0 - MX) * D; float* d1 = r1c < MX ? F.out + (size_t)r1c * D : ((float*)(F.ws + WS_HMETA)) + (size_t)(r1c - MX) * D;
#pragma unroll
        for (int j = 0; j < 4; ++j) { const f32x4 gv = ((const GAS f32x4*)g_post)[F.lane + 64 * j]; h0[j] = h0[j] + y0[j] * rs0 * gv; h1[j] = h1[j] + y1[j] * rs1 * gv;
            ((GAS f32x4*)d0)[F.lane + 64 * j] = h0[j]; if (two) ((GAS f32x4*)d1)[F.lane + 64 * j] = h1[j]; }
        if (g_pre) { const float q0 = rsqrtf(wave_sum_dpp(sumsq4(h0)) * (1.0f / D) + RMS_EPS), q1 = rsqrtf(wave_sum_dpp(sumsq4(h1)) * (1.0f / D) + RMS_EPS);
            store_xn_row(((bf16*)(F.ws + WS_XN)), r0, F.lane, h0, q0, g_pre); if (two) store_xn_row(((bf16*)(F.ws + WS_XN)), r1, F.lane, h1, q1, g_pre); }
    }
}
__device__ __forceinline__ void meta_row_post(Frame& F, int j, int nkc, float scale, const float* g_post, const float* g_pre) {
    const float* slab = (const float*)(F.ws + WS_OV + OV_SLAB) + (size_t)j * D; float* hrow = (float*)(F.ws + WS_HMETA) + (size_t)j * D;
    f32x4 y[4], hb[4];
#pragma unroll
    for (int i = 0; i < 4; ++i) { y[i] = (f32x4){0.f, 0.f, 0.f, 0.f}; hb[i] = ((const GAS f32x4*)hrow)[F.lane + 64 * i]; }
    for (int kc = 0; kc < nkc; ++kc) {
#pragma unroll
        for (int i = 0; i < 4; ++i) y[i] = y[i] + ((const GAS f32x4*)(slab + (size_t)kc * 256 * D))[F.lane + 64 * i]; }
    const float rs = scale * rsqrtf(wave_sum(sumsq4(y)) * (1.0f / D) + RMS_EPS);
#pragma unroll
    for (int i = 0; i < 4; ++i) { const f32x4 gv = ((const GAS f32x4*)g_post)[F.lane + 64 * i]; hb[i] = hb[i] + y[i] * rs * gv; ((GAS f32x4*)hrow)[F.lane + 64 * i] = hb[i]; }
    if (g_pre) { const float rstd = rsqrtf(wave_sum(sumsq4(hb)) * (1.0f / D) + RMS_EPS); store_xn_row(((bf16*)(F.ws + WS_XN)), MX + j, F.lane, hb, rstd, g_pre); }
}
typedef short bf16x8v __attribute__((ext_vector_type(8)));
typedef float f32x4v __attribute__((ext_vector_type(4)));
constexpr int FR_PER_WAVE = 24;
constexpr size_t WS_FRAG = WS_AGG + 512 * 1024, FRAG_LAYER_BYTES = (size_t)8 * FR_PER_WAVE * 64 * 16;
static_assert(WS_FRAG + NLAYER * FRAG_LAYER_BYTES <= WS_WB, "fragment store fits behind AGG");
__device__ __forceinline__ float frag_src(const float* const* in, int l, int w, int f, int lane, int j) {
    const int kq = 8 * (lane >> 4) + j, cl = lane & 15;
    if (f < 4)  return in[21][(size_t)l * 32 * 512 + (size_t)kq * 512 + 64 * w + 16 * f + cl];
    if (f < 8)  return in[23][(size_t)l * 32 * 512 + (size_t)kq * 512 + 64 * w + 16 * (f - 4) + cl];
    if (f < 16) { const int ct = (f - 8) >> 1, ks = (f - 8) & 1; return in[24][(size_t)l * 64 * 512 + (size_t)(32 * ks + kq) * 512 + 64 * w + 16 * ct + cl]; }
    { const int ct = (f - 16) >> 1, ks = (f - 16) & 1, gt = w >> 2, g = w & 3; return in[gt ? 13 : 11][(size_t)l * 16384 + (size_t)g * 4096 + (size_t)(32 * ks + kq) * 64 + 16 * ct + cl]; }
}
__device__ __forceinline__ void phase_frag(Frame& F, const float* const* in) {
    const int gt = F.vcu * (NWAVES * 64) + F.tid, NT = GRID * NWAVES * 64;
    bf16* FR = (bf16*)(F.ws + WS_FRAG);
    for (int i = gt; i < NLAYER * 8 * FR_PER_WAVE * 64 * 8; i += NT) { const int j = i & 7, lane = (i >> 3) & 63, f = (i >> 9) % FR_PER_WAVE, w = ((i >> 9) / FR_PER_WAVE) & 7, l = (i >> 9) / (FR_PER_WAVE * 8);
        FR[i] = (bf16)f2bf(frag_src(in, l, w, f, lane, j)); }
}
__device__ __forceinline__ bf16x8v pack8(const float (&v)[8]) { v4u u; u.x = pk2(v[0], v[1]); u.y = pk2(v[2], v[3]); u.z = pk2(v[4], v[5]); u.w = pk2(v[6], v[7]); return __builtin_bit_cast(bf16x8v, u); }
__device__ __forceinline__ void unpack8(const v4u& u, float (&v)[8]) { v[0] = bf2f(u.x & 0xffffu); v[1] = bf2f(u.x >> 16); v[2] = bf2f(u.y & 0xffffu); v[3] = bf2f(u.y >> 16); v[4] = bf2f(u.z & 0xffffu); v[5] = bf2f(u.z >> 16); v[6] = bf2f(u.w & 0xffffu); v[7] = bf2f(u.w >> 16); }
__device__ __forceinline__ void phase_mix_prep(Frame& F, const float* pk, int layer) {
    { int ln_ = F.tid & 63; asm volatile("" : "+v"(ln_)); F.lane = ln_; }
    LAS float* U = (LAS float*)F.lds;
    LAS float* GT = U + 16 * 256;
    const int tid = F.tid, lane = F.lane, w = F.wave, fr = lane & 15, fq = lane >> 4;
    const bf16* P = ((bf16*)(F.ws + WS_OV + OV_P)); bf16* Y = ((bf16*)(F.ws + WS_XN));
    bf16x8v Bf[FR_PER_WAVE];
    { const v4u* fp = (const v4u*)(F.ws + WS_FRAG + (size_t)layer * FRAG_LAYER_BYTES) + (size_t)w * FR_PER_WAVE * 64 + lane;
#pragma unroll
        for (int f = 0; f < FR_PER_WAVE; ++f) Bf[f] = __builtin_bit_cast(bf16x8v, fp[f * 64]); }
    const int gtp = w >> 2, gblk = w & 3;
    for (int tile = blockIdx.x; tile < 256; tile += GRID) {
        const int b = tile >> 5, c = tile & 31;
        const int s_begin = c == 0 ? 0 : NMETA + 64 * c, nsub = c == 0 ? 5 : 4;
        float hloc = 0.f, caloc = 1.f;
        const float spl = tid < 256 ? softplusf_(-pk[PK_LAM + tid]) : 0.f;
        for (int sub = 0; sub < nsub; ++sub) {
            const int s0 = s_begin + 16 * sub;
            v4u cur[4], prv[4]; unsigned zz = 0u; asm volatile("" : "+v"(zz));
            { const int s = s0 + fr; const bf16* pc = P + (size_t)row_of(b, s) * NINP + PC_LO + 8 * fq; const bf16* pp = P + (size_t)row_of(b, s > 0 ? s - 1 : 0) * NINP + PC_LO + 8 * fq;
#pragma unroll
                for (int f = 0; f < 4; ++f) { cur[f] = *(const v4u*)(pc + 32 * f); prv[f] = *(const v4u*)(pp + 32 * f); if (s == 0) prv[f] = (v4u){zz, zz, zz, zz}; } }
            { bf16x8v Af[4];
#pragma unroll
                for (int f = 0; f < 4; ++f) { float cv[8], pv[8], zv[8]; unpack8(cur[f], cv); unpack8(prv[f], pv);
                    const f32x4v m0 = *(const f32x4v*)(pk + PK_MU + 1536 + 32 * f + 8 * fq), m1 = *(const f32x4v*)(pk + PK_MU + 1536 + 32 * f + 8 * fq + 4);
#pragma unroll
                    for (int j = 0; j < 8; ++j) { const float mu = j < 4 ? m0[j & 3] : m1[j & 3]; const float z = cv[j] + (pv[j] - cv[j]) * mu; zv[j] = f == 0 ? tanhf_(z) : (f == 1 ? z : sigmoidf_(z)); }
                    Af[f] = pack8(zv); }
                const f32x4v zero = (f32x4v){0.f, 0.f, 0.f, 0.f};
#pragma unroll
                for (int ct = 0; ct < 4; ++ct) { const int n = 64 * w + 16 * ct + fr;
                    const f32x4v aw = __builtin_amdgcn_mfma_f32_16x16x32_bf16(Af[0], Bf[ct], zero, 0, 0, 0);
                    const f32x4v aa = __builtin_amdgcn_mfma_f32_16x16x32_bf16(Af[1], Bf[4 + ct], zero, 0, 0, 0);
                    f32x4v ag = __builtin_amdgcn_mfma_f32_16x16x32_bf16(Af[2], Bf[8 + 2 * ct], zero, 0, 0, 0); ag = __builtin_amdgcn_mfma_f32_16x16x32_bf16(Af[3], Bf[9 + 2 * ct], ag, 0, 0, 0);
                    const float w0n = pk[PK_W0 + n], a0n = pk[PK_A0 + n];
#pragma unroll
                    for (int i = 0; i < 4; ++i) { const size_t ro = (size_t)row_of(b, s0 + 4 * fq + i) * 512 + n;
                        const float wl = -softplusf_(-(w0n + aw[i])) - 0.5f;
                        ((float*)(F.ws + WS_OV + OV_WDEC))[ro] = __expf(-__expf(wl)); ((bf16*)(F.ws + WS_OV + OV_ABUF))[ro] = (bf16)f2bf(sigmoidf_(a0n + aa[i])); ((bf16*)(F.ws + WS_WB))[ro] = (bf16)f2bf(ag[i]); } } }
            for (int idx = tid; idx < 16 * 256; idx += NWAVES * 64) { const int t = idx >> 8, ch = idx & 255, s = s0 + t;
                float u = pk[PK_CONVB + ch];
#pragma unroll
                for (int k = 0; k < 4; ++k) { const int sp = s - 3 + k; if (sp >= 0) u += bf2f(P[(size_t)row_of(b, sp) * NINP + PC_LRUX + ch]) * pk[PK_CONVW + k * 256 + ch]; }
                U[idx] = u; }
            { float yv[8];
#pragma unroll
                for (int it = 0; it < 8; ++it) { const int idx = it * (NWAVES * 64) + tid, t = idx >> 8, ch = idx & 255, s = s0 + t; const size_t ro = (size_t)row_of(b, s);
                    float conv = 0.f;
#pragma unroll
                    for (int k = 0; k < 3; ++k) { const int sp = s - 2 + k; if (sp >= 0) { const size_t rr = (size_t)row_of(b, sp) * NINP; conv += bf2f(P[rr + PC_SCC + ch]) * bf2f(P[rr + PC_SCX + ch]) * pk[PK_SCW + k * 256 + ch]; } }
                    yv[it] = bf2f(P[ro * NINP + PC_SCB + ch]) * conv; }
#pragma unroll
                for (int it = 0; it < 8; ++it) { const int idx = it * (NWAVES * 64) + tid, t = idx >> 8, ch = idx & 255, s = s0 + t; const size_t ro = (size_t)row_of(b, s);
                    const float ss = wave_sum(yv[it] * yv[it]);
                    Y[ro * D + 256 + ch] = (bf16)f2bf(yv[it] * rsqrtf(ss * (1.0f / 64.0f) + RMS_EPS) * pk[PK_SCG + ch]); } }
            __syncthreads();
            { bf16x8v Al[2];
#pragma unroll
                for (int ks = 0; ks < 2; ++ks) { const LAS float* up = U + fr * 256 + 64 * gblk + 32 * ks + 8 * fq; const f32x4v u0 = *(const LAS f32x4v*)up, u1 = *(const LAS f32x4v*)(up + 4);
                    const float uv[8] = {u0.x, u0.y, u0.z, u0.w, u1.x, u1.y, u1.z, u1.w}; Al[ks] = pack8(uv); }
                const f32x4v zero = (f32x4v){0.f, 0.f, 0.f, 0.f};
#pragma unroll
                for (int ct = 0; ct < 4; ++ct) { const int j = 64 * gblk + 16 * ct + fr;
                    f32x4v ac = __builtin_amdgcn_mfma_f32_16x16x32_bf16(Al[0], Bf[16 + 2 * ct], zero, 0, 0, 0); ac = __builtin_amdgcn_mfma_f32_16x16x32_bf16(Al[1], Bf[17 + 2 * ct], ac, 0, 0, 0);
                    const float bias = pk[(gtp ? PK_BX : PK_BA) + j];
#pragma unroll
                    for (int i = 0; i < 4; ++i) GT[(gtp * 16 + 4 * fq + i) * 256 + j] = sigmoidf_(ac[i] + bias); } }
            __syncthreads();
#pragma unroll
            for (int it = 0; it < 8; ++it) { const int idx = it * (NWAVES * 64) + tid, ch = idx & 255;
                const float r = GT[idx], ig = GT[16 * 256 + idx], u = U[idx];
                const float la = -8.0f * r * softplusf_(-pk[PK_LAM + ch]), a = __expf(la), x2 = 2.0f * la;
                const float om = x2 < -0.25f ? (1.0f - __expf(x2)) : -x2 * (1.0f + x2 * (0.5f + x2 * (0.16666667f + x2 * (0.041666668f + x2 * 0.0083333338f))));
                const float bt = __builtin_amdgcn_sqrtf(om) * (ig * u);
                GT[idx] = a; GT[16 * 256 + idx] = bt; }
            __syncthreads();
            if (tid < 256) { const int j = tid;
#pragma unroll
                for (int t = 0; t < 16; ++t) { const float a = GT[t * 256 + j], bt = GT[(16 + t) * 256 + j];
                    hloc = a * hloc + bt; caloc *= a;
                    const size_t ro = (size_t)row_of(b, s0 + t) * 256 + j; ((float*)(F.ws + WS_OV + OV_HL))[ro] = hloc; ((float*)(F.ws + WS_OV + OV_CA))[ro] = caloc; } }
        }
        if (tid < 256) { ((float*)(F.ws + WS_AGG))[((size_t)(b * 32 + c) * 256 + tid) * 2 + 0] = caloc; ((float*)(F.ws + WS_AGG))[((size_t)(b * 32 + c) * 256 + tid) * 2 + 1] = hloc; }
        (void)spl;
        __syncthreads();
    }
}

constexpr int SC_CH = 24, SC_NCH = TT / SC_CH, SC_LW = SC_CH / 4, SC_STEPF = 336, SC_BUFF = SC_CH * SC_STEPF;
constexpr int SC_VJ = (SC_LW * 16 + 63) / 64;
static_assert(SC_NCH * SC_CH == TT && 2 * SC_BUFF * 4 <= RING_BYTES, "scan geometry");
struct ScanRegs { unsigned rr[SC_LW + 1], kk[SC_LW + 1], aa[SC_LW]; float ww[SC_LW]; unsigned vc[SC_VJ], vp[SC_VJ]; };
__device__ __forceinline__ void scan_load(const Frame& F, ScanRegs& R, int b, int h, int q, int lw, int chunk, unsigned lane) {
    const int t0 = chunk * SC_CH + SC_LW * lw;
    const bf16* P = ((bf16*)(F.ws + WS_OV + OV_P)); const bf16* AB = ((bf16*)(F.ws + WS_OV + OV_ABUF)); const float* WD = ((float*)(F.ws + WS_OV + OV_WDEC));
#pragma unroll
    for (int m = 0; m < SC_LW + 1; ++m) { const int s = t0 - 1 + m;
        if (s >= 0) { const bf16* rowp = P + (size_t)row_of(b, s) * NINP + h * 64; R.rr[m] = rowp[PC_R + lane]; R.kk[m] = rowp[PC_K + lane]; } else { R.rr[m] = 0u; R.kk[m] = 0u; } }
#pragma unroll
    for (int i = 0; i < SC_LW; ++i) { const size_t ro = (size_t)row_of(b, t0 + i) * 512 + h * 64; R.aa[i] = (AB + ro)[lane]; R.ww[i] = (WD + ro)[lane]; }
#pragma unroll
    for (int j = 0; j < SC_VJ; ++j) { const int st0 = 4 * j; const unsigned st = st0 + (lane >> 4), rw = lane & 15; R.vc[j] = 0u; R.vp[j] = 0u;
        if (st < (unsigned)SC_LW) { const int s = t0 + (int)st; const unsigned col = PC_V + h * 64 + 16 * q + rw; R.vc[j] = P[(size_t)row_of(b, s) * NINP + col]; if (s > 0) R.vp[j] = P[(size_t)row_of(b, s - 1) * NINP + col]; } }
}
__device__ __forceinline__ void scan_emit(const ScanRegs& R, LAS float* buf, int lw, unsigned lane, float mu_r, float mu_k, float kk_n, float ka_n, float mu_v) {
    LAS float* lb = buf + SC_LW * lw * SC_STEPF + lane; asm volatile("" : "+v"(lb));
#pragma unroll
    for (int i = 0; i < SC_LW; ++i) { LAS float* sp = lb + i * SC_STEPF;
        const float rc = bf2f(R.rr[i + 1]), rp = bf2f(R.rr[i]), kc = bf2f(R.kk[i + 1]), kp = bf2f(R.kk[i]);
        const float zr = rc + (rp - rc) * mu_r, zk = kc + (kp - kc) * mu_k, a = bf2f(R.aa[i]);
        const float kv = zk * kk_n; const float ss = wave_sum_dpp(kv * kv); const float kn = kv * rsqrtf(fmaxf(ss, 1e-24f));
        sp[0] = zr; sp[64] = R.ww[i]; sp[128] = zk * (1.0f + (a - 1.0f) * ka_n); sp[192] = -kn; sp[256] = kn * a; }
#pragma unroll
    for (int j = 0; j < SC_VJ; ++j) { const unsigned st = 4 * j + (lane >> 4), rw = lane & 15;
        if (st < (unsigned)SC_LW) { const float vc = bf2f(R.vc[j]), vp = bf2f(R.vp[j]); buf[(SC_LW * lw + st) * SC_STEPF + 320 + rw] = vc + (vp - vc) * mu_v; } }
}
typedef float f32x2 __attribute__((ext_vector_type(2)));
struct ScanOps { f32x4 r4, w4, k4, n4, b4; float v; };
__device__ __forceinline__ void scan_ops_load(ScanOps& o, const LAS float* lp, const LAS float* vp) {
    o.r4 = *(const LAS f32x4*)(lp); o.w4 = *(const LAS f32x4*)(lp + 64); o.k4 = *(const LAS f32x4*)(lp + 128);
    o.n4 = *(const LAS f32x4*)(lp + 192); o.b4 = *(const LAS f32x4*)(lp + 256); o.v = *vp; }
#define LO2(v) ((f32x2){(v).x, (v).y})
#define HI2(v) ((f32x2){(v).z, (v).w})
__device__ __forceinline__ float dot4p(const f32x2& a0, const f32x2& a1, const f32x4& b) { f32x2 t = a0 * LO2(b); t = a1 * HI2(b) + t; return t.x + t.y; }
__device__ __forceinline__ float scan_step(f32x2& S0, f32x2& S1, const ScanOps& o, float& q) {
    float p = dot4p(S0, S1, o.n4), y = q;
    p += dppf<0xB1>(p); y += dppf<0xB1>(y); p += dppf<0x4E>(p); y += dppf<0x4E>(y); p += dppf<0x141>(p); y += dppf<0x141>(y); p += dppf<0x128>(p); y += dppf<0x128>(y);
    const f32x2 vv = (f32x2){o.v, o.v}, sa = (f32x2){p, p};
    S0 = LO2(o.b4) * sa + (S0 * LO2(o.w4) + LO2(o.k4) * vv); S1 = HI2(o.b4) * sa + (S1 * HI2(o.w4) + HI2(o.k4) * vv);
    q = dot4p(S0, S1, o.r4);
    return y; }
constexpr int SC_YB = SC_CH * 16;
static_assert((2 * SC_BUFF + 2 * SC_YB + 256) * 4 <= RING_BYTES, "scan LDS");
__device__ __forceinline__ void scan_flush(const Frame& F, const LAS float* yb, int b, int h, int q, int chunk, int ltid) {
    bf16* Y = ((bf16*)(F.ws + WS_XN));
#pragma unroll
    for (int j = 0; j < (SC_YB + 255) / 256; ++j) { const int idx = ltid + 256 * j; if (idx < SC_YB) { const int st = idx >> 4, rw = idx & 15;
        Y[(size_t)row_of(b, chunk * SC_CH + st) * D + 512 + h * 64 + 16 * q + rw] = (bf16)f2bf(yb[idx]); } }
}
__device__ __forceinline__ void phase_scan(Frame& F, const float* pk) {
    { int ln_ = F.tid & 63; asm volatile("" : "+v"(ln_)); F.lane = ln_; }
    LAS float* buf0 = (LAS float*)F.lds; LAS float* buf1 = buf0 + SC_BUFF; LAS float* yb0 = buf1 + SC_BUFF; LAS float* yb1 = yb0 + SC_YB; LAS float* dummy = yb1 + SC_YB;
    const unsigned lane = F.lane; const int wave = F.wave;
    for (int item = blockIdx.x; item < 256; item += GRID) {
        const int b = item >> 5, h = (item >> 2) & 7, q = item & 3;
        if (wave >= 4) {
            const int lw = wave - 4, n = h * 64 + lane, ltid = lw * 64 + lane;
            const float mu_r = pk[PK_MU + n], mu_k = pk[PK_MU + 512 + n], kk_n = pk[PK_KK + n], ka_n = pk[PK_KA + n];
            const float mu_v = pk[PK_MU + 1024 + h * 64 + 16 * q + (lane & 15)];
            ScanRegs A, B;
            scan_load(F, A, b, h, q, lw, 0, lane); scan_load(F, B, b, h, q, lw, 1, lane);
            scan_emit(A, buf0, lw, lane, mu_r, mu_k, kk_n, ka_n, mu_v);
            __syncthreads();
            for (int c = 0; c < SC_NCH; ++c) {
                if ((c & 1) == 0) { if (c + 2 < SC_NCH) scan_load(F, A, b, h, q, lw, c + 2, lane); if (c + 1 < SC_NCH) scan_emit(B, buf1, lw, lane, mu_r, mu_k, kk_n, ka_n, mu_v); }
                else              { if (c + 2 < SC_NCH) scan_load(F, B, b, h, q, lw, c + 2, lane); if (c + 1 < SC_NCH) scan_emit(A, buf0, lw, lane, mu_r, mu_k, kk_n, ka_n, mu_v); }
                if (c > 0) scan_flush(F, ((c - 1) & 1) ? yb1 : yb0, b, h, q, c - 1, ltid);
                __syncthreads();
            }
            scan_flush(F, ((SC_NCH - 1) & 1) ? yb1 : yb0, b, h, q, SC_NCH - 1, ltid);
        } else {
            const int kq = lane & 15, rowl = 4 * wave + (lane >> 4);
            f32x2 S0 = (f32x2){0.f, 0.f}, S1 = S0;
            __syncthreads();
            for (int c = 0; c < SC_NCH; ++c) {
                const LAS float* bp = (c & 1) ? buf1 : buf0;
                LAS float* yw = kq == 0 ? (((c & 1) ? yb1 : yb0) + rowl) : (dummy + lane);
                const int ystep = kq == 0 ? 16 : 0;
                ScanOps oa, ob; float qp = 0.f;
                const LAS float* lp = bp + 4 * kq; const LAS float* vp = bp + 320 + rowl;
                asm volatile("" : "+v"(lp), "+v"(vp), "+v"(yw));
                scan_ops_load(oa, lp, vp);
                scan_ops_load(ob, lp + SC_STEPF, vp + SC_STEPF);
                (void)scan_step(S0, S1, oa, qp);
#pragma unroll 2
                for (int i = 1; i < SC_CH - 1; i += 2) {
                    scan_ops_load(oa, lp + (i + 1) * SC_STEPF, vp + (i + 1) * SC_STEPF);
                    const float y0 = scan_step(S0, S1, ob, qp); yw[(i - 1) * ystep] = y0;
                    scan_ops_load(ob, lp + (i + 2) * SC_STEPF, vp + (i + 2) * SC_STEPF);
                    const float y1 = scan_step(S0, S1, oa, qp); yw[i * ystep] = y1;
                }
                { const float y2 = scan_step(S0, S1, ob, qp); yw[(SC_CH - 2) * ystep] = y2; }
                yw[(SC_CH - 1) * ystep] = red16(qp);
                __syncthreads();
            }
        }
        __syncthreads();
    }
}

__device__ __forceinline__ void unpack4(unsigned long long u, float (&v)[4]) { v[0] = bf2f((unsigned)u & 0xffffu); v[1] = bf2f(((unsigned)u >> 16)); v[2] = bf2f((unsigned)(u >> 32) & 0xffffu); v[3] = bf2f((unsigned)(u >> 48)); }
__device__ __forceinline__ void phase_mix_final(Frame& F, const float* pk) {
    { int ln_ = F.tid & 63; asm volatile("" : "+v"(ln_)); F.lane = ln_; }
    LAS float* carry = (LAS float*)F.lds;
    const int tid = F.tid, lane = F.lane, w = F.wave, rg = lane >> 4, kq = lane & 15;
    const bf16* P = ((bf16*)(F.ws + WS_OV + OV_P)); bf16* Y = ((bf16*)(F.ws + WS_XN));
    const bf16* AB = ((bf16*)(F.ws + WS_OV + OV_ABUF)); const bf16* GB = ((bf16*)(F.ws + WS_WB)); const float* HLp = ((float*)(F.ws + WS_OV + OV_HL)); const float* CAp = ((float*)(F.ws + WS_OV + OV_CA));
    const int n0 = w * 64 + 4 * kq;
    const f32x4 mu_r = *(const f32x4*)(pk + PK_MU + n0), mu_k = *(const f32x4*)(pk + PK_MU + 512 + n0), mu_v = *(const f32x4*)(pk + PK_MU + 1024 + n0);
    const f32x4 ka4 = *(const f32x4*)(pk + PK_KA + n0), rk4 = *(const f32x4*)(pk + PK_RK + n0), lw4 = *(const f32x4*)(pk + PK_LNW + n0), lb4 = *(const f32x4*)(pk + PK_LNB + n0);
    const f32x4 ng4 = w < 4 ? *(const f32x4*)(pk + PK_LNG + n0) : (f32x4){0.f, 0.f, 0.f, 0.f};
    for (int tile = blockIdx.x; tile < 256; tile += GRID) {
        const int b = tile >> 5, c = tile & 31;
        const int s_begin = c == 0 ? 0 : NMETA + 64 * c, ntok = c == 0 ? 80 : 64;
        if (tid < 256) {
            const float* ag = ((float*)(F.ws + WS_AGG)) + ((size_t)(b * 32) * 256 + tid) * 2; float ca[32], hh[32];
#pragma unroll
            for (int c2 = 0; c2 < 31; ++c2) { ca[c2] = 0.f; hh[c2] = 0.f; if (c2 < c) { const f32x2v_ t2 = *(const f32x2v_*)(ag + (size_t)c2 * 512); ca[c2] = t2.x; hh[c2] = t2.y; } }
            float hc = 0.f;
#pragma unroll
            for (int c2 = 0; c2 < 31; ++c2) if (c2 < c) hc = ca[c2] * hc + hh[c2];
            carry[tid] = hc; }
        __syncthreads();
        f32x4 cr4 = (f32x4){0.f, 0.f, 0.f, 0.f}; if (w < 4) cr4 = *(const LAS f32x4*)(carry + n0);
        for (int tg = 0; tg < ntok; tg += 16) {
            unsigned long long rc[4], kc[4], vc[4], rp[4], kp[4], vp[4], av[4], yv[4], gv[4], lg[4]; f32x4 hl[4], cav[4];
#pragma unroll
            for (int u = 0; u < 4; ++u) { const int s = s_begin + tg + 4 * u + rg; const size_t ro = (size_t)row_of(b, s); const bf16* pr = P + ro * NINP + n0;
                rc[u] = *(const unsigned long long*)(pr + PC_R); kc[u] = *(const unsigned long long*)(pr + PC_K); vc[u] = *(const unsigned long long*)(pr + PC_V); rp[u] = 0ull; kp[u] = 0ull; vp[u] = 0ull;
                if (s > 0) { const bf16* pp = P + (size_t)row_of(b, s - 1) * NINP + n0; rp[u] = *(const unsigned long long*)(pp + PC_R); kp[u] = *(const unsigned long long*)(pp + PC_K); vp[u] = *(const unsigned long long*)(pp + PC_V); }
                av[u] = *(const unsigned long long*)(AB + ro * 512 + n0); yv[u] = *(const unsigned long long*)(Y + ro * D + 512 + n0); gv[u] = *(const unsigned long long*)(GB + ro * 512 + n0);
                lg[u] = 0ull; hl[u] = (f32x4){0.f, 0.f, 0.f, 0.f}; cav[u] = hl[u];
                if (w < 4) { lg[u] = *(const unsigned long long*)(pr + PC_LRUG); hl[u] = *(const f32x4*)(HLp + ro * 256 + n0); cav[u] = *(const f32x4*)(CAp + ro * 256 + n0); } }
#pragma unroll
            for (int u = 0; u < 4; ++u) { const int s = s_begin + tg + 4 * u + rg; const size_t ro = (size_t)row_of(b, s);
                float r_c[4], k_c[4], v_c[4], r_p[4], k_p[4], v_p[4], a4[4], y4[4], g4[4];
                unpack4(rc[u], r_c); unpack4(kc[u], k_c); unpack4(vc[u], v_c); unpack4(rp[u], r_p); unpack4(kp[u], k_p); unpack4(vp[u], v_p); unpack4(av[u], a4); unpack4(yv[u], y4); unpack4(gv[u], g4);
                float zv[4], cbp = 0.f, ysum = 0.f;
#pragma unroll
                for (int j = 0; j < 4; ++j) { const float zr = r_c[j] + (r_p[j] - r_c[j]) * mu_r[j], zk = k_c[j] + (k_p[j] - k_c[j]) * mu_k[j]; zv[j] = v_c[j] + (v_p[j] - v_c[j]) * mu_v[j];
                    cbp += zr * (zk * (1.0f + (a4[j] - 1.0f) * ka4[j])) * rk4[j]; ysum += y4[j]; }
                const float cb = red16(cbp), mean = red16(ysum) * (1.0f / 64.0f);
                float d4[4], vs = 0.f;
#pragma unroll
                for (int j = 0; j < 4; ++j) { d4[j] = y4[j] - mean; vs += d4[j] * d4[j]; }
                const float rstd = rsqrtf(red16(vs) * (1.0f / 64.0f) + LNX_EPS);
                float o4[4];
#pragma unroll
                for (int j = 0; j < 4; ++j) o4[j] = (d4[j] * rstd * lw4[j] + lb4[j] + cb * zv[j]) * g4[j];
                *(GAS unsigned long long*)(Y + ro * D + 512 + n0) = (unsigned long long)pk2(o4[0], o4[1]) | ((unsigned long long)pk2(o4[2], o4[3]) << 32);
                if (w < 4) { float l4[4], yy[4], ss = 0.f; unpack4(lg[u], l4);
#pragma unroll
                    for (int j = 0; j < 4; ++j) { yy[j] = gelu_tanh(l4[j]) * (hl[u][j] + cav[u][j] * cr4[j]); ss += yy[j] * yy[j]; }
                    const float rs = rsqrtf(red16(ss) * (1.0f / 64.0f) + RMS_EPS);
                    *(GAS unsigned long long*)(Y + ro * D + n0) = (unsigned long long)pk2(yy[0] * rs * ng4[0], yy[1] * rs * ng4[1]) | ((unsigned long long)pk2(yy[2] * rs * ng4[2], yy[3] * rs * ng4[3]) << 32); } }
        }
        __syncthreads();
    }
}
#ifndef MK_PER_PHASE
#define MK_PER_PHASE 0
#endif
constexpr unsigned PROBE_MASK = 0u, PROBE_AMP = 8u; constexpr int PROBE_SUB = -1;
constexpr int REP_GEMM = 1, REP_PREP = 1, REP_SCAN = 1, REP_CONV = 1;
constexpr int PH_PER_LAYER = 12, N_PHASES = 1 + NLAYER * PH_PER_LAYER;
struct Args { const float* in[30]; float* out; unsigned char* ws; int ph_lo, ph_hi; };
static_assert(sizeof(Args) == 30 * 8 + 8 + 8 + 4 + 4, "Args has no padding");

__global__ void __launch_bounds__(NWAVES * 64, 2) hybrid_fwd(Args args) {
    extern __shared__ __attribute__((aligned(16))) unsigned char lds[];
    Frame F;
    F.lds = (LAS unsigned char*)lds;
    F.tid = threadIdx.x; F.lane = F.tid & 63; F.wave = 0;
    { const int bx = blockIdx.x; F.vcu = (bx % 8) * (GRID / 8) + bx / 8; }
    unsigned char* ws = args.ws;
    F.ws = ws; F.x = args.in[0]; F.meta = args.in[1]; F.out = args.out;
    volatile LAS unsigned* MISC = (volatile LAS unsigned*)(F.lds + MISC_OFF);
    for (int u = F.tid; u < (LDS_BYTES - LDSCTL_OFF) / 4; u += NWAVES * 64) ((LAS unsigned*)(F.lds + LDSCTL_OFF))[u] = 0u;
    __syncthreads();
    { const unsigned simd = ((unsigned)__builtin_amdgcn_s_getreg((1 << 11) | (4 << 6) | 4)) & 3u;
      unsigned tk = 0u; if (vlane() == 0) tk = __hip_atomic_fetch_add((LAS unsigned*)(F.lds + MISC_OFF) + 12 + simd, 1u, __ATOMIC_RELAXED, __HIP_MEMORY_SCOPE_WORKGROUP); F.wave = (int)(simd + 4u * ((unsigned)__builtin_amdgcn_readfirstlane(tk) & 1u)); }
    F.lane = vlane(); F.tid = F.wave * 64 + F.lane;
    XcdBarrier bar; bar.bar = (unsigned*)(ws + WS_CTL) + CW_BAR; bar.x = 0; bar.st = nullptr;
    if (!MK_PER_PHASE) bar = xcd_barrier_post((unsigned*)(ws + WS_CTL) + CW_BAR, MISC + 8, F.tid == 0);
    const int lo = args.ph_lo, hi = args.ph_hi;
    unsigned long long pr_prev = 0ull, pr_acc = 0ull, pr_sub = 0ull; if (PROBE_MASK) pr_prev = __builtin_amdgcn_s_memrealtime();
#define PSTAMP(j) do { if (PROBE_MASK && PROBE_SUB >= 0) { const unsigned long long t_ = __builtin_amdgcn_s_memrealtime(); if (PROBE_SUB == (j) && ((PROBE_MASK >> ph) & 1u)) pr_acc += t_ - pr_sub; pr_sub = t_; } } while (0)
#pragma unroll 1
    for (int ph = lo; ph < hi; ++ph) {
        { GAS unsigned char* wsg = (GAS unsigned char*)args.ws; asm volatile("" : "+s"(wsg)); F.ws = (unsigned char*)wsg; }
        { int t_ = F.wave * 64 + vlane(); asm volatile("" : "+v"(t_)); F.tid = t_; }
        if (ph == 0) { phase_init(F, args.in[2]); phase_pack(F, args.in); phase_frag(F, args.in); for (int rep_ = 0; rep_ < REP_CONV; ++rep_) phase_convert(F, args.in, 0); }
        else {
            const int l = (ph - 1) / PH_PER_LAYER, k = (ph - 1) - l * PH_PER_LAYER;
            if (k == 0 || k == 1 || k == 3 || k == 7 || k == 9 || k == 10) {
                unsigned char* w = F.ws;
                const bool up = (k == 0 || k == 9), down = (k == 1 || k == 10);
                const bf16* A = (const bf16*)(w + (down ? WS_OV + OV_HID : WS_XN));
                const bf16* B = (const bf16*)(w + WS_WB + (k == 0 ? WB_W1IN : k == 1 ? WB_W1OUT : k == 3 ? WB_WIN : k == 7 ? WB_WOUT : k == 9 ? WB_W2IN : WB_W2OUT));
                const int N = up ? 2 * FF : (k == 3 ? NINP : D), K = down ? FF : D;
                pg8::EpiAny E; E.mode = up ? 0 : (k == 3 ? 1 : 2); E.O = w + WS_OV + (up ? OV_HID : k == 3 ? OV_P : k == 7 ? OV_RAWM : OV_RAWF); E.ldo = up ? FF : (k == 3 ? NINP : D);
                pg8::Gemm g{A, B, MP, N, K, K}; pg8::StaticOrder S; S.init(MP, N, GRID, (int)blockIdx.x);
                for (int rep_ = 0; rep_ < REP_GEMM; ++rep_) pg8::gemm_phase<pg8::EpiAny, pg8::StaticOrder, true, true>(F.lds, g, S, E, F.tid);
            } else if (k == 2 || k == 8 || k == 11) {
                const float* ng = args.in[2] + (size_t)l * 6 * D;
                const float* raw = (const float*)(F.ws + WS_OV + (k == 8 ? OV_RAWM : OV_RAWF));
                const float* g_post = ng + (k == 2 ? 1 : k == 8 ? 3 : 5) * D;
                const float* g_pre = k == 2 ? ng + 2 * D : k == 8 ? ng + 4 * D : (l + 1 < NLAYER ? ng + 6 * D : nullptr);
                phase_post(F, raw, (l == 0 && k == 2) ? F.x : F.out, k == 8 ? 1.0f : 0.5f, g_post, g_pre);
                if (k == 11 && l + 1 < NLAYER) for (int rep_ = 0; rep_ < REP_CONV; ++rep_) phase_convert(F, args.in, l + 1);
            } else if (k == 4) { for (int rep_ = 0; rep_ < REP_PREP; ++rep_) phase_mix_prep(F, pack_of(F, l), l); }
            else if (k == 5) { for (int rep_ = 0; rep_ < REP_SCAN; ++rep_) phase_scan(F, pack_of(F, l)); }
            else { phase_mix_final(F, pack_of(F, l)); }
        }
        if (ph + 1 < hi) xcd_barrier(bar, F.tid == 0);
        if (PROBE_MASK) { const unsigned long long t = __builtin_amdgcn_s_memrealtime(); if (PROBE_SUB < 0 && ((PROBE_MASK >> ph) & 1u)) pr_acc += t - pr_prev; pr_prev = t; pr_sub = t; }
    }
    if (PROBE_MASK && blockIdx.x == 0 && F.tid == 0) { const unsigned long long t0 = __builtin_amdgcn_s_memrealtime(); while (__builtin_amdgcn_s_memrealtime() - t0 < PROBE_AMP * pr_acc) __builtin_amdgcn_s_sleep(8); }
}

extern "C" void kernel_launch(void* const* d_in, const int* in_sizes, int n_in, void* d_out, int out_size, void* d_ws, size_t ws_size, hipStream_t stream) {
    static int grid = 0;
    if (grid == 0) {
        if (n_in != 30 || in_sizes[0] != MX * D || out_size != MX * D || ws_size < WS_END) { fprintf(stderr, "kernel_launch: unexpected shapes: n_in %d in0 %d out %d ws %zu\n", n_in, n_in > 0 ? in_sizes[0] : -1, out_size, ws_size); grid = -1; return; }
        int dev = 0, cus = 0, per_cu = 0;
        if (hipGetDevice(&dev) != hipSuccess || hipDeviceGetAttribute(&cus, hipDeviceAttributeMultiprocessorCount, dev) != hipSuccess) { grid = -1; return; }
        if (hipFuncSetAttribute((const void*)hybrid_fwd, hipFuncAttributeMaxDynamicSharedMemorySize, LDS_BYTES) != hipSuccess) { fprintf(stderr, "kernel_launch: hipFuncSetAttribute failed\n"); grid = -1; return; }
        if (hipOccupancyMaxActiveBlocksPerMultiprocessor(&per_cu, (const void*)hybrid_fwd, NWAVES * 64, LDS_BYTES) != hipSuccess || per_cu < 1) { fprintf(stderr, "kernel_launch: occupancy query says %d blocks per CU\n", per_cu); grid = -1; (void)hipGetLastError(); return; }
        (void)hipGetLastError();
        if (cus < GRID) { fprintf(stderr, "kernel_launch: this kernel needs %d CUs (one resident workgroup each), the device has %d\n", GRID, cus); grid = -1; return; }
        grid = GRID;
    }
    if (grid < 0) return;
    if (hipMemsetAsync((char*)d_ws + WS_CTL, 0, CTL_ZERO_BYTES, stream) != hipSuccess) return;
    Args a{};
    for (int i = 0; i < 30; ++i) a.in[i] = (const float*)d_in[i];
    a.out = (float*)d_out; a.ws = (unsigned char*)d_ws;
#if MK_PER_PHASE
    for (int p = 0; p < N_PHASES; ++p) { a.ph_lo = p; a.ph_hi = p + 1; hipLaunchKernelGGL(hybrid_fwd, dim3(grid), dim3(NWAVES * 64), LDS_BYTES, stream, a); }
#else
    a.ph_lo = 0; a.ph_hi = N_PHASES;
    hipLaunchKernelGGL(hybrid_fwd, dim3(grid), dim3(NWAVES * 64), LDS_BYTES, stream, a);
#endif
}
```

```cpp
#include <hip/hip_runtime.h>
#include <cstdio>
#include <cstdint>
namespace pg8 {
#define PG8_LAS __attribute__((address_space(3)))
typedef unsigned short bf16_t;
typedef short bf16x8 __attribute__((ext_vector_type(8)));
typedef float f32x4 __attribute__((ext_vector_type(4)));
typedef unsigned u32x4 __attribute__((ext_vector_type(4)));
constexpr int BM = 256, BK = 64, HALF = 128, HTB = HALF * BK * 2  , STAGE_BYTES = 8 * HTB, NXCD = 8, WGM = 8;

__host__ __device__ __forceinline__ int lds_byte(int r, int c) { const int st = (r >> 4) * 2 + (c >> 5), rr = r & 15, cc = c & 31, ob = rr * 64 + cc * 2; return st * 1024 + (ob ^ (((ob >> 9) & 1) << 5)); }
__host__ __device__ __forceinline__ void stage_rc(int b, int& R, int& C) { const int st = b / 1024, sb = b % 1024, swz = sb ^ (((sb >> 9) & 1) << 5); R = (st >> 1) * 16 + swz / 64; C = (st & 1) * 32 + (swz % 64) / 2; }
__host__ __device__ __forceinline__ int perm32(int rho) { const int n = rho >> 4, i = rho & 15; return 8 * (i >> 2) + 4 * n + (i & 3); }

struct Unit { int pm, pn; };
struct Gemm { const bf16_t* A; const bf16_t* Bt; int M, N, K, ld; };

struct StaticOrder {
    int nM, nN, nwg, G, c, one_pn;
    __host__ __device__ void init(int M, int N, int G_, int c_) { nM = M / BM; nN = N / BM; nwg = nM * nN; G = G_; c = c_; one_pn = -1; }
    __host__ __device__ bool next(int i, Unit& u) const {
        if (one_pn != -1) { if (i != 0 || one_pn < 0) return false; u.pm = 0; u.pn = one_pn; return true; }
        const long L = (long)i * G + c; if (L >= nwg) return false;
        int wgid = (int)L; { const int q = nwg / NXCD, r = nwg % NXCD, xcd = wgid % NXCD, off = wgid / NXCD; wgid = (xcd < r ? xcd * (q + 1) : r * (q + 1) + (xcd - r) * q) + off; }
        const int nig = WGM * nN, gid = wgid / nig, fm = gid * WGM, gsz = (nM - fm) < WGM ? (nM - fm) : WGM;
        u.pm = fm + ((wgid % nig) % gsz); u.pn = (wgid % nig) / gsz; return true;
    }
    __device__ __forceinline__ void a_ready(const Unit&) const {}
    __device__ __forceinline__ void done(const Unit&) const {}
};
__device__ __forceinline__ unsigned cvt_pk_bf16(float lo, float hi) { unsigned r; asm volatile("v_cvt_pk_bf16_f32 %0, %1, %2" : "=v"(r) : "v"(lo), "v"(hi)); return r; }
typedef float f32x2 __attribute__((ext_vector_type(2)));
struct EpiSwiGLU {
    static constexpr bool PERM = true, AFTER_DRAIN = false;
    bf16_t* O; int ldo;
    __device__ __forceinline__ void operator()(const f32x4 (&acc)[2][2][4][2], const Unit& u, int wr, int wc, int fr, int fq) const {
        const int row0 = u.pm * BM + wr * 64 + fr, col0 = u.pn * HALF + wc * 32 + 8 * fq;
#pragma unroll
        for (int ai = 0; ai < 2; ++ai)
#pragma unroll
            for (int m = 0; m < 4; ++m) { bf16_t* rowp = O + (size_t)(row0 + ai * HALF + m * 16) * ldo + col0;
                float hv[8];
#pragma unroll
                for (int n = 0; n < 2; ++n)
#pragma unroll
                    for (int j = 0; j < 4; ++j) { const float g = acc[ai][0][m][n][j], up = acc[ai][1][m][n][j]; hv[n * 4 + j] = g * __builtin_amdgcn_rcpf(1.0f + __expf(-g)) * up; }
                u32x4 w; w.x = cvt_pk_bf16(hv[0], hv[1]); w.y = cvt_pk_bf16(hv[2], hv[3]); w.z = cvt_pk_bf16(hv[4], hv[5]); w.w = cvt_pk_bf16(hv[6], hv[7]);
                *(u32x4*)rowp = w; }
    }
};
struct EpiStoreBf16 {
    static constexpr bool PERM = true, AFTER_DRAIN = false;
    bf16_t* O; int ldc;
    __device__ __forceinline__ void operator()(const f32x4 (&acc)[2][2][4][2], const Unit& u, int wr, int wc, int fr, int fq) const {
        const int row0 = u.pm * BM + wr * 64 + fr, col0 = u.pn * BM + wc * 32 + 8 * fq;
#pragma unroll
        for (int ai = 0; ai < 2; ++ai)
#pragma unroll
            for (int m = 0; m < 4; ++m) { bf16_t* rowp = O + (size_t)(row0 + ai * HALF + m * 16) * ldc + col0;
#pragma unroll
                for (int bj = 0; bj < 2; ++bj) { const f32x4 v0 = acc[ai][bj][m][0], v1 = acc[ai][bj][m][1];
                    u32x4 w; w.x = cvt_pk_bf16(v0[0], v0[1]); w.y = cvt_pk_bf16(v0[2], v0[3]); w.z = cvt_pk_bf16(v1[0], v1[1]); w.w = cvt_pk_bf16(v1[2], v1[3]);
                    *(u32x4*)(rowp + bj * HALF) = w; } }
    }
};
struct EpiF32 {
    static constexpr bool PERM = false, AFTER_DRAIN = false;
    float* C; int ldc;
    __device__ __forceinline__ void operator()(const f32x4 (&acc)[2][2][4][2], const Unit& u, int wr, int wc, int fr, int fq) const {
        const int row0 = u.pm * BM + wr * 64 + fr, col0 = u.pn * BM + wc * 32 + 4 * fq;
#pragma unroll
        for (int ai = 0; ai < 2; ++ai)
#pragma unroll
            for (int m = 0; m < 4; ++m) { float* rowp = C + (size_t)(row0 + ai * HALF + m * 16) * ldc + col0;
#pragma unroll
                for (int bj = 0; bj < 2; ++bj)
#pragma unroll
                    for (int n = 0; n < 2; ++n) *(f32x4*)(rowp + bj * HALF + n * 16) = acc[ai][bj][m][n]; }
    }
};
struct EpiAny {
    static constexpr bool PERM = true, AFTER_DRAIN = false;
    int mode; void* O; int ldo;
    __device__ __forceinline__ void operator()(f32x4 (&acc)[2][2][4][2], const Unit& u, int wr, int wc, int fr, int fq) const {
        if (mode == 0) { EpiSwiGLU E{(bf16_t*)O, ldo}; E(acc, u, wr, wc, fr, fq); }
        else if (mode == 1) { EpiStoreBf16 E{(bf16_t*)O, ldo}; E(acc, u, wr, wc, fr, fq); }
        else { float* C = (float*)O; const int row0 = u.pm * BM + wr * 64 + fr, col0 = u.pn * BM + wc * 32 + 8 * fq;
#pragma unroll
            for (int ai = 0; ai < 2; ++ai)
#pragma unroll
                for (int m = 0; m < 4; ++m) { float* rowp = C + (size_t)(row0 + ai * HALF + m * 16) * ldo + col0;
#pragma unroll
                    for (int bj = 0; bj < 2; ++bj)
#pragma unroll
                        for (int n = 0; n < 2; ++n) *(f32x4*)(rowp + bj * HALF + n * 4) = acc[ai][bj][m][n]; } }
    }
};
template <class Epi, class Sched, bool ALIGN_EPI = false, bool SP2 = false>
__device__ __forceinline__ void gemm_phase(PG8_LAS unsigned char* lds, const Gemm g, const Sched& S, const Epi& E, int tid_in  ) {
    int tid_ = tid_in; asm volatile("" : "+v"(tid_));
    const int tid = tid_, wid = __builtin_amdgcn_readfirstlane(tid >> 6), lane = tid & 63, wr = wid >> 2, wc = wid & 3, fr = lane & 15, fq = lane >> 4;
    const int K = g.K, LD = g.ld, nt = K / BK;
    unsigned voffA[2], voffB[2];
#pragma unroll
    for (int i = 0; i < 2; ++i) { int R, C; stage_rc(tid * 16 + i * 8192, R, C); const int Rb = Epi::PERM ? ((R & ~31) + perm32(R & 31)) : R;
        voffA[i] = (unsigned)(R * LD + C) * 2u; voffB[i] = (unsigned)(Rb * LD + C) * 2u; }
    const size_t kstep = (size_t)(BK * 2);
    const size_t hstep = (size_t)HALF * LD * 2;
    const size_t tstep = 2 * hstep;
    const unsigned ldsw = (unsigned)wid * 1024u;
    const int aoff = lds_byte(wr * 64 + fr, fq * 8), boff = lds_byte(wc * 32 + fr, fq * 8);
#define PG8_SA(b, h) (((b) * 2 + (h)) * HTB)
#define PG8_SB(b, h) ((4 + (b) * 2 + (h)) * HTB)
#define PG8_STAGE(bufoff, gbase, voff) do { _Pragma("unroll") for (int _i = 0; _i < 2; ++_i) \
        __builtin_amdgcn_global_load_lds((const unsigned*)((const char*)(gbase) + (voff)[_i]), (PG8_LAS unsigned*)(lds + (bufoff) + ldsw + _i * 8192), 16, 0, 0); } while (0)
#define PG8_LDA(dst, b, h) do { _Pragma("unroll") for (int m = 0; m < 4; ++m) _Pragma("unroll") for (int k = 0; k < 2; ++k) dst[m][k] = *(const PG8_LAS bf16x8*)(lds + PG8_SA(b, h) + aoff + m * 2048 + k * 1024); } while (0)
#define PG8_LDB(dst, b, h) do { _Pragma("unroll") for (int n = 0; n < 2; ++n) _Pragma("unroll") for (int k = 0; k < 2; ++k) dst[n][k] = *(const PG8_LAS bf16x8*)(lds + PG8_SB(b, h) + boff + n * 2048 + k * 1024); } while (0)
#define PG8_MMA(ai, bj, At, Bt) do { __builtin_amdgcn_s_setprio(1); _Pragma("unroll") for (int m = 0; m < 4; ++m) _Pragma("unroll") for (int n = 0; n < 2; ++n) _Pragma("unroll") for (int k = 0; k < 2; ++k) \
        acc[ai][bj][m][n] = __builtin_amdgcn_mfma_f32_16x16x32_bf16(Bt[n][k], At[m][k], acc[ai][bj][m][n], 0, 0, 0); __builtin_amdgcn_s_setprio(0); } while (0)
#define PG8_WAIT_V(n) asm volatile("s_waitcnt vmcnt(" #n ")" ::: "memory")
#define PG8_WAIT_L(n) asm volatile("s_waitcnt lgkmcnt(" #n ")" ::: "memory")
#define PG8_BAR __builtin_amdgcn_s_barrier()
#define PG8_SCHED __builtin_amdgcn_sched_barrier(0)
    Unit cur, nxt; int ui = 0;
    if (!S.next(0, cur)) return;
    f32x4 acc[2][2][4][2];
#pragma unroll
    for (int a = 0; a < 2; ++a)
#pragma unroll
        for (int b = 0; b < 2; ++b)
#pragma unroll
            for (int m = 0; m < 4; ++m)
#pragma unroll
                for (int n = 0; n < 2; ++n) acc[a][b][m][n] = (f32x4){0.f, 0.f, 0.f, 0.f};
    bf16x8 At[4][2], B0[2][2], B1[2][2];
    const char* cA = (const char*)g.A + (size_t)cur.pm * tstep; const char* cB = (const char*)g.Bt + (size_t)cur.pn * tstep;
    S.a_ready(cur);
    if constexpr (SP2) {
        PG8_STAGE(PG8_SB(0, 0), cB, voffB); PG8_STAGE(PG8_SB(0, 1), cB + hstep, voffB); PG8_STAGE(PG8_SA(0, 0), cA, voffA); PG8_STAGE(PG8_SA(0, 1), cA + hstep, voffA);
        if (wr == 1) PG8_BAR;
        PG8_WAIT_V(2); PG8_BAR;
        PG8_STAGE(PG8_SB(1, 0), cB + kstep, voffB); PG8_STAGE(PG8_SA(1, 0), cA + kstep, voffA); PG8_STAGE(PG8_SB(1, 1), cB + hstep + kstep, voffB);
        PG8_WAIT_V(6); PG8_BAR;
    } else {
        PG8_STAGE(PG8_SB(0, 0), cB, voffB); PG8_STAGE(PG8_SA(0, 0), cA, voffA); PG8_STAGE(PG8_SB(0, 1), cB + hstep, voffB); PG8_STAGE(PG8_SA(0, 1), cA + hstep, voffA);
        if (wr == 1) PG8_BAR;
        PG8_WAIT_V(4); PG8_BAR;
        PG8_STAGE(PG8_SB(1, 0), cB + kstep, voffB); PG8_STAGE(PG8_SA(1, 0), cA + kstep, voffA); PG8_STAGE(PG8_SB(1, 1), cB + hstep + kstep, voffB);
        PG8_WAIT_V(6); PG8_BAR;
    }
    for (;;) {
        const bool has_next = S.next(ui + 1, nxt);
        const char* nA = has_next ? (const char*)g.A + (size_t)nxt.pm * tstep : cA; const char* nB = has_next ? (const char*)g.Bt + (size_t)nxt.pn * tstep : cB;
        for (int t = 0; t < nt; t += 2) {
            const bool last = (t == nt - 2);
            const char* a1 = cA + (size_t)(t + 1) * kstep;
            const char* a2 = last ? nA : cA + (size_t)(t + 2) * kstep; const char* b2 = last ? nB : cB + (size_t)(t + 2) * kstep;
            const char* a3 = a2 + kstep; const char* b3 = b2 + kstep;
            if (last && has_next) S.a_ready(nxt);
            if constexpr (SP2) {
            PG8_LDB(B0, 0, 0); PG8_LDB(B1, 0, 1); PG8_SCHED; PG8_LDA(At, 0, 0); PG8_STAGE(PG8_SA(1, 1), a1 + hstep, voffA);
            PG8_WAIT_V(8); PG8_WAIT_L(0); PG8_BAR; PG8_MMA(0, 0, At, B0); PG8_MMA(0, 1, At, B1); PG8_BAR; PG8_SCHED;
            PG8_LDA(At, 0, 1); PG8_STAGE(PG8_SB(0, 0), b2, voffB); PG8_STAGE(PG8_SB(0, 1), b2 + hstep, voffB); PG8_STAGE(PG8_SA(0, 0), a2, voffA);
            PG8_WAIT_V(8); PG8_WAIT_L(0); PG8_BAR; PG8_MMA(1, 0, At, B0); PG8_MMA(1, 1, At, B1); PG8_BAR; PG8_SCHED;
            PG8_LDB(B0, 1, 0); PG8_LDB(B1, 1, 1); PG8_SCHED; PG8_LDA(At, 1, 0); PG8_STAGE(PG8_SA(0, 1), a2 + hstep, voffA);
            PG8_WAIT_V(8); PG8_WAIT_L(0); PG8_BAR; PG8_MMA(0, 0, At, B0); PG8_MMA(0, 1, At, B1); PG8_BAR; PG8_SCHED;
            PG8_LDA(At, 1, 1); PG8_STAGE(PG8_SB(1, 0), b3, voffB); PG8_STAGE(PG8_SB(1, 1), b3 + hstep, voffB); PG8_STAGE(PG8_SA(1, 0), a3, voffA);
            PG8_WAIT_V(8); PG8_WAIT_L(0); PG8_BAR; PG8_MMA(1, 0, At, B0); PG8_MMA(1, 1, At, B1); PG8_BAR; PG8_SCHED;
            } else {
            PG8_LDB(B0, 0, 0); PG8_SCHED; PG8_LDA(At, 0, 0); PG8_STAGE(PG8_SA(1, 1), a1 + hstep, voffA);
            PG8_WAIT_L(8); PG8_BAR; PG8_WAIT_L(0); PG8_MMA(0, 0, At, B0); PG8_BAR; PG8_SCHED;
            PG8_LDB(B1, 0, 1); PG8_STAGE(PG8_SB(0, 0), b2, voffB);
            PG8_BAR; PG8_WAIT_L(0); PG8_MMA(0, 1, At, B1); PG8_BAR;
            PG8_LDA(At, 0, 1); PG8_STAGE(PG8_SA(0, 0), a2, voffA);
            PG8_BAR; PG8_WAIT_L(0); PG8_MMA(1, 0, At, B0); PG8_BAR; PG8_SCHED;
            PG8_STAGE(PG8_SB(0, 1), b2 + hstep, voffB);
            PG8_WAIT_V(6); PG8_BAR; PG8_MMA(1, 1, At, B1); PG8_BAR;
            PG8_LDB(B0, 1, 0); PG8_SCHED; PG8_LDA(At, 1, 0); PG8_STAGE(PG8_SA(0, 1), a2 + hstep, voffA);
            PG8_WAIT_L(8); PG8_BAR; PG8_WAIT_L(0); PG8_MMA(0, 0, At, B0); PG8_BAR; PG8_SCHED;
            PG8_LDB(B1, 1, 1); PG8_STAGE(PG8_SB(1, 0), b3, voffB);
            PG8_BAR; PG8_WAIT_L(0); PG8_MMA(0, 1, At, B1); PG8_BAR;
            PG8_LDA(At, 1, 1); PG8_STAGE(PG8_SA(1, 0), a3, voffA);
            PG8_BAR; PG8_WAIT_L(0); PG8_MMA(1, 0, At, B0); PG8_BAR; PG8_SCHED;
            PG8_STAGE(PG8_SB(1, 1), b3 + hstep, voffB);
            PG8_WAIT_V(6); PG8_BAR; PG8_MMA(1, 1, At, B1); PG8_BAR;
            }
        }
        if constexpr (ALIGN_EPI) { if (wr == 0) PG8_BAR; }
        E(acc, cur, wr, wc, fr, fq); S.done(cur);
        if (!has_next) break;
#pragma unroll
        for (int a = 0; a < 2; ++a)
#pragma unroll
            for (int b = 0; b < 2; ++b)
#pragma unroll
                for (int m = 0; m < 4; ++m)
#pragma unroll
                    for (int n = 0; n < 2; ++n) acc[a][b][m][n] = (f32x4){0.f, 0.f, 0.f, 0.f};
        cur = nxt; cA = nA; cB = nB; ++ui;
        if constexpr (ALIGN_EPI) { if (wr == 1) PG8_BAR; }
    }
    PG8_WAIT_V(0);
    if constexpr (!ALIGN_EPI) { if (wr == 0) PG8_BAR; }
    PG8_BAR;
#undef PG8_SA
#undef PG8_SB
#undef PG8_STAGE
#undef PG8_LDA
#undef PG8_LDB
#undef PG8_MMA
#undef PG8_WAIT_V
#undef PG8_WAIT_L
#undef PG8_BAR
#undef PG8_SCHED
}
}
constexpr int NWAVES = 8, GRID = 256;
constexpr int D = 1024, FF = 2816, NIN = 2944, NINP = 3072, NLAYER = 2;
constexpr int NB = 8, SEQ = 2048, NMETA = 16, TT = SEQ + NMETA;
constexpr int MX = NB * SEQ, MREAL = NB * TT, MP = 16640;
constexpr float RMS_EPS = 1e-6f, LNX_EPS = 64e-5f;
constexpr int PC_LRUX = 0, PC_LRUG = 256, PC_SCB = 512, PC_SCC = 768, PC_SCX = 1024, PC_R = 1280, PC_K = 1792, PC_V = 2304, PC_LO = 2816;

constexpr size_t MiB = 1u << 20;
constexpr size_t WS_CTL = 0, CTL_ZERO_BYTES = 1 * MiB;
constexpr size_t WS_HMETA = 1 * MiB;
constexpr size_t WS_AGG = 2 * MiB;
constexpr size_t WS_WB = 3 * MiB;
constexpr size_t WB_W1IN = 0, WB_W1OUT = 11 * MiB, WB_W2IN = WB_W1OUT + 5632 * 1024, WB_W2OUT = WB_W2IN + 11 * MiB, WB_WIN = WB_W2OUT + 5632 * 1024, WB_WOUT = WB_WIN + 6 * MiB, WB_END = WB_WOUT + 2 * MiB;
static_assert(WB_END == 41 * MiB, "weight map");
constexpr size_t WS_XN = 44 * MiB;
constexpr size_t WS_OV = 77 * MiB;
constexpr size_t OV_HID = 0, OV_RAWF = 90 * MiB;
constexpr size_t OV_P = 0, OV_WDEC = OV_P + (size_t)MP * NINP * 2, OV_ABUF = OV_WDEC + (size_t)MP * 512 * 2, OV_GBUF = OV_ABUF + (size_t)MP * 512 * 2, OV_HL = OV_GBUF + (size_t)MP * 512 * 2, OV_CA = OV_HL + (size_t)MP * 256 * 4, OV_MIXEND = OV_CA + (size_t)MP * 256 * 4;
constexpr size_t OV_HTMP = 130 * MiB;
constexpr size_t OV_RAWM = 0;
constexpr size_t WS_END = 256 * MiB;
static_assert(WS_XN + (size_t)MP * D * 2 <= WS_OV && WS_OV + OV_MIXEND <= WS_END && WS_OV + OV_RAWF + (size_t)MP * D * 4 <= WS_END && (size_t)MP * FF * 2 <= OV_RAWF, "d_ws map");
constexpr int CW_TMO = 8, CW_CNTM = 72, CW_BAR = 4096, CW_CNTA = 8192, CW_CNTB = CW_CNTA + 65 * 64;
constexpr size_t OV_X1 = 156 * MiB, OV_SLAB = 158 * MiB;

constexpr unsigned PROBE_MASK = 0u, PROBE_AMP = 8u; constexpr int PROBE_SUB = -1;
#define PSTAMP(j) do { if (PROBE_MASK && PROBE_SUB >= 0) { const unsigned long long t_ = __builtin_amdgcn_s_memrealtime(); if (PROBE_SUB == (j) && ((PROBE_MASK >> F.ph) & 1u)) F.pr_acc += t_ - F.pr_sub; F.pr_sub = t_; } } while (0)
constexpr int RING_BYTES = 143360, LDSCTL_OFF = RING_BYTES, MISC_OFF = LDSCTL_OFF + 320, LDS_BYTES = 147456;

#define GAS __attribute__((address_space(1)))
#define LAS __attribute__((address_space(3)))
typedef unsigned short bf16;
typedef unsigned v4u __attribute__((ext_vector_type(4)));
typedef float f32x4 __attribute__((ext_vector_type(4)));
typedef GAS unsigned gu32;
typedef float f32x2v_ __attribute__((ext_vector_type(2)));
#define LDS_WAIT() asm volatile("s_waitcnt lgkmcnt(0)" ::: "memory")
__device__ __forceinline__ unsigned f2bf(float f) { unsigned u = __builtin_bit_cast(unsigned, f); return (u + 0x7fffu + ((u >> 16) & 1u)) >> 16; }
__device__ __forceinline__ unsigned pk2(float lo, float hi) { return f2bf(lo) | (f2bf(hi) << 16); }
__device__ __forceinline__ float bf2f(unsigned b) { return __builtin_bit_cast(float, b << 16); }
__device__ __forceinline__ float sigmoidf_(float x) { return __builtin_amdgcn_rcpf(1.0f + __expf(-x)); }
__device__ __forceinline__ float tanhf_(float x) { return 1.0f - 2.0f * __builtin_amdgcn_rcpf(1.0f + __expf(2.0f * x)); }
__device__ __forceinline__ float softplusf_(float x) { return fmaxf(x, 0.f) + __logf(1.0f + __expf(-fabsf(x))); }
__device__ __forceinline__ float gelu_tanh(float x) { const float u = 0.7978845608028654f * (x + 0.044715f * x * x * x); return 0.5f * x * (1.0f + tanhf_(u)); }
template <int CTRL> __device__ __forceinline__ float dppf(float x) { return __builtin_bit_cast(float, __builtin_amdgcn_mov_dpp(__builtin_bit_cast(int, x), CTRL, 0xf, 0xf, true)); }
__device__ __forceinline__ float red16(float x) { x += dppf<0xB1>(x); x += dppf<0x4E>(x); x += dppf<0x141>(x); x += dppf<0x128>(x); return x; }
__device__ __forceinline__ float wave_sum(float x) {
    x = red16(x);
    x += __builtin_bit_cast(float, __builtin_amdgcn_update_dpp(0, __builtin_bit_cast(int, x), 0x142, 0xa, 0xf, false));
    x += __builtin_bit_cast(float, __builtin_amdgcn_update_dpp(0, __builtin_bit_cast(int, x), 0x143, 0xc, 0xf, false));
    return __builtin_bit_cast(float, __builtin_amdgcn_readlane(__builtin_bit_cast(int, x), 63)); }
__device__ __forceinline__ float wave_sum_dpp(float x) { return wave_sum(x); }
__device__ __forceinline__ int vlane() { return (int)__builtin_amdgcn_mbcnt_hi(~0u, __builtin_amdgcn_mbcnt_lo(~0u, 0u)); }
__device__ __forceinline__ int row_of(int b, int s) { return s < NMETA ? (MX + b * NMETA + s) : (b * SEQ + s - NMETA); }
#define XB_TMO      128
#define XB_XCNT(j)  (256  + 64 * (j))
#define XB_XSUB(j)  (1280 + 64 * (j))
#define XB_XGEN(j)  (2304 + 64 * (j))
#define XB_TOP      3328
#define XB_TOPGEN   3392
#define XCD_BAR_WORDS 3456
#define XB_SPIN_CAP (1u << 18)

__device__ __forceinline__ unsigned xb_ld(unsigned* p)              { return __hip_atomic_load(p, __ATOMIC_RELAXED, __HIP_MEMORY_SCOPE_AGENT); }
__device__ __forceinline__ unsigned xb_add(unsigned* p, unsigned v) { return __hip_atomic_fetch_add(p, v, __ATOMIC_RELAXED, __HIP_MEMORY_SCOPE_AGENT); }
__device__ __forceinline__ unsigned xb_xcc_id() { return (unsigned)__builtin_amdgcn_s_getreg((3 << 11) | 20) & 0xFu; }
#define XB_SPIN(cond, bar) do { unsigned _sp = 0; while (cond) { __builtin_amdgcn_s_sleep(1); \
    if ((++_sp & 255u) == 0u) { if (xb_ld(&(bar)[XB_TMO])) break; if (_sp > XB_SPIN_CAP) { atomicAdd(&(bar)[XB_TMO], 1u); break; } } } } while (0)

struct XcdBarrier {
    unsigned* bar; unsigned x;
    volatile LAS unsigned* st;
};

__device__ __forceinline__ XcdBarrier xcd_barrier_post(unsigned* bar, volatile LAS unsigned* st, bool leader  ) {
    XcdBarrier b; b.bar = bar; b.x = xb_xcc_id(); b.st = st;
    if (leader) (void)xb_add(&bar[XB_XCNT(b.x)], 1u);
    return b;
}
__device__ __forceinline__ void xcd_barrier_complete(unsigned* bar, unsigned x, unsigned& nloc, unsigned& nx) {
    const unsigned G = gridDim.x * gridDim.y * gridDim.z;
    unsigned sum, cnt, mine, sp = 0u;
    for (;;) {
        sum = 0u; cnt = 0u; mine = 0u;
#pragma unroll
        for (unsigned j = 0; j < 16; ++j) { const unsigned c = xb_ld(&bar[XB_XCNT(j)]); sum += c; cnt += (c > 0u) ? 1u : 0u; mine = (j == x) ? c : mine; }
        if (sum == G) break;
        __builtin_amdgcn_s_sleep(1);
        if ((++sp & 255u) == 0u) { if (xb_ld(&bar[XB_TMO])) break; if (sp > XB_SPIN_CAP) { atomicAdd(&bar[XB_TMO], 1u); break; } }
    }
    nloc = mine > 0u ? mine : 1u; nx = cnt > 0u ? cnt : 1u;
}

__device__ __forceinline__ void xcd_barrier(const XcdBarrier& b, bool leader  ) {
    asm volatile("s_waitcnt vmcnt(0)" ::: "memory");
    __syncthreads();
    if (leader) {
        unsigned* bar = b.bar;
        __builtin_amdgcn_s_waitcnt(0);
        unsigned nloc = b.st[0], nx = b.st[1];
        if (nloc == 0u) { xcd_barrier_complete(bar, b.x, nloc, nx); b.st[0] = nloc; b.st[1] = nx; }
        const unsigned old = xb_add(&bar[XB_XSUB(b.x)], 1u);
        const unsigned gen = old / nloc;
        if (old + 1u == (gen + 1u) * nloc) {
            __builtin_amdgcn_fence(__ATOMIC_RELEASE, "agent");
            asm volatile("s_waitcnt vmcnt(0)" ::: "memory");
            const unsigned og = xb_add(&bar[XB_TOP], 1u);
            const unsigned tg = og / nx;
            if (og + 1u == (tg + 1u) * nx) xb_add(&bar[XB_TOPGEN], 1u);
            else XB_SPIN(xb_ld(&bar[XB_TOPGEN]) == tg, bar);
            __builtin_amdgcn_fence(__ATOMIC_ACQUIRE, "agent");
            xb_add(&bar[XB_XGEN(b.x)], 1u);
            asm volatile("s_waitcnt vmcnt(0)" ::: "memory");
        } else {
            XB_SPIN(xb_ld(&bar[XB_XGEN(b.x)]) == gen, bar);
            __builtin_amdgcn_fence(__ATOMIC_ACQUIRE, "agent");
            asm volatile("s_waitcnt vmcnt(0)" ::: "memory");
        }
    }
    __syncthreads();
}
struct Frame {
    LAS unsigned char* lds;
    int tid, lane, wave, vcu;
    unsigned long long pr_acc, pr_sub; int ph;
    unsigned char* ws;
    const float* x; const float* meta; float* out;
};

constexpr int PK_CONVW = 0, PK_CONVB = 1024, PK_WA = 1280, PK_BA = 17664, PK_WX = 17920, PK_BX = 34304, PK_LAM = 34560, PK_LNG = 34816, PK_SCW = 35072, PK_SCG = 35840, PK_MU = 36096, PK_W0 = 37760,
              PK_W2 = 38272, PK_A0 = 54656, PK_A2 = 55168, PK_G2 = 71552, PK_KK = 104320, PK_KA = 104832, PK_RK = 105344, PK_LNW = 105856, PK_LNB = 106368, PK_SIZE = 106880;
constexpr size_t WS_PACK = 72 * 1024;
static_assert(WS_PACK + (size_t)NLAYER * PK_SIZE * 4 <= CTL_ZERO_BYTES && (CW_CNTB + 65 * 64) * 4 <= (int)WS_PACK && CW_BAR + 3456 <= CW_CNTA, "pack inside CTL, above the barrier words");
__device__ __forceinline__ const float* pack_of(const Frame& F, int l) { return (const float*)(F.ws + WS_PACK) + (size_t)l * PK_SIZE; }
__device__ __forceinline__ void pack_copy(Frame& F, const float* src, int per_layer, int off) {
    const int gt = F.vcu * (NWAVES * 64) + F.tid, NT = GRID * NWAVES * 64;
    for (int i = gt; i < NLAYER * per_layer; i += NT) { const int l = i / per_layer, j = i - l * per_layer; ((float*)(F.ws + WS_PACK))[(size_t)l * PK_SIZE + off + j] = src[i]; }
}
__device__ __forceinline__ void phase_pack(Frame& F, const float* const* in) {
    pack_copy(F, in[9], 1024, PK_CONVW); pack_copy(F, in[10], 256, PK_CONVB); pack_copy(F, in[11], 16384, PK_WA); pack_copy(F, in[12], 256, PK_BA); pack_copy(F, in[13], 16384, PK_WX); pack_copy(F, in[14], 256, PK_BX);
    pack_copy(F, in[15], 256, PK_LAM); pack_copy(F, in[16], 256, PK_LNG); pack_copy(F, in[17], 768, PK_SCW); pack_copy(F, in[18], 256, PK_SCG); pack_copy(F, in[19], 1664, PK_MU); pack_copy(F, in[20], 512, PK_W0);
    pack_copy(F, in[21], 16384, PK_W2); pack_copy(F, in[22], 512, PK_A0); pack_copy(F, in[23], 16384, PK_A2); pack_copy(F, in[24], 32768, PK_G2); pack_copy(F, in[25], 512, PK_KK); pack_copy(F, in[26], 512, PK_KA);
    pack_copy(F, in[27], 512, PK_RK); pack_copy(F, in[28], 512, PK_LNW); pack_copy(F, in[29], 512, PK_LNB);
}

__device__ __forceinline__ void transpose_item(const float* W, int K, int N, bf16* WT, int k0, int n0, int drow0, LAS float* scr, int lane) {
#pragma unroll 8
    for (int i = 0; i < 32; ++i) { const int kk = 2 * i + (lane >> 5); scr[kk * 33 + (lane & 31)] = W[(size_t)(k0 + kk) * N + n0 + (lane & 31)]; }
    LDS_WAIT(); asm volatile("" ::: "memory");
    const int c = lane & 7;
#pragma unroll
    for (int j = 0; j < 4; ++j) { const int n = (lane >> 3) + 8 * j; const LAS float* s = scr + (8 * c) * 33 + n;
        v4u o; o.x = pk2(s[0 * 33], s[1 * 33]); o.y = pk2(s[2 * 33], s[3 * 33]); o.z = pk2(s[4 * 33], s[5 * 33]); o.w = pk2(s[6 * 33], s[7 * 33]);
        *(GAS v4u*)(WT + (size_t)(drow0 + n) * K + k0 + 8 * c) = o; }
    LDS_WAIT(); asm volatile("" ::: "memory");
}
__device__ __forceinline__ int swiglu_row(int n0) { return n0 < FF ? ((n0 >> 7) * 256 + (n0 & 127)) : (((n0 - FF) >> 7) * 256 + 128 + ((n0 - FF) & 127)); }
constexpr int CI_IN = (D / 64) * (2 * FF / 32), CI_OUT = (FF / 64) * (D / 32), CI_MI = (D / 64) * (NIN / 32), CI_MO = (D / 64) * (D / 32);
constexpr int CI_SET0 = CI_IN + CI_OUT + CI_MI, CI_SET1 = CI_MO + CI_IN + CI_OUT;
struct ConvItem { const float* W; bf16* WT; int K, N, k0, n0, drow0; };
__device__ __forceinline__ ConvItem conv_item(unsigned char* ws, const float* const* in, int l, int set, int r) {
    ConvItem ci;
    if (set == 0) {
        if (r < CI_IN) { const int nblk = 2 * FF / 32, kb = r / nblk, nb = r % nblk; ci = ConvItem{in[3] + (size_t)l * D * 2 * FF, (bf16*)(ws + WS_WB + WB_W1IN), D, 2 * FF, 64 * kb, 32 * nb, swiglu_row(32 * nb)}; return ci; }
        r -= CI_IN;
        if (r < CI_OUT) { const int nblk = D / 32, kb = r / nblk, nb = r % nblk; ci = ConvItem{in[4] + (size_t)l * FF * D, (bf16*)(ws + WS_WB + WB_W1OUT), FF, D, 64 * kb, 32 * nb, 32 * nb}; return ci; }
        r -= CI_OUT;
        { const int nblk = NIN / 32, kb = r / nblk, nb = r % nblk; ci = ConvItem{in[7] + (size_t)l * D * NIN, (bf16*)(ws + WS_WB + WB_WIN), D, NIN, 64 * kb, 32 * nb, 32 * nb}; return ci; }
    }
    if (r < CI_MO) { const int nblk = D / 32, kb = r / nblk, nb = r % nblk; ci = ConvItem{in[8] + (size_t)l * D * D, (bf16*)(ws + WS_WB + WB_WOUT), D, D, 64 * kb, 32 * nb, 32 * nb}; return ci; }
    r -= CI_MO;
    if (r < CI_IN) { const int nblk = 2 * FF / 32, kb = r / nblk, nb = r % nblk; ci = ConvItem{in[5] + (size_t)l * D * 2 * FF, (bf16*)(ws + WS_WB + WB_W2IN), D, 2 * FF, 64 * kb, 32 * nb, swiglu_row(32 * nb)}; return ci; }
    r -= CI_IN;
    { const int nblk = D / 32, kb = r / nblk, nb = r % nblk; ci = ConvItem{in[6] + (size_t)l * FF * D, (bf16*)(ws + WS_WB + WB_W2OUT), FF, D, 64 * kb, 32 * nb, 32 * nb}; return ci; }
}
__device__ __forceinline__ void conv_loads(const ConvItem& ci, int lane, float (&v)[32]) {
    const float* src = ci.W + (size_t)(ci.k0 + (lane >> 5)) * ci.N + ci.n0 + (lane & 31);
#pragma unroll
    for (int i = 0; i < 32; ++i) v[i] = src[(size_t)(2 * i) * ci.N];
}
__device__ __forceinline__ void conv_store(const ConvItem& ci, int lane, const float (&v)[32], LAS float* scr) {
#pragma unroll
    for (int i = 0; i < 32; ++i) scr[(2 * i + (lane >> 5)) * 33 + (lane & 31)] = v[i];
    LDS_WAIT(); asm volatile("" ::: "memory");
    const int c = lane & 7;
#pragma unroll
    for (int j = 0; j < 4; ++j) { const int n = (lane >> 3) + 8 * j; const LAS float* s = scr + (8 * c) * 33 + n;
        v4u o; o.x = pk2(s[0 * 33], s[1 * 33]); o.y = pk2(s[2 * 33], s[3 * 33]); o.z = pk2(s[4 * 33], s[5 * 33]); o.w = pk2(s[6 * 33], s[7 * 33]);
        *(GAS v4u*)(ci.WT + (size_t)(ci.drow0 + n) * ci.K + ci.k0 + 8 * c) = o; }
    LDS_WAIT(); asm volatile("" ::: "memory");
}
__device__ __forceinline__ void phase_convert(Frame& F, const float* const* in, int l, int set) {
    { int ln_ = F.tid & 63; asm volatile("" : "+v"(ln_)); F.lane = ln_; }
    LAS float* scr = (LAS float*)(F.lds + F.wave * 16384);
    const int gw = F.vcu * NWAVES + F.wave, NGW = GRID * NWAVES, nitems = set == 0 ? CI_SET0 : CI_SET1;
    for (int it = gw; it < nitems; it += NGW) { const ConvItem ci = conv_item(F.ws, in, l, set, it); transpose_item(ci.W, ci.K, ci.N, ci.WT, ci.k0, ci.n0, ci.drow0, scr, F.lane); }
    if (set == 0) { unsigned zz = 0u; asm volatile("" : "+v"(zz));
      for (int i = gw * 64 + F.lane; i < (NINP - NIN) * D / 8; i += NGW * 64) *(GAS v4u*)(((bf16*)(F.ws + WS_WB + WB_WIN)) + (size_t)NIN * D + (size_t)i * 8) = (v4u){zz, zz, zz, zz}; }
}

__device__ __forceinline__ const float* hrow_c(const Frame& F, const float* xrows, int r) { return r < MX ? xrows + (size_t)r * D : ((float*)(F.ws + WS_HMETA)) + (size_t)(r - MX) * D; }
__device__ __forceinline__ void store_xn_row(bf16* XN, int r, int lane, const f32x4 (&v)[4], float rstd, const float* g) {
    GAS unsigned long long* o8 = (GAS unsigned long long*)(XN + (size_t)r * D) + lane;
#pragma unroll
    for (int j = 0; j < 4; ++j) { const f32x4 gv = ((const GAS f32x4*)g)[lane + 64 * j];
        o8[64 * j] = (unsigned long long)pk2(v[j].x * rstd * gv.x, v[j].y * rstd * gv.y) | ((unsigned long long)pk2(v[j].z * rstd * gv.z, v[j].w * rstd * gv.w) << 32); }
}
__device__ __forceinline__ float sumsq4(const f32x4 (&v)[4]) { float s = 0.f;
#pragma unroll
    for (int j = 0; j < 4; ++j) s += (v[j].x * v[j].x + v[j].y * v[j].y) + (v[j].z * v[j].z + v[j].w * v[j].w);
    return s; }
__device__ __forceinline__ void row_ld_f32(const float* p, int lane, f32x4 (&v)[4]) {
#pragma unroll
    for (int j = 0; j < 4; ++j) v[j] = ((const GAS f32x4*)p)[lane + 64 * j]; }
__device__ __forceinline__ void row_ld_bf16(const bf16* p, int lane, f32x4 (&v)[4]) {
#pragma unroll
    for (int j = 0; j < 4; ++j) { const unsigned long long u = ((const GAS unsigned long long*)p)[lane + 64 * j]; v[j][0] = bf2f((unsigned)u & 0xffffu); v[j][1] = bf2f((unsigned)u >> 16); v[j][2] = bf2f((unsigned)(u >> 32) & 0xffffu); v[j][3] = bf2f((unsigned)(u >> 48)); } }
__device__ __forceinline__ void row_st_bf16(bf16* p, int lane, const f32x4 (&v)[4]) {
#pragma unroll
    for (int j = 0; j < 4; ++j) ((GAS unsigned long long*)p)[lane + 64 * j] = (unsigned long long)pk2(v[j][0], v[j][1]) | ((unsigned long long)pk2(v[j][2], v[j][3]) << 32); }
__device__ __forceinline__ void phase_init(Frame& F, const float* g_pre) {
    { int ln_ = F.tid & 63; asm volatile("" : "+v"(ln_)); F.lane = ln_; }
    const int gw = F.vcu * NWAVES + F.wave, NGW = GRID * NWAVES;
    for (int r = gw; r < MP; r += NGW) {
        if (r >= MREAL) { GAS unsigned long long* o8 = (GAS unsigned long long*)(((bf16*)(F.ws + WS_XN)) + (size_t)r * D) + F.lane;
#pragma unroll
            for (int j = 0; j < 4; ++j) { unsigned zz = 0u; asm volatile("" : "+v"(zz)); o8[64 * j] = (unsigned long long)zz; }
            continue; }
        const float* src = r < MX ? F.x + (size_t)r * D : F.meta + (size_t)((r - MX) & (NMETA - 1)) * D;
        f32x4 v[4]; row_ld_f32(src, F.lane, v);
        if (r >= MX) row_st_bf16((bf16*)(F.ws + WS_HMETA) + (size_t)(r - MX) * D, F.lane, v);
        const float rstd = rsqrtf(wave_sum(sumsq4(v)) * (1.0f / D) + RMS_EPS);
        store_xn_row(((bf16*)(F.ws + WS_XN)), r, F.lane, v, rstd, g_pre);
    }
}
struct PostIO { const bf16* raw16; const float* x32; const bf16* hin16; bf16* hout16; float* out32; };
__device__ __forceinline__ void post_row_load(const Frame& F, const PostIO& io, int r, f32x4 (&y)[4], f32x4 (&h)[4]) {
    row_ld_bf16(io.raw16 + (size_t)r * D, F.lane, y);
    if (r >= MX) row_ld_bf16((const bf16*)(F.ws + WS_HMETA) + (size_t)(r - MX) * D, F.lane, h);
    else if (io.x32) row_ld_f32(io.x32 + (size_t)r * D, F.lane, h);
    else row_ld_bf16(io.hin16 + (size_t)r * D, F.lane, h);
}
__device__ __forceinline__ void post_row_store(const Frame& F, const PostIO& io, int r, const f32x4 (&h)[4]) {
    if (r >= MX) row_st_bf16((bf16*)(F.ws + WS_HMETA) + (size_t)(r - MX) * D, F.lane, h);
    else if (io.out32) {
#pragma unroll
        for (int j = 0; j < 4; ++j) ((GAS f32x4*)(io.out32 + (size_t)r * D))[F.lane + 64 * j] = h[j]; }
    else row_st_bf16(io.hout16 + (size_t)r * D, F.lane, h);
}
__device__ __forceinline__ void phase_post(Frame& F, const PostIO& io, float scale, const float* g_post, const float* g_pre) {
    { int ln_ = F.tid & 63; asm volatile("" : "+v"(ln_)); F.lane = ln_; }
    const int gw = F.vcu * NWAVES + F.wave, NGW = GRID * NWAVES, nrows = io.out32 ? MX : MREAL;
    for (int r0 = gw; r0 < nrows; r0 += 2 * NGW) {
        const int r1 = r0 + NGW; const bool two = r1 < nrows; const int r1c = two ? r1 : r0;
        f32x4 y0[4], h0[4], y1[4], h1[4];
        post_row_load(F, io, r0, y0, h0); post_row_load(F, io, r1c, y1, h1);
        const float rs0 = scale * rsqrtf(wave_sum(sumsq4(y0)) * (1.0f / D) + RMS_EPS), rs1 = scale * rsqrtf(wave_sum(sumsq4(y1)) * (1.0f / D) + RMS_EPS);
#pragma unroll
        for (int j = 0; j < 4; ++j) { const f32x4 gv = ((const GAS f32x4*)g_post)[F.lane + 64 * j]; h0[j] = h0[j] + y0[j] * rs0 * gv; h1[j] = h1[j] + y1[j] * rs1 * gv; }
        post_row_store(F, io, r0, h0); if (two) post_row_store(F, io, r1, h1);
        if (g_pre) { const float q0 = rsqrtf(wave_sum(sumsq4(h0)) * (1.0f / D) + RMS_EPS), q1 = rsqrtf(wave_sum(sumsq4(h1)) * (1.0f / D) + RMS_EPS);
            store_xn_row(((bf16*)(F.ws + WS_XN)), r0, F.lane, h0, q0, g_pre); if (two) store_xn_row(((bf16*)(F.ws + WS_XN)), r1, F.lane, h1, q1, g_pre); }
    }
}
typedef short bf16x8v __attribute__((ext_vector_type(8)));
typedef float f32x4v __attribute__((ext_vector_type(4)));
constexpr int FR_PER_WAVE = 24;
constexpr size_t WS_FRAG = WS_AGG + 512 * 1024, FRAG_LAYER_BYTES = (size_t)8 * FR_PER_WAVE * 64 * 16;
static_assert(WS_FRAG + NLAYER * FRAG_LAYER_BYTES <= WS_WB, "fragment store fits behind AGG");
__device__ __forceinline__ float frag_src(const float* const* in, int l, int w, int f, int lane, int j) {
    const int kq = 8 * (lane >> 4) + j, cl = lane & 15;
    if (f < 4)  return in[21][(size_t)l * 32 * 512 + (size_t)kq * 512 + 64 * w + 16 * f + cl];
    if (f < 8)  return in[23][(size_t)l * 32 * 512 + (size_t)kq * 512 + 64 * w + 16 * (f - 4) + cl];
    if (f < 16) { const int ct = (f - 8) >> 1, ks = (f - 8) & 1; return in[24][(size_t)l * 64 * 512 + (size_t)(32 * ks + kq) * 512 + 64 * w + 16 * ct + cl]; }
    { const int ct = (f - 16) >> 1, ks = (f - 16) & 1, gt = w >> 2, g = w & 3; return in[gt ? 13 : 11][(size_t)l * 16384 + (size_t)g * 4096 + (size_t)(32 * ks + kq) * 64 + 16 * ct + cl]; }
}
__device__ __forceinline__ void phase_frag(Frame& F, const float* const* in) {
    const int gt = F.vcu * (NWAVES * 64) + F.tid, NT = GRID * NWAVES * 64;
    bf16* FR = (bf16*)(F.ws + WS_FRAG);
    for (int i = gt; i < NLAYER * 8 * FR_PER_WAVE * 64 * 8; i += NT) { const int j = i & 7, lane = (i >> 3) & 63, f = (i >> 9) % FR_PER_WAVE, w = ((i >> 9) / FR_PER_WAVE) & 7, l = (i >> 9) / (FR_PER_WAVE * 8);
        FR[i] = (bf16)f2bf(frag_src(in, l, w, f, lane, j)); }
}
__device__ __forceinline__ bf16x8v pack8(const float (&v)[8]) { v4u u; u.x = pk2(v[0], v[1]); u.y = pk2(v[2], v[3]); u.z = pk2(v[4], v[5]); u.w = pk2(v[6], v[7]); return __builtin_bit_cast(bf16x8v, u); }
__device__ __forceinline__ void unpack8(const v4u& u, float (&v)[8]) { v[0] = bf2f(u.x & 0xffffu); v[1] = bf2f(u.x >> 16); v[2] = bf2f(u.y & 0xffffu); v[3] = bf2f(u.y >> 16); v[4] = bf2f(u.z & 0xffffu); v[5] = bf2f(u.z >> 16); v[6] = bf2f(u.w & 0xffffu); v[7] = bf2f(u.w >> 16); }
__device__ __forceinline__ void unpack4f(unsigned long long u, f32x4& v) { v[0] = bf2f((unsigned)u & 0xffffu); v[1] = bf2f(((unsigned)u >> 16)); v[2] = bf2f((unsigned)(u >> 32) & 0xffffu); v[3] = bf2f((unsigned)(u >> 48)); }
__device__ __forceinline__ void phase_mix_prep(Frame& F, const float* pk, int layer) {
    { int ln_ = F.tid & 63; asm volatile("" : "+v"(ln_)); F.lane = ln_; }
    LAS float* U = (LAS float*)F.lds;
    LAS float* GT = U + 16 * 256;
    LAS float* XL = GT + 32 * 256;
    LAS float* VL = XL + 19 * 256;
    const int tid = F.tid, lane = F.lane, w = F.wave, fr = lane & 15, fq = lane >> 4;
    const bf16* P = ((bf16*)(F.ws + WS_OV + OV_P)); bf16* Y = ((bf16*)(F.ws + WS_XN));
    bf16x8v Bf[FR_PER_WAVE];
    { const v4u* fp = (const v4u*)(F.ws + WS_FRAG + (size_t)layer * FRAG_LAYER_BYTES) + (size_t)w * FR_PER_WAVE * 64 + lane;
#pragma unroll
        for (int f = 0; f < FR_PER_WAVE; ++f) Bf[f] = __builtin_bit_cast(bf16x8v, fp[f * 64]); }
    const int gtp = w >> 2, gblk = w & 3;
    const int cg4 = 4 * (tid & 63);
    for (int tile = blockIdx.x; tile < 256; tile += GRID) {
        const int b = tile >> 5, c = tile & 31;
        const int s_begin = c == 0 ? 0 : NMETA + 64 * c, nsub = c == 0 ? 5 : 4;
        float hloc = 0.f, caloc = 1.f;
        for (int sub = 0; sub < nsub; ++sub) {
            const int s0 = s_begin + 16 * sub;
            unsigned zz = 0u; asm volatile("" : "+v"(zz));
            v4u cur[4], prv[4];
            { const int s = s0 + fr; const bf16* pc = P + (size_t)row_of(b, s) * NINP + PC_LO + 8 * fq; const bf16* pp = P + (size_t)row_of(b, s > 0 ? s - 1 : 0) * NINP + PC_LO + 8 * fq;
#pragma unroll
                for (int f = 0; f < 4; ++f) { cur[f] = *(const v4u*)(pc + 32 * f); prv[f] = *(const v4u*)(pp + 32 * f); if (s == 0) prv[f] = (v4u){zz, zz, zz, zz}; } }
            unsigned long long lx[3], lc[3], lxx[3], lb[2];
#pragma unroll
            for (int j = 0; j < 3; ++j) { const int idx = tid + 512 * j, r = idx >> 6, s = s0 - 3 + r; lx[j] = zz; lc[j] = zz; lxx[j] = zz;
                if (idx < 19 * 64 && s >= 0) { const bf16* pr = P + (size_t)row_of(b, s) * NINP + cg4; lx[j] = *(const unsigned long long*)(pr + PC_LRUX); lc[j] = *(const unsigned long long*)(pr + PC_SCC); lxx[j] = *(const unsigned long long*)(pr + PC_SCX); } }
#pragma unroll
            for (int j = 0; j < 2; ++j) { const int t = (tid >> 6) + 8 * j; lb[j] = *(const unsigned long long*)(P + (size_t)row_of(b, s0 + t) * NINP + PC_SCB + cg4); }
            { bf16x8v Af[4];
#pragma unroll
                for (int f = 0; f < 4; ++f) { float cv[8], pv[8], zv[8]; unpack8(cur[f], cv); unpack8(prv[f], pv);
                    const f32x4v m0 = *(const f32x4v*)(pk + PK_MU + 1536 + 32 * f + 8 * fq), m1 = *(const f32x4v*)(pk + PK_MU + 1536 + 32 * f + 8 * fq + 4);
#pragma unroll
                    for (int j = 0; j < 8; ++j) { const float mu = j < 4 ? m0[j & 3] : m1[j & 3]; const float z = cv[j] + (pv[j] - cv[j]) * mu; zv[j] = f == 0 ? tanhf_(z) : (f == 1 ? z : sigmoidf_(z)); }
                    Af[f] = pack8(zv); }
                const f32x4v zero = (f32x4v){0.f, 0.f, 0.f, 0.f};
                const size_t ro = (size_t)row_of(b, s0 + fr) * 512;
#pragma unroll
                for (int ct = 0; ct < 4; ++ct) { const int n = 64 * w + 16 * ct + 4 * fq;
                    const f32x4v aw = __builtin_amdgcn_mfma_f32_16x16x32_bf16(Bf[ct], Af[0], zero, 0, 0, 0);
                    const f32x4v aa = __builtin_amdgcn_mfma_f32_16x16x32_bf16(Bf[4 + ct], Af[1], zero, 0, 0, 0);
                    f32x4v ag = __builtin_amdgcn_mfma_f32_16x16x32_bf16(Bf[8 + 2 * ct], Af[2], zero, 0, 0, 0); ag = __builtin_amdgcn_mfma_f32_16x16x32_bf16(Bf[9 + 2 * ct], Af[3], ag, 0, 0, 0);
                    const f32x4v w04 = *(const f32x4v*)(pk + PK_W0 + n), a04 = *(const f32x4v*)(pk + PK_A0 + n);
                    float wd[4], av4[4];
#pragma unroll
                    for (int i = 0; i < 4; ++i) { const float wl = -softplusf_(-(w04[i] + aw[i])) - 0.5f, e = __expf(wl); wd[i] = e * (1.0f - e * (0.5f - e * (0.16666667f - e * (0.041666668f - e * 0.0083333338f)))); av4[i] = sigmoidf_(a04[i] + aa[i]); }
                    *(GAS unsigned long long*)((bf16*)(F.ws + WS_OV + OV_WDEC) + ro + n) = (unsigned long long)pk2(wd[0], wd[1]) | ((unsigned long long)pk2(wd[2], wd[3]) << 32);
                    *(GAS unsigned long long*)((bf16*)(F.ws + WS_OV + OV_ABUF) + ro + n) = (unsigned long long)pk2(av4[0], av4[1]) | ((unsigned long long)pk2(av4[2], av4[3]) << 32);
                    *(GAS unsigned long long*)((bf16*)(F.ws + WS_OV + OV_GBUF) + ro + n) = (unsigned long long)pk2(ag[0], ag[1]) | ((unsigned long long)pk2(ag[2], ag[3]) << 32); } }
            PSTAMP(0);
#pragma unroll
            for (int j = 0; j < 3; ++j) { const int idx = tid + 512 * j; if (idx < 19 * 64) { f32x4 a4, c4, x4; unpack4f(lx[j], a4); unpack4f(lc[j], c4); unpack4f(lxx[j], x4);
                *(LAS f32x4*)(XL + (idx >> 6) * 256 + cg4) = a4; *(LAS f32x4*)(VL + (idx >> 6) * 256 + cg4) = c4 * x4; } }
            __syncthreads();
            const float* pkc = pk + cg4;
            const f32x4 cb4 = *(const f32x4*)(pkc + PK_CONVB), cw0 = *(const f32x4*)(pkc + PK_CONVW), cw1 = *(const f32x4*)(pkc + PK_CONVW + 256), cw2 = *(const f32x4*)(pkc + PK_CONVW + 512), cw3 = *(const f32x4*)(pkc + PK_CONVW + 768);
            const f32x4 sw0 = *(const f32x4*)(pkc + PK_SCW), sw1 = *(const f32x4*)(pkc + PK_SCW + 256), sw2 = *(const f32x4*)(pkc + PK_SCW + 512), sg4 = *(const f32x4*)(pkc + PK_SCG);
#pragma unroll
            for (int j = 0; j < 2; ++j) { const int t = (tid >> 6) + 8 * j;
                const LAS float* xr = XL + t * 256 + cg4; const LAS float* vr = VL + (t + 1) * 256 + cg4;
                *(LAS f32x4*)(U + t * 256 + cg4) = cb4 + *(const LAS f32x4*)xr * cw0 + *(const LAS f32x4*)(xr + 256) * cw1 + *(const LAS f32x4*)(xr + 512) * cw2 + *(const LAS f32x4*)(xr + 768) * cw3;
                f32x4 b4; unpack4f(lb[j], b4);
                const f32x4 y4 = b4 * (*(const LAS f32x4*)vr * sw0 + *(const LAS f32x4*)(vr + 256) * sw1 + *(const LAS f32x4*)(vr + 512) * sw2);
                const float ss = red16((y4[0] * y4[0] + y4[1] * y4[1]) + (y4[2] * y4[2] + y4[3] * y4[3])); const float rs = rsqrtf(ss * (1.0f / 64.0f) + RMS_EPS);
                *(GAS unsigned long long*)(Y + (size_t)row_of(b, s0 + t) * D + 256 + cg4) = (unsigned long long)pk2(y4[0] * rs * sg4[0], y4[1] * rs * sg4[1]) | ((unsigned long long)pk2(y4[2] * rs * sg4[2], y4[3] * rs * sg4[3]) << 32); }
            PSTAMP(1);
            __syncthreads();
            { bf16x8v Al[2];
#pragma unroll
                for (int ks = 0; ks < 2; ++ks) { const LAS float* up = U + fr * 256 + 64 * gblk + 32 * ks + 8 * fq; const f32x4v u0 = *(const LAS f32x4v*)up, u1 = *(const LAS f32x4v*)(up + 4);
                    const float uv[8] = {u0.x, u0.y, u0.z, u0.w, u1.x, u1.y, u1.z, u1.w}; Al[ks] = pack8(uv); }
                const f32x4v zero = (f32x4v){0.f, 0.f, 0.f, 0.f};
#pragma unroll
                for (int ct = 0; ct < 4; ++ct) { const int j = 64 * gblk + 16 * ct + 4 * fq;
                    f32x4v ac = __builtin_amdgcn_mfma_f32_16x16x32_bf16(Bf[16 + 2 * ct], Al[0], zero, 0, 0, 0); ac = __builtin_amdgcn_mfma_f32_16x16x32_bf16(Bf[17 + 2 * ct], Al[1], ac, 0, 0, 0);
                    const f32x4v bias = *(const f32x4v*)(pk + (gtp ? PK_BX : PK_BA) + j);
                    f32x4v gv;
#pragma unroll
                    for (int i = 0; i < 4; ++i) gv[i] = sigmoidf_(ac[i] + bias[i]);
                    *(LAS f32x4v*)(GT + (gtp * 16 + fr) * 256 + j) = gv; } }
            PSTAMP(2);
            __syncthreads();
#pragma unroll
            for (int it = 0; it < 8; ++it) { const int idx = it * (NWAVES * 64) + tid, ch = idx & 255;
                const float r = GT[idx], ig = GT[16 * 256 + idx], u = U[idx];
                const float la = -8.0f * r * softplusf_(-pk[PK_LAM + ch]), a = __expf(la), x2 = 2.0f * la;
                const float om = x2 < -0.25f ? (1.0f - __expf(x2)) : -x2 * (1.0f + x2 * (0.5f + x2 * (0.16666667f + x2 * (0.041666668f + x2 * 0.0083333338f))));
                const float bt = __builtin_amdgcn_sqrtf(om) * (ig * u);
                GT[idx] = a; GT[16 * 256 + idx] = bt; }
            __syncthreads();
            PSTAMP(3);
            if (tid < 256) { const int j = tid;
#pragma unroll
                for (int t = 0; t < 16; ++t) { const float a = GT[t * 256 + j], bt = GT[(16 + t) * 256 + j];
                    hloc = a * hloc + bt; caloc *= a;
                    const size_t ro = (size_t)row_of(b, s0 + t) * 256 + j; ((float*)(F.ws + WS_OV + OV_HL))[ro] = hloc; ((float*)(F.ws + WS_OV + OV_CA))[ro] = caloc; } }
            PSTAMP(4);
        }
        if (tid < 256) { ((float*)(F.ws + WS_AGG))[((size_t)(b * 32 + c) * 256 + tid) * 2 + 0] = caloc; ((float*)(F.ws + WS_AGG))[((size_t)(b * 32 + c) * 256 + tid) * 2 + 1] = hloc; }
        __syncthreads();
    }
}

constexpr int SC_CH = 24, SC_NCH = TT / SC_CH, SC_LW = SC_CH / 4, SC_STEPF = 336, SC_BUFF = SC_CH * SC_STEPF;
constexpr int SC_VJ = (SC_LW * 16 + 63) / 64;
static_assert(SC_NCH * SC_CH == TT && 2 * SC_BUFF * 4 <= RING_BYTES, "scan geometry");
struct ScanRegs { unsigned rr[SC_LW + 1], kk[SC_LW + 1], aa[SC_LW], ww[SC_LW]; unsigned vc[SC_VJ], vp[SC_VJ]; };
__device__ __forceinline__ void scan_load(const Frame& F, ScanRegs& R, int b, int h, int q, int lw, int chunk, unsigned lane) {
    const int t0 = chunk * SC_CH + SC_LW * lw;
    const bf16* P = ((bf16*)(F.ws + WS_OV + OV_P)); const bf16* AB = ((bf16*)(F.ws + WS_OV + OV_ABUF)); const bf16* WD = ((bf16*)(F.ws + WS_OV + OV_WDEC));
#pragma unroll
    for (int m = 0; m < SC_LW + 1; ++m) { const int s = t0 - 1 + m;
        if (s >= 0) { const bf16* rowp = P + (size_t)row_of(b, s) * NINP + h * 64; R.rr[m] = rowp[PC_R + lane]; R.kk[m] = rowp[PC_K + lane]; } else { R.rr[m] = 0u; R.kk[m] = 0u; } }
#pragma unroll
    for (int i = 0; i < SC_LW; ++i) { const size_t ro = (size_t)row_of(b, t0 + i) * 512 + h * 64; R.aa[i] = (AB + ro)[lane]; R.ww[i] = (WD + ro)[lane]; }
#pragma unroll
    for (int j = 0; j < SC_VJ; ++j) { const int st0 = 4 * j; const unsigned st = st0 + (lane >> 4), rw = lane & 15; R.vc[j] = 0u; R.vp[j] = 0u;
        if (st < (unsigned)SC_LW) { const int s = t0 + (int)st; const unsigned col = PC_V + h * 64 + 16 * q + rw; R.vc[j] = P[(size_t)row_of(b, s) * NINP + col]; if (s > 0) R.vp[j] = P[(size_t)row_of(b, s - 1) * NINP + col]; } }
}
__device__ __forceinline__ void scan_emit(const ScanRegs& R, LAS float* buf, int lw, unsigned lane, float mu_r, float mu_k, float kk_n, float ka_n, float mu_v) {
    LAS float* lb = buf + SC_LW * lw * SC_STEPF + lane; asm volatile("" : "+v"(lb));
#pragma unroll
    for (int i = 0; i < SC_LW; ++i) { LAS float* sp = lb + i * SC_STEPF;
        const float rc = bf2f(R.rr[i + 1]), rp = bf2f(R.rr[i]), kc = bf2f(R.kk[i + 1]), kp = bf2f(R.kk[i]);
        const float zr = rc + (rp - rc) * mu_r, zk = kc + (kp - kc) * mu_k, a = bf2f(R.aa[i]);
        const float kv = zk * kk_n; const float ss = wave_sum_dpp(kv * kv); const float kn = kv * rsqrtf(fmaxf(ss, 1e-24f));
        sp[0] = zr; sp[64] = 1.0f - bf2f(R.ww[i]); sp[128] = zk * (1.0f + (a - 1.0f) * ka_n); sp[192] = -kn; sp[256] = kn * a; }
#pragma unroll
    for (int j = 0; j < SC_VJ; ++j) { const unsigned st = 4 * j + (lane >> 4), rw = lane & 15;
        if (st < (unsigned)SC_LW) { const float vc = bf2f(R.vc[j]), vp = bf2f(R.vp[j]); buf[(SC_LW * lw + st) * SC_STEPF + 320 + rw] = vc + (vp - vc) * mu_v; } }
}
typedef float f32x2 __attribute__((ext_vector_type(2)));
struct ScanOps { f32x4 r4, w4, k4, n4, b4; float v; };
__device__ __forceinline__ void scan_ops_load(ScanOps& o, const LAS float* lp, const LAS float* vp) {
    o.r4 = *(const LAS f32x4*)(lp); o.w4 = *(const LAS f32x4*)(lp + 64); o.k4 = *(const LAS f32x4*)(lp + 128);
    o.n4 = *(const LAS f32x4*)(lp + 192); o.b4 = *(const LAS f32x4*)(lp + 256); o.v = *vp; }
#define LO2(v) ((f32x2){(v).x, (v).y})
#define HI2(v) ((f32x2){(v).z, (v).w})
__device__ __forceinline__ float dot4p(const f32x2& a0, const f32x2& a1, const f32x4& b) { f32x2 t = a0 * LO2(b); t = a1 * HI2(b) + t; return t.x + t.y; }
__device__ __forceinline__ float scan_step(f32x2& S0, f32x2& S1, const ScanOps& o, float& q) {
    float p = dot4p(S0, S1, o.n4), y = q;
    p += dppf<0xB1>(p); y += dppf<0xB1>(y); p += dppf<0x4E>(p); y += dppf<0x4E>(y); p += dppf<0x141>(p); y += dppf<0x141>(y); p += dppf<0x128>(p); y += dppf<0x128>(y);
    const f32x2 vv = (f32x2){o.v, o.v}, sa = (f32x2){p, p};
    S0 = LO2(o.b4) * sa + (S0 * LO2(o.w4) + LO2(o.k4) * vv); S1 = HI2(o.b4) * sa + (S1 * HI2(o.w4) + HI2(o.k4) * vv);
    q = dot4p(S0, S1, o.r4);
    return y; }
constexpr int SC_YB = SC_CH * 16;
static_assert((2 * SC_BUFF + 2 * SC_YB + 256 + 256 + 4 * 64 * 33) * 4 <= RING_BYTES, "scan LDS");
__device__ __forceinline__ void scan_flush(const Frame& F, const LAS float* yb, int b, int h, int q, int chunk, int ltid) {
    bf16* Y = ((bf16*)(F.ws + WS_XN));
#pragma unroll
    for (int j = 0; j < (SC_YB + 255) / 256; ++j) { const int idx = ltid + 256 * j; if (idx < SC_YB) { const int st = idx >> 4, rw = idx & 15;
        Y[(size_t)row_of(b, chunk * SC_CH + st) * D + 512 + h * 64 + 16 * q + rw] = (bf16)f2bf(yb[idx]); } }
}
__device__ __forceinline__ void phase_scan(Frame& F, const float* pk, const float* const* in, int l) {
    { int ln_ = F.tid & 63; asm volatile("" : "+v"(ln_)); F.lane = ln_; }
    LAS float* buf0 = (LAS float*)F.lds; LAS float* buf1 = buf0 + SC_BUFF; LAS float* yb0 = buf1 + SC_BUFF; LAS float* yb1 = yb0 + SC_YB; LAS float* dummy = yb1 + SC_YB;
    const unsigned lane = F.lane; const int wave = F.wave;
    const int cv_split = CI_SET1, cv_n = CI_SET1 + (l + 1 < NLAYER ? CI_SET0 : 0);
    for (int item = blockIdx.x; item < 256; item += GRID) {
        const int b = item >> 5, h = (item >> 2) & 7, q = item & 3;
        if (wave >= 4) {
            const int lw = wave - 4, n = h * 64 + lane, ltid = lw * 64 + lane;
            const float mu_r = pk[PK_MU + n], mu_k = pk[PK_MU + 512 + n], kk_n = pk[PK_KK + n], ka_n = pk[PK_KA + n];
            const float mu_v = pk[PK_MU + 1024 + h * 64 + 16 * q + (lane & 15)];
            ScanRegs A, B;
            scan_load(F, A, b, h, q, lw, 0, lane); scan_load(F, B, b, h, q, lw, 1, lane);
            scan_emit(A, buf0, lw, lane, mu_r, mu_k, kk_n, ka_n, mu_v);
            __syncthreads();
            LAS float* cscr = dummy + 256 + lw * (64 * 33);
            int cv_it = (item * 4 + lw); bool cv_pending = false; ConvItem cvi; float cvv[32];
            cvi = conv_item(F.ws, in, l, 1, 0);
            for (int c = 0; c < SC_NCH; ++c) {
                if ((c & 1) == 0) { if (c + 2 < SC_NCH) scan_load(F, A, b, h, q, lw, c + 2, lane); if (c + 1 < SC_NCH) scan_emit(B, buf1, lw, lane, mu_r, mu_k, kk_n, ka_n, mu_v); }
                else              { if (c + 2 < SC_NCH) scan_load(F, B, b, h, q, lw, c + 2, lane); if (c + 1 < SC_NCH) scan_emit(A, buf0, lw, lane, mu_r, mu_k, kk_n, ka_n, mu_v); }
                if (c > 0) scan_flush(F, ((c - 1) & 1) ? yb1 : yb0, b, h, q, c - 1, ltid);
                if ((c & 7) == 1 && cv_pending) { conv_store(cvi, (int)lane, cvv, cscr); cv_pending = false; cv_it += 4 * 256; }
                if ((c & 7) == 0 && cv_it < cv_n) { cvi = cv_it < cv_split ? conv_item(F.ws, in, l, 1, cv_it) : conv_item(F.ws, in, l + 1, 0, cv_it - cv_split); conv_loads(cvi, (int)lane, cvv); cv_pending = true; }
                __syncthreads();
            }
            if (cv_pending) { conv_store(cvi, (int)lane, cvv, cscr); cv_it += 4 * 256; }
            for (; cv_it < cv_n; cv_it += 4 * 256) { cvi = cv_it < cv_split ? conv_item(F.ws, in, l, 1, cv_it) : conv_item(F.ws, in, l + 1, 0, cv_it - cv_split); conv_loads(cvi, (int)lane, cvv); conv_store(cvi, (int)lane, cvv, cscr); }
            scan_flush(F, ((SC_NCH - 1) & 1) ? yb1 : yb0, b, h, q, SC_NCH - 1, ltid);
        } else {
            const int kq = lane & 15, rowl = 4 * wave + (lane >> 4);
            f32x2 S0 = (f32x2){0.f, 0.f}, S1 = S0;
            __builtin_amdgcn_s_setprio(3);
            __syncthreads();
            for (int c = 0; c < SC_NCH; ++c) {
                const LAS float* bp = (c & 1) ? buf1 : buf0;
                LAS float* yw = kq == 0 ? (((c & 1) ? yb1 : yb0) + rowl) : (dummy + lane);
                const int ystep = kq == 0 ? 16 : 0;
                ScanOps oa, ob; float qp = 0.f;
                const LAS float* lp = bp + 4 * kq; const LAS float* vp = bp + 320 + rowl;
                asm volatile("" : "+v"(lp), "+v"(vp), "+v"(yw));
                scan_ops_load(oa, lp, vp);
                scan_ops_load(ob, lp + SC_STEPF, vp + SC_STEPF);
                (void)scan_step(S0, S1, oa, qp);
#pragma unroll 2
                for (int i = 1; i < SC_CH - 1; i += 2) {
                    scan_ops_load(oa, lp + (i + 1) * SC_STEPF, vp + (i + 1) * SC_STEPF);
                    const float y0 = scan_step(S0, S1, ob, qp); yw[(i - 1) * ystep] = y0;
                    scan_ops_load(ob, lp + (i + 2) * SC_STEPF, vp + (i + 2) * SC_STEPF);
                    const float y1 = scan_step(S0, S1, oa, qp); yw[i * ystep] = y1;
                }
                { const float y2 = scan_step(S0, S1, ob, qp); yw[(SC_CH - 2) * ystep] = y2; }
                yw[(SC_CH - 1) * ystep] = red16(qp);
                __syncthreads();
            }
            __builtin_amdgcn_s_setprio(0);
        }
        __syncthreads();
    }
}

__device__ __forceinline__ void unpack4(unsigned long long u, float (&v)[4]) { v[0] = bf2f((unsigned)u & 0xffffu); v[1] = bf2f(((unsigned)u >> 16)); v[2] = bf2f((unsigned)(u >> 32) & 0xffffu); v[3] = bf2f((unsigned)(u >> 48)); }
__device__ __forceinline__ void phase_mix_final(Frame& F, const float* pk) {
    { int ln_ = F.tid & 63; asm volatile("" : "+v"(ln_)); F.lane = ln_; }
    LAS float* carry = (LAS float*)F.lds;
    const int tid = F.tid, lane = F.lane, w = F.wave, rg = lane >> 4, kq = lane & 15;
    const bf16* P = ((bf16*)(F.ws + WS_OV + OV_P)); bf16* Y = ((bf16*)(F.ws + WS_XN));
    const bf16* AB = ((bf16*)(F.ws + WS_OV + OV_ABUF)); const bf16* GB = ((bf16*)(F.ws + WS_OV + OV_GBUF)); const float* HLp = ((float*)(F.ws + WS_OV + OV_HL)); const float* CAp = ((float*)(F.ws + WS_OV + OV_CA));
    const int n0 = w * 64 + 4 * kq;
    const f32x4 mu_r = *(const f32x4*)(pk + PK_MU + n0), mu_k = *(const f32x4*)(pk + PK_MU + 512 + n0), mu_v = *(const f32x4*)(pk + PK_MU + 1024 + n0);
    const f32x4 ka4 = *(const f32x4*)(pk + PK_KA + n0), rk4 = *(const f32x4*)(pk + PK_RK + n0), lw4 = *(const f32x4*)(pk + PK_LNW + n0), lb4 = *(const f32x4*)(pk + PK_LNB + n0);
    const f32x4 ng4 = w < 4 ? *(const f32x4*)(pk + PK_LNG + n0) : (f32x4){0.f, 0.f, 0.f, 0.f};
    for (int tile = blockIdx.x; tile < 256; tile += GRID) {
        const int b = tile >> 5, c = tile & 31;
        const int s_begin = c == 0 ? 0 : NMETA + 64 * c, ntok = c == 0 ? 80 : 64;
        if (tid < 256) {
            const float* ag = ((float*)(F.ws + WS_AGG)) + ((size_t)(b * 32) * 256 + tid) * 2; float ca[32], hh[32];
#pragma unroll
            for (int c2 = 0; c2 < 31; ++c2) { ca[c2] = 0.f; hh[c2] = 0.f; if (c2 < c) { const f32x2v_ t2 = *(const f32x2v_*)(ag + (size_t)c2 * 512); ca[c2] = t2.x; hh[c2] = t2.y; } }
            float hc = 0.f;
#pragma unroll
            for (int c2 = 0; c2 < 31; ++c2) if (c2 < c) hc = ca[c2] * hc + hh[c2];
            carry[tid] = hc; }
        __syncthreads();
        f32x4 cr4 = (f32x4){0.f, 0.f, 0.f, 0.f}; if (w < 4) cr4 = *(const LAS f32x4*)(carry + n0);
        for (int tg = 0; tg < ntok; tg += 16) {
            unsigned long long rc[4], kc[4], vc[4], rp[4], kp[4], vp[4], av[4], yv[4], gv[4], lg[4]; f32x4 hl[4], cav[4];
#pragma unroll
            for (int u = 0; u < 4; ++u) { const int s = s_begin + tg + 4 * u + rg; const size_t ro = (size_t)row_of(b, s); const bf16* pr = P + ro * NINP + n0;
                rc[u] = *(const unsigned long long*)(pr + PC_R); kc[u] = *(const unsigned long long*)(pr + PC_K); vc[u] = *(const unsigned long long*)(pr + PC_V); rp[u] = 0ull; kp[u] = 0ull; vp[u] = 0ull;
                if (s > 0) { const bf16* pp = P + (size_t)row_of(b, s - 1) * NINP + n0; rp[u] = *(const unsigned long long*)(pp + PC_R); kp[u] = *(const unsigned long long*)(pp + PC_K); vp[u] = *(const unsigned long long*)(pp + PC_V); }
                av[u] = *(const unsigned long long*)(AB + ro * 512 + n0); yv[u] = *(const unsigned long long*)(Y + ro * D + 512 + n0); gv[u] = *(const unsigned long long*)(GB + ro * 512 + n0);
                lg[u] = 0ull; hl[u] = (f32x4){0.f, 0.f, 0.f, 0.f}; cav[u] = hl[u];
                if (w < 4) { lg[u] = *(const unsigned long long*)(pr + PC_LRUG); hl[u] = *(const f32x4*)(HLp + ro * 256 + n0); cav[u] = *(const f32x4*)(CAp + ro * 256 + n0); } }
#pragma unroll
            for (int u = 0; u < 4; ++u) { const int s = s_begin + tg + 4 * u + rg; const size_t ro = (size_t)row_of(b, s);
                float r_c[4], k_c[4], v_c[4], r_p[4], k_p[4], v_p[4], a4[4], y4[4], g4[4];
                unpack4(rc[u], r_c); unpack4(kc[u], k_c); unpack4(vc[u], v_c); unpack4(rp[u], r_p); unpack4(kp[u], k_p); unpack4(vp[u], v_p); unpack4(av[u], a4); unpack4(yv[u], y4); unpack4(gv[u], g4);
                float zv[4], cbp = 0.f, ysum = 0.f;
#pragma unroll
                for (int j = 0; j < 4; ++j) { const float zr = r_c[j] + (r_p[j] - r_c[j]) * mu_r[j], zk = k_c[j] + (k_p[j] - k_c[j]) * mu_k[j]; zv[j] = v_c[j] + (v_p[j] - v_c[j]) * mu_v[j];
                    cbp += zr * (zk * (1.0f + (a4[j] - 1.0f) * ka4[j])) * rk4[j]; ysum += y4[j]; }
                const float cb = red16(cbp), mean = red16(ysum) * (1.0f / 64.0f);
                float d4[4], vs = 0.f;
#pragma unroll
                for (int j = 0; j < 4; ++j) { d4[j] = y4[j] - mean; vs += d4[j] * d4[j]; }
                const float rstd = rsqrtf(red16(vs) * (1.0f / 64.0f) + LNX_EPS);
                float o4[4];
#pragma unroll
                for (int j = 0; j < 4; ++j) o4[j] = (d4[j] * rstd * lw4[j] + lb4[j] + cb * zv[j]) * g4[j];
                *(GAS unsigned long long*)(Y + ro * D + 512 + n0) = (unsigned long long)pk2(o4[0], o4[1]) | ((unsigned long long)pk2(o4[2], o4[3]) << 32);
                if (w < 4) { float l4[4], yy[4], ss = 0.f; unpack4(lg[u], l4);
#pragma unroll
                    for (int j = 0; j < 4; ++j) { yy[j] = gelu_tanh(l4[j]) * (hl[u][j] + cav[u][j] * cr4[j]); ss += yy[j] * yy[j]; }
                    const float rs = rsqrtf(red16(ss) * (1.0f / 64.0f) + RMS_EPS);
                    *(GAS unsigned long long*)(Y + ro * D + n0) = (unsigned long long)pk2(yy[0] * rs * ng4[0], yy[1] * rs * ng4[1]) | ((unsigned long long)pk2(yy[2] * rs * ng4[2], yy[3] * rs * ng4[3]) << 32); } }
        }
        __syncthreads();
    }
}
#ifndef MK_PER_PHASE
#define MK_PER_PHASE 0
#endif
constexpr int REP_GEMM = 1, REP_PREP = 1, REP_SCAN = 1, REP_CONV = 1;
constexpr int PH_PER_LAYER = 12, N_PHASES = 1 + NLAYER * PH_PER_LAYER;
struct Args { const float* in[30]; float* out; unsigned char* ws; int ph_lo, ph_hi; };
static_assert(sizeof(Args) == 30 * 8 + 8 + 8 + 4 + 4, "Args has no padding");

__global__ void __launch_bounds__(NWAVES * 64, 2) hybrid_fwd(Args args) {
    extern __shared__ __attribute__((aligned(16))) unsigned char lds[];
    Frame F;
    F.lds = (LAS unsigned char*)lds;
    F.tid = threadIdx.x; F.lane = F.tid & 63; F.wave = 0;
    { const int bx = blockIdx.x; F.vcu = (bx % 8) * (GRID / 8) + bx / 8; }
    unsigned char* ws = args.ws;
    F.ws = ws; F.x = args.in[0]; F.meta = args.in[1]; F.out = args.out;
    volatile LAS unsigned* MISC = (volatile LAS unsigned*)(F.lds + MISC_OFF);
    for (int u = F.tid; u < (LDS_BYTES - LDSCTL_OFF) / 4; u += NWAVES * 64) ((LAS unsigned*)(F.lds + LDSCTL_OFF))[u] = 0u;
    __syncthreads();
    { const unsigned simd = ((unsigned)__builtin_amdgcn_s_getreg((1 << 11) | (4 << 6) | 4)) & 3u;
      unsigned tk = 0u; if (vlane() == 0) tk = __hip_atomic_fetch_add((LAS unsigned*)(F.lds + MISC_OFF) + 12 + simd, 1u, __ATOMIC_RELAXED, __HIP_MEMORY_SCOPE_WORKGROUP); F.wave = (int)(simd + 4u * ((unsigned)__builtin_amdgcn_readfirstlane(tk) & 1u)); }
    F.lane = vlane(); F.tid = F.wave * 64 + F.lane;
    XcdBarrier bar; bar.bar = (unsigned*)(ws + WS_CTL) + CW_BAR; bar.x = 0; bar.st = nullptr;
    if (!MK_PER_PHASE) bar = xcd_barrier_post((unsigned*)(ws + WS_CTL) + CW_BAR, MISC + 8, F.tid == 0);
    const int lo = args.ph_lo, hi = args.ph_hi;
    unsigned long long pr_prev = 0ull; F.pr_acc = 0ull; F.pr_sub = 0ull; F.ph = 0; if (PROBE_MASK) pr_prev = __builtin_amdgcn_s_memrealtime();
#pragma unroll 1
    for (int ph = lo; ph < hi; ++ph) {
        if (PROBE_MASK) F.ph = ph;
        { GAS unsigned char* wsg = (GAS unsigned char*)args.ws; asm volatile("" : "+s"(wsg)); F.ws = (unsigned char*)wsg; }
        { int t_ = F.wave * 64 + vlane(); asm volatile("" : "+v"(t_)); F.tid = t_; }
        if (ph == 0) { phase_init(F, args.in[2]); phase_pack(F, args.in); phase_frag(F, args.in); for (int rep_ = 0; rep_ < REP_CONV; ++rep_) phase_convert(F, args.in, 0, 0); }
        else {
            const int l = (ph - 1) / PH_PER_LAYER, k = (ph - 1) - l * PH_PER_LAYER;
            if (k == 0 || k == 1 || k == 3 || k == 7 || k == 9 || k == 10) {
                unsigned char* w = F.ws;
                const bool up = (k == 0 || k == 9), down = (k == 1 || k == 10);
                const bf16* A = (const bf16*)(w + (down ? WS_OV + OV_HID : WS_XN));
                const bf16* B = (const bf16*)(w + WS_WB + (k == 0 ? WB_W1IN : k == 1 ? WB_W1OUT : k == 3 ? WB_WIN : k == 7 ? WB_WOUT : k == 9 ? WB_W2IN : WB_W2OUT));
                const int N = up ? 2 * FF : (k == 3 ? NINP : D), K = down ? FF : D;
                pg8::EpiAny E; E.mode = up ? 0 : 1; E.O = w + WS_OV + (up ? OV_HID : k == 3 ? OV_P : k == 7 ? OV_RAWM : OV_RAWF); E.ldo = up ? FF : (k == 3 ? NINP : D);
                pg8::Gemm g{A, B, MP, N, K, K}; pg8::StaticOrder S; S.init(MP, N, GRID, (int)blockIdx.x);
                for (int rep_ = 0; rep_ < REP_GEMM; ++rep_) pg8::gemm_phase<pg8::EpiAny, pg8::StaticOrder, true, true>(F.lds, g, S, E, F.tid);
            } else if (k == 2 || k == 8 || k == 11) {
                const float* ng = args.in[2] + (size_t)l * 6 * D;
                const bool last = l + 1 == NLAYER;
                const float* g_post = ng + (k == 2 ? 1 : k == 8 ? 3 : 5) * D;
                const float* g_pre = k == 2 ? ng + 2 * D : k == 8 ? ng + 4 * D : (!last ? ng + 6 * D : nullptr);
                bf16* h16 = (bf16*)F.out; bf16* htmp = (bf16*)(F.ws + WS_OV + OV_HTMP);
                PostIO io; io.raw16 = (const bf16*)(F.ws + WS_OV + (k == 8 ? OV_RAWM : OV_RAWF)); io.x32 = (l == 0 && k == 2) ? F.x : nullptr;
                io.hin16 = (last && k == 11) ? htmp : h16; io.hout16 = (last && k == 8) ? htmp : h16; io.out32 = (last && k == 11) ? F.out : nullptr;
                phase_post(F, io, k == 8 ? 1.0f : 0.5f, g_post, g_pre);
            } else if (k == 4) { for (int rep_ = 0; rep_ < REP_PREP; ++rep_) phase_mix_prep(F, pack_of(F, l), l); }
            else if (k == 5) { for (int rep_ = 0; rep_ < REP_SCAN; ++rep_) phase_scan(F, pack_of(F, l), args.in, l); }
            else { phase_mix_final(F, pack_of(F, l)); }
        }
        if (ph + 1 < hi) xcd_barrier(bar, F.tid == 0);
        if (PROBE_MASK) { const unsigned long long t = __builtin_amdgcn_s_memrealtime(); if (PROBE_SUB < 0 && ((PROBE_MASK >> ph) & 1u)) F.pr_acc += t - pr_prev; pr_prev = t; F.pr_sub = t; }
    }
    if (PROBE_MASK && blockIdx.x == 0 && F.tid == 0) { const unsigned long long t0 = __builtin_amdgcn_s_memrealtime(); while (__builtin_amdgcn_s_memrealtime() - t0 < PROBE_AMP * F.pr_acc) __builtin_amdgcn_s_sleep(8); }
}

extern "C" void kernel_launch(void* const* d_in, const int* in_sizes, int n_in, void* d_out, int out_size, void* d_ws, size_t ws_size, hipStream_t stream) {
    static int grid = 0;
    if (grid == 0) {
        if (n_in != 30 || in_sizes[0] != MX * D || out_size != MX * D || ws_size < WS_END) { fprintf(stderr, "kernel_launch: unexpected shapes: n_in %d in0 %d out %d ws %zu\n", n_in, n_in > 0 ? in_sizes[0] : -1, out_size, ws_size); grid = -1; return; }
        int dev = 0, cus = 0, per_cu = 0;
        if (hipGetDevice(&dev) != hipSuccess || hipDeviceGetAttribute(&cus, hipDeviceAttributeMultiprocessorCount, dev) != hipSuccess) { grid = -1; return; }
        if (hipFuncSetAttribute((const void*)hybrid_fwd, hipFuncAttributeMaxDynamicSharedMemorySize, LDS_BYTES) != hipSuccess) { fprintf(stderr, "kernel_launch: hipFuncSetAttribute failed\n"); grid = -1; return; }
        if (hipOccupancyMaxActiveBlocksPerMultiprocessor(&per_cu, (const void*)hybrid_fwd, NWAVES * 64, LDS_BYTES) != hipSuccess || per_cu < 1) { fprintf(stderr, "kernel_launch: occupancy query says %d blocks per CU\n", per_cu); grid = -1; (void)hipGetLastError(); return; }
        (void)hipGetLastError();
        if (cus < GRID) { fprintf(stderr, "kernel_launch: this kernel needs %d CUs (one resident workgroup each), the device has %d\n", GRID, cus); grid = -1; return; }
        grid = GRID;
    }
    if (grid < 0) return;
    if (hipMemsetAsync((char*)d_ws + WS_CTL, 0, CTL_ZERO_BYTES, stream) != hipSuccess) return;
    Args a{};
    for (int i = 0; i < 30; ++i) a.in[i] = (const float*)d_in[i];
    a.out = (float*)d_out; a.ws = (unsigned char*)d_ws;
#if MK_PER_PHASE
    for (int p = 0; p < N_PHASES; ++p) { a.ph_lo = p; a.ph_hi = p + 1; hipLaunchKernelGGL(hybrid_fwd, dim3(grid), dim3(NWAVES * 64), LDS_BYTES, stream, a); }
#else
    a.ph_lo = 0; a.ph_hi = N_PHASES;
    hipLaunchKernelGGL(hybrid_fwd, dim3(grid), dim3(NWAVES * 64), LDS_BYTES, stream, a);
#endif
}
```

```cpp
#include <hip/hip_runtime.h>
#include <cstdio>
#include <cstdint>
namespace pg8 {
#define PG8_LAS __attribute__((address_space(3)))
typedef unsigned short bf16_t;
typedef short bf16x8 __attribute__((ext_vector_type(8)));
typedef float f32x4 __attribute__((ext_vector_type(4)));
typedef unsigned u32x4 __attribute__((ext_vector_type(4)));
constexpr int BM = 256, BK = 64, HALF = 128, HTB = HALF * BK * 2  , STAGE_BYTES = 8 * HTB, NXCD = 8, WGM = 8;

__host__ __device__ __forceinline__ int lds_byte(int r, int c) { const int st = (r >> 4) * 2 + (c >> 5), rr = r & 15, cc = c & 31, ob = rr * 64 + cc * 2; return st * 1024 + (ob ^ (((ob >> 9) & 1) << 5)); }
__host__ __device__ __forceinline__ void stage_rc(int b, int& R, int& C) { const int st = b / 1024, sb = b % 1024, swz = sb ^ (((sb >> 9) & 1) << 5); R = (st >> 1) * 16 + swz / 64; C = (st & 1) * 32 + (swz % 64) / 2; }
__host__ __device__ __forceinline__ int perm32(int rho) { const int n = rho >> 4, i = rho & 15; return 8 * (i >> 2) + 4 * n + (i & 3); }

struct Unit { int pm, pn; };
struct Gemm { const bf16_t* A; const bf16_t* Bt; int M, N, K, ld; };

struct StaticOrder {
    int nM, nN, nwg, G, c, one_pn;
    __host__ __device__ void init(int M, int N, int G_, int c_) { nM = M / BM; nN = N / BM; nwg = nM * nN; G = G_; c = c_; one_pn = -1; }
    __host__ __device__ bool next(int i, Unit& u) const {
        if (one_pn != -1) { if (i != 0 || one_pn < 0) return false; u.pm = 0; u.pn = one_pn; return true; }
        const long L = (long)i * G + c; if (L >= nwg) return false;
        int wgid = (int)L; { const int q = nwg / NXCD, r = nwg % NXCD, xcd = wgid % NXCD, off = wgid / NXCD; wgid = (xcd < r ? xcd * (q + 1) : r * (q + 1) + (xcd - r) * q) + off; }
        const int nig = WGM * nN, gid = wgid / nig, fm = gid * WGM, gsz = (nM - fm) < WGM ? (nM - fm) : WGM;
        u.pm = fm + ((wgid % nig) % gsz); u.pn = (wgid % nig) / gsz; return true;
    }
    __device__ __forceinline__ void a_ready(const Unit&) const {}
    __device__ __forceinline__ void done(const Unit&) const {}
};
__device__ __forceinline__ unsigned cvt_pk_bf16(float lo, float hi) { unsigned r; asm volatile("v_cvt_pk_bf16_f32 %0, %1, %2" : "=v"(r) : "v"(lo), "v"(hi)); return r; }
typedef float f32x2 __attribute__((ext_vector_type(2)));
struct EpiSwiGLU {
    static constexpr bool PERM = true, AFTER_DRAIN = false;
    bf16_t* O; int ldo;
    __device__ __forceinline__ void operator()(const f32x4 (&acc)[2][2][4][2], const Unit& u, int wr, int wc, int fr, int fq) const {
        const int row0 = u.pm * BM + wr * 64 + fr, col0 = u.pn * HALF + wc * 32 + 8 * fq;
#pragma unroll
        for (int ai = 0; ai < 2; ++ai)
#pragma unroll
            for (int m = 0; m < 4; ++m) { bf16_t* rowp = O + (size_t)(row0 + ai * HALF + m * 16) * ldo + col0;
                float hv[8];
#pragma unroll
                for (int n = 0; n < 2; ++n)
#pragma unroll
                    for (int j = 0; j < 4; ++j) { const float g = acc[ai][0][m][n][j], up = acc[ai][1][m][n][j]; hv[n * 4 + j] = g * __builtin_amdgcn_rcpf(1.0f + __expf(-g)) * up; }
                u32x4 w; w.x = cvt_pk_bf16(hv[0], hv[1]); w.y = cvt_pk_bf16(hv[2], hv[3]); w.z = cvt_pk_bf16(hv[4], hv[5]); w.w = cvt_pk_bf16(hv[6], hv[7]);
                *(u32x4*)rowp = w; }
    }
};
struct EpiStoreBf16 {
    static constexpr bool PERM = true, AFTER_DRAIN = false;
    bf16_t* O; int ldc;
    __device__ __forceinline__ void operator()(const f32x4 (&acc)[2][2][4][2], const Unit& u, int wr, int wc, int fr, int fq) const {
        const int row0 = u.pm * BM + wr * 64 + fr, col0 = u.pn * BM + wc * 32 + 8 * fq;
#pragma unroll
        for (int ai = 0; ai < 2; ++ai)
#pragma unroll
            for (int m = 0; m < 4; ++m) { bf16_t* rowp = O + (size_t)(row0 + ai * HALF + m * 16) * ldc + col0;
#pragma unroll
                for (int bj = 0; bj < 2; ++bj) { const f32x4 v0 = acc[ai][bj][m][0], v1 = acc[ai][bj][m][1];
                    u32x4 w; w.x = cvt_pk_bf16(v0[0], v0[1]); w.y = cvt_pk_bf16(v0[2], v0[3]); w.z = cvt_pk_bf16(v1[0], v1[1]); w.w = cvt_pk_bf16(v1[2], v1[3]);
                    *(u32x4*)(rowp + bj * HALF) = w; } }
    }
};
struct EpiF32 {
    static constexpr bool PERM = false, AFTER_DRAIN = false;
    float* C; int ldc;
    __device__ __forceinline__ void operator()(const f32x4 (&acc)[2][2][4][2], const Unit& u, int wr, int wc, int fr, int fq) const {
        const int row0 = u.pm * BM + wr * 64 + fr, col0 = u.pn * BM + wc * 32 + 4 * fq;
#pragma unroll
        for (int ai = 0; ai < 2; ++ai)
#pragma unroll
            for (int m = 0; m < 4; ++m) { float* rowp = C + (size_t)(row0 + ai * HALF + m * 16) * ldc + col0;
#pragma unroll
                for (int bj = 0; bj < 2; ++bj)
#pragma unroll
                    for (int n = 0; n < 2; ++n) *(f32x4*)(rowp + bj * HALF + n * 16) = acc[ai][bj][m][n]; }
    }
};
struct EpiAny {
    static constexpr bool PERM = true, AFTER_DRAIN = false;
    int mode; void* O; int ldo;
    __device__ __forceinline__ void operator()(f32x4 (&acc)[2][2][4][2], const Unit& u, int wr, int wc, int fr, int fq) const {
        if (mode == 0) { EpiSwiGLU E{(bf16_t*)O, ldo}; E(acc, u, wr, wc, fr, fq); }
        else if (mode == 1) { EpiStoreBf16 E{(bf16_t*)O, ldo}; E(acc, u, wr, wc, fr, fq); }
        else { float* C = (float*)O; const int row0 = u.pm * BM + wr * 64 + fr, col0 = u.pn * BM + wc * 32 + 8 * fq;
#pragma unroll
            for (int ai = 0; ai < 2; ++ai)
#pragma unroll
                for (int m = 0; m < 4; ++m) { float* rowp = C + (size_t)(row0 + ai * HALF + m * 16) * ldo + col0;
#pragma unroll
                    for (int bj = 0; bj < 2; ++bj)
#pragma unroll
                        for (int n = 0; n < 2; ++n) *(f32x4*)(rowp + bj * HALF + n * 4) = acc[ai][bj][m][n]; } }
    }
};
template <class Epi, class Sched, bool ALIGN_EPI = false, bool SP2 = false>
__device__ __forceinline__ void gemm_phase(PG8_LAS unsigned char* lds, const Gemm g, const Sched& S, const Epi& E, int tid_in  ) {
    int tid_ = tid_in; asm volatile("" : "+v"(tid_));
    const int tid = tid_, wid = __builtin_amdgcn_readfirstlane(tid >> 6), lane = tid & 63, wr = wid >> 2, wc = wid & 3, fr = lane & 15, fq = lane >> 4;
    const int K = g.K, LD = g.ld, nt = K / BK;
    unsigned voffA[2], voffB[2];
#pragma unroll
    for (int i = 0; i < 2; ++i) { int R, C; stage_rc(tid * 16 + i * 8192, R, C); const int Rb = Epi::PERM ? ((R & ~31) + perm32(R & 31)) : R;
        voffA[i] = (unsigned)(R * LD + C) * 2u; voffB[i] = (unsigned)(Rb * LD + C) * 2u; }
    const size_t kstep = (size_t)(BK * 2);
    const size_t hstep = (size_t)HALF * LD * 2;
    const size_t tstep = 2 * hstep;
    const unsigned ldsw = (unsigned)wid * 1024u;
    const int aoff = lds_byte(wr * 64 + fr, fq * 8), boff = lds_byte(wc * 32 + fr, fq * 8);
#define PG8_SA(b, h) (((b) * 2 + (h)) * HTB)
#define PG8_SB(b, h) ((4 + (b) * 2 + (h)) * HTB)
#define PG8_STAGE(bufoff, gbase, voff) do { _Pragma("unroll") for (int _i = 0; _i < 2; ++_i) \
        __builtin_amdgcn_global_load_lds((const unsigned*)((const char*)(gbase) + (voff)[_i]), (PG8_LAS unsigned*)(lds + (bufoff) + ldsw + _i * 8192), 16, 0, 0); } while (0)
#define PG8_LDA(dst, b, h) do { _Pragma("unroll") for (int m = 0; m < 4; ++m) _Pragma("unroll") for (int k = 0; k < 2; ++k) dst[m][k] = *(const PG8_LAS bf16x8*)(lds + PG8_SA(b, h) + aoff + m * 2048 + k * 1024); } while (0)
#define PG8_LDB(dst, b, h) do { _Pragma("unroll") for (int n = 0; n < 2; ++n) _Pragma("unroll") for (int k = 0; k < 2; ++k) dst[n][k] = *(const PG8_LAS bf16x8*)(lds + PG8_SB(b, h) + boff + n * 2048 + k * 1024); } while (0)
#define PG8_MMA(ai, bj, At, Bt) do { __builtin_amdgcn_s_setprio(1); _Pragma("unroll") for (int m = 0; m < 4; ++m) _Pragma("unroll") for (int n = 0; n < 2; ++n) _Pragma("unroll") for (int k = 0; k < 2; ++k) \
        acc[ai][bj][m][n] = __builtin_amdgcn_mfma_f32_16x16x32_bf16(Bt[n][k], At[m][k], acc[ai][bj][m][n], 0, 0, 0); __builtin_amdgcn_s_setprio(0); } while (0)
#define PG8_WAIT_V(n) asm volatile("s_waitcnt vmcnt(" #n ")" ::: "memory")
#define PG8_WAIT_L(n) asm volatile("s_waitcnt lgkmcnt(" #n ")" ::: "memory")
#define PG8_BAR __builtin_amdgcn_s_barrier()
#define PG8_SCHED __builtin_amdgcn_sched_barrier(0)
    Unit cur, nxt; int ui = 0;
    if (!S.next(0, cur)) return;
    f32x4 acc[2][2][4][2];
#pragma unroll
    for (int a = 0; a < 2; ++a)
#pragma unroll
        for (int b = 0; b < 2; ++b)
#pragma unroll
            for (int m = 0; m < 4; ++m)
#pragma unroll
                for (int n = 0; n < 2; ++n) acc[a][b][m][n] = (f32x4){0.f, 0.f, 0.f, 0.f};
    bf16x8 At[4][2], B0[2][2], B1[2][2];
    const char* cA = (const char*)g.A + (size_t)cur.pm * tstep; const char* cB = (const char*)g.Bt + (size_t)cur.pn * tstep;
    S.a_ready(cur);
    if constexpr (SP2) {
        PG8_STAGE(PG8_SB(0, 0), cB, voffB); PG8_STAGE(PG8_SB(0, 1), cB + hstep, voffB); PG8_STAGE(PG8_SA(0, 0), cA, voffA); PG8_STAGE(PG8_SA(0, 1), cA + hstep, voffA);
        if (wr == 1) PG8_BAR;
        PG8_WAIT_V(2); PG8_BAR;
        PG8_STAGE(PG8_SB(1, 0), cB + kstep, voffB); PG8_STAGE(PG8_SA(1, 0), cA + kstep, voffA); PG8_STAGE(PG8_SB(1, 1), cB + hstep + kstep, voffB);
        PG8_WAIT_V(6); PG8_BAR;
    } else {
        PG8_STAGE(PG8_SB(0, 0), cB, voffB); PG8_STAGE(PG8_SA(0, 0), cA, voffA); PG8_STAGE(PG8_SB(0, 1), cB + hstep, voffB); PG8_STAGE(PG8_SA(0, 1), cA + hstep, voffA);
        if (wr == 1) PG8_BAR;
        PG8_WAIT_V(4); PG8_BAR;
        PG8_STAGE(PG8_SB(1, 0), cB + kstep, voffB); PG8_STAGE(PG8_SA(1, 0), cA + kstep, voffA); PG8_STAGE(PG8_SB(1, 1), cB + hstep + kstep, voffB);
        PG8_WAIT_V(6); PG8_BAR;
    }
    for (;;) {
        const bool has_next = S.next(ui + 1, nxt);
        const char* nA = has_next ? (const char*)g.A + (size_t)nxt.pm * tstep : cA; const char* nB = has_next ? (const char*)g.Bt + (size_t)nxt.pn * tstep : cB;
        for (int t = 0; t < nt; t += 2) {
            const bool last = (t == nt - 2);
            const char* a1 = cA + (size_t)(t + 1) * kstep;
            const char* a2 = last ? nA : cA + (size_t)(t + 2) * kstep; const char* b2 = last ? nB : cB + (size_t)(t + 2) * kstep;
            const char* a3 = a2 + kstep; const char* b3 = b2 + kstep;
            if (last && has_next) S.a_ready(nxt);
            if constexpr (SP2) {
            PG8_LDB(B0, 0, 0); PG8_LDB(B1, 0, 1); PG8_SCHED; PG8_LDA(At, 0, 0); PG8_STAGE(PG8_SA(1, 1), a1 + hstep, voffA);
            PG8_WAIT_V(8); PG8_WAIT_L(0); PG8_BAR; PG8_MMA(0, 0, At, B0); PG8_MMA(0, 1, At, B1); PG8_BAR; PG8_SCHED;
            PG8_LDA(At, 0, 1); PG8_STAGE(PG8_SB(0, 0), b2, voffB); PG8_STAGE(PG8_SB(0, 1), b2 + hstep, voffB); PG8_STAGE(PG8_SA(0, 0), a2, voffA);
            PG8_WAIT_V(8); PG8_WAIT_L(0); PG8_BAR; PG8_MMA(1, 0, At, B0); PG8_MMA(1, 1, At, B1); PG8_BAR; PG8_SCHED;
            PG8_LDB(B0, 1, 0); PG8_LDB(B1, 1, 1); PG8_SCHED; PG8_LDA(At, 1, 0); PG8_STAGE(PG8_SA(0, 1), a2 + hstep, voffA);
            PG8_WAIT_V(8); PG8_WAIT_L(0); PG8_BAR; PG8_MMA(0, 0, At, B0); PG8_MMA(0, 1, At, B1); PG8_BAR; PG8_SCHED;
            PG8_LDA(At, 1, 1); PG8_STAGE(PG8_SB(1, 0), b3, voffB); PG8_STAGE(PG8_SB(1, 1), b3 + hstep, voffB); PG8_STAGE(PG8_SA(1, 0), a3, voffA);
            PG8_WAIT_V(8); PG8_WAIT_L(0); PG8_BAR; PG8_MMA(1, 0, At, B0); PG8_MMA(1, 1, At, B1); PG8_BAR; PG8_SCHED;
            } else {
            PG8_LDB(B0, 0, 0); PG8_SCHED; PG8_LDA(At, 0, 0); PG8_STAGE(PG8_SA(1, 1), a1 + hstep, voffA);
            PG8_WAIT_L(8); PG8_BAR; PG8_WAIT_L(0); PG8_MMA(0, 0, At, B0); PG8_BAR; PG8_SCHED;
            PG8_LDB(B1, 0, 1); PG8_STAGE(PG8_SB(0, 0), b2, voffB);
            PG8_BAR; PG8_WAIT_L(0); PG8_MMA(0, 1, At, B1); PG8_BAR;
            PG8_LDA(At, 0, 1); PG8_STAGE(PG8_SA(0, 0), a2, voffA);
            PG8_BAR; PG8_WAIT_L(0); PG8_MMA(1, 0, At, B0); PG8_BAR; PG8_SCHED;
            PG8_STAGE(PG8_SB(0, 1), b2 + hstep, voffB);
            PG8_WAIT_V(6); PG8_BAR; PG8_MMA(1, 1, At, B1); PG8_BAR;
            PG8_LDB(B0, 1, 0); PG8_SCHED; PG8_LDA(At, 1, 0); PG8_STAGE(PG8_SA(0, 1), a2 + hstep, voffA);
            PG8_WAIT_L(8); PG8_BAR; PG8_WAIT_L(0); PG8_MMA(0, 0, At, B0); PG8_BAR; PG8_SCHED;
            PG8_LDB(B1, 1, 1); PG8_STAGE(PG8_SB(1, 0), b3, voffB);
            PG8_BAR; PG8_WAIT_L(0); PG8_MMA(0, 1, At, B1); PG8_BAR;
            PG8_LDA(At, 1, 1); PG8_STAGE(PG8_SA(1, 0), a3, voffA);
            PG8_BAR; PG8_WAIT_L(0); PG8_MMA(1, 0, At, B0); PG8_BAR; PG8_SCHED;
            PG8_STAGE(PG8_SB(1, 1), b3 + hstep, voffB);
            PG8_WAIT_V(6); PG8_BAR; PG8_MMA(1, 1, At, B1); PG8_BAR;
            }
        }
        if constexpr (ALIGN_EPI) { if (wr == 0) PG8_BAR; }
        E(acc, cur, wr, wc, fr, fq); S.done(cur);
        if (!has_next) break;
#pragma unroll
        for (int a = 0; a < 2; ++a)
#pragma unroll
            for (int b = 0; b < 2; ++b)
#pragma unroll
                for (int m = 0; m < 4; ++m)
#pragma unroll
                    for (int n = 0; n < 2; ++n) acc[a][b][m][n] = (f32x4){0.f, 0.f, 0.f, 0.f};
        cur = nxt; cA = nA; cB = nB; ++ui;
        if constexpr (ALIGN_EPI) { if (wr == 1) PG8_BAR; }
    }
    PG8_WAIT_V(0);
    if constexpr (!ALIGN_EPI) { if (wr == 0) PG8_BAR; }
    PG8_BAR;
#undef PG8_SA
#undef PG8_SB
#undef PG8_STAGE
#undef PG8_LDA
#undef PG8_LDB
#undef PG8_MMA
#undef PG8_WAIT_V
#undef PG8_WAIT_L
#undef PG8_BAR
#undef PG8_SCHED
}
}
constexpr int NWAVES = 8, GRID = 256;
constexpr int D = 1024, FF = 2816, NIN = 2944, NINP = 3072, NLAYER = 2;
constexpr int NB = 8, SEQ = 2048, NMETA = 16, TT = SEQ + NMETA;
constexpr int MX = NB * SEQ, MREAL = MX + NMETA, MP = 16640;
constexpr float RMS_EPS = 1e-6f, LNX_EPS = 64e-5f;
constexpr int PC_LRUX = 0, PC_LRUG = 256, PC_SCB = 512, PC_SCC = 768, PC_SCX = 1024, PC_R = 1280, PC_K = 1792, PC_V = 2304, PC_LO = 2816;

constexpr size_t MiB = 1u << 20;
constexpr size_t WS_CTL = 0, CTL_ZERO_BYTES = 1 * MiB;
constexpr size_t WS_HMETA = 1 * MiB;
constexpr size_t WS_MSLAB = WS_HMETA + 64 * 1024;
constexpr size_t WS_AGG = 2 * MiB;
constexpr size_t WS_WB = 3 * MiB;
constexpr size_t WB_W1IN = 0, WB_W1OUT = 11 * MiB, WB_W2IN = WB_W1OUT + 5632 * 1024, WB_W2OUT = WB_W2IN + 11 * MiB, WB_WIN = WB_W2OUT + 5632 * 1024, WB_WOUT = WB_WIN + 6 * MiB, WB_END = WB_WOUT + 2 * MiB;
static_assert(WB_END == 41 * MiB, "weight map");
constexpr size_t WS_XN = 44 * MiB;
constexpr size_t WS_OV = 77 * MiB;
constexpr size_t OV_HID = 0, OV_RAWF = 90 * MiB;
constexpr size_t OV_P = 0, OV_WDEC = OV_P + (size_t)MP * NINP * 2, OV_ABUF = OV_WDEC + (size_t)MP * 512 * 2, OV_GBUF = OV_ABUF + (size_t)MP * 512 * 2, OV_HL = OV_GBUF + (size_t)MP * 512 * 2, OV_CA = OV_HL + (size_t)MP * 256 * 4, OV_MIXEND = OV_CA + (size_t)MP * 256 * 4;
constexpr size_t OV_HTMP = 130 * MiB;
constexpr size_t OV_RAWM = 0;
constexpr size_t WS_END = 256 * MiB;
static_assert(WS_XN + (size_t)MP * D * 2 <= WS_OV && WS_OV + OV_MIXEND <= WS_END && WS_OV + OV_RAWF + (size_t)MP * D * 4 <= WS_END && (size_t)MP * FF * 2 <= OV_RAWF, "d_ws map");
constexpr int CW_TMO = 8, CW_CNTM = 72, CW_BAR = 4096, CW_CNTA = 8192, CW_CNTB = CW_CNTA + 65 * 64;
constexpr size_t OV_X1 = 156 * MiB, OV_SLAB = 158 * MiB;

constexpr unsigned PROBE_MASK = 0u, PROBE_AMP = 8u; constexpr int PROBE_SUB = -1;
#define PSTAMP(j) do { if (PROBE_MASK && PROBE_SUB >= 0) { const unsigned long long t_ = __builtin_amdgcn_s_memrealtime(); if (PROBE_SUB == (j) && ((PROBE_MASK >> F.ph) & 1u)) F.pr_acc += t_ - F.pr_sub; F.pr_sub = t_; } } while (0)
constexpr int RING_BYTES = 143360, LDSCTL_OFF = RING_BYTES, MISC_OFF = LDSCTL_OFF + 320, LDS_BYTES = 147456;

#define GAS __attribute__((address_space(1)))
#define LAS __attribute__((address_space(3)))
typedef unsigned short bf16;
typedef unsigned v4u __attribute__((ext_vector_type(4)));
typedef float f32x4 __attribute__((ext_vector_type(4)));
typedef GAS unsigned gu32;
typedef float f32x2v_ __attribute__((ext_vector_type(2)));
#define LDS_WAIT() asm volatile("s_waitcnt lgkmcnt(0)" ::: "memory")
__device__ __forceinline__ unsigned f2bf(float f) { unsigned u = __builtin_bit_cast(unsigned, f); return (u + 0x7fffu + ((u >> 16) & 1u)) >> 16; }
__device__ __forceinline__ unsigned pk2(float lo, float hi) { return f2bf(lo) | (f2bf(hi) << 16); }
__device__ __forceinline__ float bf2f(unsigned b) { return __builtin_bit_cast(float, b << 16); }
__device__ __forceinline__ float sigmoidf_(float x) { return __builtin_amdgcn_rcpf(1.0f + __expf(-x)); }
__device__ __forceinline__ float tanhf_(float x) { return 1.0f - 2.0f * __builtin_amdgcn_rcpf(1.0f + __expf(2.0f * x)); }
__device__ __forceinline__ float softplusf_(float x) { return fmaxf(x, 0.f) + __logf(1.0f + __expf(-fabsf(x))); }
__device__ __forceinline__ float gelu_tanh(float x) { const float u = 0.7978845608028654f * (x + 0.044715f * x * x * x); return 0.5f * x * (1.0f + tanhf_(u)); }
template <int CTRL> __device__ __forceinline__ float dppf(float x) { return __builtin_bit_cast(float, __builtin_amdgcn_mov_dpp(__builtin_bit_cast(int, x), CTRL, 0xf, 0xf, true)); }
__device__ __forceinline__ float red16(float x) { x += dppf<0xB1>(x); x += dppf<0x4E>(x); x += dppf<0x141>(x); x += dppf<0x128>(x); return x; }
__device__ __forceinline__ float wave_sum(float x) {
    x = red16(x);
    x += __builtin_bit_cast(float, __builtin_amdgcn_update_dpp(0, __builtin_bit_cast(int, x), 0x142, 0xa, 0xf, false));
    x += __builtin_bit_cast(float, __builtin_amdgcn_update_dpp(0, __builtin_bit_cast(int, x), 0x143, 0xc, 0xf, false));
    return __builtin_bit_cast(float, __builtin_amdgcn_readlane(__builtin_bit_cast(int, x), 63)); }
__device__ __forceinline__ float wave_sum_dpp(float x) { return wave_sum(x); }
__device__ __forceinline__ int vlane() { return (int)__builtin_amdgcn_mbcnt_hi(~0u, __builtin_amdgcn_mbcnt_lo(~0u, 0u)); }
__device__ __forceinline__ int row_of(int b, int s) { return s < NMETA ? (MX + s) : (b * SEQ + s - NMETA); }
#define XB_TMO      128
#define XB_XCNT(j)  (256  + 64 * (j))
#define XB_XSUB(j)  (1280 + 64 * (j))
#define XB_XGEN(j)  (2304 + 64 * (j))
#define XB_TOP      3328
#define XB_TOPGEN   3392
#define XCD_BAR_WORDS 3456
#define XB_SPIN_CAP (1u << 18)

__device__ __forceinline__ unsigned xb_ld(unsigned* p)              { return __hip_atomic_load(p, __ATOMIC_RELAXED, __HIP_MEMORY_SCOPE_AGENT); }
__device__ __forceinline__ unsigned xb_add(unsigned* p, unsigned v) { return __hip_atomic_fetch_add(p, v, __ATOMIC_RELAXED, __HIP_MEMORY_SCOPE_AGENT); }
__device__ __forceinline__ unsigned xb_xcc_id() { return (unsigned)__builtin_amdgcn_s_getreg((3 << 11) | 20) & 0xFu; }
#define XB_SPIN(cond, bar) do { unsigned _sp = 0; while (cond) { __builtin_amdgcn_s_sleep(1); \
    if ((++_sp & 255u) == 0u) { if (xb_ld(&(bar)[XB_TMO])) break; if (_sp > XB_SPIN_CAP) { atomicAdd(&(bar)[XB_TMO], 1u); break; } } } } while (0)

struct XcdBarrier {
    unsigned* bar; unsigned x;
    volatile LAS unsigned* st;
};

__device__ __forceinline__ XcdBarrier xcd_barrier_post(unsigned* bar, volatile LAS unsigned* st, bool leader  ) {
    XcdBarrier b; b.bar = bar; b.x = xb_xcc_id(); b.st = st;
    if (leader) (void)xb_add(&bar[XB_XCNT(b.x)], 1u);
    return b;
}
__device__ __forceinline__ void xcd_barrier_complete(unsigned* bar, unsigned x, unsigned& nloc, unsigned& nx) {
    const unsigned G = gridDim.x * gridDim.y * gridDim.z;
    unsigned sum, cnt, mine, sp = 0u;
    for (;;) {
        sum = 0u; cnt = 0u; mine = 0u;
#pragma unroll
        for (unsigned j = 0; j < 16; ++j) { const unsigned c = xb_ld(&bar[XB_XCNT(j)]); sum += c; cnt += (c > 0u) ? 1u : 0u; mine = (j == x) ? c : mine; }
        if (sum == G) break;
        __builtin_amdgcn_s_sleep(1);
        if ((++sp & 255u) == 0u) { if (xb_ld(&bar[XB_TMO])) break; if (sp > XB_SPIN_CAP) { atomicAdd(&bar[XB_TMO], 1u); break; } }
    }
    nloc = mine > 0u ? mine : 1u; nx = cnt > 0u ? cnt : 1u;
}

__device__ __forceinline__ void xcd_barrier(const XcdBarrier& b, bool leader  ) {
    asm volatile("s_waitcnt vmcnt(0)" ::: "memory");
    __syncthreads();
    if (leader) {
        unsigned* bar = b.bar;
        __builtin_amdgcn_s_waitcnt(0);
        unsigned nloc = b.st[0], nx = b.st[1];
        if (nloc == 0u) { xcd_barrier_complete(bar, b.x, nloc, nx); b.st[0] = nloc; b.st[1] = nx; }
        const unsigned old = xb_add(&bar[XB_XSUB(b.x)], 1u);
        const unsigned gen = old / nloc;
        if (old + 1u == (gen + 1u) * nloc) {
            __builtin_amdgcn_fence(__ATOMIC_RELEASE, "agent");
            asm volatile("s_waitcnt vmcnt(0)" ::: "memory");
            const unsigned og = xb_add(&bar[XB_TOP], 1u);
            const unsigned tg = og / nx;
            if (og + 1u == (tg + 1u) * nx) xb_add(&bar[XB_TOPGEN], 1u);
            else XB_SPIN(xb_ld(&bar[XB_TOPGEN]) == tg, bar);
            __builtin_amdgcn_fence(__ATOMIC_ACQUIRE, "agent");
            xb_add(&bar[XB_XGEN(b.x)], 1u);
            asm volatile("s_waitcnt vmcnt(0)" ::: "memory");
        } else {
            XB_SPIN(xb_ld(&bar[XB_XGEN(b.x)]) == gen, bar);
            __builtin_amdgcn_fence(__ATOMIC_ACQUIRE, "agent");
            asm volatile("s_waitcnt vmcnt(0)" ::: "memory");
        }
    }
    __syncthreads();
}
struct Frame {
    LAS unsigned char* lds;
    int tid, lane, wave, vcu;
    unsigned long long pr_acc, pr_sub; int ph;
    unsigned char* ws;
    const float* x; const float* meta; float* out;
};

constexpr int PK_CONVW = 0, PK_CONVB = 1024, PK_WA = 1280, PK_BA = 17664, PK_WX = 17920, PK_BX = 34304, PK_LAM = 34560, PK_LNG = 34816, PK_SCW = 35072, PK_SCG = 35840, PK_MU = 36096, PK_W0 = 37760,
              PK_W2 = 38272, PK_A0 = 54656, PK_A2 = 55168, PK_G2 = 71552, PK_KK = 104320, PK_KA = 104832, PK_RK = 105344, PK_LNW = 105856, PK_LNB = 106368, PK_SIZE = 106880;
constexpr size_t WS_PACK = 72 * 1024;
static_assert(WS_PACK + (size_t)NLAYER * PK_SIZE * 4 <= CTL_ZERO_BYTES && (CW_CNTB + 65 * 64) * 4 <= (int)WS_PACK && CW_BAR + 3456 <= CW_CNTA, "pack inside CTL, above the barrier words");
__device__ __forceinline__ const float* pack_of(const Frame& F, int l) { return (const float*)(F.ws + WS_PACK) + (size_t)l * PK_SIZE; }
__device__ __forceinline__ void pack_copy(Frame& F, const float* src, int per_layer, int off) {
    const int gt = F.vcu * (NWAVES * 64) + F.tid, NT = GRID * NWAVES * 64;
    for (int i = gt; i < NLAYER * per_layer; i += NT) { const int l = i / per_layer, j = i - l * per_layer; ((float*)(F.ws + WS_PACK))[(size_t)l * PK_SIZE + off + j] = src[i]; }
}
__device__ __forceinline__ void phase_pack(Frame& F, const float* const* in) {
    pack_copy(F, in[9], 1024, PK_CONVW); pack_copy(F, in[10], 256, PK_CONVB); pack_copy(F, in[11], 16384, PK_WA); pack_copy(F, in[12], 256, PK_BA); pack_copy(F, in[13], 16384, PK_WX); pack_copy(F, in[14], 256, PK_BX);
    pack_copy(F, in[15], 256, PK_LAM); pack_copy(F, in[16], 256, PK_LNG); pack_copy(F, in[17], 768, PK_SCW); pack_copy(F, in[18], 256, PK_SCG); pack_copy(F, in[19], 1664, PK_MU); pack_copy(F, in[20], 512, PK_W0);
    pack_copy(F, in[21], 16384, PK_W2); pack_copy(F, in[22], 512, PK_A0); pack_copy(F, in[23], 16384, PK_A2); pack_copy(F, in[24], 32768, PK_G2); pack_copy(F, in[25], 512, PK_KK); pack_copy(F, in[26], 512, PK_KA);
    pack_copy(F, in[27], 512, PK_RK); pack_copy(F, in[28], 512, PK_LNW); pack_copy(F, in[29], 512, PK_LNB);
}

__device__ __forceinline__ void transpose_item(const float* W, int K, int N, bf16* WT, int k0, int n0, int drow0, LAS float* scr, int lane) {
#pragma unroll 8
    for (int i = 0; i < 32; ++i) { const int kk = 2 * i + (lane >> 5); scr[kk * 33 + (lane & 31)] = W[(size_t)(k0 + kk) * N + n0 + (lane & 31)]; }
    LDS_WAIT(); asm volatile("" ::: "memory");
    const int c = lane & 7;
#pragma unroll
    for (int j = 0; j < 4; ++j) { const int n = (lane >> 3) + 8 * j; const LAS float* s = scr + (8 * c) * 33 + n;
        v4u o; o.x = pk2(s[0 * 33], s[1 * 33]); o.y = pk2(s[2 * 33], s[3 * 33]); o.z = pk2(s[4 * 33], s[5 * 33]); o.w = pk2(s[6 * 33], s[7 * 33]);
        *(GAS v4u*)(WT + (size_t)(drow0 + n) * K + k0 + 8 * c) = o; }
    LDS_WAIT(); asm volatile("" ::: "memory");
}
__device__ __forceinline__ int swiglu_row(int n0) { return n0 < FF ? ((n0 >> 7) * 256 + (n0 & 127)) : (((n0 - FF) >> 7) * 256 + 128 + ((n0 - FF) & 127)); }
constexpr int CI_IN = (D / 64) * (2 * FF / 32), CI_OUT = (FF / 64) * (D / 32), CI_MI = (D / 64) * (NIN / 32), CI_MO = (D / 64) * (D / 32);
constexpr int CI_SET0 = CI_IN + CI_OUT + CI_MI, CI_SET1 = CI_MO + CI_IN + CI_OUT;
struct ConvItem { const float* W; bf16* WT; int K, N, k0, n0, drow0; };
__device__ __forceinline__ ConvItem conv_item(unsigned char* ws, const float* const* in, int l, int set, int r) {
    ConvItem ci;
    if (set == 0) {
        if (r < CI_IN) { const int nblk = 2 * FF / 32, kb = r / nblk, nb = r % nblk; ci = ConvItem{in[3] + (size_t)l * D * 2 * FF, (bf16*)(ws + WS_WB + WB_W1IN), D, 2 * FF, 64 * kb, 32 * nb, swiglu_row(32 * nb)}; return ci; }
        r -= CI_IN;
        if (r < CI_OUT) { const int nblk = D / 32, kb = r / nblk, nb = r % nblk; ci = ConvItem{in[4] + (size_t)l * FF * D, (bf16*)(ws + WS_WB + WB_W1OUT), FF, D, 64 * kb, 32 * nb, 32 * nb}; return ci; }
        r -= CI_OUT;
        { const int nblk = NIN / 32, kb = r / nblk, nb = r % nblk; ci = ConvItem{in[7] + (size_t)l * D * NIN, (bf16*)(ws + WS_WB + WB_WIN), D, NIN, 64 * kb, 32 * nb, 32 * nb}; return ci; }
    }
    if (r < CI_MO) { const int nblk = D / 32, kb = r / nblk, nb = r % nblk; ci = ConvItem{in[8] + (size_t)l * D * D, (bf16*)(ws + WS_WB + WB_WOUT), D, D, 64 * kb, 32 * nb, 32 * nb}; return ci; }
    r -= CI_MO;
    if (r < CI_IN) { const int nblk = 2 * FF / 32, kb = r / nblk, nb = r % nblk; ci = ConvItem{in[5] + (size_t)l * D * 2 * FF, (bf16*)(ws + WS_WB + WB_W2IN), D, 2 * FF, 64 * kb, 32 * nb, swiglu_row(32 * nb)}; return ci; }
    r -= CI_IN;
    { const int nblk = D / 32, kb = r / nblk, nb = r % nblk; ci = ConvItem{in[6] + (size_t)l * FF * D, (bf16*)(ws + WS_WB + WB_W2OUT), FF, D, 64 * kb, 32 * nb, 32 * nb}; return ci; }
}
__device__ __forceinline__ void conv_loads(const ConvItem& ci, int lane, float (&v)[32]) {
    const float* src = ci.W + (size_t)(ci.k0 + (lane >> 5)) * ci.N + ci.n0 + (lane & 31);
#pragma unroll
    for (int i = 0; i < 32; ++i) v[i] = src[(size_t)(2 * i) * ci.N];
}
__device__ __forceinline__ void conv_store(const ConvItem& ci, int lane, const float (&v)[32], LAS float* scr) {
#pragma unroll
    for (int i = 0; i < 32; ++i) scr[(2 * i + (lane >> 5)) * 33 + (lane & 31)] = v[i];
    LDS_WAIT(); asm volatile("" ::: "memory");
    const int c = lane & 7;
#pragma unroll
    for (int j = 0; j < 4; ++j) { const int n = (lane >> 3) + 8 * j; const LAS float* s = scr + (8 * c) * 33 + n;
        v4u o; o.x = pk2(s[0 * 33], s[1 * 33]); o.y = pk2(s[2 * 33], s[3 * 33]); o.z = pk2(s[4 * 33], s[5 * 33]); o.w = pk2(s[6 * 33], s[7 * 33]);
        *(GAS v4u*)(ci.WT + (size_t)(ci.drow0 + n) * ci.K + ci.k0 + 8 * c) = o; }
    LDS_WAIT(); asm volatile("" ::: "memory");
}
__device__ __forceinline__ void phase_convert(Frame& F, const float* const* in, int l, int set) {
    { int ln_ = F.tid & 63; asm volatile("" : "+v"(ln_)); F.lane = ln_; }
    LAS float* scr = (LAS float*)(F.lds + F.wave * 16384);
    const int gw = F.vcu * NWAVES + F.wave, NGW = GRID * NWAVES, nitems = set == 0 ? CI_SET0 : CI_SET1;
    for (int it = gw; it < nitems; it += NGW) { const ConvItem ci = conv_item(F.ws, in, l, set, it); transpose_item(ci.W, ci.K, ci.N, ci.WT, ci.k0, ci.n0, ci.drow0, scr, F.lane); }
    if (set == 0) { unsigned zz = 0u; asm volatile("" : "+v"(zz));
      for (int i = gw * 64 + F.lane; i < (NINP - NIN) * D / 8; i += NGW * 64) *(GAS v4u*)(((bf16*)(F.ws + WS_WB + WB_WIN)) + (size_t)NIN * D + (size_t)i * 8) = (v4u){zz, zz, zz, zz}; }
}

__device__ __forceinline__ const float* hrow_c(const Frame& F, const float* xrows, int r) { return r < MX ? xrows + (size_t)r * D : ((float*)(F.ws + WS_HMETA)) + (size_t)(r - MX) * D; }
__device__ __forceinline__ void store_xn_row(bf16* XN, int r, int lane, const f32x4 (&v)[4], float rstd, const float* g) {
    GAS unsigned long long* o8 = (GAS unsigned long long*)(XN + (size_t)r * D) + lane;
#pragma unroll
    for (int j = 0; j < 4; ++j) { const f32x4 gv = ((const GAS f32x4*)g)[lane + 64 * j];
        o8[64 * j] = (unsigned long long)pk2(v[j].x * rstd * gv.x, v[j].y * rstd * gv.y) | ((unsigned long long)pk2(v[j].z * rstd * gv.z, v[j].w * rstd * gv.w) << 32); }
}
__device__ __forceinline__ float sumsq4(const f32x4 (&v)[4]) { float s = 0.f;
#pragma unroll
    for (int j = 0; j < 4; ++j) s += (v[j].x * v[j].x + v[j].y * v[j].y) + (v[j].z * v[j].z + v[j].w * v[j].w);
    return s; }
typedef short mbf16x8 __attribute__((ext_vector_type(8)));
__device__ __forceinline__ void meta_tile(const bf16* A, const bf16* Bt, int K, int k0, int kl, int nb0, int nb1, int mode, void* O, int ldo, int ocol, int lane) {
    const int fr = lane & 15, fq = lane >> 4;
    const bf16* ap = A + (size_t)(MX + fr) * K + k0 + 8 * fq; const bf16* b0p = Bt + (size_t)(nb0 + fr) * K + k0 + 8 * fq; const bf16* b1p = Bt + (size_t)((mode == 0 ? nb1 : nb0) + fr) * K + k0 + 8 * fq;
    f32x4 acc0 = (f32x4){0.f, 0.f, 0.f, 0.f}, acc1 = acc0;
#pragma unroll 16
    for (int ks = 0; ks < kl; ks += 32) { const mbf16x8 a = *(const mbf16x8*)(ap + ks), w0 = *(const mbf16x8*)(b0p + ks);
        acc0 = __builtin_amdgcn_mfma_f32_16x16x32_bf16(w0, a, acc0, 0, 0, 0);
        if (mode == 0) { const mbf16x8 w1 = *(const mbf16x8*)(b1p + ks); acc1 = __builtin_amdgcn_mfma_f32_16x16x32_bf16(w1, a, acc1, 0, 0, 0); } }
    const int col = ocol + 4 * fq;
    if (mode == 2) { *(f32x4*)((float*)O + (size_t)fr * ldo + col) = acc0; return; }
    float v[4];
#pragma unroll
    for (int i = 0; i < 4; ++i) v[i] = mode == 0 ? acc0[i] * __builtin_amdgcn_rcpf(1.0f + __expf(-acc0[i])) * acc1[i] : acc0[i];
    *(GAS unsigned long long*)((bf16*)O + (size_t)(MX + fr) * ldo + col) = (unsigned long long)pk2(v[0], v[1]) | ((unsigned long long)pk2(v[2], v[3]) << 32);
}
__device__ __forceinline__ void meta_gemm(Frame& F, const bf16* A, const bf16* Bt, int K, int N, int mode, void* O, int ldo, int nks, int gw  ) {
    const int lane = F.tid & 63; if (gw < 0) return;
    if (mode == 0) { if (gw < FF / 16) { const int j0 = 16 * gw, nb0 = (j0 >> 7) * 256 + (j0 & 127); meta_tile(A, Bt, K, 0, K, nb0, nb0 + 128, 0, O, ldo, j0, lane); } return; }
    const int ntile = N / 16;
    if (gw < ntile * nks) { const int tile = gw % ntile, sl = gw / ntile, kl = K / nks;
        meta_tile(A, Bt, K, sl * kl, kl, 16 * tile, 0, mode, mode == 2 ? (void*)((float*)O + (size_t)sl * NMETA * D) : O, ldo, 16 * tile, lane); }
}

__device__ __forceinline__ void row_ld_f32(const float* p, int lane, f32x4 (&v)[4]) {
#pragma unroll
    for (int j = 0; j < 4; ++j) v[j] = ((const GAS f32x4*)p)[lane + 64 * j]; }
__device__ __forceinline__ void row_ld_bf16(const bf16* p, int lane, f32x4 (&v)[4]) {
#pragma unroll
    for (int j = 0; j < 4; ++j) { const unsigned long long u = ((const GAS unsigned long long*)p)[lane + 64 * j]; v[j][0] = bf2f((unsigned)u & 0xffffu); v[j][1] = bf2f((unsigned)u >> 16); v[j][2] = bf2f((unsigned)(u >> 32) & 0xffffu); v[j][3] = bf2f((unsigned)(u >> 48)); } }
__device__ __forceinline__ void row_st_bf16(bf16* p, int lane, const f32x4 (&v)[4]) {
#pragma unroll
    for (int j = 0; j < 4; ++j) ((GAS unsigned long long*)p)[lane + 64 * j] = (unsigned long long)pk2(v[j][0], v[j][1]) | ((unsigned long long)pk2(v[j][2], v[j][3]) << 32); }
__device__ __forceinline__ void phase_init(Frame& F, const float* g_pre) {
    { int ln_ = F.tid & 63; asm volatile("" : "+v"(ln_)); F.lane = ln_; }
    const int gw = F.vcu * NWAVES + F.wave, NGW = GRID * NWAVES;
    for (int r = gw; r < MP; r += NGW) {
        if (r >= MREAL) { GAS unsigned long long* o8 = (GAS unsigned long long*)(((bf16*)(F.ws + WS_XN)) + (size_t)r * D) + F.lane;
#pragma unroll
            for (int j = 0; j < 4; ++j) { unsigned zz = 0u; asm volatile("" : "+v"(zz)); o8[64 * j] = (unsigned long long)zz; }
            continue; }
        const float* src = r < MX ? F.x + (size_t)r * D : F.meta + (size_t)(r - MX) * D;
        f32x4 v[4]; row_ld_f32(src, F.lane, v);
        if (r >= MX) row_st_bf16((bf16*)(F.ws + WS_HMETA) + (size_t)(r - MX) * D, F.lane, v);
        const float rstd = rsqrtf(wave_sum(sumsq4(v)) * (1.0f / D) + RMS_EPS);
        store_xn_row(((bf16*)(F.ws + WS_XN)), r, F.lane, v, rstd, g_pre);
    }
}
struct PostIO { const bf16* raw16; const float* x32; const bf16* hin16; bf16* hout16; float* out32; int nks; };
__device__ __forceinline__ void post_row_load(const Frame& F, const PostIO& io, int r, f32x4 (&y)[4], f32x4 (&h)[4]) {
    if (r >= MX) { const float* sl = (const float*)(F.ws + WS_MSLAB) + (size_t)(r - MX) * D; row_ld_f32(sl, F.lane, y);
        for (int s = 1; s < io.nks; ++s) { f32x4 t[4]; row_ld_f32(sl + (size_t)s * NMETA * D, F.lane, t);
#pragma unroll
            for (int j = 0; j < 4; ++j) y[j] = y[j] + t[j]; }
        row_ld_bf16((const bf16*)(F.ws + WS_HMETA) + (size_t)(r - MX) * D, F.lane, h); return; }
    row_ld_bf16(io.raw16 + (size_t)r * D, F.lane, y);
    if (io.x32) row_ld_f32(io.x32 + (size_t)r * D, F.lane, h);
    else row_ld_bf16(io.hin16 + (size_t)r * D, F.lane, h);
}
__device__ __forceinline__ void post_row_store(const Frame& F, const PostIO& io, int r, const f32x4 (&h)[4]) {
    if (r >= MX) row_st_bf16((bf16*)(F.ws + WS_HMETA) + (size_t)(r - MX) * D, F.lane, h);
    else if (io.out32) {
#pragma unroll
        for (int j = 0; j < 4; ++j) ((GAS f32x4*)(io.out32 + (size_t)r * D))[F.lane + 64 * j] = h[j]; }
    else row_st_bf16(io.hout16 + (size_t)r * D, F.lane, h);
}
__device__ __forceinline__ void phase_post(Frame& F, const PostIO& io, float scale, const float* g_post, const float* g_pre) {
    { int ln_ = F.tid & 63; asm volatile("" : "+v"(ln_)); F.lane = ln_; }
    const int gw = F.vcu * NWAVES + F.wave, NGW = GRID * NWAVES, nrows = io.out32 ? MX : MREAL;
    for (int r0 = gw; r0 < nrows; r0 += 2 * NGW) {
        const int r1 = r0 + NGW; const bool two = r1 < nrows; const int r1c = two ? r1 : r0;
        f32x4 y0[4], h0[4], y1[4], h1[4];
        post_row_load(F, io, r0, y0, h0); post_row_load(F, io, r1c, y1, h1);
        const float rs0 = scale * rsqrtf(wave_sum(sumsq4(y0)) * (1.0f / D) + RMS_EPS), rs1 = scale * rsqrtf(wave_sum(sumsq4(y1)) * (1.0f / D) + RMS_EPS);
#pragma unroll
        for (int j = 0; j < 4; ++j) { const f32x4 gv = ((const GAS f32x4*)g_post)[F.lane + 64 * j]; h0[j] = h0[j] + y0[j] * rs0 * gv; h1[j] = h1[j] + y1[j] * rs1 * gv; }
        post_row_store(F, io, r0, h0); if (two) post_row_store(F, io, r1, h1);
        if (g_pre) { const float q0 = rsqrtf(wave_sum(sumsq4(h0)) * (1.0f / D) + RMS_EPS), q1 = rsqrtf(wave_sum(sumsq4(h1)) * (1.0f / D) + RMS_EPS);
            store_xn_row(((bf16*)(F.ws + WS_XN)), r0, F.lane, h0, q0, g_pre); if (two) store_xn_row(((bf16*)(F.ws + WS_XN)), r1, F.lane, h1, q1, g_pre); }
    }
}
typedef short bf16x8v __attribute__((ext_vector_type(8)));
typedef float f32x4v __attribute__((ext_vector_type(4)));
constexpr int FR_PER_WAVE = 24;
constexpr size_t WS_FRAG = WS_AGG + 512 * 1024, FRAG_LAYER_BYTES = (size_t)8 * FR_PER_WAVE * 64 * 16;
static_assert(WS_FRAG + NLAYER * FRAG_LAYER_BYTES <= WS_WB, "fragment store fits behind AGG");
__device__ __forceinline__ float frag_src(const float* const* in, int l, int w, int f, int lane, int j) {
    const int kq = 8 * (lane >> 4) + j, cl = lane & 15;
    if (f < 4)  return in[21][(size_t)l * 32 * 512 + (size_t)kq * 512 + 64 * w + 16 * f + cl];
    if (f < 8)  return in[23][(size_t)l * 32 * 512 + (size_t)kq * 512 + 64 * w + 16 * (f - 4) + cl];
    if (f < 16) { const int ct = (f - 8) >> 1, ks = (f - 8) & 1; return in[24][(size_t)l * 64 * 512 + (size_t)(32 * ks + kq) * 512 + 64 * w + 16 * ct + cl]; }
    { const int ct = (f - 16) >> 1, ks = (f - 16) & 1, gt = w >> 2, g = w & 3; return in[gt ? 13 : 11][(size_t)l * 16384 + (size_t)g * 4096 + (size_t)(32 * ks + kq) * 64 + 16 * ct + cl]; }
}
__device__ __forceinline__ void phase_frag(Frame& F, const float* const* in) {
    const int gt = F.vcu * (NWAVES * 64) + F.tid, NT = GRID * NWAVES * 64;
    bf16* FR = (bf16*)(F.ws + WS_FRAG);
    for (int i = gt; i < NLAYER * 8 * FR_PER_WAVE * 64 * 8; i += NT) { const int j = i & 7, lane = (i >> 3) & 63, f = (i >> 9) % FR_PER_WAVE, w = ((i >> 9) / FR_PER_WAVE) & 7, l = (i >> 9) / (FR_PER_WAVE * 8);
        FR[i] = (bf16)f2bf(frag_src(in, l, w, f, lane, j)); }
}
__device__ __forceinline__ bf16x8v pack8(const float (&v)[8]) { v4u u; u.x = pk2(v[0], v[1]); u.y = pk2(v[2], v[3]); u.z = pk2(v[4], v[5]); u.w = pk2(v[6], v[7]); return __builtin_bit_cast(bf16x8v, u); }
__device__ __forceinline__ void unpack8(const v4u& u, float (&v)[8]) { v[0] = bf2f(u.x & 0xffffu); v[1] = bf2f(u.x >> 16); v[2] = bf2f(u.y & 0xffffu); v[3] = bf2f(u.y >> 16); v[4] = bf2f(u.z & 0xffffu); v[5] = bf2f(u.z >> 16); v[6] = bf2f(u.w & 0xffffu); v[7] = bf2f(u.w >> 16); }
__device__ __forceinline__ void unpack4f(unsigned long long u, f32x4& v) { v[0] = bf2f((unsigned)u & 0xffffu); v[1] = bf2f(((unsigned)u >> 16)); v[2] = bf2f((unsigned)(u >> 32) & 0xffffu); v[3] = bf2f((unsigned)(u >> 48)); }
__device__ __forceinline__ void phase_mix_prep(Frame& F, const float* pk, int layer) {
    { int ln_ = F.tid & 63; asm volatile("" : "+v"(ln_)); F.lane = ln_; }
    LAS float* U = (LAS float*)F.lds;
    LAS float* GT = U + 16 * 256;
    LAS float* XL = GT + 32 * 256;
    LAS float* VL = XL + 19 * 256;
    const int tid = F.tid, lane = F.lane, w = F.wave, fr = lane & 15, fq = lane >> 4;
    const bf16* P = ((bf16*)(F.ws + WS_OV + OV_P)); bf16* Y = ((bf16*)(F.ws + WS_XN));
    bf16x8v Bf[FR_PER_WAVE];
    { const v4u* fp = (const v4u*)(F.ws + WS_FRAG + (size_t)layer * FRAG_LAYER_BYTES) + (size_t)w * FR_PER_WAVE * 64 + lane;
#pragma unroll
        for (int f = 0; f < FR_PER_WAVE; ++f) Bf[f] = __builtin_bit_cast(bf16x8v, fp[f * 64]); }
    const int gtp = w >> 2, gblk = w & 3;
    const int cg4 = 4 * (tid & 63);
    for (int tile = blockIdx.x; tile < 256; tile += GRID) {
        const int b = tile >> 5, c = tile & 31;
        const int s_begin = c == 0 ? 0 : NMETA + 64 * c, nsub = c == 0 ? 5 : 4;
        float hloc = 0.f, caloc = 1.f;
        for (int sub = 0; sub < nsub; ++sub) {
            const int s0 = s_begin + 16 * sub;
            unsigned zz = 0u; asm volatile("" : "+v"(zz));
            v4u cur[4], prv[4];
            { const int s = s0 + fr; const bf16* pc = P + (size_t)row_of(b, s) * NINP + PC_LO + 8 * fq; const bf16* pp = P + (size_t)row_of(b, s > 0 ? s - 1 : 0) * NINP + PC_LO + 8 * fq;
#pragma unroll
                for (int f = 0; f < 4; ++f) { cur[f] = *(const v4u*)(pc + 32 * f); prv[f] = *(const v4u*)(pp + 32 * f); if (s == 0) prv[f] = (v4u){zz, zz, zz, zz}; } }
            unsigned long long lx[3], lc[3], lxx[3], lb[2];
#pragma unroll
            for (int j = 0; j < 3; ++j) { const int idx = tid + 512 * j, r = idx >> 6, s = s0 - 3 + r; lx[j] = zz; lc[j] = zz; lxx[j] = zz;
                if (idx < 19 * 64 && s >= 0) { const bf16* pr = P + (size_t)row_of(b, s) * NINP + cg4; lx[j] = *(const unsigned long long*)(pr + PC_LRUX); lc[j] = *(const unsigned long long*)(pr + PC_SCC); lxx[j] = *(const unsigned long long*)(pr + PC_SCX); } }
#pragma unroll
            for (int j = 0; j < 2; ++j) { const int t = (tid >> 6) + 8 * j; lb[j] = *(const unsigned long long*)(P + (size_t)row_of(b, s0 + t) * NINP + PC_SCB + cg4); }
            { bf16x8v Af[4];
#pragma unroll
                for (int f = 0; f < 4; ++f) { float cv[8], pv[8], zv[8]; unpack8(cur[f], cv); unpack8(prv[f], pv);
                    const f32x4v m0 = *(const f32x4v*)(pk + PK_MU + 1536 + 32 * f + 8 * fq), m1 = *(const f32x4v*)(pk + PK_MU + 1536 + 32 * f + 8 * fq + 4);
#pragma unroll
                    for (int j = 0; j < 8; ++j) { const float mu = j < 4 ? m0[j & 3] : m1[j & 3]; const float z = cv[j] + (pv[j] - cv[j]) * mu; zv[j] = f == 0 ? tanhf_(z) : (f == 1 ? z : sigmoidf_(z)); }
                    Af[f] = pack8(zv); }
                const f32x4v zero = (f32x4v){0.f, 0.f, 0.f, 0.f};
                const size_t ro = (size_t)row_of(b, s0 + fr) * 512;
#pragma unroll
                for (int ct = 0; ct < 4; ++ct) { const int n = 64 * w + 16 * ct + 4 * fq;
                    const f32x4v aw = __builtin_amdgcn_mfma_f32_16x16x32_bf16(Bf[ct], Af[0], zero, 0, 0, 0);
                    const f32x4v aa = __builtin_amdgcn_mfma_f32_16x16x32_bf16(Bf[4 + ct], Af[1], zero, 0, 0, 0);
                    f32x4v ag = __builtin_amdgcn_mfma_f32_16x16x32_bf16(Bf[8 + 2 * ct], Af[2], zero, 0, 0, 0); ag = __builtin_amdgcn_mfma_f32_16x16x32_bf16(Bf[9 + 2 * ct], Af[3], ag, 0, 0, 0);
                    const f32x4v w04 = *(const f32x4v*)(pk + PK_W0 + n), a04 = *(const f32x4v*)(pk + PK_A0 + n);
                    float wd[4], av4[4];
#pragma unroll
                    for (int i = 0; i < 4; ++i) { const float wl = -softplusf_(-(w04[i] + aw[i])) - 0.5f, e = __expf(wl); wd[i] = e * (1.0f - e * (0.5f - e * (0.16666667f - e * (0.041666668f - e * 0.0083333338f)))); av4[i] = sigmoidf_(a04[i] + aa[i]); }
                    *(GAS unsigned long long*)((bf16*)(F.ws + WS_OV + OV_WDEC) + ro + n) = (unsigned long long)pk2(wd[0], wd[1]) | ((unsigned long long)pk2(wd[2], wd[3]) << 32);
                    *(GAS unsigned long long*)((bf16*)(F.ws + WS_OV + OV_ABUF) + ro + n) = (unsigned long long)pk2(av4[0], av4[1]) | ((unsigned long long)pk2(av4[2], av4[3]) << 32);
                    *(GAS unsigned long long*)((bf16*)(F.ws + WS_OV + OV_GBUF) + ro + n) = (unsigned long long)pk2(ag[0], ag[1]) | ((unsigned long long)pk2(ag[2], ag[3]) << 32); } }
            PSTAMP(0);
#pragma unroll
            for (int j = 0; j < 3; ++j) { const int idx = tid + 512 * j; if (idx < 19 * 64) { f32x4 a4, c4, x4; unpack4f(lx[j], a4); unpack4f(lc[j], c4); unpack4f(lxx[j], x4);
                *(LAS f32x4*)(XL + (idx >> 6) * 256 + cg4) = a4; *(LAS f32x4*)(VL + (idx >> 6) * 256 + cg4) = c4 * x4; } }
            __syncthreads();
            const float* pkc = pk + cg4;
            const f32x4 cb4 = *(const f32x4*)(pkc + PK_CONVB), cw0 = *(const f32x4*)(pkc + PK_CONVW), cw1 = *(const f32x4*)(pkc + PK_CONVW + 256), cw2 = *(const f32x4*)(pkc + PK_CONVW + 512), cw3 = *(const f32x4*)(pkc + PK_CONVW + 768);
            const f32x4 sw0 = *(const f32x4*)(pkc + PK_SCW), sw1 = *(const f32x4*)(pkc + PK_SCW + 256), sw2 = *(const f32x4*)(pkc + PK_SCW + 512), sg4 = *(const f32x4*)(pkc + PK_SCG);
#pragma unroll
            for (int j = 0; j < 2; ++j) { const int t = (tid >> 6) + 8 * j;
                const LAS float* xr = XL + t * 256 + cg4; const LAS float* vr = VL + (t + 1) * 256 + cg4;
                *(LAS f32x4*)(U + t * 256 + cg4) = cb4 + *(const LAS f32x4*)xr * cw0 + *(const LAS f32x4*)(xr + 256) * cw1 + *(const LAS f32x4*)(xr + 512) * cw2 + *(const LAS f32x4*)(xr + 768) * cw3;
                f32x4 b4; unpack4f(lb[j], b4);
                const f32x4 y4 = b4 * (*(const LAS f32x4*)vr * sw0 + *(const LAS f32x4*)(vr + 256) * sw1 + *(const LAS f32x4*)(vr + 512) * sw2);
                const float ss = red16((y4[0] * y4[0] + y4[1] * y4[1]) + (y4[2] * y4[2] + y4[3] * y4[3])); const float rs = rsqrtf(ss * (1.0f / 64.0f) + RMS_EPS);
                *(GAS unsigned long long*)(Y + (size_t)row_of(b, s0 + t) * D + 256 + cg4) = (unsigned long long)pk2(y4[0] * rs * sg4[0], y4[1] * rs * sg4[1]) | ((unsigned long long)pk2(y4[2] * rs * sg4[2], y4[3] * rs * sg4[3]) << 32); }
            PSTAMP(1);
            __syncthreads();
            { bf16x8v Al[2];
#pragma unroll
                for (int ks = 0; ks < 2; ++ks) { const LAS float* up = U + fr * 256 + 64 * gblk + 32 * ks + 8 * fq; const f32x4v u0 = *(const LAS f32x4v*)up, u1 = *(const LAS f32x4v*)(up + 4);
                    const float uv[8] = {u0.x, u0.y, u0.z, u0.w, u1.x, u1.y, u1.z, u1.w}; Al[ks] = pack8(uv); }
                const f32x4v zero = (f32x4v){0.f, 0.f, 0.f, 0.f};
#pragma unroll
                for (int ct = 0; ct < 4; ++ct) { const int j = 64 * gblk + 16 * ct + 4 * fq;
                    f32x4v ac = __builtin_amdgcn_mfma_f32_16x16x32_bf16(Bf[16 + 2 * ct], Al[0], zero, 0, 0, 0); ac = __builtin_amdgcn_mfma_f32_16x16x32_bf16(Bf[17 + 2 * ct], Al[1], ac, 0, 0, 0);
                    const f32x4v bias = *(const f32x4v*)(pk + (gtp ? PK_BX : PK_BA) + j);
                    f32x4v gv;
#pragma unroll
                    for (int i = 0; i < 4; ++i) gv[i] = sigmoidf_(ac[i] + bias[i]);
                    *(LAS f32x4v*)(GT + (gtp * 16 + fr) * 256 + j) = gv; } }
            PSTAMP(2);
            __syncthreads();
#pragma unroll
            for (int it = 0; it < 8; ++it) { const int idx = it * (NWAVES * 64) + tid, ch = idx & 255;
                const float r = GT[idx], ig = GT[16 * 256 + idx], u = U[idx];
                const float la = -8.0f * r * softplusf_(-pk[PK_LAM + ch]), a = __expf(la), x2 = 2.0f * la;
                const float om = x2 < -0.25f ? (1.0f - __expf(x2)) : -x2 * (1.0f + x2 * (0.5f + x2 * (0.16666667f + x2 * (0.041666668f + x2 * 0.0083333338f))));
                const float bt = __builtin_amdgcn_sqrtf(om) * (ig * u);
                GT[idx] = a; GT[16 * 256 + idx] = bt; }
            __syncthreads();
            PSTAMP(3);
            if (tid < 256) { const int j = tid;
#pragma unroll
                for (int t = 0; t < 16; ++t) { const float a = GT[t * 256 + j], bt = GT[(16 + t) * 256 + j];
                    hloc = a * hloc + bt; caloc *= a;
                    const size_t ro = (size_t)row_of(b, s0 + t) * 256 + j; ((float*)(F.ws + WS_OV + OV_HL))[ro] = hloc; ((float*)(F.ws + WS_OV + OV_CA))[ro] = caloc; } }
            PSTAMP(4);
        }
        if (tid < 256) { ((float*)(F.ws + WS_AGG))[((size_t)(b * 32 + c) * 256 + tid) * 2 + 0] = caloc; ((float*)(F.ws + WS_AGG))[((size_t)(b * 32 + c) * 256 + tid) * 2 + 1] = hloc; }
        __syncthreads();
    }
}

constexpr int SC_CH = 24, SC_NCH = TT / SC_CH, SC_LW = SC_CH / 4, SC_STEPF = 336, SC_BUFF = SC_CH * SC_STEPF;
constexpr int SC_VJ = (SC_LW * 16 + 63) / 64;
static_assert(SC_NCH * SC_CH == TT && 2 * SC_BUFF * 4 <= RING_BYTES, "scan geometry");
struct ScanRegs { unsigned rr[SC_LW + 1], kk[SC_LW + 1], aa[SC_LW], ww[SC_LW]; unsigned vc[SC_VJ], vp[SC_VJ]; };
__device__ __forceinline__ void scan_load(const Frame& F, ScanRegs& R, int b, int h, int q, int lw, int chunk, unsigned lane) {
    const int t0 = chunk * SC_CH + SC_LW * lw;
    const bf16* P = ((bf16*)(F.ws + WS_OV + OV_P)); const bf16* AB = ((bf16*)(F.ws + WS_OV + OV_ABUF)); const bf16* WD = ((bf16*)(F.ws + WS_OV + OV_WDEC));
#pragma unroll
    for (int m = 0; m < SC_LW + 1; ++m) { const int s = t0 - 1 + m;
        if (s >= 0) { const bf16* rowp = P + (size_t)row_of(b, s) * NINP + h * 64; R.rr[m] = rowp[PC_R + lane]; R.kk[m] = rowp[PC_K + lane]; } else { R.rr[m] = 0u; R.kk[m] = 0u; } }
#pragma unroll
    for (int i = 0; i < SC_LW; ++i) { const size_t ro = (size_t)row_of(b, t0 + i) * 512 + h * 64; R.aa[i] = (AB + ro)[lane]; R.ww[i] = (WD + ro)[lane]; }
#pragma unroll
    for (int j = 0; j < SC_VJ; ++j) { const int st0 = 4 * j; const unsigned st = st0 + (lane >> 4), rw = lane & 15; R.vc[j] = 0u; R.vp[j] = 0u;
        if (st < (unsigned)SC_LW) { const int s = t0 + (int)st; const unsigned col = PC_V + h * 64 + 16 * q + rw; R.vc[j] = P[(size_t)row_of(b, s) * NINP + col]; if (s > 0) R.vp[j] = P[(size_t)row_of(b, s - 1) * NINP + col]; } }
}
__device__ __forceinline__ void scan_emit(const ScanRegs& R, LAS float* buf, int lw, unsigned lane, float mu_r, float mu_k, float kk_n, float ka_n, float mu_v) {
    LAS float* lb = buf + SC_LW * lw * SC_STEPF + lane; asm volatile("" : "+v"(lb));
#pragma unroll
    for (int i = 0; i < SC_LW; ++i) { LAS float* sp = lb + i * SC_STEPF;
        const float rc = bf2f(R.rr[i + 1]), rp = bf2f(R.rr[i]), kc = bf2f(R.kk[i + 1]), kp = bf2f(R.kk[i]);
        const float zr = rc + (rp - rc) * mu_r, zk = kc + (kp - kc) * mu_k, a = bf2f(R.aa[i]);
        const float kv = zk * kk_n; const float ss = wave_sum_dpp(kv * kv); const float kn = kv * rsqrtf(fmaxf(ss, 1e-24f));
        sp[0] = zr; sp[64] = 1.0f - bf2f(R.ww[i]); sp[128] = zk * (1.0f + (a - 1.0f) * ka_n); sp[192] = -kn; sp[256] = kn * a; }
#pragma unroll
    for (int j = 0; j < SC_VJ; ++j) { const unsigned st = 4 * j + (lane >> 4), rw = lane & 15;
        if (st < (unsigned)SC_LW) { const float vc = bf2f(R.vc[j]), vp = bf2f(R.vp[j]); buf[(SC_LW * lw + st) * SC_STEPF + 320 + rw] = vc + (vp - vc) * mu_v; } }
}
typedef float f32x2 __attribute__((ext_vector_type(2)));
struct ScanOps { f32x4 r4, w4, k4, n4, b4; float v; };
__device__ __forceinline__ void scan_ops_load(ScanOps& o, const LAS float* lp, const LAS float* vp) {
    o.r4 = *(const LAS f32x4*)(lp); o.w4 = *(const LAS f32x4*)(lp + 64); o.k4 = *(const LAS f32x4*)(lp + 128);
    o.n4 = *(const LAS f32x4*)(lp + 192); o.b4 = *(const LAS f32x4*)(lp + 256); o.v = *vp; }
#define LO2(v) ((f32x2){(v).x, (v).y})
#define HI2(v) ((f32x2){(v).z, (v).w})
__device__ __forceinline__ float dot4p(const f32x2& a0, const f32x2& a1, const f32x4& b) { f32x2 t = a0 * LO2(b); t = a1 * HI2(b) + t; return t.x + t.y; }
__device__ __forceinline__ float scan_step(f32x2& S0, f32x2& S1, const ScanOps& o, float& q) {
    float p = dot4p(S0, S1, o.n4), y = q;
    p += dppf<0xB1>(p); y += dppf<0xB1>(y); p += dppf<0x4E>(p); y += dppf<0x4E>(y); p += dppf<0x141>(p); y += dppf<0x141>(y); p += dppf<0x128>(p); y += dppf<0x128>(y);
    const f32x2 vv = (f32x2){o.v, o.v}, sa = (f32x2){p, p};
    S0 = LO2(o.b4) * sa + (S0 * LO2(o.w4) + LO2(o.k4) * vv); S1 = HI2(o.b4) * sa + (S1 * HI2(o.w4) + HI2(o.k4) * vv);
    q = dot4p(S0, S1, o.r4);
    return y; }
constexpr int SC_YB = SC_CH * 16;
static_assert((2 * SC_BUFF + 2 * SC_YB + 256 + 256 + 4 * 64 * 33) * 4 <= RING_BYTES, "scan LDS");
__device__ __forceinline__ void scan_flush(const Frame& F, const LAS float* yb, int b, int h, int q, int chunk, int ltid) {
    bf16* Y = ((bf16*)(F.ws + WS_XN)); asm volatile("" : "+v"(ltid));
#pragma unroll
    for (int j = 0; j < (SC_YB + 255) / 256; ++j) { const int idx = ltid + 256 * j; if (idx < SC_YB) { const int st = idx >> 4, rw = idx & 15;
        Y[(size_t)row_of(b, chunk * SC_CH + st) * D + 512 + h * 64 + 16 * q + rw] = (bf16)f2bf(yb[idx]); } }
}
__device__ __forceinline__ void phase_scan(Frame& F, const float* pk, const float* const* in, int l) {
    { int ln_ = F.tid & 63; asm volatile("" : "+v"(ln_)); F.lane = ln_; }
    LAS float* buf0 = (LAS float*)F.lds; LAS float* buf1 = buf0 + SC_BUFF; LAS float* yb0 = buf1 + SC_BUFF; LAS float* yb1 = yb0 + SC_YB; LAS float* dummy = yb1 + SC_YB;
    const unsigned lane = F.lane; const int wave = F.wave;
    const int cv_split = CI_SET1, cv_n = CI_SET1 + (l + 1 < NLAYER ? CI_SET0 : 0);
    for (int item = blockIdx.x; item < 256; item += GRID) {
        const int b = item >> 5, h = (item >> 2) & 7, q = item & 3;
        if (wave >= 4) {
            const int lw = wave - 4, n = h * 64 + lane, ltid = lw * 64 + lane;
            const float mu_r = pk[PK_MU + n], mu_k = pk[PK_MU + 512 + n], kk_n = pk[PK_KK + n], ka_n = pk[PK_KA + n];
            const float mu_v = pk[PK_MU + 1024 + h * 64 + 16 * q + (lane & 15)];
            ScanRegs A, B;
            scan_load(F, A, b, h, q, lw, 0, lane); scan_load(F, B, b, h, q, lw, 1, lane);
            scan_emit(A, buf0, lw, lane, mu_r, mu_k, kk_n, ka_n, mu_v);
            __syncthreads();
            LAS float* cscr = dummy + 256 + lw * (64 * 33);
            int cv_it = (item * 4 + lw); bool cv_pending = false; ConvItem cvi; float cvv[32];
            cvi = conv_item(F.ws, in, l, 1, 0);
            for (int c = 0; c < SC_NCH; ++c) {
                if ((c & 1) == 0) { if (c + 2 < SC_NCH) scan_load(F, A, b, h, q, lw, c + 2, lane); if (c + 1 < SC_NCH) scan_emit(B, buf1, lw, lane, mu_r, mu_k, kk_n, ka_n, mu_v); }
                else              { if (c + 2 < SC_NCH) scan_load(F, B, b, h, q, lw, c + 2, lane); if (c + 1 < SC_NCH) scan_emit(A, buf0, lw, lane, mu_r, mu_k, kk_n, ka_n, mu_v); }
                if (c > 0) scan_flush(F, ((c - 1) & 1) ? yb1 : yb0, b, h, q, c - 1, ltid);
                if ((c & 7) == 1 && cv_pending) { conv_store(cvi, (int)lane, cvv, cscr); cv_pending = false; cv_it += 4 * 256; }
                if ((c & 7) == 0 && cv_it < cv_n) { cvi = cv_it < cv_split ? conv_item(F.ws, in, l, 1, cv_it) : conv_item(F.ws, in, l + 1, 0, cv_it - cv_split); conv_loads(cvi, (int)lane, cvv); cv_pending = true; }
                __syncthreads();
            }
            if (cv_pending) { conv_store(cvi, (int)lane, cvv, cscr); cv_it += 4 * 256; }
            for (; cv_it < cv_n; cv_it += 4 * 256) { cvi = cv_it < cv_split ? conv_item(F.ws, in, l, 1, cv_it) : conv_item(F.ws, in, l + 1, 0, cv_it - cv_split); conv_loads(cvi, (int)lane, cvv); conv_store(cvi, (int)lane, cvv, cscr); }
            scan_flush(F, ((SC_NCH - 1) & 1) ? yb1 : yb0, b, h, q, SC_NCH - 1, ltid);
        } else {
            const int kq = lane & 15, rowl = 4 * wave + (lane >> 4);
            f32x2 S0 = (f32x2){0.f, 0.f}, S1 = S0;
            __builtin_amdgcn_s_setprio(3);
            __syncthreads();
            for (int c = 0; c < SC_NCH; ++c) {
                const LAS float* bp = (c & 1) ? buf1 : buf0;
                LAS float* yw = kq == 0 ? (((c & 1) ? yb1 : yb0) + rowl) : (dummy + lane);
                const int ystep = kq == 0 ? 16 : 0;
                ScanOps oa, ob; float qp = 0.f;
                const LAS float* lp = bp + 4 * kq; const LAS float* vp = bp + 320 + rowl;
                asm volatile("" : "+v"(lp), "+v"(vp), "+v"(yw));
                scan_ops_load(oa, lp, vp);
                scan_ops_load(ob, lp + SC_STEPF, vp + SC_STEPF);
                (void)scan_step(S0, S1, oa, qp);
#pragma unroll 2
                for (int i = 1; i < SC_CH - 1; i += 2) {
                    scan_ops_load(oa, lp + (i + 1) * SC_STEPF, vp + (i + 1) * SC_STEPF);
                    const float y0 = scan_step(S0, S1, ob, qp); yw[(i - 1) * ystep] = y0;
                    scan_ops_load(ob, lp + (i + 2) * SC_STEPF, vp + (i + 2) * SC_STEPF);
                    const float y1 = scan_step(S0, S1, oa, qp); yw[i * ystep] = y1;
                }
                { const float y2 = scan_step(S0, S1, ob, qp); yw[(SC_CH - 2) * ystep] = y2; }
                yw[(SC_CH - 1) * ystep] = red16(qp);
                __syncthreads();
            }
            __builtin_amdgcn_s_setprio(0);
        }
        __syncthreads();
    }
}

__device__ __forceinline__ void unpack4(unsigned long long u, float (&v)[4]) { v[0] = bf2f((unsigned)u & 0xffffu); v[1] = bf2f(((unsigned)u >> 16)); v[2] = bf2f((unsigned)(u >> 32) & 0xffffu); v[3] = bf2f((unsigned)(u >> 48)); }
__device__ __forceinline__ void phase_mix_final(Frame& F, const float* pk) {
    { int ln_ = F.tid & 63; asm volatile("" : "+v"(ln_)); F.lane = ln_; }
    LAS float* carry = (LAS float*)F.lds;
    const int tid = F.tid, lane = F.lane, w = F.wave, rg = lane >> 4, kq = lane & 15;
    const bf16* P = ((bf16*)(F.ws + WS_OV + OV_P)); bf16* Y = ((bf16*)(F.ws + WS_XN));
    const bf16* AB = ((bf16*)(F.ws + WS_OV + OV_ABUF)); const bf16* GB = ((bf16*)(F.ws + WS_OV + OV_GBUF)); const float* HLp = ((float*)(F.ws + WS_OV + OV_HL)); const float* CAp = ((float*)(F.ws + WS_OV + OV_CA));
    const int n0 = w * 64 + 4 * kq;
    const f32x4 mu_r = *(const f32x4*)(pk + PK_MU + n0), mu_k = *(const f32x4*)(pk + PK_MU + 512 + n0), mu_v = *(const f32x4*)(pk + PK_MU + 1024 + n0);
    const f32x4 ka4 = *(const f32x4*)(pk + PK_KA + n0), rk4 = *(const f32x4*)(pk + PK_RK + n0), lw4 = *(const f32x4*)(pk + PK_LNW + n0), lb4 = *(const f32x4*)(pk + PK_LNB + n0);
    const f32x4 ng4 = w < 4 ? *(const f32x4*)(pk + PK_LNG + n0) : (f32x4){0.f, 0.f, 0.f, 0.f};
    for (int tile = blockIdx.x; tile < 256; tile += GRID) {
        const int b = tile >> 5, c = tile & 31;
        const int s_begin = c == 0 ? 0 : NMETA + 64 * c, ntok = c == 0 ? 80 : 64;
        if (tid < 256) {
            const float* ag = ((float*)(F.ws + WS_AGG)) + ((size_t)(b * 32) * 256 + tid) * 2; float ca[32], hh[32];
#pragma unroll
            for (int c2 = 0; c2 < 31; ++c2) { ca[c2] = 0.f; hh[c2] = 0.f; if (c2 < c) { const f32x2v_ t2 = *(const f32x2v_*)(ag + (size_t)c2 * 512); ca[c2] = t2.x; hh[c2] = t2.y; } }
            float hc = 0.f;
#pragma unroll
            for (int c2 = 0; c2 < 31; ++c2) if (c2 < c) hc = ca[c2] * hc + hh[c2];
            carry[tid] = hc; }
        __syncthreads();
        f32x4 cr4 = (f32x4){0.f, 0.f, 0.f, 0.f}; if (w < 4) cr4 = *(const LAS f32x4*)(carry + n0);
        for (int tg = (c == 0 && b != 0) ? NMETA : 0; tg < ntok; tg += 16) {
            unsigned long long rc[4], kc[4], vc[4], rp[4], kp[4], vp[4], av[4], yv[4], gv[4], lg[4]; f32x4 hl[4], cav[4];
#pragma unroll
            for (int u = 0; u < 4; ++u) { const int s = s_begin + tg + 4 * u + rg; const size_t ro = (size_t)row_of(b, s); const bf16* pr = P + ro * NINP + n0;
                rc[u] = *(const unsigned long long*)(pr + PC_R); kc[u] = *(const unsigned long long*)(pr + PC_K); vc[u] = *(const unsigned long long*)(pr + PC_V); rp[u] = 0ull; kp[u] = 0ull; vp[u] = 0ull;
                if (s > 0) { const bf16* pp = P + (size_t)row_of(b, s - 1) * NINP + n0; rp[u] = *(const unsigned long long*)(pp + PC_R); kp[u] = *(const unsigned long long*)(pp + PC_K); vp[u] = *(const unsigned long long*)(pp + PC_V); }
                av[u] = *(const unsigned long long*)(AB + ro * 512 + n0); yv[u] = *(const unsigned long long*)(Y + ro * D + 512 + n0); gv[u] = *(const unsigned long long*)(GB + ro * 512 + n0);
                lg[u] = 0ull; hl[u] = (f32x4){0.f, 0.f, 0.f, 0.f}; cav[u] = hl[u];
                if (w < 4) { lg[u] = *(const unsigned long long*)(pr + PC_LRUG); hl[u] = *(const f32x4*)(HLp + ro * 256 + n0); cav[u] = *(const f32x4*)(CAp + ro * 256 + n0); } }
#pragma unroll
            for (int u = 0; u < 4; ++u) { const int s = s_begin + tg + 4 * u + rg; const size_t ro = (size_t)row_of(b, s);
                float r_c[4], k_c[4], v_c[4], r_p[4], k_p[4], v_p[4], a4[4], y4[4], g4[4];
                unpack4(rc[u], r_c); unpack4(kc[u], k_c); unpack4(vc[u], v_c); unpack4(rp[u], r_p); unpack4(kp[u], k_p); unpack4(vp[u], v_p); unpack4(av[u], a4); unpack4(yv[u], y4); unpack4(gv[u], g4);
                float zv[4], cbp = 0.f, ysum = 0.f;
#pragma unroll
                for (int j = 0; j < 4; ++j) { const float zr = r_c[j] + (r_p[j] - r_c[j]) * mu_r[j], zk = k_c[j] + (k_p[j] - k_c[j]) * mu_k[j]; zv[j] = v_c[j] + (v_p[j] - v_c[j]) * mu_v[j];
                    cbp += zr * (zk * (1.0f + (a4[j] - 1.0f) * ka4[j])) * rk4[j]; ysum += y4[j]; }
                const float cb = red16(cbp), mean = red16(ysum) * (1.0f / 64.0f);
                float d4[4], vs = 0.f;
#pragma unroll
                for (int j = 0; j < 4; ++j) { d4[j] = y4[j] - mean; vs += d4[j] * d4[j]; }
                const float rstd = rsqrtf(red16(vs) * (1.0f / 64.0f) + LNX_EPS);
                float o4[4];
#pragma unroll
                for (int j = 0; j < 4; ++j) o4[j] = (d4[j] * rstd * lw4[j] + lb4[j] + cb * zv[j]) * g4[j];
                *(GAS unsigned long long*)(Y + ro * D + 512 + n0) = (unsigned long long)pk2(o4[0], o4[1]) | ((unsigned long long)pk2(o4[2], o4[3]) << 32);
                if (w < 4) { float l4[4], yy[4], ss = 0.f; unpack4(lg[u], l4);
#pragma unroll
                    for (int j = 0; j < 4; ++j) { yy[j] = gelu_tanh(l4[j]) * (hl[u][j] + cav[u][j] * cr4[j]); ss += yy[j] * yy[j]; }
                    const float rs = rsqrtf(red16(ss) * (1.0f / 64.0f) + RMS_EPS);
                    *(GAS unsigned long long*)(Y + ro * D + n0) = (unsigned long long)pk2(yy[0] * rs * ng4[0], yy[1] * rs * ng4[1]) | ((unsigned long long)pk2(yy[2] * rs * ng4[2], yy[3] * rs * ng4[3]) << 32); } }
        }
        __syncthreads();
    }
}
#ifndef MK_PER_PHASE
#define MK_PER_PHASE 0
#endif
constexpr int REP_GEMM = 1, REP_PREP = 1, REP_SCAN = 1, REP_CONV = 1;
constexpr int PH_PER_LAYER = 12, N_PHASES = 1 + NLAYER * PH_PER_LAYER;
struct Args { const float* in[30]; float* out; unsigned char* ws; int ph_lo, ph_hi; };
static_assert(sizeof(Args) == 30 * 8 + 8 + 8 + 4 + 4, "Args has no padding");

__global__ void __launch_bounds__(NWAVES * 64, 2) hybrid_fwd(Args args) {
    extern __shared__ __attribute__((aligned(16))) unsigned char lds[];
    Frame F;
    F.lds = (LAS unsigned char*)lds;
    F.tid = threadIdx.x; F.lane = F.tid & 63; F.wave = 0;
    { const int bx = blockIdx.x; F.vcu = (bx % 8) * (GRID / 8) + bx / 8; }
    unsigned char* ws = args.ws;
    F.ws = ws; F.x = args.in[0]; F.meta = args.in[1]; F.out = args.out;
    volatile LAS unsigned* MISC = (volatile LAS unsigned*)(F.lds + MISC_OFF);
    for (int u = F.tid; u < (LDS_BYTES - LDSCTL_OFF) / 4; u += NWAVES * 64) ((LAS unsigned*)(F.lds + LDSCTL_OFF))[u] = 0u;
    __syncthreads();
    { const unsigned simd = ((unsigned)__builtin_amdgcn_s_getreg((1 << 11) | (4 << 6) | 4)) & 3u;
      unsigned tk = 0u; if (vlane() == 0) tk = __hip_atomic_fetch_add((LAS unsigned*)(F.lds + MISC_OFF) + 12 + simd, 1u, __ATOMIC_RELAXED, __HIP_MEMORY_SCOPE_WORKGROUP); F.wave = (int)(simd + 4u * ((unsigned)__builtin_amdgcn_readfirstlane(tk) & 1u)); }
    F.lane = vlane(); F.tid = F.wave * 64 + F.lane;
    XcdBarrier bar; bar.bar = (unsigned*)(ws + WS_CTL) + CW_BAR; bar.x = 0; bar.st = nullptr;
    if (!MK_PER_PHASE) bar = xcd_barrier_post((unsigned*)(ws + WS_CTL) + CW_BAR, MISC + 8, F.tid == 0);
    const int lo = args.ph_lo, hi = args.ph_hi;
    unsigned long long pr_prev = 0ull; F.pr_acc = 0ull; F.pr_sub = 0ull; F.ph = 0; if (PROBE_MASK) pr_prev = __builtin_amdgcn_s_memrealtime();
#pragma unroll 1
    for (int ph = lo; ph < hi; ++ph) {
        if (PROBE_MASK) F.ph = ph;
        { GAS unsigned char* wsg = (GAS unsigned char*)args.ws; asm volatile("" : "+s"(wsg)); F.ws = (unsigned char*)wsg; }
        { int t_ = F.wave * 64 + vlane(); asm volatile("" : "+v"(t_)); F.tid = t_; }
        if (ph == 0) { phase_init(F, args.in[2]); phase_pack(F, args.in); phase_frag(F, args.in); for (int rep_ = 0; rep_ < REP_CONV; ++rep_) phase_convert(F, args.in, 0, 0); }
        else {
            const int l = (ph - 1) / PH_PER_LAYER, k = (ph - 1) - l * PH_PER_LAYER;
            if (k == 0 || k == 1 || k == 3 || k == 7 || k == 9 || k == 10) {
                unsigned char* w = F.ws;
                const bool up = (k == 0 || k == 9), down = (k == 1 || k == 10);
                const bf16* A = (const bf16*)(w + (down ? WS_OV + OV_HID : WS_XN));
                const bf16* B = (const bf16*)(w + WS_WB + (k == 0 ? WB_W1IN : k == 1 ? WB_W1OUT : k == 3 ? WB_WIN : k == 7 ? WB_WOUT : k == 9 ? WB_W2IN : WB_W2OUT));
                const int N = up ? 2 * FF : (k == 3 ? NINP : D), K = down ? FF : D;
                pg8::EpiAny E; E.mode = up ? 0 : 1; E.O = w + WS_OV + (up ? OV_HID : k == 3 ? OV_P : k == 7 ? OV_RAWM : OV_RAWF); E.ldo = up ? FF : (k == 3 ? NINP : D);
                const int gwv = F.vcu * NWAVES + F.wave;
                if (k == 3) meta_gemm(F, A, B, K, N, 1, w + WS_OV + OV_P, NINP, 1, gwv);
                else if (!up) meta_gemm(F, A, B, K, N, 2, w + WS_MSLAB, D, down ? 8 : 4, gwv);
                pg8::Gemm g{A, B, MX, N, K, K}; pg8::StaticOrder S; S.init(MX, N, GRID, (int)blockIdx.x);
                for (int rep_ = 0; rep_ < REP_GEMM; ++rep_) pg8::gemm_phase<pg8::EpiAny, pg8::StaticOrder, true, true>(F.lds, g, S, E, F.tid);
                if (up) meta_gemm(F, A, B, K, N, 0, w + WS_OV + OV_HID, FF, 1, (int)blockIdx.x >= 128 ? ((int)blockIdx.x - 128) * NWAVES + F.wave : -1);
            } else if (k == 2 || k == 8 || k == 11) {
                const float* ng = args.in[2] + (size_t)l * 6 * D;
                const bool last = l + 1 == NLAYER;
                const float* g_post = ng + (k == 2 ? 1 : k == 8 ? 3 : 5) * D;
                const float* g_pre = k == 2 ? ng + 2 * D : k == 8 ? ng + 4 * D : (!last ? ng + 6 * D : nullptr);
                bf16* h16 = (bf16*)F.out; bf16* htmp = (bf16*)(F.ws + WS_OV + OV_HTMP);
                PostIO io; io.raw16 = (const bf16*)(F.ws + WS_OV + (k == 8 ? OV_RAWM : OV_RAWF)); io.x32 = (l == 0 && k == 2) ? F.x : nullptr;
                io.hin16 = (last && k == 11) ? htmp : h16; io.hout16 = (last && k == 8) ? htmp : h16; io.out32 = (last && k == 11) ? F.out : nullptr; io.nks = k == 8 ? 4 : 8;
                phase_post(F, io, k == 8 ? 1.0f : 0.5f, g_post, g_pre);
            } else if (k == 4) { for (int rep_ = 0; rep_ < REP_PREP; ++rep_) phase_mix_prep(F, pack_of(F, l), l); }
            else if (k == 5) { for (int rep_ = 0; rep_ < REP_SCAN; ++rep_) phase_scan(F, pack_of(F, l), args.in, l); }
            else { phase_mix_final(F, pack_of(F, l)); }
        }
        if (ph + 1 < hi) xcd_barrier(bar, F.tid == 0);
        if (PROBE_MASK) { const unsigned long long t = __builtin_amdgcn_s_memrealtime(); if (PROBE_SUB < 0 && ((PROBE_MASK >> ph) & 1u)) F.pr_acc += t - pr_prev; pr_prev = t; F.pr_sub = t; }
    }
    if (PROBE_MASK && blockIdx.x == 0 && F.tid == 0) { const unsigned long long t0 = __builtin_amdgcn_s_memrealtime(); while (__builtin_amdgcn_s_memrealtime() - t0 < PROBE_AMP * F.pr_acc) __builtin_amdgcn_s_sleep(8); }
}

extern "C" void kernel_launch(void* const* d_in, const int* in_sizes, int n_in, void* d_out, int out_size, void* d_ws, size_t ws_size, hipStream_t stream) {
    static int grid = 0;
    if (grid == 0) {
        if (n_in != 30 || in_sizes[0] != MX * D || out_size != MX * D || ws_size < WS_END) { fprintf(stderr, "kernel_launch: unexpected shapes: n_in %d in0 %d out %d ws %zu\n", n_in, n_in > 0 ? in_sizes[0] : -1, out_size, ws_size); grid = -1; return; }
        int dev = 0, cus = 0, per_cu = 0;
        if (hipGetDevice(&dev) != hipSuccess || hipDeviceGetAttribute(&cus, hipDeviceAttributeMultiprocessorCount, dev) != hipSuccess) { grid = -1; return; }
        if (hipFuncSetAttribute((const void*)hybrid_fwd, hipFuncAttributeMaxDynamicSharedMemorySize, LDS_BYTES) != hipSuccess) { fprintf(stderr, "kernel_launch: hipFuncSetAttribute failed\n"); grid = -1; return; }
        if (hipOccupancyMaxActiveBlocksPerMultiprocessor(&per_cu, (const void*)hybrid_fwd, NWAVES * 64, LDS_BYTES) != hipSuccess || per_cu < 1) { fprintf(stderr, "kernel_launch: occupancy query says %d blocks per CU\n", per_cu); grid = -1; (void)hipGetLastError(); return; }
        (void)hipGetLastError();
        if (cus < GRID) { fprintf(stderr, "kernel_launch: this kernel needs %d CUs (one resident workgroup each), the device has %d\n", GRID, cus); grid = -1; return; }
        grid = GRID;
    }
    if (grid < 0) return;
    if (hipMemsetAsync((char*)d_ws + WS_CTL, 0, CTL_ZERO_BYTES, stream) != hipSuccess) return;
    Args a{};
    for (int i = 0; i < 30; ++i) a.in[i] = (const float*)d_in[i];
    a.out = (float*)d_out; a.ws = (unsigned char*)d_ws;
#if MK_PER_PHASE
    for (int p = 0; p < N_PHASES; ++p) { a.ph_lo = p; a.ph_hi = p + 1; hipLaunchKernelGGL(hybrid_fwd, dim3(grid), dim3(NWAVES * 64), LDS_BYTES, stream, a); }
#else
    a.ph_lo = 0; a.ph_hi = N_PHASES;
    hipLaunchKernelGGL(hybrid_fwd, dim3(grid), dim3(NWAVES * 64), LDS_BYTES, stream, a);
#endif
}
```

```cpp
#include <hip/hip_runtime.h>
#include <cstdio>
#include <cstdint>
namespace pg8 {
#define PG8_LAS __attribute__((address_space(3)))
typedef unsigned short bf16_t;
typedef short bf16x8 __attribute__((ext_vector_type(8)));
typedef float f32x4 __attribute__((ext_vector_type(4)));
typedef unsigned u32x4 __attribute__((ext_vector_type(4)));
constexpr int BM = 256, BK = 64, HALF = 128, HTB = HALF * BK * 2  , STAGE_BYTES = 8 * HTB, NXCD = 8, WGM = 8;

__host__ __device__ __forceinline__ int lds_byte(int r, int c) { const int st = (r >> 4) * 2 + (c >> 5), rr = r & 15, cc = c & 31, ob = rr * 64 + cc * 2; return st * 1024 + (ob ^ (((ob >> 9) & 1) << 5)); }
__host__ __device__ __forceinline__ void stage_rc(int b, int& R, int& C) { const int st = b / 1024, sb = b % 1024, swz = sb ^ (((sb >> 9) & 1) << 5); R = (st >> 1) * 16 + swz / 64; C = (st & 1) * 32 + (swz % 64) / 2; }
__host__ __device__ __forceinline__ int perm32(int rho) { const int n = rho >> 4, i = rho & 15; return 8 * (i >> 2) + 4 * n + (i & 3); }

struct Unit { int pm, pn; };
struct Gemm { const bf16_t* A; const bf16_t* Bt; int M, N, K, ld; };

struct StaticOrder {
    int nM, nN, nwg, G, c, one_pn;
    __host__ __device__ void init(int M, int N, int G_, int c_) { nM = M / BM; nN = N / BM; nwg = nM * nN; G = G_; c = c_; one_pn = -1; }
    __host__ __device__ bool next(int i, Unit& u) const {
        if (one_pn != -1) { if (i != 0 || one_pn < 0) return false; u.pm = 0; u.pn = one_pn; return true; }
        const long L = (long)i * G + c; if (L >= nwg) return false;
        int wgid = (int)L; { const int q = nwg / NXCD, r = nwg % NXCD, xcd = wgid % NXCD, off = wgid / NXCD; wgid = (xcd < r ? xcd * (q + 1) : r * (q + 1) + (xcd - r) * q) + off; }
        const int nig = WGM * nN, gid = wgid / nig, fm = gid * WGM, gsz = (nM - fm) < WGM ? (nM - fm) : WGM;
        u.pm = fm + ((wgid % nig) % gsz); u.pn = (wgid % nig) / gsz; return true;
    }
    __device__ __forceinline__ void a_ready(const Unit&) const {}
    __device__ __forceinline__ void done(const Unit&) const {}
};
__device__ __forceinline__ unsigned cvt_pk_bf16(float lo, float hi) { unsigned r; asm volatile("v_cvt_pk_bf16_f32 %0, %1, %2" : "=v"(r) : "v"(lo), "v"(hi)); return r; }
typedef float f32x2 __attribute__((ext_vector_type(2)));
struct EpiSwiGLU {
    static constexpr bool PERM = true, AFTER_DRAIN = false;
    bf16_t* O; int ldo; const PG8_LAS float* rst;
    __device__ __forceinline__ void operator()(const f32x4 (&acc)[2][2][4][2], const Unit& u, int wr, int wc, int fr, int fq) const {
        const int row0 = u.pm * BM + wr * 64 + fr, col0 = u.pn * HALF + wc * 32 + 8 * fq;
#pragma unroll
        for (int ai = 0; ai < 2; ++ai)
#pragma unroll
            for (int m = 0; m < 4; ++m) { bf16_t* rowp = O + (size_t)(row0 + ai * HALF + m * 16) * ldo + col0; const float sc = rst ? rst[64 * ai + 16 * m + fr] : 1.0f;
                float hv[8];
#pragma unroll
                for (int n = 0; n < 2; ++n)
#pragma unroll
                    for (int j = 0; j < 4; ++j) { const float g = acc[ai][0][m][n][j] * sc, up = acc[ai][1][m][n][j] * sc; hv[n * 4 + j] = g * __builtin_amdgcn_rcpf(1.0f + __expf(-g)) * up; }
                u32x4 w; w.x = cvt_pk_bf16(hv[0], hv[1]); w.y = cvt_pk_bf16(hv[2], hv[3]); w.z = cvt_pk_bf16(hv[4], hv[5]); w.w = cvt_pk_bf16(hv[6], hv[7]);
                *(u32x4*)rowp = w; }
    }
};
struct EpiStoreBf16 {
    static constexpr bool PERM = true, AFTER_DRAIN = false;
    bf16_t* O; int ldc; const PG8_LAS float* rst;
    __device__ __forceinline__ void operator()(const f32x4 (&acc)[2][2][4][2], const Unit& u, int wr, int wc, int fr, int fq) const {
        const int row0 = u.pm * BM + wr * 64 + fr, col0 = u.pn * BM + wc * 32 + 8 * fq;
#pragma unroll
        for (int ai = 0; ai < 2; ++ai)
#pragma unroll
            for (int m = 0; m < 4; ++m) { bf16_t* rowp = O + (size_t)(row0 + ai * HALF + m * 16) * ldc + col0; const float sc = rst ? rst[64 * ai + 16 * m + fr] : 1.0f;
#pragma unroll
                for (int bj = 0; bj < 2; ++bj) { const f32x4 v0 = acc[ai][bj][m][0] * sc, v1 = acc[ai][bj][m][1] * sc;
                    u32x4 w; w.x = cvt_pk_bf16(v0[0], v0[1]); w.y = cvt_pk_bf16(v0[2], v0[3]); w.z = cvt_pk_bf16(v1[0], v1[1]); w.w = cvt_pk_bf16(v1[2], v1[3]);
                    *(u32x4*)(rowp + bj * HALF) = w; } }
    }
};
struct EpiF32 {
    static constexpr bool PERM = false, AFTER_DRAIN = false;
    float* C; int ldc;
    __device__ __forceinline__ void operator()(const f32x4 (&acc)[2][2][4][2], const Unit& u, int wr, int wc, int fr, int fq) const {
        const int row0 = u.pm * BM + wr * 64 + fr, col0 = u.pn * BM + wc * 32 + 4 * fq;
#pragma unroll
        for (int ai = 0; ai < 2; ++ai)
#pragma unroll
            for (int m = 0; m < 4; ++m) { float* rowp = C + (size_t)(row0 + ai * HALF + m * 16) * ldc + col0;
#pragma unroll
                for (int bj = 0; bj < 2; ++bj)
#pragma unroll
                    for (int n = 0; n < 2; ++n) *(f32x4*)(rowp + bj * HALF + n * 16) = acc[ai][bj][m][n]; }
    }
};
struct EpiAny {
    static constexpr bool PERM = true, AFTER_DRAIN = false;
    int mode; void* O; int ldo; const float* rs;
    __device__ __forceinline__ void row_scale_issue(const Unit& u, int wr, int fr, int fq, float& v0, float& v1) const {
        if (rs) { const float* p = rs + u.pm * BM + wr * 64 + fr + (fq >> 1) * HALF + (fq & 1) * 32; v0 = p[0]; v1 = p[16]; } }
    __device__ __forceinline__ void row_scale_park(PG8_LAS unsigned char* tab, int wid, int lane, float v0, float v1) const {
        if (rs) { PG8_LAS float* t = (PG8_LAS float*)(tab + wid * 512) + ((lane >> 5) * 64 + ((lane >> 4) & 1) * 32 + (lane & 15)); t[0] = v0; t[16] = v1; asm volatile("s_waitcnt lgkmcnt(0)" ::: "memory"); } }
    __device__ __forceinline__ void operator()(f32x4 (&acc)[2][2][4][2], const Unit& u, int wr, int wc, int fr, int fq, PG8_LAS unsigned char* tab, int wid) const {
        const PG8_LAS float* rst = rs ? (const PG8_LAS float*)(tab + wid * 512) : nullptr;
        if (mode == 0) { EpiSwiGLU E{(bf16_t*)O, ldo, rst}; E(acc, u, wr, wc, fr, fq); }
        else if (mode == 1) { EpiStoreBf16 E{(bf16_t*)O, ldo, rst}; E(acc, u, wr, wc, fr, fq); }
        else { float* C = (float*)O; const int row0 = u.pm * BM + wr * 64 + fr, col0 = u.pn * BM + wc * 32 + 8 * fq;
#pragma unroll
            for (int ai = 0; ai < 2; ++ai)
#pragma unroll
                for (int m = 0; m < 4; ++m) { float* rowp = C + (size_t)(row0 + ai * HALF + m * 16) * ldo + col0;
#pragma unroll
                    for (int bj = 0; bj < 2; ++bj)
#pragma unroll
                        for (int n = 0; n < 2; ++n) *(f32x4*)(rowp + bj * HALF + n * 4) = acc[ai][bj][m][n]; } }
    }
};
template <class Epi, class Sched, bool ALIGN_EPI = false, bool SP2 = false>
__device__ __forceinline__ void gemm_phase(PG8_LAS unsigned char* lds, const Gemm g, const Sched& S, const Epi& E, int tid_in  ) {
    int tid_ = tid_in; asm volatile("" : "+v"(tid_));
    const int tid = tid_, wid = __builtin_amdgcn_readfirstlane(tid >> 6), lane = tid & 63, wr = wid >> 2, wc = wid & 3, fr = lane & 15, fq = lane >> 4;
    const int K = g.K, LD = g.ld, nt = K / BK;
    unsigned voffA[2], voffB[2];
#pragma unroll
    for (int i = 0; i < 2; ++i) { int R, C; stage_rc(tid * 16 + i * 8192, R, C); const int Rb = Epi::PERM ? ((R & ~31) + perm32(R & 31)) : R;
        voffA[i] = (unsigned)(R * LD + C) * 2u; voffB[i] = (unsigned)(Rb * LD + C) * 2u; }
    const size_t kstep = (size_t)(BK * 2);
    const size_t hstep = (size_t)HALF * LD * 2;
    const size_t tstep = 2 * hstep;
    const unsigned ldsw = (unsigned)wid * 1024u;
    const int aoff = lds_byte(wr * 64 + fr, fq * 8), boff = lds_byte(wc * 32 + fr, fq * 8);
#define PG8_SA(b, h) (((b) * 2 + (h)) * HTB)
#define PG8_SB(b, h) ((4 + (b) * 2 + (h)) * HTB)
#define PG8_STAGE(bufoff, gbase, voff) do { _Pragma("unroll") for (int _i = 0; _i < 2; ++_i) \
        __builtin_amdgcn_global_load_lds((const unsigned*)((const char*)(gbase) + (voff)[_i]), (PG8_LAS unsigned*)(lds + (bufoff) + ldsw + _i * 8192), 16, 0, 0); } while (0)
#define PG8_LDA(dst, b, h) do { _Pragma("unroll") for (int m = 0; m < 4; ++m) _Pragma("unroll") for (int k = 0; k < 2; ++k) dst[m][k] = *(const PG8_LAS bf16x8*)(lds + PG8_SA(b, h) + aoff + m * 2048 + k * 1024); } while (0)
#define PG8_LDB(dst, b, h) do { _Pragma("unroll") for (int n = 0; n < 2; ++n) _Pragma("unroll") for (int k = 0; k < 2; ++k) dst[n][k] = *(const PG8_LAS bf16x8*)(lds + PG8_SB(b, h) + boff + n * 2048 + k * 1024); } while (0)
#define PG8_MMA(ai, bj, At, Bt) do { __builtin_amdgcn_s_setprio(1); _Pragma("unroll") for (int m = 0; m < 4; ++m) _Pragma("unroll") for (int n = 0; n < 2; ++n) _Pragma("unroll") for (int k = 0; k < 2; ++k) \
        acc[ai][bj][m][n] = __builtin_amdgcn_mfma_f32_16x16x32_bf16(Bt[n][k], At[m][k], acc[ai][bj][m][n], 0, 0, 0); __builtin_amdgcn_s_setprio(0); } while (0)
#define PG8_WAIT_V(n) asm volatile("s_waitcnt vmcnt(" #n ")" ::: "memory")
#define PG8_WAIT_L(n) asm volatile("s_waitcnt lgkmcnt(" #n ")" ::: "memory")
#define PG8_BAR __builtin_amdgcn_s_barrier()
#define PG8_SCHED __builtin_amdgcn_sched_barrier(0)
    Unit cur, nxt; int ui = 0;
    if (!S.next(0, cur)) return;
    f32x4 acc[2][2][4][2];
#pragma unroll
    for (int a = 0; a < 2; ++a)
#pragma unroll
        for (int b = 0; b < 2; ++b)
#pragma unroll
            for (int m = 0; m < 4; ++m)
#pragma unroll
                for (int n = 0; n < 2; ++n) acc[a][b][m][n] = (f32x4){0.f, 0.f, 0.f, 0.f};
    bf16x8 At[4][2], B0[2][2], B1[2][2];
    const char* cA = (const char*)g.A + (size_t)cur.pm * tstep; const char* cB = (const char*)g.Bt + (size_t)cur.pn * tstep;
    S.a_ready(cur);
    if constexpr (SP2) {
        PG8_STAGE(PG8_SB(0, 0), cB, voffB); PG8_STAGE(PG8_SB(0, 1), cB + hstep, voffB); PG8_STAGE(PG8_SA(0, 0), cA, voffA); PG8_STAGE(PG8_SA(0, 1), cA + hstep, voffA);
        if (wr == 1) PG8_BAR;
        PG8_WAIT_V(2); PG8_BAR;
        PG8_STAGE(PG8_SB(1, 0), cB + kstep, voffB); PG8_STAGE(PG8_SA(1, 0), cA + kstep, voffA); PG8_STAGE(PG8_SB(1, 1), cB + hstep + kstep, voffB);
        PG8_WAIT_V(6); PG8_BAR;
    } else {
        PG8_STAGE(PG8_SB(0, 0), cB, voffB); PG8_STAGE(PG8_SA(0, 0), cA, voffA); PG8_STAGE(PG8_SB(0, 1), cB + hstep, voffB); PG8_STAGE(PG8_SA(0, 1), cA + hstep, voffA);
        if (wr == 1) PG8_BAR;
        PG8_WAIT_V(4); PG8_BAR;
        PG8_STAGE(PG8_SB(1, 0), cB + kstep, voffB); PG8_STAGE(PG8_SA(1, 0), cA + kstep, voffA); PG8_STAGE(PG8_SB(1, 1), cB + hstep + kstep, voffB);
        PG8_WAIT_V(6); PG8_BAR;
    }
    for (;;) {
        const bool has_next = S.next(ui + 1, nxt);
        { float rsv0 = 1.0f, rsv1 = 1.0f; E.row_scale_issue(cur, wr, fr, fq, rsv0, rsv1); E.row_scale_park(lds + STAGE_BYTES, wid, lane, rsv0, rsv1); }
        const char* nA = has_next ? (const char*)g.A + (size_t)nxt.pm * tstep : cA; const char* nB = has_next ? (const char*)g.Bt + (size_t)nxt.pn * tstep : cB;
        for (int t = 0; t < nt; t += 2) {
            const bool last = (t == nt - 2);
            const char* a1 = cA + (size_t)(t + 1) * kstep;
            const char* a2 = last ? nA : cA + (size_t)(t + 2) * kstep; const char* b2 = last ? nB : cB + (size_t)(t + 2) * kstep;
            const char* a3 = a2 + kstep; const char* b3 = b2 + kstep;
            if (last && has_next) S.a_ready(nxt);
            if constexpr (SP2) {
            PG8_LDB(B0, 0, 0); PG8_LDB(B1, 0, 1); PG8_SCHED; PG8_LDA(At, 0, 0); PG8_STAGE(PG8_SA(1, 1), a1 + hstep, voffA);
            PG8_WAIT_V(8); PG8_WAIT_L(0); PG8_BAR; PG8_MMA(0, 0, At, B0); PG8_MMA(0, 1, At, B1); PG8_BAR; PG8_SCHED;
            PG8_LDA(At, 0, 1); PG8_STAGE(PG8_SB(0, 0), b2, voffB); PG8_STAGE(PG8_SB(0, 1), b2 + hstep, voffB); PG8_STAGE(PG8_SA(0, 0), a2, voffA);
            PG8_WAIT_V(8); PG8_WAIT_L(0); PG8_BAR; PG8_MMA(1, 0, At, B0); PG8_MMA(1, 1, At, B1); PG8_BAR; PG8_SCHED;
            PG8_LDB(B0, 1, 0); PG8_LDB(B1, 1, 1); PG8_SCHED; PG8_LDA(At, 1, 0); PG8_STAGE(PG8_SA(0, 1), a2 + hstep, voffA);
            PG8_WAIT_V(8); PG8_WAIT_L(0); PG8_BAR; PG8_MMA(0, 0, At, B0); PG8_MMA(0, 1, At, B1); PG8_BAR; PG8_SCHED;
            PG8_LDA(At, 1, 1); PG8_STAGE(PG8_SB(1, 0), b3, voffB); PG8_STAGE(PG8_SB(1, 1), b3 + hstep, voffB); PG8_STAGE(PG8_SA(1, 0), a3, voffA);
            PG8_WAIT_V(8); PG8_WAIT_L(0); PG8_BAR; PG8_MMA(1, 0, At, B0); PG8_MMA(1, 1, At, B1); PG8_BAR; PG8_SCHED;
            } else {
            PG8_LDB(B0, 0, 0); PG8_SCHED; PG8_LDA(At, 0, 0); PG8_STAGE(PG8_SA(1, 1), a1 + hstep, voffA);
            PG8_WAIT_L(8); PG8_BAR; PG8_WAIT_L(0); PG8_MMA(0, 0, At, B0); PG8_BAR; PG8_SCHED;
            PG8_LDB(B1, 0, 1); PG8_STAGE(PG8_SB(0, 0), b2, voffB);
            PG8_BAR; PG8_WAIT_L(0); PG8_MMA(0, 1, At, B1); PG8_BAR;
            PG8_LDA(At, 0, 1); PG8_STAGE(PG8_SA(0, 0), a2, voffA);
            PG8_BAR; PG8_WAIT_L(0); PG8_MMA(1, 0, At, B0); PG8_BAR; PG8_SCHED;
            PG8_STAGE(PG8_SB(0, 1), b2 + hstep, voffB);
            PG8_WAIT_V(6); PG8_BAR; PG8_MMA(1, 1, At, B1); PG8_BAR;
            PG8_LDB(B0, 1, 0); PG8_SCHED; PG8_LDA(At, 1, 0); PG8_STAGE(PG8_SA(0, 1), a2 + hstep, voffA);
            PG8_WAIT_L(8); PG8_BAR; PG8_WAIT_L(0); PG8_MMA(0, 0, At, B0); PG8_BAR; PG8_SCHED;
            PG8_LDB(B1, 1, 1); PG8_STAGE(PG8_SB(1, 0), b3, voffB);
            PG8_BAR; PG8_WAIT_L(0); PG8_MMA(0, 1, At, B1); PG8_BAR;
            PG8_LDA(At, 1, 1); PG8_STAGE(PG8_SA(1, 0), a3, voffA);
            PG8_BAR; PG8_WAIT_L(0); PG8_MMA(1, 0, At, B0); PG8_BAR; PG8_SCHED;
            PG8_STAGE(PG8_SB(1, 1), b3 + hstep, voffB);
            PG8_WAIT_V(6); PG8_BAR; PG8_MMA(1, 1, At, B1); PG8_BAR;
            }
        }
        if constexpr (ALIGN_EPI) { if (wr == 0) PG8_BAR; }
        E(acc, cur, wr, wc, fr, fq, lds + STAGE_BYTES, wid); S.done(cur);
        if (!has_next) break;
#pragma unroll
        for (int a = 0; a < 2; ++a)
#pragma unroll
            for (int b = 0; b < 2; ++b)
#pragma unroll
                for (int m = 0; m < 4; ++m)
#pragma unroll
                    for (int n = 0; n < 2; ++n) acc[a][b][m][n] = (f32x4){0.f, 0.f, 0.f, 0.f};
        cur = nxt; cA = nA; cB = nB; ++ui;
        if constexpr (ALIGN_EPI) { if (wr == 1) PG8_BAR; }
    }
    PG8_WAIT_V(0);
    if constexpr (!ALIGN_EPI) { if (wr == 0) PG8_BAR; }
    PG8_BAR;
#undef PG8_SA
#undef PG8_SB
#undef PG8_STAGE
#undef PG8_LDA
#undef PG8_LDB
#undef PG8_MMA
#undef PG8_WAIT_V
#undef PG8_WAIT_L
#undef PG8_BAR
#undef PG8_SCHED
}
}
constexpr int NWAVES = 8, GRID = 256;
constexpr int D = 1024, FF = 2816, NIN = 2944, NINP = 3072, NLAYER = 2;
constexpr int NB = 8, SEQ = 2048, NMETA = 16, TT = SEQ + NMETA;
constexpr int MX = NB * SEQ, MREAL = MX + NMETA, MP = 16640;
constexpr float RMS_EPS = 1e-6f, LNX_EPS = 64e-5f;
constexpr int PC_LRUX = 0, PC_LRUG = 256, PC_SCB = 512, PC_SCC = 768, PC_SCX = 1024, PC_R = 1280, PC_K = 1792, PC_V = 2304, PC_LO = 2816;

constexpr size_t MiB = 1u << 20;
constexpr size_t WS_CTL = 0, CTL_ZERO_BYTES = 1 * MiB;
constexpr size_t WS_HMETA = 1 * MiB;
constexpr size_t WS_RS = WS_HMETA + 640 * 1024;
constexpr size_t WS_MSLAB = WS_HMETA + 64 * 1024;
constexpr size_t WS_AGG = 2 * MiB;
constexpr size_t WS_WB = 3 * MiB;
constexpr size_t WB_W1IN = 0, WB_W1OUT = 11 * MiB, WB_W2IN = WB_W1OUT + 5632 * 1024, WB_W2OUT = WB_W2IN + 11 * MiB, WB_WIN = WB_W2OUT + 5632 * 1024, WB_WOUT = WB_WIN + 6 * MiB, WB_END = WB_WOUT + 2 * MiB;
static_assert(WB_END == 41 * MiB, "weight map");
constexpr size_t WS_XN = 44 * MiB;
constexpr size_t WS_OV = 77 * MiB;
constexpr size_t OV_HID = 0, OV_RAWF = 90 * MiB;
constexpr size_t OV_P = 0, OV_WDEC = OV_P + (size_t)MP * NINP * 2, OV_ABUF = OV_WDEC + (size_t)MP * 512 * 2, OV_GBUF = OV_ABUF + (size_t)MP * 512 * 2, OV_HL = OV_GBUF + (size_t)MP * 512 * 2, OV_CA = OV_HL + (size_t)MP * 256 * 4, OV_MIXEND = OV_CA + (size_t)MP * 256 * 4;
constexpr size_t OV_HTMP = 130 * MiB;
constexpr size_t OV_RAWM = 0;
constexpr size_t WS_END = 256 * MiB;
static_assert(WS_XN + (size_t)MP * D * 2 <= WS_OV && WS_OV + OV_MIXEND <= WS_END && WS_OV + OV_RAWF + (size_t)MP * D * 4 <= WS_END && (size_t)MP * FF * 2 <= OV_RAWF, "d_ws map");
constexpr int CW_TMO = 8, CW_CNTM = 72, CW_BAR = 4096, CW_CNTA = 8192, CW_CNTB = CW_CNTA + 65 * 64;
constexpr size_t OV_X1 = 156 * MiB, OV_SLAB = 158 * MiB;

constexpr unsigned PROBE_MASK = 0u, PROBE_AMP = 8u; constexpr int PROBE_SUB = -1;
#define PSTAMP(j) do { if (PROBE_MASK && PROBE_SUB >= 0) { const unsigned long long t_ = __builtin_amdgcn_s_memrealtime(); if (PROBE_SUB == (j) && ((PROBE_MASK >> F.ph) & 1u)) F.pr_acc += t_ - F.pr_sub; F.pr_sub = t_; } } while (0)
constexpr int RING_BYTES = 143360, LDSCTL_OFF = RING_BYTES, MISC_OFF = LDSCTL_OFF + 320, LDS_BYTES = 147456;

#define GAS __attribute__((address_space(1)))
#define LAS __attribute__((address_space(3)))
typedef unsigned short bf16;
typedef unsigned v4u __attribute__((ext_vector_type(4)));
typedef float f32x4 __attribute__((ext_vector_type(4)));
typedef GAS unsigned gu32;
typedef float f32x2v_ __attribute__((ext_vector_type(2)));
#define LDS_WAIT() asm volatile("s_waitcnt lgkmcnt(0)" ::: "memory")
__device__ __forceinline__ unsigned f2bf(float f) { unsigned u = __builtin_bit_cast(unsigned, f); return (u + 0x7fffu + ((u >> 16) & 1u)) >> 16; }
__device__ __forceinline__ unsigned pk2(float lo, float hi) { return f2bf(lo) | (f2bf(hi) << 16); }
__device__ __forceinline__ float bf2f(unsigned b) { return __builtin_bit_cast(float, b << 16); }
__device__ __forceinline__ float sigmoidf_(float x) { return __builtin_amdgcn_rcpf(1.0f + __expf(-x)); }
__device__ __forceinline__ float tanhf_(float x) { return 1.0f - 2.0f * __builtin_amdgcn_rcpf(1.0f + __expf(2.0f * x)); }
__device__ __forceinline__ float softplusf_(float x) { return fmaxf(x, 0.f) + __logf(1.0f + __expf(-fabsf(x))); }
__device__ __forceinline__ float gelu_tanh(float x) { const float u = 0.7978845608028654f * (x + 0.044715f * x * x * x); return 0.5f * x * (1.0f + tanhf_(u)); }
template <int CTRL> __device__ __forceinline__ float dppf(float x) { return __builtin_bit_cast(float, __builtin_amdgcn_mov_dpp(__builtin_bit_cast(int, x), CTRL, 0xf, 0xf, true)); }
__device__ __forceinline__ float red16(float x) { x += dppf<0xB1>(x); x += dppf<0x4E>(x); x += dppf<0x141>(x); x += dppf<0x128>(x); return x; }
__device__ __forceinline__ float wave_sum(float x) {
    x = red16(x);
    x += __builtin_bit_cast(float, __builtin_amdgcn_update_dpp(0, __builtin_bit_cast(int, x), 0x142, 0xa, 0xf, false));
    x += __builtin_bit_cast(float, __builtin_amdgcn_update_dpp(0, __builtin_bit_cast(int, x), 0x143, 0xc, 0xf, false));
    return __builtin_bit_cast(float, __builtin_amdgcn_readlane(__builtin_bit_cast(int, x), 63)); }
__device__ __forceinline__ float wave_sum_dpp(float x) { return wave_sum(x); }
__device__ __forceinline__ int vlane() { return (int)__builtin_amdgcn_mbcnt_hi(~0u, __builtin_amdgcn_mbcnt_lo(~0u, 0u)); }
__device__ __forceinline__ int row_of(int b, int s) { return s < NMETA ? (MX + s) : (b * SEQ + s - NMETA); }
#define XB_TMO      128
#define XB_XCNT(j)  (256  + 64 * (j))
#define XB_XSUB(j)  (1280 + 64 * (j))
#define XB_XGEN(j)  (2304 + 64 * (j))
#define XB_TOP      3328
#define XB_TOPGEN   3392
#define XCD_BAR_WORDS 3456
#define XB_SPIN_CAP (1u << 18)

__device__ __forceinline__ unsigned xb_ld(unsigned* p)              { return __hip_atomic_load(p, __ATOMIC_RELAXED, __HIP_MEMORY_SCOPE_AGENT); }
__device__ __forceinline__ unsigned xb_add(unsigned* p, unsigned v) { return __hip_atomic_fetch_add(p, v, __ATOMIC_RELAXED, __HIP_MEMORY_SCOPE_AGENT); }
__device__ __forceinline__ unsigned xb_xcc_id() { return (unsigned)__builtin_amdgcn_s_getreg((3 << 11) | 20) & 0xFu; }
#define XB_SPIN(cond, bar) do { unsigned _sp = 0; while (cond) { __builtin_amdgcn_s_sleep(1); \
    if ((++_sp & 255u) == 0u) { if (xb_ld(&(bar)[XB_TMO])) break; if (_sp > XB_SPIN_CAP) { atomicAdd(&(bar)[XB_TMO], 1u); break; } } } } while (0)

struct XcdBarrier {
    unsigned* bar; unsigned x;
    volatile LAS unsigned* st;
};

__device__ __forceinline__ XcdBarrier xcd_barrier_post(unsigned* bar, volatile LAS unsigned* st, bool leader  ) {
    XcdBarrier b; b.bar = bar; b.x = xb_xcc_id(); b.st = st;
    if (leader) (void)xb_add(&bar[XB_XCNT(b.x)], 1u);
    return b;
}
__device__ __forceinline__ void xcd_barrier_complete(unsigned* bar, unsigned x, unsigned& nloc, unsigned& nx) {
    const unsigned G = gridDim.x * gridDim.y * gridDim.z;
    unsigned sum, cnt, mine, sp = 0u;
    for (;;) {
        sum = 0u; cnt = 0u; mine = 0u;
#pragma unroll
        for (unsigned j = 0; j < 16; ++j) { const unsigned c = xb_ld(&bar[XB_XCNT(j)]); sum += c; cnt += (c > 0u) ? 1u : 0u; mine = (j == x) ? c : mine; }
        if (sum == G) break;
        __builtin_amdgcn_s_sleep(1);
        if ((++sp & 255u) == 0u) { if (xb_ld(&bar[XB_TMO])) break; if (sp > XB_SPIN_CAP) { atomicAdd(&bar[XB_TMO], 1u); break; } }
    }
    nloc = mine > 0u ? mine : 1u; nx = cnt > 0u ? cnt : 1u;
}

__device__ __forceinline__ void xcd_barrier(const XcdBarrier& b, bool leader  ) {
    asm volatile("s_waitcnt vmcnt(0)" ::: "memory");
    __syncthreads();
    if (leader) {
        unsigned* bar = b.bar;
        __builtin_amdgcn_s_waitcnt(0);
        unsigned nloc = b.st[0], nx = b.st[1];
        if (nloc == 0u) { xcd_barrier_complete(bar, b.x, nloc, nx); b.st[0] = nloc; b.st[1] = nx; }
        const unsigned old = xb_add(&bar[XB_XSUB(b.x)], 1u);
        const unsigned gen = old / nloc;
        if (old + 1u == (gen + 1u) * nloc) {
            __builtin_amdgcn_fence(__ATOMIC_RELEASE, "agent");
            asm volatile("s_waitcnt vmcnt(0)" ::: "memory");
            const unsigned og = xb_add(&bar[XB_TOP], 1u);
            const unsigned tg = og / nx;
            if (og + 1u == (tg + 1u) * nx) xb_add(&bar[XB_TOPGEN], 1u);
            else XB_SPIN(xb_ld(&bar[XB_TOPGEN]) == tg, bar);
            __builtin_amdgcn_fence(__ATOMIC_ACQUIRE, "agent");
            xb_add(&bar[XB_XGEN(b.x)], 1u);
            asm volatile("s_waitcnt vmcnt(0)" ::: "memory");
        } else {
            XB_SPIN(xb_ld(&bar[XB_XGEN(b.x)]) == gen, bar);
            __builtin_amdgcn_fence(__ATOMIC_ACQUIRE, "agent");
            asm volatile("s_waitcnt vmcnt(0)" ::: "memory");
        }
    }
    __syncthreads();
}
struct Frame {
    LAS unsigned char* lds;
    int tid, lane, wave, vcu;
    unsigned long long pr_acc, pr_sub; int ph;
    unsigned char* ws;
    const float* x; const float* meta; float* out;
};

constexpr int PK_CONVW = 0, PK_CONVB = 1024, PK_WA = 1280, PK_BA = 17664, PK_WX = 17920, PK_BX = 34304, PK_LAM = 34560, PK_LNG = 34816, PK_SCW = 35072, PK_SCG = 35840, PK_MU = 36096, PK_W0 = 37760,
              PK_W2 = 38272, PK_A0 = 54656, PK_A2 = 55168, PK_G2 = 71552, PK_KK = 104320, PK_KA = 104832, PK_RK = 105344, PK_LNW = 105856, PK_LNB = 106368, PK_SIZE = 106880;
constexpr size_t WS_PACK = 72 * 1024;
static_assert(WS_PACK + (size_t)NLAYER * PK_SIZE * 4 <= CTL_ZERO_BYTES && (CW_CNTB + 65 * 64) * 4 <= (int)WS_PACK && CW_BAR + 3456 <= CW_CNTA, "pack inside CTL, above the barrier words");
__device__ __forceinline__ const float* pack_of(const Frame& F, int l) { return (const float*)(F.ws + WS_PACK) + (size_t)l * PK_SIZE; }
__device__ __forceinline__ void pack_copy(Frame& F, const float* src, int per_layer, int off) {
    const int gt = F.vcu * (NWAVES * 64) + F.tid, NT = GRID * NWAVES * 64;
    for (int i = gt; i < NLAYER * per_layer; i += NT) { const int l = i / per_layer, j = i - l * per_layer; ((float*)(F.ws + WS_PACK))[(size_t)l * PK_SIZE + off + j] = src[i]; }
}
__device__ __forceinline__ void phase_pack(Frame& F, const float* const* in) {
    pack_copy(F, in[9], 1024, PK_CONVW); pack_copy(F, in[10], 256, PK_CONVB); pack_copy(F, in[11], 16384, PK_WA); pack_copy(F, in[12], 256, PK_BA); pack_copy(F, in[13], 16384, PK_WX); pack_copy(F, in[14], 256, PK_BX);
    pack_copy(F, in[15], 256, PK_LAM); pack_copy(F, in[16], 256, PK_LNG); pack_copy(F, in[17], 768, PK_SCW); pack_copy(F, in[18], 256, PK_SCG); pack_copy(F, in[19], 1664, PK_MU); pack_copy(F, in[20], 512, PK_W0);
    pack_copy(F, in[21], 16384, PK_W2); pack_copy(F, in[22], 512, PK_A0); pack_copy(F, in[23], 16384, PK_A2); pack_copy(F, in[24], 32768, PK_G2); pack_copy(F, in[25], 512, PK_KK); pack_copy(F, in[26], 512, PK_KA);
    pack_copy(F, in[27], 512, PK_RK); pack_copy(F, in[28], 512, PK_LNW); pack_copy(F, in[29], 512, PK_LNB);
}

__device__ __forceinline__ void transpose_item(const float* W, int K, int N, bf16* WT, int k0, int n0, int drow0, LAS float* scr, int lane) {
#pragma unroll 8
    for (int i = 0; i < 32; ++i) { const int kk = 2 * i + (lane >> 5); scr[kk * 33 + (lane & 31)] = W[(size_t)(k0 + kk) * N + n0 + (lane & 31)]; }
    LDS_WAIT(); asm volatile("" ::: "memory");
    const int c = lane & 7;
#pragma unroll
    for (int j = 0; j < 4; ++j) { const int n = (lane >> 3) + 8 * j; const LAS float* s = scr + (8 * c) * 33 + n;
        v4u o; o.x = pk2(s[0 * 33], s[1 * 33]); o.y = pk2(s[2 * 33], s[3 * 33]); o.z = pk2(s[4 * 33], s[5 * 33]); o.w = pk2(s[6 * 33], s[7 * 33]);
        *(GAS v4u*)(WT + (size_t)(drow0 + n) * K + k0 + 8 * c) = o; }
    LDS_WAIT(); asm volatile("" ::: "memory");
}
__device__ __forceinline__ int swiglu_row(int n0) { return n0 < FF ? ((n0 >> 7) * 256 + (n0 & 127)) : (((n0 - FF) >> 7) * 256 + 128 + ((n0 - FF) & 127)); }
constexpr int CI_IN = (D / 64) * (2 * FF / 32), CI_OUT = (FF / 64) * (D / 32), CI_MI = (D / 64) * (NIN / 32), CI_MO = (D / 64) * (D / 32);
constexpr int CI_SET0 = CI_IN + CI_OUT + CI_MI, CI_SET1 = CI_MO + CI_IN + CI_OUT;
struct ConvItem { const float* W; bf16* WT; int K, N, k0, n0, drow0; const float* g; };
__device__ __forceinline__ ConvItem conv_item(unsigned char* ws, const float* const* in, int l, int set, int r) {
    ConvItem ci;
    if (set == 0) {
        if (r < CI_IN) { const int nblk = 2 * FF / 32, kb = r / nblk, nb = r % nblk; ci = ConvItem{in[3] + (size_t)l * D * 2 * FF, (bf16*)(ws + WS_WB + WB_W1IN), D, 2 * FF, 64 * kb, 32 * nb, swiglu_row(32 * nb), in[2] + (size_t)(l * 6 + 0) * D}; return ci; }
        r -= CI_IN;
        if (r < CI_OUT) { const int nblk = D / 32, kb = r / nblk, nb = r % nblk; ci = ConvItem{in[4] + (size_t)l * FF * D, (bf16*)(ws + WS_WB + WB_W1OUT), FF, D, 64 * kb, 32 * nb, 32 * nb, nullptr}; return ci; }
        r -= CI_OUT;
        { const int nblk = NIN / 32, kb = r / nblk, nb = r % nblk; ci = ConvItem{in[7] + (size_t)l * D * NIN, (bf16*)(ws + WS_WB + WB_WIN), D, NIN, 64 * kb, 32 * nb, 32 * nb, in[2] + (size_t)(l * 6 + 2) * D}; return ci; }
    }
    if (r < CI_MO) { const int nblk = D / 32, kb = r / nblk, nb = r % nblk; ci = ConvItem{in[8] + (size_t)l * D * D, (bf16*)(ws + WS_WB + WB_WOUT), D, D, 64 * kb, 32 * nb, 32 * nb, nullptr}; return ci; }
    r -= CI_MO;
    if (r < CI_IN) { const int nblk = 2 * FF / 32, kb = r / nblk, nb = r % nblk; ci = ConvItem{in[5] + (size_t)l * D * 2 * FF, (bf16*)(ws + WS_WB + WB_W2IN), D, 2 * FF, 64 * kb, 32 * nb, swiglu_row(32 * nb), in[2] + (size_t)(l * 6 + 4) * D}; return ci; }
    r -= CI_IN;
    { const int nblk = D / 32, kb = r / nblk, nb = r % nblk; ci = ConvItem{in[6] + (size_t)l * FF * D, (bf16*)(ws + WS_WB + WB_W2OUT), FF, D, 64 * kb, 32 * nb, 32 * nb, nullptr}; return ci; }
}
__device__ __forceinline__ void conv_loads(const ConvItem& ci, int lane, float (&v)[32]) {
    const float* src = ci.W + (size_t)(ci.k0 + (lane >> 5)) * ci.N + ci.n0 + (lane & 31);
#pragma unroll
    for (int i = 0; i < 32; ++i) v[i] = src[(size_t)(2 * i) * ci.N];
}
__device__ __forceinline__ void conv_store(const ConvItem& ci, int lane, const float (&v)[32], LAS float* scr) {
#pragma unroll
    for (int i = 0; i < 32; ++i) scr[(2 * i + (lane >> 5)) * 33 + (lane & 31)] = v[i];
    LDS_WAIT(); asm volatile("" ::: "memory");
    const int c = lane & 7;
    f32x4 g0 = (f32x4){1.f, 1.f, 1.f, 1.f}, g1 = g0; if (ci.g) { g0 = *(const f32x4*)(ci.g + ci.k0 + 8 * c); g1 = *(const f32x4*)(ci.g + ci.k0 + 8 * c + 4); }
#pragma unroll
    for (int j = 0; j < 4; ++j) { const int n = (lane >> 3) + 8 * j; const LAS float* s = scr + (8 * c) * 33 + n;
        v4u o; o.x = pk2(s[0 * 33] * g0[0], s[1 * 33] * g0[1]); o.y = pk2(s[2 * 33] * g0[2], s[3 * 33] * g0[3]); o.z = pk2(s[4 * 33] * g1[0], s[5 * 33] * g1[1]); o.w = pk2(s[6 * 33] * g1[2], s[7 * 33] * g1[3]);
        *(GAS v4u*)(ci.WT + (size_t)(ci.drow0 + n) * ci.K + ci.k0 + 8 * c) = o; }
    LDS_WAIT(); asm volatile("" ::: "memory");
}
__device__ __forceinline__ void phase_convert(Frame& F, const float* const* in, int l, int set) {
    { int ln_ = F.tid & 63; asm volatile("" : "+v"(ln_)); F.lane = ln_; }
    LAS float* scr = (LAS float*)(F.lds + F.wave * 16384);
    const int gw = F.vcu * NWAVES + F.wave, NGW = GRID * NWAVES, nitems = set == 0 ? CI_SET0 : CI_SET1;
    for (int it = gw; it < nitems; it += NGW) { const ConvItem ci = conv_item(F.ws, in, l, set, it); float v[32]; conv_loads(ci, F.lane, v); conv_store(ci, F.lane, v, scr); }
    if (set == 0) { unsigned zz = 0u; asm volatile("" : "+v"(zz));
      for (int i = gw * 64 + F.lane; i < (NINP - NIN) * D / 8; i += NGW * 64) *(GAS v4u*)(((bf16*)(F.ws + WS_WB + WB_WIN)) + (size_t)NIN * D + (size_t)i * 8) = (v4u){zz, zz, zz, zz}; }
}

__device__ __forceinline__ const float* hrow_c(const Frame& F, const float* xrows, int r) { return r < MX ? xrows + (size_t)r * D : ((float*)(F.ws + WS_HMETA)) + (size_t)(r - MX) * D; }
__device__ __forceinline__ void store_xn_row(bf16* XN, int r, int lane, const f32x4 (&v)[4], float rstd, const float* g) {
    GAS unsigned long long* o8 = (GAS unsigned long long*)(XN + (size_t)r * D) + lane;
#pragma unroll
    for (int j = 0; j < 4; ++j) { const f32x4 gv = ((const GAS f32x4*)g)[lane + 64 * j];
        o8[64 * j] = (unsigned long long)pk2(v[j].x * rstd * gv.x, v[j].y * rstd * gv.y) | ((unsigned long long)pk2(v[j].z * rstd * gv.z, v[j].w * rstd * gv.w) << 32); }
}
__device__ __forceinline__ float sumsq4(const f32x4 (&v)[4]) { float s = 0.f;
#pragma unroll
    for (int j = 0; j < 4; ++j) s += (v[j].x * v[j].x + v[j].y * v[j].y) + (v[j].z * v[j].z + v[j].w * v[j].w);
    return s; }
typedef short mbf16x8 __attribute__((ext_vector_type(8)));
__device__ __forceinline__ void meta_tile(const bf16* A, const bf16* Bt, int K, int k0, int kl, int nb0, int nb1, int mode, void* O, int ldo, int ocol, int lane, const float* rs) {
    const int fr = lane & 15, fq = lane >> 4;
    const bf16* ap = A + (size_t)(MX + fr) * K + k0 + 8 * fq; const bf16* b0p = Bt + (size_t)(nb0 + fr) * K + k0 + 8 * fq; const bf16* b1p = Bt + (size_t)((mode == 0 ? nb1 : nb0) + fr) * K + k0 + 8 * fq;
    f32x4 acc0 = (f32x4){0.f, 0.f, 0.f, 0.f}, acc1 = acc0;
#pragma unroll 16
    for (int ks = 0; ks < kl; ks += 32) { const mbf16x8 a = *(const mbf16x8*)(ap + ks), w0 = *(const mbf16x8*)(b0p + ks);
        acc0 = __builtin_amdgcn_mfma_f32_16x16x32_bf16(w0, a, acc0, 0, 0, 0);
        if (mode == 0) { const mbf16x8 w1 = *(const mbf16x8*)(b1p + ks); acc1 = __builtin_amdgcn_mfma_f32_16x16x32_bf16(w1, a, acc1, 0, 0, 0); } }
    const int col = ocol + 4 * fq;
    if (mode == 2) { *(f32x4*)((float*)O + (size_t)fr * ldo + col) = acc0; return; }
    float v[4];
    const float sc = rs ? rs[MX + fr] : 1.0f;
#pragma unroll
    for (int i = 0; i < 4; ++i) { const float g = acc0[i] * sc; v[i] = mode == 0 ? g * __builtin_amdgcn_rcpf(1.0f + __expf(-g)) * (acc1[i] * sc) : g; }
    *(GAS unsigned long long*)((bf16*)O + (size_t)(MX + fr) * ldo + col) = (unsigned long long)pk2(v[0], v[1]) | ((unsigned long long)pk2(v[2], v[3]) << 32);
}
__device__ __forceinline__ void meta_gemm(Frame& F, const bf16* A, const bf16* Bt, int K, int N, int mode, void* O, int ldo, int nks, int gw  , const float* rs) {
    const int lane = F.tid & 63; if (gw < 0) return;
    if (mode == 0) { if (gw < FF / 16) { const int j0 = 16 * gw, nb0 = (j0 >> 7) * 256 + (j0 & 127); meta_tile(A, Bt, K, 0, K, nb0, nb0 + 128, 0, O, ldo, j0, lane, rs); } return; }
    const int ntile = N / 16;
    if (gw < ntile * nks) { const int tile = gw % ntile, sl = gw / ntile, kl = K / nks;
        meta_tile(A, Bt, K, sl * kl, kl, 16 * tile, 0, mode, mode == 2 ? (void*)((float*)O + (size_t)sl * NMETA * D) : O, ldo, 16 * tile, lane, rs); }
}

__device__ __forceinline__ void row_ld_f32(const float* p, int lane, f32x4 (&v)[4]) {
#pragma unroll
    for (int j = 0; j < 4; ++j) v[j] = ((const GAS f32x4*)p)[lane + 64 * j]; }
__device__ __forceinline__ void row_ld_bf16(const bf16* p, int lane, f32x4 (&v)[4]) {
#pragma unroll
    for (int j = 0; j < 4; ++j) { const unsigned long long u = ((const GAS unsigned long long*)p)[lane + 64 * j]; v[j][0] = bf2f((unsigned)u & 0xffffu); v[j][1] = bf2f((unsigned)u >> 16); v[j][2] = bf2f((unsigned)(u >> 32) & 0xffffu); v[j][3] = bf2f((unsigned)(u >> 48)); } }
__device__ __forceinline__ void row_st_bf16(bf16* p, int lane, const f32x4 (&v)[4]) {
#pragma unroll
    for (int j = 0; j < 4; ++j) ((GAS unsigned long long*)p)[lane + 64 * j] = (unsigned long long)pk2(v[j][0], v[j][1]) | ((unsigned long long)pk2(v[j][2], v[j][3]) << 32); }
__device__ __forceinline__ void phase_init(Frame& F) {
    { int ln_ = F.tid & 63; asm volatile("" : "+v"(ln_)); F.lane = ln_; }
    const int gw = F.vcu * NWAVES + F.wave, NGW = GRID * NWAVES;
    float* RS = (float*)(F.ws + WS_RS);
    for (int r = gw; r < MREAL; r += NGW) {
        const float* src = r < MX ? F.x + (size_t)r * D : F.meta + (size_t)(r - MX) * D;
        f32x4 v[4]; row_ld_f32(src, F.lane, v);
        const float rstd = rsqrtf(wave_sum(sumsq4(v)) * (1.0f / D) + RMS_EPS);
#pragma unroll
        for (int j = 0; j < 4; ++j) v[j] = v[j] * rstd;
        row_st_bf16(r < MX ? (bf16*)F.out + (size_t)r * D : (bf16*)(F.ws + WS_HMETA) + (size_t)(r - MX) * D, F.lane, v);
        if (F.lane == 0) RS[r] = rstd;
    }
}
struct PostIO { const bf16* raw16; const bf16* hin16; bf16* hout16; float* out32; int nks; };
__device__ __forceinline__ void post_row_load(const Frame& F, const PostIO& io, int r, f32x4 (&y)[4], f32x4 (&h)[4]) {
    if (r >= MX) { const float* sl = (const float*)(F.ws + WS_MSLAB) + (size_t)(r - MX) * D; row_ld_f32(sl, F.lane, y);
        for (int s = 1; s < io.nks; ++s) { f32x4 t[4]; row_ld_f32(sl + (size_t)s * NMETA * D, F.lane, t);
#pragma unroll
            for (int j = 0; j < 4; ++j) y[j] = y[j] + t[j]; }
        row_ld_bf16((const bf16*)(F.ws + WS_HMETA) + (size_t)(r - MX) * D, F.lane, h);
        const float inv = 1.0f / ((const float*)(F.ws + WS_RS))[r];
#pragma unroll
        for (int j = 0; j < 4; ++j) h[j] = h[j] * inv;
        return; }
    row_ld_bf16(io.raw16 + (size_t)r * D, F.lane, y);
    row_ld_bf16(io.hin16 + (size_t)r * D, F.lane, h);
    const float inv = 1.0f / ((const float*)(F.ws + WS_RS))[r];
#pragma unroll
    for (int j = 0; j < 4; ++j) h[j] = h[j] * inv;
}
__device__ __forceinline__ void post_row_store(const Frame& F, const PostIO& io, int r, const f32x4 (&h)[4]) {
    if (r >= MX) row_st_bf16((bf16*)(F.ws + WS_HMETA) + (size_t)(r - MX) * D, F.lane, h);
    else if (io.out32) {
#pragma unroll
        for (int j = 0; j < 4; ++j) ((GAS f32x4*)(io.out32 + (size_t)r * D))[F.lane + 64 * j] = h[j]; }
    else row_st_bf16(io.hout16 + (size_t)r * D, F.lane, h);
}
__device__ __forceinline__ void phase_post(Frame& F, const PostIO& io, float scale, const float* g_post, bool want_rs) {
    { int ln_ = F.tid & 63; asm volatile("" : "+v"(ln_)); F.lane = ln_; }
    const int gw = F.vcu * NWAVES + F.wave, NGW = GRID * NWAVES, nrows = io.out32 ? MX : MREAL;
    for (int r0 = gw; r0 < nrows; r0 += 2 * NGW) {
        const int r1 = r0 + NGW; const bool two = r1 < nrows; const int r1c = two ? r1 : r0;
        f32x4 y0[4], h0[4], y1[4], h1[4];
        post_row_load(F, io, r0, y0, h0); post_row_load(F, io, r1c, y1, h1);
        const float rs0 = scale * rsqrtf(wave_sum(sumsq4(y0)) * (1.0f / D) + RMS_EPS), rs1 = scale * rsqrtf(wave_sum(sumsq4(y1)) * (1.0f / D) + RMS_EPS);
#pragma unroll
        for (int j = 0; j < 4; ++j) { const f32x4 gv = ((const GAS f32x4*)g_post)[F.lane + 64 * j]; h0[j] = h0[j] + y0[j] * rs0 * gv; h1[j] = h1[j] + y1[j] * rs1 * gv; }
        if (want_rs) { const float q0 = rsqrtf(wave_sum(sumsq4(h0)) * (1.0f / D) + RMS_EPS), q1 = rsqrtf(wave_sum(sumsq4(h1)) * (1.0f / D) + RMS_EPS);
#pragma unroll
            for (int j = 0; j < 4; ++j) { h0[j] = h0[j] * q0; h1[j] = h1[j] * q1; }
            if (F.lane == 0) { ((float*)(F.ws + WS_RS))[r0] = q0; if (two) ((float*)(F.ws + WS_RS))[r1] = q1; } }
        post_row_store(F, io, r0, h0); if (two) post_row_store(F, io, r1, h1);
    }
}
typedef short bf16x8v __attribute__((ext_vector_type(8)));
typedef float f32x4v __attribute__((ext_vector_type(4)));
constexpr int FR_PER_WAVE = 24;
constexpr size_t WS_FRAG = WS_AGG + 512 * 1024, FRAG_LAYER_BYTES = (size_t)8 * FR_PER_WAVE * 64 * 16;
static_assert(WS_FRAG + NLAYER * FRAG_LAYER_BYTES <= WS_WB, "fragment store fits behind AGG");
__device__ __forceinline__ float frag_src(const float* const* in, int l, int w, int f, int lane, int j) {
    const int kq = 8 * (lane >> 4) + j, cl = lane & 15;
    if (f < 4)  return in[21][(size_t)l * 32 * 512 + (size_t)kq * 512 + 64 * w + 16 * f + cl];
    if (f < 8)  return in[23][(size_t)l * 32 * 512 + (size_t)kq * 512 + 64 * w + 16 * (f - 4) + cl];
    if (f < 16) { const int ct = (f - 8) >> 1, ks = (f - 8) & 1; return in[24][(size_t)l * 64 * 512 + (size_t)(32 * ks + kq) * 512 + 64 * w + 16 * ct + cl]; }
    { const int ct = (f - 16) >> 1, ks = (f - 16) & 1, gt = w >> 2, g = w & 3; return in[gt ? 13 : 11][(size_t)l * 16384 + (size_t)g * 4096 + (size_t)(32 * ks + kq) * 64 + 16 * ct + cl]; }
}
__device__ __forceinline__ void phase_frag(Frame& F, const float* const* in) {
    const int gt = F.vcu * (NWAVES * 64) + F.tid, NT = GRID * NWAVES * 64;
    bf16* FR = (bf16*)(F.ws + WS_FRAG);
    for (int i = gt; i < NLAYER * 8 * FR_PER_WAVE * 64 * 8; i += NT) { const int j = i & 7, lane = (i >> 3) & 63, f = (i >> 9) % FR_PER_WAVE, w = ((i >> 9) / FR_PER_WAVE) & 7, l = (i >> 9) / (FR_PER_WAVE * 8);
        FR[i] = (bf16)f2bf(frag_src(in, l, w, f, lane, j)); }
}
__device__ __forceinline__ bf16x8v pack8(const float (&v)[8]) { v4u u; u.x = pk2(v[0], v[1]); u.y = pk2(v[2], v[3]); u.z = pk2(v[4], v[5]); u.w = pk2(v[6], v[7]); return __builtin_bit_cast(bf16x8v, u); }
__device__ __forceinline__ void unpack8(const v4u& u, float (&v)[8]) { v[0] = bf2f(u.x & 0xffffu); v[1] = bf2f(u.x >> 16); v[2] = bf2f(u.y & 0xffffu); v[3] = bf2f(u.y >> 16); v[4] = bf2f(u.z & 0xffffu); v[5] = bf2f(u.z >> 16); v[6] = bf2f(u.w & 0xffffu); v[7] = bf2f(u.w >> 16); }
__device__ __forceinline__ void unpack4f(unsigned long long u, f32x4& v) { v[0] = bf2f((unsigned)u & 0xffffu); v[1] = bf2f(((unsigned)u >> 16)); v[2] = bf2f((unsigned)(u >> 32) & 0xffffu); v[3] = bf2f((unsigned)(u >> 48)); }
__device__ __forceinline__ void phase_mix_prep(Frame& F, const float* pk, int layer) {
    { int ln_ = F.tid & 63; asm volatile("" : "+v"(ln_)); F.lane = ln_; }
    LAS float* U = (LAS float*)F.lds;
    LAS float* GT = U + 16 * 256;
    LAS float* XL = GT + 32 * 256;
    LAS float* VL = XL + 19 * 256;
    const int tid = F.tid, lane = F.lane, w = F.wave, fr = lane & 15, fq = lane >> 4;
    const bf16* P = ((bf16*)(F.ws + WS_OV + OV_P)); bf16* Y = ((bf16*)(F.ws + WS_XN));
    bf16x8v Bf[FR_PER_WAVE];
    { const v4u* fp = (const v4u*)(F.ws + WS_FRAG + (size_t)layer * FRAG_LAYER_BYTES) + (size_t)w * FR_PER_WAVE * 64 + lane;
#pragma unroll
        for (int f = 0; f < FR_PER_WAVE; ++f) Bf[f] = __builtin_bit_cast(bf16x8v, fp[f * 64]); }
    const int gtp = w >> 2, gblk = w & 3;
    const int cg4 = 4 * (tid & 63);
    for (int tile = blockIdx.x; tile < 256; tile += GRID) {
        const int b = tile >> 5, c = tile & 31;
        const int s_begin = c == 0 ? 0 : NMETA + 64 * c, nsub = c == 0 ? 5 : 4;
        float hloc = 0.f, caloc = 1.f;
        for (int sub = 0; sub < nsub; ++sub) {
            const int s0 = s_begin + 16 * sub;
            unsigned zz = 0u; asm volatile("" : "+v"(zz));
            v4u cur[4], prv[4];
            { const int s = s0 + fr; const bf16* pc = P + (size_t)row_of(b, s) * NINP + PC_LO + 8 * fq; const bf16* pp = P + (size_t)row_of(b, s > 0 ? s - 1 : 0) * NINP + PC_LO + 8 * fq;
#pragma unroll
                for (int f = 0; f < 4; ++f) { cur[f] = *(const v4u*)(pc + 32 * f); prv[f] = *(const v4u*)(pp + 32 * f); if (s == 0) prv[f] = (v4u){zz, zz, zz, zz}; } }
            unsigned long long lx[3], lc[3], lxx[3], lb[2];
#pragma unroll
            for (int j = 0; j < 3; ++j) { const int idx = tid + 512 * j, r = idx >> 6, s = s0 - 3 + r; lx[j] = zz; lc[j] = zz; lxx[j] = zz;
                if (idx < 19 * 64 && s >= 0) { const bf16* pr = P + (size_t)row_of(b, s) * NINP + cg4; lx[j] = *(const unsigned long long*)(pr + PC_LRUX); lc[j] = *(const unsigned long long*)(pr + PC_SCC); lxx[j] = *(const unsigned long long*)(pr + PC_SCX); } }
#pragma unroll
            for (int j = 0; j < 2; ++j) { const int t = (tid >> 6) + 8 * j; lb[j] = *(const unsigned long long*)(P + (size_t)row_of(b, s0 + t) * NINP + PC_SCB + cg4); }
            { bf16x8v Af[4];
#pragma unroll
                for (int f = 0; f < 4; ++f) { float cv[8], pv[8], zv[8]; unpack8(cur[f], cv); unpack8(prv[f], pv);
                    const f32x4v m0 = *(const f32x4v*)(pk + PK_MU + 1536 + 32 * f + 8 * fq), m1 = *(const f32x4v*)(pk + PK_MU + 1536 + 32 * f + 8 * fq + 4);
#pragma unroll
                    for (int j = 0; j < 8; ++j) { const float mu = j < 4 ? m0[j & 3] : m1[j & 3]; const float z = cv[j] + (pv[j] - cv[j]) * mu; zv[j] = f == 0 ? tanhf_(z) : (f == 1 ? z : sigmoidf_(z)); }
                    Af[f] = pack8(zv); }
                const f32x4v zero = (f32x4v){0.f, 0.f, 0.f, 0.f};
                const size_t ro = (size_t)row_of(b, s0 + fr) * 512;
#pragma unroll
                for (int ct = 0; ct < 4; ++ct) { const int n = 64 * w + 16 * ct + 4 * fq;
                    const f32x4v aw = __builtin_amdgcn_mfma_f32_16x16x32_bf16(Bf[ct], Af[0], zero, 0, 0, 0);
                    const f32x4v aa = __builtin_amdgcn_mfma_f32_16x16x32_bf16(Bf[4 + ct], Af[1], zero, 0, 0, 0);
                    f32x4v ag = __builtin_amdgcn_mfma_f32_16x16x32_bf16(Bf[8 + 2 * ct], Af[2], zero, 0, 0, 0); ag = __builtin_amdgcn_mfma_f32_16x16x32_bf16(Bf[9 + 2 * ct], Af[3], ag, 0, 0, 0);
                    const f32x4v w04 = *(const f32x4v*)(pk + PK_W0 + n), a04 = *(const f32x4v*)(pk + PK_A0 + n);
                    float wd[4], av4[4];
#pragma unroll
                    for (int i = 0; i < 4; ++i) { const float wl = -softplusf_(-(w04[i] + aw[i])) - 0.5f, e = __expf(wl); wd[i] = e * (1.0f - e * (0.5f - e * (0.16666667f - e * (0.041666668f - e * 0.0083333338f)))); av4[i] = sigmoidf_(a04[i] + aa[i]); }
                    *(GAS unsigned long long*)((bf16*)(F.ws + WS_OV + OV_WDEC) + ro + n) = (unsigned long long)pk2(wd[0], wd[1]) | ((unsigned long long)pk2(wd[2], wd[3]) << 32);
                    *(GAS unsigned long long*)((bf16*)(F.ws + WS_OV + OV_ABUF) + ro + n) = (unsigned long long)pk2(av4[0], av4[1]) | ((unsigned long long)pk2(av4[2], av4[3]) << 32);
                    *(GAS unsigned long long*)((bf16*)(F.ws + WS_OV + OV_GBUF) + ro + n) = (unsigned long long)pk2(ag[0], ag[1]) | ((unsigned long long)pk2(ag[2], ag[3]) << 32); } }
            PSTAMP(0);
#pragma unroll
            for (int j = 0; j < 3; ++j) { const int idx = tid + 512 * j; if (idx < 19 * 64) { f32x4 a4, c4, x4; unpack4f(lx[j], a4); unpack4f(lc[j], c4); unpack4f(lxx[j], x4);
                *(LAS f32x4*)(XL + (idx >> 6) * 256 + cg4) = a4; *(LAS f32x4*)(VL + (idx >> 6) * 256 + cg4) = c4 * x4; } }
            __syncthreads();
            const float* pkc = pk + cg4;
            const f32x4 cb4 = *(const f32x4*)(pkc + PK_CONVB), cw0 = *(const f32x4*)(pkc + PK_CONVW), cw1 = *(const f32x4*)(pkc + PK_CONVW + 256), cw2 = *(const f32x4*)(pkc + PK_CONVW + 512), cw3 = *(const f32x4*)(pkc + PK_CONVW + 768);
            const f32x4 sw0 = *(const f32x4*)(pkc + PK_SCW), sw1 = *(const f32x4*)(pkc + PK_SCW + 256), sw2 = *(const f32x4*)(pkc + PK_SCW + 512), sg4 = *(const f32x4*)(pkc + PK_SCG);
#pragma unroll
            for (int j = 0; j < 2; ++j) { const int t = (tid >> 6) + 8 * j;
                const LAS float* xr = XL + t * 256 + cg4; const LAS float* vr = VL + (t + 1) * 256 + cg4;
                *(LAS f32x4*)(U + t * 256 + cg4) = cb4 + *(const LAS f32x4*)xr * cw0 + *(const LAS f32x4*)(xr + 256) * cw1 + *(const LAS f32x4*)(xr + 512) * cw2 + *(const LAS f32x4*)(xr + 768) * cw3;
                f32x4 b4; unpack4f(lb[j], b4);
                const f32x4 y4 = b4 * (*(const LAS f32x4*)vr * sw0 + *(const LAS f32x4*)(vr + 256) * sw1 + *(const LAS f32x4*)(vr + 512) * sw2);
                const float ss = red16((y4[0] * y4[0] + y4[1] * y4[1]) + (y4[2] * y4[2] + y4[3] * y4[3])); const float rs = rsqrtf(ss * (1.0f / 64.0f) + RMS_EPS);
                *(GAS unsigned long long*)(Y + (size_t)row_of(b, s0 + t) * D + 256 + cg4) = (unsigned long long)pk2(y4[0] * rs * sg4[0], y4[1] * rs * sg4[1]) | ((unsigned long long)pk2(y4[2] * rs * sg4[2], y4[3] * rs * sg4[3]) << 32); }
            PSTAMP(1);
            __syncthreads();
            { bf16x8v Al[2];
#pragma unroll
                for (int ks = 0; ks < 2; ++ks) { const LAS float* up = U + fr * 256 + 64 * gblk + 32 * ks + 8 * fq; const f32x4v u0 = *(const LAS f32x4v*)up, u1 = *(const LAS f32x4v*)(up + 4);
                    const float uv[8] = {u0.x, u0.y, u0.z, u0.w, u1.x, u1.y, u1.z, u1.w}; Al[ks] = pack8(uv); }
                const f32x4v zero = (f32x4v){0.f, 0.f, 0.f, 0.f};
#pragma unroll
                for (int ct = 0; ct < 4; ++ct) { const int j = 64 * gblk + 16 * ct + 4 * fq;
                    f32x4v ac = __builtin_amdgcn_mfma_f32_16x16x32_bf16(Bf[16 + 2 * ct], Al[0], zero, 0, 0, 0); ac = __builtin_amdgcn_mfma_f32_16x16x32_bf16(Bf[17 + 2 * ct], Al[1], ac, 0, 0, 0);
                    const f32x4v bias = *(const f32x4v*)(pk + (gtp ? PK_BX : PK_BA) + j);
                    f32x4v gv;
#pragma unroll
                    for (int i = 0; i < 4; ++i) gv[i] = sigmoidf_(ac[i] + bias[i]);
                    *(LAS f32x4v*)(GT + (gtp * 16 + fr) * 256 + j) = gv; } }
            PSTAMP(2);
            __syncthreads();
#pragma unroll
            for (int it = 0; it < 8; ++it) { const int idx = it * (NWAVES * 64) + tid, ch = idx & 255;
                const float r = GT[idx], ig = GT[16 * 256 + idx], u = U[idx];
                const float la = -8.0f * r * softplusf_(-pk[PK_LAM + ch]), a = __expf(la), x2 = 2.0f * la;
                const float om = x2 < -0.25f ? (1.0f - __expf(x2)) : -x2 * (1.0f + x2 * (0.5f + x2 * (0.16666667f + x2 * (0.041666668f + x2 * 0.0083333338f))));
                const float bt = __builtin_amdgcn_sqrtf(om) * (ig * u);
                GT[idx] = a; GT[16 * 256 + idx] = bt; }
            __syncthreads();
            PSTAMP(3);
            if (tid < 256) { const int j = tid;
#pragma unroll
                for (int t = 0; t < 16; ++t) { const float a = GT[t * 256 + j], bt = GT[(16 + t) * 256 + j];
                    hloc = a * hloc + bt; caloc *= a;
                    const size_t ro = (size_t)row_of(b, s0 + t) * 256 + j; ((float*)(F.ws + WS_OV + OV_HL))[ro] = hloc; ((float*)(F.ws + WS_OV + OV_CA))[ro] = caloc; } }
            PSTAMP(4);
        }
        if (tid < 256) { ((float*)(F.ws + WS_AGG))[((size_t)(b * 32 + c) * 256 + tid) * 2 + 0] = caloc; ((float*)(F.ws + WS_AGG))[((size_t)(b * 32 + c) * 256 + tid) * 2 + 1] = hloc; }
        __syncthreads();
    }
}

constexpr int SC_CH = 24, SC_NCH = TT / SC_CH, SC_LW = SC_CH / 4, SC_STEPF = 336, SC_BUFF = SC_CH * SC_STEPF;
constexpr int SC_VJ = (SC_LW * 16 + 63) / 64;
static_assert(SC_NCH * SC_CH == TT && 2 * SC_BUFF * 4 <= RING_BYTES, "scan geometry");
struct ScanRegs { unsigned rr[SC_LW + 1], kk[SC_LW + 1], aa[SC_LW], ww[SC_LW]; unsigned vc[SC_VJ], vp[SC_VJ]; };
__device__ __forceinline__ void scan_load(const Frame& F, ScanRegs& R, int b, int h, int q, int lw, int chunk, unsigned lane) {
    const int t0 = chunk * SC_CH + SC_LW * lw;
    const bf16* P = ((bf16*)(F.ws + WS_OV + OV_P)); const bf16* AB = ((bf16*)(F.ws + WS_OV + OV_ABUF)); const bf16* WD = ((bf16*)(F.ws + WS_OV + OV_WDEC));
#pragma unroll
    for (int m = 0; m < SC_LW + 1; ++m) { const int s = t0 - 1 + m;
        if (s >= 0) { const bf16* rowp = P + (size_t)row_of(b, s) * NINP + h * 64; R.rr[m] = rowp[PC_R + lane]; R.kk[m] = rowp[PC_K + lane]; } else { R.rr[m] = 0u; R.kk[m] = 0u; } }
#pragma unroll
    for (int i = 0; i < SC_LW; ++i) { const size_t ro = (size_t)row_of(b, t0 + i) * 512 + h * 64; R.aa[i] = (AB + ro)[lane]; R.ww[i] = (WD + ro)[lane]; }
#pragma unroll
    for (int j = 0; j < SC_VJ; ++j) { const int st0 = 4 * j; const unsigned st = st0 + (lane >> 4), rw = lane & 15; R.vc[j] = 0u; R.vp[j] = 0u;
        if (st < (unsigned)SC_LW) { const int s = t0 + (int)st; const unsigned col = PC_V + h * 64 + 16 * q + rw; R.vc[j] = P[(size_t)row_of(b, s) * NINP + col]; if (s > 0) R.vp[j] = P[(size_t)row_of(b, s - 1) * NINP + col]; } }
}
__device__ __forceinline__ void scan_emit(const ScanRegs& R, LAS float* buf, int lw, unsigned lane, float mu_r, float mu_k, float kk_n, float ka_n, float mu_v) {
    LAS float* lb = buf + SC_LW * lw * SC_STEPF + lane; asm volatile("" : "+v"(lb));
#pragma unroll
    for (int i = 0; i < SC_LW; ++i) { LAS float* sp = lb + i * SC_STEPF;
        const float rc = bf2f(R.rr[i + 1]), rp = bf2f(R.rr[i]), kc = bf2f(R.kk[i + 1]), kp = bf2f(R.kk[i]);
        const float zr = rc + (rp - rc) * mu_r, zk = kc + (kp - kc) * mu_k, a = bf2f(R.aa[i]);
        const float kv = zk * kk_n; const float ss = wave_sum_dpp(kv * kv); const float kn = kv * rsqrtf(fmaxf(ss, 1e-24f));
        sp[0] = zr; sp[64] = 1.0f - bf2f(R.ww[i]); sp[128] = zk * (1.0f + (a - 1.0f) * ka_n); sp[192] = -kn; sp[256] = kn * a; }
#pragma unroll
    for (int j = 0; j < SC_VJ; ++j) { const unsigned st = 4 * j + (lane >> 4), rw = lane & 15;
        if (st < (unsigned)SC_LW) { const float vc = bf2f(R.vc[j]), vp = bf2f(R.vp[j]); buf[(SC_LW * lw + st) * SC_STEPF + 320 + rw] = vc + (vp - vc) * mu_v; } }
}
typedef float f32x2 __attribute__((ext_vector_type(2)));
struct ScanOps { f32x4 r4, w4, k4, n4, b4; float v; };
__device__ __forceinline__ void scan_ops_load(ScanOps& o, const LAS float* lp, const LAS float* vp) {
    o.r4 = *(const LAS f32x4*)(lp); o.w4 = *(const LAS f32x4*)(lp + 64); o.k4 = *(const LAS f32x4*)(lp + 128);
    o.n4 = *(const LAS f32x4*)(lp + 192); o.b4 = *(const LAS f32x4*)(lp + 256); o.v = *vp; }
#define LO2(v) ((f32x2){(v).x, (v).y})
#define HI2(v) ((f32x2){(v).z, (v).w})
__device__ __forceinline__ float dot4p(const f32x2& a0, const f32x2& a1, const f32x4& b) { f32x2 t = a0 * LO2(b); t = a1 * HI2(b) + t; return t.x + t.y; }
__device__ __forceinline__ float scan_step(f32x2& S0, f32x2& S1, const ScanOps& o, float& q) {
    float p = dot4p(S0, S1, o.n4), y = q;
    p += dppf<0xB1>(p); y += dppf<0xB1>(y); p += dppf<0x4E>(p); y += dppf<0x4E>(y); p += dppf<0x141>(p); y += dppf<0x141>(y); p += dppf<0x128>(p); y += dppf<0x128>(y);
    const f32x2 vv = (f32x2){o.v, o.v}, sa = (f32x2){p, p};
    S0 = LO2(o.b4) * sa + (S0 * LO2(o.w4) + LO2(o.k4) * vv); S1 = HI2(o.b4) * sa + (S1 * HI2(o.w4) + HI2(o.k4) * vv);
    q = dot4p(S0, S1, o.r4);
    return y; }
constexpr int SC_YB = SC_CH * 16;
static_assert((2 * SC_BUFF + 2 * SC_YB + 256 + 256 + 4 * 64 * 33) * 4 <= RING_BYTES, "scan LDS");
__device__ __forceinline__ void scan_flush(const Frame& F, const LAS float* yb, int b, int h, int q, int chunk, int ltid) {
    bf16* Y = ((bf16*)(F.ws + WS_XN)); asm volatile("" : "+v"(ltid));
#pragma unroll
    for (int j = 0; j < (SC_YB + 255) / 256; ++j) { const int idx = ltid + 256 * j; if (idx < SC_YB) { const int st = idx >> 4, rw = idx & 15;
        Y[(size_t)row_of(b, chunk * SC_CH + st) * D + 512 + h * 64 + 16 * q + rw] = (bf16)f2bf(yb[idx]); } }
}
__device__ __forceinline__ void phase_scan(Frame& F, const float* pk, const float* const* in, int l) {
    { int ln_ = F.tid & 63; asm volatile("" : "+v"(ln_)); F.lane = ln_; }
    LAS float* buf0 = (LAS float*)F.lds; LAS float* buf1 = buf0 + SC_BUFF; LAS float* yb0 = buf1 + SC_BUFF; LAS float* yb1 = yb0 + SC_YB; LAS float* dummy = yb1 + SC_YB;
    const unsigned lane = F.lane; const int wave = F.wave;
    const int cv_split = CI_SET1, cv_n = CI_SET1 + (l + 1 < NLAYER ? CI_SET0 : 0);
    for (int item = blockIdx.x; item < 256; item += GRID) {
        const int b = item >> 5, h = (item >> 2) & 7, q = item & 3;
        if (wave >= 4) {
            const int lw = wave - 4, n = h * 64 + lane, ltid = lw * 64 + lane;
            const float mu_r = pk[PK_MU + n], mu_k = pk[PK_MU + 512 + n], kk_n = pk[PK_KK + n], ka_n = pk[PK_KA + n];
            const float mu_v = pk[PK_MU + 1024 + h * 64 + 16 * q + (lane & 15)];
            ScanRegs A, B;
            scan_load(F, A, b, h, q, lw, 0, lane); scan_load(F, B, b, h, q, lw, 1, lane);
            scan_emit(A, buf0, lw, lane, mu_r, mu_k, kk_n, ka_n, mu_v);
            __syncthreads();
            LAS float* cscr = dummy + 256 + lw * (64 * 33);
            int cv_it = (item * 4 + lw); bool cv_pending = false; ConvItem cvi; float cvv[32];
            cvi = conv_item(F.ws, in, l, 1, 0);
            for (int c = 0; c < SC_NCH; ++c) {
                if ((c & 1) == 0) { if (c + 2 < SC_NCH) scan_load(F, A, b, h, q, lw, c + 2, lane); if (c + 1 < SC_NCH) scan_emit(B, buf1, lw, lane, mu_r, mu_k, kk_n, ka_n, mu_v); }
                else              { if (c + 2 < SC_NCH) scan_load(F, B, b, h, q, lw, c + 2, lane); if (c + 1 < SC_NCH) scan_emit(A, buf0, lw, lane, mu_r, mu_k, kk_n, ka_n, mu_v); }
                if (c > 0) scan_flush(F, ((c - 1) & 1) ? yb1 : yb0, b, h, q, c - 1, ltid);
                if ((c & 7) == 1 && cv_pending) { conv_store(cvi, (int)lane, cvv, cscr); cv_pending = false; cv_it += 4 * 256; }
                if ((c & 7) == 0 && cv_it < cv_n) { cvi = cv_it < cv_split ? conv_item(F.ws, in, l, 1, cv_it) : conv_item(F.ws, in, l + 1, 0, cv_it - cv_split); conv_loads(cvi, (int)lane, cvv); cv_pending = true; }
                __syncthreads();
            }
            if (cv_pending) { conv_store(cvi, (int)lane, cvv, cscr); cv_it += 4 * 256; }
            for (; cv_it < cv_n; cv_it += 4 * 256) { cvi = cv_it < cv_split ? conv_item(F.ws, in, l, 1, cv_it) : conv_item(F.ws, in, l + 1, 0, cv_it - cv_split); conv_loads(cvi, (int)lane, cvv); conv_store(cvi, (int)lane, cvv, cscr); }
            scan_flush(F, ((SC_NCH - 1) & 1) ? yb1 : yb0, b, h, q, SC_NCH - 1, ltid);
        } else {
            const int kq = lane & 15, rowl = 4 * wave + (lane >> 4);
            f32x2 S0 = (f32x2){0.f, 0.f}, S1 = S0;
            __builtin_amdgcn_s_setprio(3);
            __syncthreads();
            for (int c = 0; c < SC_NCH; ++c) {
                const LAS float* bp = (c & 1) ? buf1 : buf0;
                LAS float* yw = kq == 0 ? (((c & 1) ? yb1 : yb0) + rowl) : (dummy + lane);
                const int ystep = kq == 0 ? 16 : 0;
                ScanOps oa, ob; float qp = 0.f;
                const LAS float* lp = bp + 4 * kq; const LAS float* vp = bp + 320 + rowl;
                asm volatile("" : "+v"(lp), "+v"(vp), "+v"(yw));
                scan_ops_load(oa, lp, vp);
                scan_ops_load(ob, lp + SC_STEPF, vp + SC_STEPF);
                (void)scan_step(S0, S1, oa, qp);
#pragma unroll 2
                for (int i = 1; i < SC_CH - 1; i += 2) {
                    scan_ops_load(oa, lp + (i + 1) * SC_STEPF, vp + (i + 1) * SC_STEPF);
                    const float y0 = scan_step(S0, S1, ob, qp); yw[(i - 1) * ystep] = y0;
                    scan_ops_load(ob, lp + (i + 2) * SC_STEPF, vp + (i + 2) * SC_STEPF);
                    const float y1 = scan_step(S0, S1, oa, qp); yw[i * ystep] = y1;
                }
                { const float y2 = scan_step(S0, S1, ob, qp); yw[(SC_CH - 2) * ystep] = y2; }
                yw[(SC_CH - 1) * ystep] = red16(qp);
                __syncthreads();
            }
            __builtin_amdgcn_s_setprio(0);
        }
        __syncthreads();
    }
}

__device__ __forceinline__ void unpack4(unsigned long long u, float (&v)[4]) { v[0] = bf2f((unsigned)u & 0xffffu); v[1] = bf2f(((unsigned)u >> 16)); v[2] = bf2f((unsigned)(u >> 32) & 0xffffu); v[3] = bf2f((unsigned)(u >> 48)); }
__device__ __forceinline__ void phase_mix_final(Frame& F, const float* pk) {
    { int ln_ = F.tid & 63; asm volatile("" : "+v"(ln_)); F.lane = ln_; }
    LAS float* carry = (LAS float*)F.lds;
    const int tid = F.tid, lane = F.lane, w = F.wave, rg = lane >> 4, kq = lane & 15;
    const bf16* P = ((bf16*)(F.ws + WS_OV + OV_P)); bf16* Y = ((bf16*)(F.ws + WS_XN));
    const bf16* AB = ((bf16*)(F.ws + WS_OV + OV_ABUF)); const bf16* GB = ((bf16*)(F.ws + WS_OV + OV_GBUF)); const float* HLp = ((float*)(F.ws + WS_OV + OV_HL)); const float* CAp = ((float*)(F.ws + WS_OV + OV_CA));
    const int n0 = w * 64 + 4 * kq;
    const f32x4 mu_r = *(const f32x4*)(pk + PK_MU + n0), mu_k = *(const f32x4*)(pk + PK_MU + 512 + n0), mu_v = *(const f32x4*)(pk + PK_MU + 1024 + n0);
    const f32x4 ka4 = *(const f32x4*)(pk + PK_KA + n0), rk4 = *(const f32x4*)(pk + PK_RK + n0), lw4 = *(const f32x4*)(pk + PK_LNW + n0), lb4 = *(const f32x4*)(pk + PK_LNB + n0);
    const f32x4 ng4 = w < 4 ? *(const f32x4*)(pk + PK_LNG + n0) : (f32x4){0.f, 0.f, 0.f, 0.f};
    for (int tile = blockIdx.x; tile < 256; tile += GRID) {
        const int b = tile >> 5, c = tile & 31;
        const int s_begin = c == 0 ? 0 : NMETA + 64 * c, ntok = c == 0 ? 80 : 64;
        if (tid < 256) {
            const float* ag = ((float*)(F.ws + WS_AGG)) + ((size_t)(b * 32) * 256 + tid) * 2; float ca[32], hh[32];
#pragma unroll
            for (int c2 = 0; c2 < 31; ++c2) { ca[c2] = 0.f; hh[c2] = 0.f; if (c2 < c) { const f32x2v_ t2 = *(const f32x2v_*)(ag + (size_t)c2 * 512); ca[c2] = t2.x; hh[c2] = t2.y; } }
            float hc = 0.f;
#pragma unroll
            for (int c2 = 0; c2 < 31; ++c2) if (c2 < c) hc = ca[c2] * hc + hh[c2];
            carry[tid] = hc; }
        __syncthreads();
        f32x4 cr4 = (f32x4){0.f, 0.f, 0.f, 0.f}; if (w < 4) cr4 = *(const LAS f32x4*)(carry + n0);
        for (int tg = (c == 0 && b != 0) ? NMETA : 0; tg < ntok; tg += 16) {
            unsigned long long rc[4], kc[4], vc[4], rp[4], kp[4], vp[4], av[4], yv[4], gv[4], lg[4]; f32x4 hl[4], cav[4];
#pragma unroll
            for (int u = 0; u < 4; ++u) { const int s = s_begin + tg + 4 * u + rg; const size_t ro = (size_t)row_of(b, s); const bf16* pr = P + ro * NINP + n0;
                rc[u] = *(const unsigned long long*)(pr + PC_R); kc[u] = *(const unsigned long long*)(pr + PC_K); vc[u] = *(const unsigned long long*)(pr + PC_V); rp[u] = 0ull; kp[u] = 0ull; vp[u] = 0ull;
                if (s > 0) { const bf16* pp = P + (size_t)row_of(b, s - 1) * NINP + n0; rp[u] = *(const unsigned long long*)(pp + PC_R); kp[u] = *(const unsigned long long*)(pp + PC_K); vp[u] = *(const unsigned long long*)(pp + PC_V); }
                av[u] = *(const unsigned long long*)(AB + ro * 512 + n0); yv[u] = *(const unsigned long long*)(Y + ro * D + 512 + n0); gv[u] = *(const unsigned long long*)(GB + ro * 512 + n0);
                lg[u] = 0ull; hl[u] = (f32x4){0.f, 0.f, 0.f, 0.f}; cav[u] = hl[u];
                if (w < 4) { lg[u] = *(const unsigned long long*)(pr + PC_LRUG); hl[u] = *(const f32x4*)(HLp + ro * 256 + n0); cav[u] = *(const f32x4*)(CAp + ro * 256 + n0); } }
#pragma unroll
            for (int u = 0; u < 4; ++u) { const int s = s_begin + tg + 4 * u + rg; const size_t ro = (size_t)row_of(b, s);
                float r_c[4], k_c[4], v_c[4], r_p[4], k_p[4], v_p[4], a4[4], y4[4], g4[4];
                unpack4(rc[u], r_c); unpack4(kc[u], k_c); unpack4(vc[u], v_c); unpack4(rp[u], r_p); unpack4(kp[u], k_p); unpack4(vp[u], v_p); unpack4(av[u], a4); unpack4(yv[u], y4); unpack4(gv[u], g4);
                float zv[4], cbp = 0.f, ysum = 0.f;
#pragma unroll
                for (int j = 0; j < 4; ++j) { const float zr = r_c[j] + (r_p[j] - r_c[j]) * mu_r[j], zk = k_c[j] + (k_p[j] - k_c[j]) * mu_k[j]; zv[j] = v_c[j] + (v_p[j] - v_c[j]) * mu_v[j];
                    cbp += zr * (zk * (1.0f + (a4[j] - 1.0f) * ka4[j])) * rk4[j]; ysum += y4[j]; }
                const float cb = red16(cbp), mean = red16(ysum) * (1.0f / 64.0f);
                float d4[4], vs = 0.f;
#pragma unroll
                for (int j = 0; j < 4; ++j) { d4[j] = y4[j] - mean; vs += d4[j] * d4[j]; }
                const float rstd = rsqrtf(red16(vs) * (1.0f / 64.0f) + LNX_EPS);
                float o4[4];
#pragma unroll
                for (int j = 0; j < 4; ++j) o4[j] = (d4[j] * rstd * lw4[j] + lb4[j] + cb * zv[j]) * g4[j];
                *(GAS unsigned long long*)(Y + ro * D + 512 + n0) = (unsigned long long)pk2(o4[0], o4[1]) | ((unsigned long long)pk2(o4[2], o4[3]) << 32);
                if (w < 4) { float l4[4], yy[4], ss = 0.f; unpack4(lg[u], l4);
#pragma unroll
                    for (int j = 0; j < 4; ++j) { yy[j] = gelu_tanh(l4[j]) * (hl[u][j] + cav[u][j] * cr4[j]); ss += yy[j] * yy[j]; }
                    const float rs = rsqrtf(red16(ss) * (1.0f / 64.0f) + RMS_EPS);
                    *(GAS unsigned long long*)(Y + ro * D + n0) = (unsigned long long)pk2(yy[0] * rs * ng4[0], yy[1] * rs * ng4[1]) | ((unsigned long long)pk2(yy[2] * rs * ng4[2], yy[3] * rs * ng4[3]) << 32); } }
        }
        __syncthreads();
    }
}
#ifndef MK_PER_PHASE
#define MK_PER_PHASE 0
#endif
constexpr int REP_GEMM = 1, REP_PREP = 1, REP_SCAN = 1, REP_CONV = 1;
constexpr int PH_PER_LAYER = 12, N_PHASES = 1 + NLAYER * PH_PER_LAYER;
struct Args { const float* in[30]; float* out; unsigned char* ws; int ph_lo, ph_hi; };
static_assert(sizeof(Args) == 30 * 8 + 8 + 8 + 4 + 4, "Args has no padding");

__global__ void __launch_bounds__(NWAVES * 64, 2) hybrid_fwd(Args args) {
    extern __shared__ __attribute__((aligned(16))) unsigned char lds[];
    Frame F;
    F.lds = (LAS unsigned char*)lds;
    F.tid = threadIdx.x; F.lane = F.tid & 63; F.wave = 0;
    { const int bx = blockIdx.x; F.vcu = (bx % 8) * (GRID / 8) + bx / 8; }
    unsigned char* ws = args.ws;
    F.ws = ws; F.x = args.in[0]; F.meta = args.in[1]; F.out = args.out;
    volatile LAS unsigned* MISC = (volatile LAS unsigned*)(F.lds + MISC_OFF);
    for (int u = F.tid; u < (LDS_BYTES - LDSCTL_OFF) / 4; u += NWAVES * 64) ((LAS unsigned*)(F.lds + LDSCTL_OFF))[u] = 0u;
    __syncthreads();
    { const unsigned simd = ((unsigned)__builtin_amdgcn_s_getreg((1 << 11) | (4 << 6) | 4)) & 3u;
      LAS unsigned* tkw = (LAS unsigned*)(F.lds + MISC_OFF) + 12;
      unsigned tk = 0u, tg = 0u; if (vlane() == 0) { tk = __hip_atomic_fetch_add(tkw + simd, 1u, __ATOMIC_RELAXED, __HIP_MEMORY_SCOPE_WORKGROUP); tg = __hip_atomic_fetch_add(tkw + 4, 1u, __ATOMIC_RELAXED, __HIP_MEMORY_SCOPE_WORKGROUP); }
      tk = (unsigned)__builtin_amdgcn_readfirstlane(tk); tg = (unsigned)__builtin_amdgcn_readfirstlane(tg);
      __syncthreads();
      const bool two_each = tkw[0] == 2u && tkw[1] == 2u && tkw[2] == 2u && tkw[3] == 2u;
      F.wave = two_each ? (int)(simd + 4u * tk) : (int)tg; }
    F.lane = vlane(); F.tid = F.wave * 64 + F.lane;
    XcdBarrier bar; bar.bar = (unsigned*)(ws + WS_CTL) + CW_BAR; bar.x = 0; bar.st = nullptr;
    if (!MK_PER_PHASE) bar = xcd_barrier_post((unsigned*)(ws + WS_CTL) + CW_BAR, MISC + 8, F.tid == 0);
    const int lo = args.ph_lo, hi = args.ph_hi;
    unsigned long long pr_prev = 0ull; F.pr_acc = 0ull; F.pr_sub = 0ull; F.ph = 0; if (PROBE_MASK) pr_prev = __builtin_amdgcn_s_memrealtime();
#pragma unroll 1
    for (int ph = lo; ph < hi; ++ph) {
        if (PROBE_MASK) F.ph = ph;
        { GAS unsigned char* wsg = (GAS unsigned char*)args.ws; asm volatile("" : "+s"(wsg)); F.ws = (unsigned char*)wsg; }
        { int t_ = F.wave * 64 + vlane(); asm volatile("" : "+v"(t_)); F.tid = t_; }
        if (ph == 0) { phase_init(F); phase_pack(F, args.in); phase_frag(F, args.in); for (int rep_ = 0; rep_ < REP_CONV; ++rep_) phase_convert(F, args.in, 0, 0); }
        else {
            const int l = (ph - 1) / PH_PER_LAYER, k = (ph - 1) - l * PH_PER_LAYER;
            if (k == 0 || k == 1 || k == 3 || k == 7 || k == 9 || k == 10) {
                unsigned char* w = F.ws;
                const bool up = (k == 0 || k == 9), down = (k == 1 || k == 10);
                const bool lastl = l + 1 == NLAYER;
                const bf16* hcur = (lastl && k == 9) ? (const bf16*)(w + WS_OV + OV_HTMP) : (const bf16*)F.out;
                const bf16* A = down ? (const bf16*)(w + WS_OV + OV_HID) : (k == 7 ? (const bf16*)(w + WS_XN) : hcur);
                const bf16* Am = (down || k == 7) ? A : (const bf16*)(w + WS_HMETA) - (size_t)MX * D;
                const bf16* B = (const bf16*)(w + WS_WB + (k == 0 ? WB_W1IN : k == 1 ? WB_W1OUT : k == 3 ? WB_WIN : k == 7 ? WB_WOUT : k == 9 ? WB_W2IN : WB_W2OUT));
                const int N = up ? 2 * FF : (k == 3 ? NINP : D), K = down ? FF : D;
                const float* rs = nullptr;
                pg8::EpiAny E; E.mode = up ? 0 : 1; E.O = w + WS_OV + (up ? OV_HID : k == 3 ? OV_P : k == 7 ? OV_RAWM : OV_RAWF); E.ldo = up ? FF : (k == 3 ? NINP : D); E.rs = rs;
                const int gwv = F.vcu * NWAVES + F.wave;
                if (k == 3) meta_gemm(F, Am, B, K, N, 1, w + WS_OV + OV_P, NINP, 1, gwv, rs);
                else if (!up) meta_gemm(F, Am, B, K, N, 2, w + WS_MSLAB, D, down ? 8 : 4, gwv, nullptr);
                pg8::Gemm g{A, B, MX, N, K, K}; pg8::StaticOrder S; S.init(MX, N, GRID, (int)blockIdx.x);
                for (int rep_ = 0; rep_ < REP_GEMM; ++rep_) pg8::gemm_phase<pg8::EpiAny, pg8::StaticOrder, true, true>(F.lds, g, S, E, F.tid);
                if (up) meta_gemm(F, Am, B, K, N, 0, w + WS_OV + OV_HID, FF, 1, (int)blockIdx.x >= 128 ? ((int)blockIdx.x - 128) * NWAVES + F.wave : -1, rs);
            } else if (k == 2 || k == 8 || k == 11) {
                const float* ng = args.in[2] + (size_t)l * 6 * D;
                const bool last = l + 1 == NLAYER;
                const float* g_post = ng + (k == 2 ? 1 : k == 8 ? 3 : 5) * D;
                bf16* h16 = (bf16*)F.out; bf16* htmp = (bf16*)(F.ws + WS_OV + OV_HTMP);
                PostIO io; io.raw16 = (const bf16*)(F.ws + WS_OV + (k == 8 ? OV_RAWM : OV_RAWF));
                io.hin16 = (last && k == 11) ? htmp : h16; io.hout16 = (last && k == 8) ? htmp : h16; io.out32 = (last && k == 11) ? F.out : nullptr; io.nks = k == 8 ? 4 : 8;
                phase_post(F, io, k == 8 ? 1.0f : 0.5f, g_post, !(last && k == 11));
            } else if (k == 4) { for (int rep_ = 0; rep_ < REP_PREP; ++rep_) phase_mix_prep(F, pack_of(F, l), l); }
            else if (k == 5) { for (int rep_ = 0; rep_ < REP_SCAN; ++rep_) phase_scan(F, pack_of(F, l), args.in, l); }
            else { phase_mix_final(F, pack_of(F, l)); }
        }
        if (ph + 1 < hi) xcd_barrier(bar, F.tid == 0);
        if (PROBE_MASK) { const unsigned long long t = __builtin_amdgcn_s_memrealtime(); if (PROBE_SUB < 0 && ((PROBE_MASK >> ph) & 1u)) F.pr_acc += t - pr_prev; pr_prev = t; F.pr_sub = t; }
    }
    if (PROBE_MASK && blockIdx.x == 0 && F.tid == 0) { const unsigned long long t0 = __builtin_amdgcn_s_memrealtime(); while (__builtin_amdgcn_s_memrealtime() - t0 < PROBE_AMP * F.pr_acc) __builtin_amdgcn_s_sleep(8); }
}

extern "C" void kernel_launch(void* const* d_in, const int* in_sizes, int n_in, void* d_out, int out_size, void* d_ws, size_t ws_size, hipStream_t stream) {
    static int grid = 0;
    if (grid == 0) {
        if (n_in != 30 || in_sizes[0] != MX * D || out_size != MX * D || ws_size < WS_END) { fprintf(stderr, "kernel_launch: unexpected shapes: n_in %d in0 %d out %d ws %zu\n", n_in, n_in > 0 ? in_sizes[0] : -1, out_size, ws_size); grid = -1; return; }
        int dev = 0, cus = 0, per_cu = 0;
        if (hipGetDevice(&dev) != hipSuccess || hipDeviceGetAttribute(&cus, hipDeviceAttributeMultiprocessorCount, dev) != hipSuccess) { grid = -1; return; }
        if (hipFuncSetAttribute((const void*)hybrid_fwd, hipFuncAttributeMaxDynamicSharedMemorySize, LDS_BYTES) != hipSuccess) { fprintf(stderr, "kernel_launch: hipFuncSetAttribute failed\n"); grid = -1; return; }
        if (hipOccupancyMaxActiveBlocksPerMultiprocessor(&per_cu, (const void*)hybrid_fwd, NWAVES * 64, LDS_BYTES) != hipSuccess || per_cu < 1) { fprintf(stderr, "kernel_launch: occupancy query says %d blocks per CU\n", per_cu); grid = -1; (void)hipGetLastError(); return; }
        (void)hipGetLastError();
        if (cus < GRID) { fprintf(stderr, "kernel_launch: this kernel needs %d CUs (one resident workgroup each), the device has %d\n", GRID, cus); grid = -1; return; }
        grid = GRID;
    }
    if (grid < 0) return;
    if (hipMemsetAsync((char*)d_ws + WS_CTL, 0, CTL_ZERO_BYTES, stream) != hipSuccess) return;
    Args a{};
    for (int i = 0; i < 30; ++i) a.in[i] = (const float*)d_in[i];
    a.out = (float*)d_out; a.ws = (unsigned char*)d_ws;
#if MK_PER_PHASE
    for (int p = 0; p < N_PHASES; ++p) { a.ph_lo = p; a.ph_hi = p + 1; hipLaunchKernelGGL(hybrid_fwd, dim3(grid), dim3(NWAVES * 64), LDS_BYTES, stream, a); }
#else
    a.ph_lo = 0; a.ph_hi = N_PHASES;
    hipLaunchKernelGGL(hybrid_fwd, dim3(grid), dim3(NWAVES * 64), LDS_BYTES, stream, a);
#endif
}
```

```cpp
#include <hip/hip_runtime.h>
#include <cstdio>
#include <cstdint>
namespace pg8 {
#define PG8_LAS __attribute__((address_space(3)))
typedef unsigned short bf16_t;
typedef short bf16x8 __attribute__((ext_vector_type(8)));
typedef float f32x4 __attribute__((ext_vector_type(4)));
typedef unsigned u32x4 __attribute__((ext_vector_type(4)));
constexpr int BM = 256, BK = 64, HALF = 128, HTB = HALF * BK * 2  , STAGE_BYTES = 8 * HTB, NXCD = 8, WGM = 8;

__host__ __device__ __forceinline__ int lds_byte(int r, int c) { const int st = (r >> 4) * 2 + (c >> 5), rr = r & 15, cc = c & 31, ob = rr * 64 + cc * 2; return st * 1024 + (ob ^ (((ob >> 9) & 1) << 5)); }
__host__ __device__ __forceinline__ void stage_rc(int b, int& R, int& C) { const int st = b / 1024, sb = b % 1024, swz = sb ^ (((sb >> 9) & 1) << 5); R = (st >> 1) * 16 + swz / 64; C = (st & 1) * 32 + (swz % 64) / 2; }
__host__ __device__ __forceinline__ int perm32(int rho) { const int n = rho >> 4, i = rho & 15; return 8 * (i >> 2) + 4 * n + (i & 3); }

struct Unit { int pm, pn; };
struct Gemm { const bf16_t* A; const bf16_t* Bt; int M, N, K, ld; };

struct StaticOrder {
    int nM, nN, nwg, G, c, one_pn;
    __host__ __device__ void init(int M, int N, int G_, int c_) { nM = M / BM; nN = N / BM; nwg = nM * nN; G = G_; c = c_; one_pn = -1; }
    __host__ __device__ bool next(int i, Unit& u) const {
        if (one_pn != -1) { if (i != 0 || one_pn < 0) return false; u.pm = 0; u.pn = one_pn; return true; }
        const long L = (long)i * G + c; if (L >= nwg) return false;
        int wgid = (int)L; { const int q = nwg / NXCD, r = nwg % NXCD, xcd = wgid % NXCD, off = wgid / NXCD; wgid = (xcd < r ? xcd * (q + 1) : r * (q + 1) + (xcd - r) * q) + off; }
        const int nig = WGM * nN, gid = wgid / nig, fm = gid * WGM, gsz = (nM - fm) < WGM ? (nM - fm) : WGM;
        u.pm = fm + ((wgid % nig) % gsz); u.pn = (wgid % nig) / gsz; return true;
    }
    __device__ __forceinline__ void a_ready(const Unit&) const {}
    __device__ __forceinline__ void done(const Unit&) const {}
};
__device__ __forceinline__ unsigned cvt_pk_bf16(float lo, float hi) { unsigned r; asm volatile("v_cvt_pk_bf16_f32 %0, %1, %2" : "=v"(r) : "v"(lo), "v"(hi)); return r; }
typedef float f32x2 __attribute__((ext_vector_type(2)));
struct EpiSwiGLU {
    static constexpr bool PERM = true, AFTER_DRAIN = false;
    bf16_t* O; int ldo; const PG8_LAS float* rst;
    __device__ __forceinline__ void operator()(const f32x4 (&acc)[2][2][4][2], const Unit& u, int wr, int wc, int fr, int fq) const {
        const int row0 = u.pm * BM + wr * 64 + fr, col0 = u.pn * HALF + wc * 32 + 8 * fq;
#pragma unroll
        for (int ai = 0; ai < 2; ++ai)
#pragma unroll
            for (int m = 0; m < 4; ++m) { bf16_t* rowp = O + (size_t)(row0 + ai * HALF + m * 16) * ldo + col0; const float sc = rst ? rst[64 * ai + 16 * m + fr] : 1.0f;
                float hv[8];
#pragma unroll
                for (int n = 0; n < 2; ++n)
#pragma unroll
                    for (int j = 0; j < 4; ++j) { const float g = acc[ai][0][m][n][j] * sc, up = acc[ai][1][m][n][j] * sc; hv[n * 4 + j] = g * __builtin_amdgcn_rcpf(1.0f + __expf(-g)) * up; }
                u32x4 w; w.x = cvt_pk_bf16(hv[0], hv[1]); w.y = cvt_pk_bf16(hv[2], hv[3]); w.z = cvt_pk_bf16(hv[4], hv[5]); w.w = cvt_pk_bf16(hv[6], hv[7]);
                *(u32x4*)rowp = w; }
    }
};
struct EpiStoreBf16 {
    static constexpr bool PERM = true, AFTER_DRAIN = false;
    bf16_t* O; int ldc; const PG8_LAS float* rst;
    __device__ __forceinline__ void operator()(const f32x4 (&acc)[2][2][4][2], const Unit& u, int wr, int wc, int fr, int fq) const {
        const int row0 = u.pm * BM + wr * 64 + fr, col0 = u.pn * BM + wc * 32 + 8 * fq;
#pragma unroll
        for (int ai = 0; ai < 2; ++ai)
#pragma unroll
            for (int m = 0; m < 4; ++m) { bf16_t* rowp = O + (size_t)(row0 + ai * HALF + m * 16) * ldc + col0; const float sc = rst ? rst[64 * ai + 16 * m + fr] : 1.0f;
#pragma unroll
                for (int bj = 0; bj < 2; ++bj) { const f32x4 v0 = acc[ai][bj][m][0] * sc, v1 = acc[ai][bj][m][1] * sc;
                    u32x4 w; w.x = cvt_pk_bf16(v0[0], v0[1]); w.y = cvt_pk_bf16(v0[2], v0[3]); w.z = cvt_pk_bf16(v1[0], v1[1]); w.w = cvt_pk_bf16(v1[2], v1[3]);
                    *(u32x4*)(rowp + bj * HALF) = w; } }
    }
};
struct EpiF32 {
    static constexpr bool PERM = false, AFTER_DRAIN = false;
    float* C; int ldc;
    __device__ __forceinline__ void operator()(const f32x4 (&acc)[2][2][4][2], const Unit& u, int wr, int wc, int fr, int fq) const {
        const int row0 = u.pm * BM + wr * 64 + fr, col0 = u.pn * BM + wc * 32 + 4 * fq;
#pragma unroll
        for (int ai = 0; ai < 2; ++ai)
#pragma unroll
            for (int m = 0; m < 4; ++m) { float* rowp = C + (size_t)(row0 + ai * HALF + m * 16) * ldc + col0;
#pragma unroll
                for (int bj = 0; bj < 2; ++bj)
#pragma unroll
                    for (int n = 0; n < 2; ++n) *(f32x4*)(rowp + bj * HALF + n * 16) = acc[ai][bj][m][n]; }
    }
};
struct EpiAny {
    static constexpr bool PERM = true, AFTER_DRAIN = false;
    int mode; void* O; int ldo; const float* rs;
    __device__ __forceinline__ void row_scale_issue(const Unit& u, int wr, int fr, int fq, float& v0, float& v1) const {
        if (rs) { const float* p = rs + u.pm * BM + wr * 64 + fr + (fq >> 1) * HALF + (fq & 1) * 32; v0 = p[0]; v1 = p[16]; } }
    __device__ __forceinline__ void row_scale_park(PG8_LAS unsigned char* tab, int wid, int lane, float v0, float v1) const {
        if (rs) { PG8_LAS float* t = (PG8_LAS float*)(tab + wid * 512) + ((lane >> 5) * 64 + ((lane >> 4) & 1) * 32 + (lane & 15)); t[0] = v0; t[16] = v1; asm volatile("s_waitcnt lgkmcnt(0)" ::: "memory"); } }
    __device__ __forceinline__ void operator()(f32x4 (&acc)[2][2][4][2], const Unit& u, int wr, int wc, int fr, int fq, PG8_LAS unsigned char* tab, int wid) const {
        const PG8_LAS float* rst = rs ? (const PG8_LAS float*)(tab + wid * 512) : nullptr;
        if (mode == 0) { EpiSwiGLU E{(bf16_t*)O, ldo, rst}; E(acc, u, wr, wc, fr, fq); }
        else if (mode == 1) { EpiStoreBf16 E{(bf16_t*)O, ldo, rst}; E(acc, u, wr, wc, fr, fq); }
        else { float* C = (float*)O; const int row0 = u.pm * BM + wr * 64 + fr, col0 = u.pn * BM + wc * 32 + 8 * fq;
#pragma unroll
            for (int ai = 0; ai < 2; ++ai)
#pragma unroll
                for (int m = 0; m < 4; ++m) { float* rowp = C + (size_t)(row0 + ai * HALF + m * 16) * ldo + col0;
#pragma unroll
                    for (int bj = 0; bj < 2; ++bj)
#pragma unroll
                        for (int n = 0; n < 2; ++n) *(f32x4*)(rowp + bj * HALF + n * 4) = acc[ai][bj][m][n]; } }
    }
};
template <class Epi, class Sched, bool ALIGN_EPI = false, bool SP2 = false>
__device__ __forceinline__ void gemm_phase(PG8_LAS unsigned char* lds, const Gemm g, const Sched& S, const Epi& E, int tid_in  ) {
    int tid_ = tid_in; asm volatile("" : "+v"(tid_));
    const int tid = tid_, wid = __builtin_amdgcn_readfirstlane(tid >> 6), lane = tid & 63, wr = wid >> 2, wc = wid & 3, fr = lane & 15, fq = lane >> 4;
    const int K = g.K, LD = g.ld, nt = K / BK;
    unsigned voffA[2], voffB[2];
#pragma unroll
    for (int i = 0; i < 2; ++i) { int R, C; stage_rc(tid * 16 + i * 8192, R, C); const int Rb = Epi::PERM ? ((R & ~31) + perm32(R & 31)) : R;
        voffA[i] = (unsigned)(R * LD + C) * 2u; voffB[i] = (unsigned)(Rb * LD + C) * 2u; }
    const size_t kstep = (size_t)(BK * 2);
    const size_t hstep = (size_t)HALF * LD * 2;
    const size_t tstep = 2 * hstep;
    const unsigned ldsw = (unsigned)wid * 1024u;
    const int aoff = lds_byte(wr * 64 + fr, fq * 8), boff = lds_byte(wc * 32 + fr, fq * 8);
#define PG8_SA(b, h) (((b) * 2 + (h)) * HTB)
#define PG8_SB(b, h) ((4 + (b) * 2 + (h)) * HTB)
#define PG8_STAGE(bufoff, gbase, voff) do { _Pragma("unroll") for (int _i = 0; _i < 2; ++_i) \
        __builtin_amdgcn_global_load_lds((const unsigned*)((const char*)(gbase) + (voff)[_i]), (PG8_LAS unsigned*)(lds + (bufoff) + ldsw + _i * 8192), 16, 0, 0); } while (0)
#define PG8_LDA(dst, b, h) do { _Pragma("unroll") for (int m = 0; m < 4; ++m) _Pragma("unroll") for (int k = 0; k < 2; ++k) dst[m][k] = *(const PG8_LAS bf16x8*)(lds + PG8_SA(b, h) + aoff + m * 2048 + k * 1024); } while (0)
#define PG8_LDB(dst, b, h) do { _Pragma("unroll") for (int n = 0; n < 2; ++n) _Pragma("unroll") for (int k = 0; k < 2; ++k) dst[n][k] = *(const PG8_LAS bf16x8*)(lds + PG8_SB(b, h) + boff + n * 2048 + k * 1024); } while (0)
#define PG8_MMA(ai, bj, At, Bt) do { __builtin_amdgcn_s_setprio(1); _Pragma("unroll") for (int m = 0; m < 4; ++m) _Pragma("unroll") for (int n = 0; n < 2; ++n) _Pragma("unroll") for (int k = 0; k < 2; ++k) \
        acc[ai][bj][m][n] = __builtin_amdgcn_mfma_f32_16x16x32_bf16(Bt[n][k], At[m][k], acc[ai][bj][m][n], 0, 0, 0); __builtin_amdgcn_s_setprio(0); } while (0)
#define PG8_WAIT_V(n) asm volatile("s_waitcnt vmcnt(" #n ")" ::: "memory")
#define PG8_WAIT_L(n) asm volatile("s_waitcnt lgkmcnt(" #n ")" ::: "memory")
#define PG8_BAR __builtin_amdgcn_s_barrier()
#define PG8_SCHED __builtin_amdgcn_sched_barrier(0)
    Unit cur, nxt; int ui = 0;
    if (!S.next(0, cur)) return;
    f32x4 acc[2][2][4][2];
#pragma unroll
    for (int a = 0; a < 2; ++a)
#pragma unroll
        for (int b = 0; b < 2; ++b)
#pragma unroll
            for (int m = 0; m < 4; ++m)
#pragma unroll
                for (int n = 0; n < 2; ++n) acc[a][b][m][n] = (f32x4){0.f, 0.f, 0.f, 0.f};
    bf16x8 At[4][2], B0[2][2], B1[2][2];
    const char* cA = (const char*)g.A + (size_t)cur.pm * tstep; const char* cB = (const char*)g.Bt + (size_t)cur.pn * tstep;
    S.a_ready(cur);
    if constexpr (SP2) {
        PG8_STAGE(PG8_SB(0, 0), cB, voffB); PG8_STAGE(PG8_SB(0, 1), cB + hstep, voffB); PG8_STAGE(PG8_SA(0, 0), cA, voffA); PG8_STAGE(PG8_SA(0, 1), cA + hstep, voffA);
        if (wr == 1) PG8_BAR;
        PG8_WAIT_V(2); PG8_BAR;
        PG8_STAGE(PG8_SB(1, 0), cB + kstep, voffB); PG8_STAGE(PG8_SA(1, 0), cA + kstep, voffA); PG8_STAGE(PG8_SB(1, 1), cB + hstep + kstep, voffB);
        PG8_WAIT_V(6); PG8_BAR;
    } else {
        PG8_STAGE(PG8_SB(0, 0), cB, voffB); PG8_STAGE(PG8_SA(0, 0), cA, voffA); PG8_STAGE(PG8_SB(0, 1), cB + hstep, voffB); PG8_STAGE(PG8_SA(0, 1), cA + hstep, voffA);
        if (wr == 1) PG8_BAR;
        PG8_WAIT_V(4); PG8_BAR;
        PG8_STAGE(PG8_SB(1, 0), cB + kstep, voffB); PG8_STAGE(PG8_SA(1, 0), cA + kstep, voffA); PG8_STAGE(PG8_SB(1, 1), cB + hstep + kstep, voffB);
        PG8_WAIT_V(6); PG8_BAR;
    }
    for (;;) {
        const bool has_next = S.next(ui + 1, nxt);
        { float rsv0 = 1.0f, rsv1 = 1.0f; E.row_scale_issue(cur, wr, fr, fq, rsv0, rsv1); E.row_scale_park(lds + STAGE_BYTES, wid, lane, rsv0, rsv1); }
        const char* nA = has_next ? (const char*)g.A + (size_t)nxt.pm * tstep : cA; const char* nB = has_next ? (const char*)g.Bt + (size_t)nxt.pn * tstep : cB;
        for (int t = 0; t < nt; t += 2) {
            const bool last = (t == nt - 2);
            const char* a1 = cA + (size_t)(t + 1) * kstep;
            const char* a2 = last ? nA : cA + (size_t)(t + 2) * kstep; const char* b2 = last ? nB : cB + (size_t)(t + 2) * kstep;
            const char* a3 = a2 + kstep; const char* b3 = b2 + kstep;
            if (last && has_next) S.a_ready(nxt);
            if constexpr (SP2) {
            PG8_LDB(B0, 0, 0); PG8_LDB(B1, 0, 1); PG8_SCHED; PG8_LDA(At, 0, 0); PG8_STAGE(PG8_SA(1, 1), a1 + hstep, voffA);
            PG8_WAIT_V(8); PG8_WAIT_L(0); PG8_BAR; PG8_MMA(0, 0, At, B0); PG8_MMA(0, 1, At, B1); PG8_BAR; PG8_SCHED;
            PG8_LDA(At, 0, 1); PG8_STAGE(PG8_SB(0, 0), b2, voffB); PG8_STAGE(PG8_SB(0, 1), b2 + hstep, voffB); PG8_STAGE(PG8_SA(0, 0), a2, voffA);
            PG8_WAIT_V(8); PG8_WAIT_L(0); PG8_BAR; PG8_MMA(1, 0, At, B0); PG8_MMA(1, 1, At, B1); PG8_BAR; PG8_SCHED;
            PG8_LDB(B0, 1, 0); PG8_LDB(B1, 1, 1); PG8_SCHED; PG8_LDA(At, 1, 0); PG8_STAGE(PG8_SA(0, 1), a2 + hstep, voffA);
            PG8_WAIT_V(8); PG8_WAIT_L(0); PG8_BAR; PG8_MMA(0, 0, At, B0); PG8_MMA(0, 1, At, B1); PG8_BAR; PG8_SCHED;
            PG8_LDA(At, 1, 1); PG8_STAGE(PG8_SB(1, 0), b3, voffB); PG8_STAGE(PG8_SB(1, 1), b3 + hstep, voffB); PG8_STAGE(PG8_SA(1, 0), a3, voffA);
            PG8_WAIT_V(8); PG8_WAIT_L(0); PG8_BAR; PG8_MMA(1, 0, At, B0); PG8_MMA(1, 1, At, B1); PG8_BAR; PG8_SCHED;
            } else {
            PG8_LDB(B0, 0, 0); PG8_SCHED; PG8_LDA(At, 0, 0); PG8_STAGE(PG8_SA(1, 1), a1 + hstep, voffA);
            PG8_WAIT_L(8); PG8_BAR; PG8_WAIT_L(0); PG8_MMA(0, 0, At, B0); PG8_BAR; PG8_SCHED;
            PG8_LDB(B1, 0, 1); PG8_STAGE(PG8_SB(0, 0), b2, voffB);
            PG8_BAR; PG8_WAIT_L(0); PG8_MMA(0, 1, At, B1); PG8_BAR;
            PG8_LDA(At, 0, 1); PG8_STAGE(PG8_SA(0, 0), a2, voffA);
            PG8_BAR; PG8_WAIT_L(0); PG8_MMA(1, 0, At, B0); PG8_BAR; PG8_SCHED;
            PG8_STAGE(PG8_SB(0, 1), b2 + hstep, voffB);
            PG8_WAIT_V(6); PG8_BAR; PG8_MMA(1, 1, At, B1); PG8_BAR;
            PG8_LDB(B0, 1, 0); PG8_SCHED; PG8_LDA(At, 1, 0); PG8_STAGE(PG8_SA(0, 1), a2 + hstep, voffA);
            PG8_WAIT_L(8); PG8_BAR; PG8_WAIT_L(0); PG8_MMA(0, 0, At, B0); PG8_BAR; PG8_SCHED;
            PG8_LDB(B1, 1, 1); PG8_STAGE(PG8_SB(1, 0), b3, voffB);
            PG8_BAR; PG8_WAIT_L(0); PG8_MMA(0, 1, At, B1); PG8_BAR;
            PG8_LDA(At, 1, 1); PG8_STAGE(PG8_SA(1, 0), a3, voffA);
            PG8_BAR; PG8_WAIT_L(0); PG8_MMA(1, 0, At, B0); PG8_BAR; PG8_SCHED;
            PG8_STAGE(PG8_SB(1, 1), b3 + hstep, voffB);
            PG8_WAIT_V(6); PG8_BAR; PG8_MMA(1, 1, At, B1); PG8_BAR;
            }
        }
        if constexpr (ALIGN_EPI) { if (wr == 0) PG8_BAR; }
        E(acc, cur, wr, wc, fr, fq, lds + STAGE_BYTES, wid); S.done(cur);
        if (!has_next) break;
#pragma unroll
        for (int a = 0; a < 2; ++a)
#pragma unroll
            for (int b = 0; b < 2; ++b)
#pragma unroll
                for (int m = 0; m < 4; ++m)
#pragma unroll
                    for (int n = 0; n < 2; ++n) acc[a][b][m][n] = (f32x4){0.f, 0.f, 0.f, 0.f};
        cur = nxt; cA = nA; cB = nB; ++ui;
        if constexpr (ALIGN_EPI) { if (wr == 1) PG8_BAR; }
    }
    PG8_WAIT_V(0);
    if constexpr (!ALIGN_EPI) { if (wr == 0) PG8_BAR; }
    PG8_BAR;
#undef PG8_SA
#undef PG8_SB
#undef PG8_STAGE
#undef PG8_LDA
#undef PG8_LDB
#undef PG8_MMA
#undef PG8_WAIT_V
#undef PG8_WAIT_L
#undef PG8_BAR
#undef PG8_SCHED
}
}
constexpr int NWAVES = 8, GRID = 256;
constexpr int D = 1024, FF = 2816, NIN = 2944, NINP = 3072, NLAYER = 2;
constexpr int NB = 8, SEQ = 2048, NMETA = 16, TT = SEQ + NMETA;
constexpr int MX = NB * SEQ, MREAL = MX + NMETA, MP = 16640;
constexpr float RMS_EPS = 1e-6f, LNX_EPS = 64e-5f;
constexpr int PC_LRUX = 0, PC_LRUG = 256, PC_SCB = 512, PC_SCC = 768, PC_SCX = 1024, PC_R = 1280, PC_K = 1792, PC_V = 2304, PC_LO = 2816;

constexpr size_t MiB = 1u << 20;
constexpr size_t WS_CTL = 0, CTL_ZERO_BYTES = 1 * MiB;
constexpr size_t WS_HMETA = 1 * MiB;
constexpr size_t WS_RS = WS_HMETA + 640 * 1024;
constexpr size_t WS_MSLAB = WS_HMETA + 64 * 1024;
constexpr size_t WS_AGG = 2 * MiB;
constexpr size_t WS_WB = 3 * MiB;
constexpr size_t WB_W1IN = 0, WB_W1OUT = 11 * MiB, WB_W2IN = WB_W1OUT + 5632 * 1024, WB_W2OUT = WB_W2IN + 11 * MiB, WB_WIN = WB_W2OUT + 5632 * 1024, WB_WOUT = WB_WIN + 6 * MiB, WB_END = WB_WOUT + 2 * MiB;
static_assert(WB_END == 41 * MiB, "weight map");
constexpr size_t WS_XN = 44 * MiB;
constexpr size_t WS_OV = 77 * MiB;
constexpr size_t OV_HID = 0, OV_RAWF = 90 * MiB;
constexpr size_t OV_P = 0, OV_WDEC = OV_P + (size_t)MP * NINP * 2, OV_ABUF = OV_WDEC + (size_t)MP * 512 * 2, OV_GBUF = OV_ABUF + (size_t)MP * 512 * 2, OV_HL = OV_GBUF + (size_t)MP * 512 * 2, OV_CA = OV_HL + (size_t)MP * 256 * 4, OV_MIXEND = OV_CA + (size_t)MP * 256 * 4;
constexpr size_t OV_HTMP = 130 * MiB;
constexpr size_t OV_RAWM = 0;
constexpr size_t WS_END = 256 * MiB;
static_assert(WS_XN + (size_t)MP * D * 2 <= WS_OV && WS_OV + OV_MIXEND <= WS_END && WS_OV + OV_RAWF + (size_t)MP * D * 2 <= WS_OV + OV_HTMP && WS_OV + OV_HTMP + (size_t)MX * D * 2 <= WS_END && (size_t)MP * FF * 2 <= OV_RAWF, "d_ws map");
constexpr int CW_BAR = 4096;

constexpr unsigned PROBE_MASK = 0u, PROBE_AMP = 8u; constexpr int PROBE_SUB = -1;
#define PSTAMP(j) do { if (PROBE_MASK && PROBE_SUB >= 0) { const unsigned long long t_ = __builtin_amdgcn_s_memrealtime(); if (PROBE_SUB == (j) && ((PROBE_MASK >> F.ph) & 1u)) F.pr_acc += t_ - F.pr_sub; F.pr_sub = t_; } } while (0)
constexpr int RING_BYTES = 143360, LDSCTL_OFF = RING_BYTES, MISC_OFF = LDSCTL_OFF + 320, LDS_BYTES = 147456;

#define GAS __attribute__((address_space(1)))
#define LAS __attribute__((address_space(3)))
typedef unsigned short bf16;
typedef unsigned v4u __attribute__((ext_vector_type(4)));
typedef float f32x4 __attribute__((ext_vector_type(4)));
typedef GAS unsigned gu32;
typedef float f32x2v_ __attribute__((ext_vector_type(2)));
#define LDS_WAIT() asm volatile("s_waitcnt lgkmcnt(0)" ::: "memory")
__device__ __forceinline__ unsigned f2bf(float f) { unsigned u = __builtin_bit_cast(unsigned, f); return (u + 0x7fffu + ((u >> 16) & 1u)) >> 16; }
__device__ __forceinline__ unsigned pk2(float lo, float hi) { return f2bf(lo) | (f2bf(hi) << 16); }
__device__ __forceinline__ float bf2f(unsigned b) { return __builtin_bit_cast(float, b << 16); }
__device__ __forceinline__ float sigmoidf_(float x) { return __builtin_amdgcn_rcpf(1.0f + __expf(-x)); }
__device__ __forceinline__ float tanhf_(float x) { return 1.0f - 2.0f * __builtin_amdgcn_rcpf(1.0f + __expf(2.0f * x)); }
__device__ __forceinline__ float softplusf_(float x) { return fmaxf(x, 0.f) + __logf(1.0f + __expf(-fabsf(x))); }
__device__ __forceinline__ float gelu_tanh(float x) { const float u = 0.7978845608028654f * (x + 0.044715f * x * x * x); return 0.5f * x * (1.0f + tanhf_(u)); }
template <int CTRL> __device__ __forceinline__ float dppf(float x) { return __builtin_bit_cast(float, __builtin_amdgcn_mov_dpp(__builtin_bit_cast(int, x), CTRL, 0xf, 0xf, true)); }
__device__ __forceinline__ float red16(float x) { x += dppf<0xB1>(x); x += dppf<0x4E>(x); x += dppf<0x141>(x); x += dppf<0x128>(x); return x; }
__device__ __forceinline__ float wave_sum(float x) {
    x = red16(x);
    x += __builtin_bit_cast(float, __builtin_amdgcn_update_dpp(0, __builtin_bit_cast(int, x), 0x142, 0xa, 0xf, false));
    x += __builtin_bit_cast(float, __builtin_amdgcn_update_dpp(0, __builtin_bit_cast(int, x), 0x143, 0xc, 0xf, false));
    return __builtin_bit_cast(float, __builtin_amdgcn_readlane(__builtin_bit_cast(int, x), 63)); }
__device__ __forceinline__ float wave_sum_dpp(float x) { return wave_sum(x); }
__device__ __forceinline__ int vlane() { return (int)__builtin_amdgcn_mbcnt_hi(~0u, __builtin_amdgcn_mbcnt_lo(~0u, 0u)); }
__device__ __forceinline__ int row_of(int b, int s) { return s < NMETA ? (MX + s) : (b * SEQ + s - NMETA); }
#define XB_TMO      128
#define XB_XCNT(j)  (256  + 64 * (j))
#define XB_XSUB(j)  (1280 + 64 * (j))
#define XB_XGEN(j)  (2304 + 64 * (j))
#define XB_TOP      3328
#define XB_TOPGEN   3392
#define XCD_BAR_WORDS 3456
#define XB_SPIN_CAP (1u << 18)

__device__ __forceinline__ unsigned xb_ld(unsigned* p)              { return __hip_atomic_load(p, __ATOMIC_RELAXED, __HIP_MEMORY_SCOPE_AGENT); }
__device__ __forceinline__ unsigned xb_add(unsigned* p, unsigned v) { return __hip_atomic_fetch_add(p, v, __ATOMIC_RELAXED, __HIP_MEMORY_SCOPE_AGENT); }
__device__ __forceinline__ unsigned xb_xcc_id() { return (unsigned)__builtin_amdgcn_s_getreg((3 << 11) | 20) & 0xFu; }
#define XB_SPIN(cond, bar) do { unsigned _sp = 0; while (cond) { __builtin_amdgcn_s_sleep(1); \
    if ((++_sp & 255u) == 0u) { if (xb_ld(&(bar)[XB_TMO])) break; if (_sp > XB_SPIN_CAP) { atomicAdd(&(bar)[XB_TMO], 1u); break; } } } } while (0)

struct XcdBarrier {
    unsigned* bar; unsigned x;
    volatile LAS unsigned* st;
};

__device__ __forceinline__ XcdBarrier xcd_barrier_post(unsigned* bar, volatile LAS unsigned* st, bool leader  ) {
    XcdBarrier b; b.bar = bar; b.x = xb_xcc_id(); b.st = st;
    if (leader) (void)xb_add(&bar[XB_XCNT(b.x)], 1u);
    return b;
}
__device__ __forceinline__ void xcd_barrier_complete(unsigned* bar, unsigned x, unsigned& nloc, unsigned& nx) {
    const unsigned G = gridDim.x * gridDim.y * gridDim.z;
    unsigned sum, cnt, mine, sp = 0u;
    for (;;) {
        sum = 0u; cnt = 0u; mine = 0u;
#pragma unroll
        for (unsigned j = 0; j < 16; ++j) { const unsigned c = xb_ld(&bar[XB_XCNT(j)]); sum += c; cnt += (c > 0u) ? 1u : 0u; mine = (j == x) ? c : mine; }
        if (sum == G) break;
        __builtin_amdgcn_s_sleep(1);
        if ((++sp & 255u) == 0u) { if (xb_ld(&bar[XB_TMO])) break; if (sp > XB_SPIN_CAP) { atomicAdd(&bar[XB_TMO], 1u); break; } }
    }
    nloc = mine > 0u ? mine : 1u; nx = cnt > 0u ? cnt : 1u;
}

__device__ __forceinline__ void xcd_barrier(const XcdBarrier& b, bool leader  ) {
    asm volatile("s_waitcnt vmcnt(0)" ::: "memory");
    __syncthreads();
    if (leader) {
        unsigned* bar = b.bar;
        __builtin_amdgcn_s_waitcnt(0);
        unsigned nloc = b.st[0], nx = b.st[1];
        if (nloc == 0u) { xcd_barrier_complete(bar, b.x, nloc, nx); b.st[0] = nloc; b.st[1] = nx; }
        const unsigned old = xb_add(&bar[XB_XSUB(b.x)], 1u);
        const unsigned gen = old / nloc;
        if (old + 1u == (gen + 1u) * nloc) {
            __builtin_amdgcn_fence(__ATOMIC_RELEASE, "agent");
            asm volatile("s_waitcnt vmcnt(0)" ::: "memory");
            const unsigned og = xb_add(&bar[XB_TOP], 1u);
            const unsigned tg = og / nx;
            if (og + 1u == (tg + 1u) * nx) xb_add(&bar[XB_TOPGEN], 1u);
            else XB_SPIN(xb_ld(&bar[XB_TOPGEN]) == tg, bar);
            __builtin_amdgcn_fence(__ATOMIC_ACQUIRE, "agent");
            xb_add(&bar[XB_XGEN(b.x)], 1u);
            asm volatile("s_waitcnt vmcnt(0)" ::: "memory");
        } else {
            XB_SPIN(xb_ld(&bar[XB_XGEN(b.x)]) == gen, bar);
            __builtin_amdgcn_fence(__ATOMIC_ACQUIRE, "agent");
            asm volatile("s_waitcnt vmcnt(0)" ::: "memory");
        }
    }
    __syncthreads();
}
struct Frame {
    LAS unsigned char* lds;
    int tid, lane, wave, vcu;
    unsigned long long pr_acc, pr_sub; int ph;
    unsigned char* ws;
    const float* x; const float* meta; float* out;
};

constexpr int PK_CONVW = 0, PK_CONVB = 1024, PK_WA = 1280, PK_BA = 17664, PK_WX = 17920, PK_BX = 34304, PK_LAM = 34560, PK_LNG = 34816, PK_SCW = 35072, PK_SCG = 35840, PK_MU = 36096, PK_W0 = 37760,
              PK_W2 = 38272, PK_A0 = 54656, PK_A2 = 55168, PK_G2 = 71552, PK_KK = 104320, PK_KA = 104832, PK_RK = 105344, PK_LNW = 105856, PK_LNB = 106368, PK_SIZE = 106880;
constexpr size_t WS_PACK = 72 * 1024;
static_assert(WS_PACK + (size_t)NLAYER * PK_SIZE * 4 <= CTL_ZERO_BYTES && (CW_BAR + 3456) * 4 <= (int)WS_PACK, "pack inside CTL, above the barrier words");
__device__ __forceinline__ const float* pack_of(const Frame& F, int l) { return (const float*)(F.ws + WS_PACK) + (size_t)l * PK_SIZE; }
__device__ __forceinline__ void pack_copy(Frame& F, const float* src, int per_layer, int off) {
    const int gt = F.vcu * (NWAVES * 64) + F.tid, NT = GRID * NWAVES * 64;
    for (int i = gt; i < NLAYER * per_layer; i += NT) { const int l = i / per_layer, j = i - l * per_layer; ((float*)(F.ws + WS_PACK))[(size_t)l * PK_SIZE + off + j] = src[i]; }
}
__device__ __forceinline__ void phase_pack(Frame& F, const float* const* in) {
    pack_copy(F, in[9], 1024, PK_CONVW); pack_copy(F, in[10], 256, PK_CONVB); pack_copy(F, in[11], 16384, PK_WA); pack_copy(F, in[12], 256, PK_BA); pack_copy(F, in[13], 16384, PK_WX); pack_copy(F, in[14], 256, PK_BX);
    pack_copy(F, in[15], 256, PK_LAM); pack_copy(F, in[16], 256, PK_LNG); pack_copy(F, in[17], 768, PK_SCW); pack_copy(F, in[18], 256, PK_SCG); pack_copy(F, in[19], 1664, PK_MU); pack_copy(F, in[20], 512, PK_W0);
    pack_copy(F, in[21], 16384, PK_W2); pack_copy(F, in[22], 512, PK_A0); pack_copy(F, in[23], 16384, PK_A2); pack_copy(F, in[24], 32768, PK_G2); pack_copy(F, in[25], 512, PK_KK); pack_copy(F, in[26], 512, PK_KA);
    pack_copy(F, in[27], 512, PK_RK); pack_copy(F, in[28], 512, PK_LNW); pack_copy(F, in[29], 512, PK_LNB);
}

__device__ __forceinline__ int swiglu_row(int n0) { return n0 < FF ? ((n0 >> 7) * 256 + (n0 & 127)) : (((n0 - FF) >> 7) * 256 + 128 + ((n0 - FF) & 127)); }
constexpr int CI_IN = (D / 64) * (2 * FF / 32), CI_OUT = (FF / 64) * (D / 32), CI_MI = (D / 64) * (NIN / 32), CI_MO = (D / 64) * (D / 32);
constexpr int CI_SET0 = CI_IN + CI_OUT + CI_MI, CI_SET1 = CI_MO + CI_IN + CI_OUT;
struct ConvItem { const float* W; bf16* WT; int K, N, k0, n0, drow0; const float* g; };
__device__ __forceinline__ ConvItem conv_item(unsigned char* ws, const float* const* in, int l, int set, int r) {
    ConvItem ci;
    if (set == 0) {
        if (r < CI_IN) { const int nblk = 2 * FF / 32, kb = r / nblk, nb = r % nblk; ci = ConvItem{in[3] + (size_t)l * D * 2 * FF, (bf16*)(ws + WS_WB + WB_W1IN), D, 2 * FF, 64 * kb, 32 * nb, swiglu_row(32 * nb), in[2] + (size_t)(l * 6 + 0) * D}; return ci; }
        r -= CI_IN;
        if (r < CI_OUT) { const int nblk = D / 32, kb = r / nblk, nb = r % nblk; ci = ConvItem{in[4] + (size_t)l * FF * D, (bf16*)(ws + WS_WB + WB_W1OUT), FF, D, 64 * kb, 32 * nb, 32 * nb, nullptr}; return ci; }
        r -= CI_OUT;
        { const int nblk = NIN / 32, kb = r / nblk, nb = r % nblk; ci = ConvItem{in[7] + (size_t)l * D * NIN, (bf16*)(ws + WS_WB + WB_WIN), D, NIN, 64 * kb, 32 * nb, 32 * nb, in[2] + (size_t)(l * 6 + 2) * D}; return ci; }
    }
    if (r < CI_MO) { const int nblk = D / 32, kb = r / nblk, nb = r % nblk; ci = ConvItem{in[8] + (size_t)l * D * D, (bf16*)(ws + WS_WB + WB_WOUT), D, D, 64 * kb, 32 * nb, 32 * nb, nullptr}; return ci; }
    r -= CI_MO;
    if (r < CI_IN) { const int nblk = 2 * FF / 32, kb = r / nblk, nb = r % nblk; ci = ConvItem{in[5] + (size_t)l * D * 2 * FF, (bf16*)(ws + WS_WB + WB_W2IN), D, 2 * FF, 64 * kb, 32 * nb, swiglu_row(32 * nb), in[2] + (size_t)(l * 6 + 4) * D}; return ci; }
    r -= CI_IN;
    { const int nblk = D / 32, kb = r / nblk, nb = r % nblk; ci = ConvItem{in[6] + (size_t)l * FF * D, (bf16*)(ws + WS_WB + WB_W2OUT), FF, D, 64 * kb, 32 * nb, 32 * nb, nullptr}; return ci; }
}
__device__ __forceinline__ void conv_loads(const ConvItem& ci, int lane, float (&v)[32]) {
    const float* src = ci.W + (size_t)(ci.k0 + (lane >> 5)) * ci.N + ci.n0 + (lane & 31);
#pragma unroll
    for (int i = 0; i < 32; ++i) v[i] = src[(size_t)(2 * i) * ci.N];
}
__device__ __forceinline__ void conv_store(const ConvItem& ci, int lane, const float (&v)[32], LAS float* scr) {
#pragma unroll
    for (int i = 0; i < 32; ++i) scr[(2 * i + (lane >> 5)) * 33 + (lane & 31)] = v[i];
    LDS_WAIT(); asm volatile("" ::: "memory");
    const int c = lane & 7;
    f32x4 g0 = (f32x4){1.f, 1.f, 1.f, 1.f}, g1 = g0; if (ci.g) { g0 = *(const f32x4*)(ci.g + ci.k0 + 8 * c); g1 = *(const f32x4*)(ci.g + ci.k0 + 8 * c + 4); }
#pragma unroll
    for (int j = 0; j < 4; ++j) { const int n = (lane >> 3) + 8 * j; const LAS float* s = scr + (8 * c) * 33 + n;
        v4u o; o.x = pk2(s[0 * 33] * g0[0], s[1 * 33] * g0[1]); o.y = pk2(s[2 * 33] * g0[2], s[3 * 33] * g0[3]); o.z = pk2(s[4 * 33] * g1[0], s[5 * 33] * g1[1]); o.w = pk2(s[6 * 33] * g1[2], s[7 * 33] * g1[3]);
        *(GAS v4u*)(ci.WT + (size_t)(ci.drow0 + n) * ci.K + ci.k0 + 8 * c) = o; }
    LDS_WAIT(); asm volatile("" ::: "memory");
}
__device__ __forceinline__ void phase_convert(Frame& F, const float* const* in, int l, int set) {
    { int ln_ = F.tid & 63; asm volatile("" : "+v"(ln_)); F.lane = ln_; }
    LAS float* scr = (LAS float*)(F.lds + F.wave * 16384);
    const int gw = F.vcu * NWAVES + F.wave, NGW = GRID * NWAVES, nitems = set == 0 ? CI_SET0 : CI_SET1;
    { ConvItem ca, cb; float va[32], vb[32]; int it = gw;
      if (it < nitems) { ca = conv_item(F.ws, in, l, set, it); conv_loads(ca, F.lane, va); }
      while (it < nitems) {
          const int itb = it + NGW; if (itb < nitems) { cb = conv_item(F.ws, in, l, set, itb); conv_loads(cb, F.lane, vb); }
          conv_store(ca, F.lane, va, scr);
          if (itb >= nitems) break;
          const int ita = itb + NGW; if (ita < nitems) { ca = conv_item(F.ws, in, l, set, ita); conv_loads(ca, F.lane, va); }
          conv_store(cb, F.lane, vb, scr);
          it = ita; } }
    if (set == 0) { unsigned zz = 0u; asm volatile("" : "+v"(zz));
      for (int i = gw * 64 + F.lane; i < (NINP - NIN) * D / 8; i += NGW * 64) *(GAS v4u*)(((bf16*)(F.ws + WS_WB + WB_WIN)) + (size_t)NIN * D + (size_t)i * 8) = (v4u){zz, zz, zz, zz}; }
}

__device__ __forceinline__ float sumsq4(const f32x4 (&v)[4]) { float s = 0.f;
#pragma unroll
    for (int j = 0; j < 4; ++j) s += (v[j].x * v[j].x + v[j].y * v[j].y) + (v[j].z * v[j].z + v[j].w * v[j].w);
    return s; }
typedef short mbf16x8 __attribute__((ext_vector_type(8)));
__device__ __forceinline__ void meta_tile(const bf16* A, const bf16* Bt, int K, int k0, int kl, int nb0, int nb1, int mode, void* O, int ldo, int ocol, int lane, const float* rs) {
    const int fr = lane & 15, fq = lane >> 4;
    const bf16* ap = A + (size_t)(MX + fr) * K + k0 + 8 * fq; const bf16* b0p = Bt + (size_t)(nb0 + fr) * K + k0 + 8 * fq; const bf16* b1p = Bt + (size_t)((mode == 0 ? nb1 : nb0) + fr) * K + k0 + 8 * fq;
    f32x4 acc0 = (f32x4){0.f, 0.f, 0.f, 0.f}, acc1 = acc0;
    for (int kb = 0; kb < kl; kb += 256) {
        mbf16x8 a[8], w0[8], w1[8];
#pragma unroll
        for (int j = 0; j < 8; ++j) { const int ks = kb + 32 * j; const bool on = ks < kl; const int kc = on ? ks : kb;
            a[j] = *(const mbf16x8*)(ap + kc); w0[j] = *(const mbf16x8*)(b0p + kc); if (mode == 0) w1[j] = *(const mbf16x8*)(b1p + kc); }
#pragma unroll
        for (int j = 0; j < 8; ++j) { if (kb + 32 * j < kl) { acc0 = __builtin_amdgcn_mfma_f32_16x16x32_bf16(w0[j], a[j], acc0, 0, 0, 0);
            if (mode == 0) acc1 = __builtin_amdgcn_mfma_f32_16x16x32_bf16(w1[j], a[j], acc1, 0, 0, 0); } } }
    const int col = ocol + 4 * fq;
    if (mode == 2) { *(f32x4*)((float*)O + (size_t)fr * ldo + col) = acc0; return; }
    float v[4];
    const float sc = rs ? rs[MX + fr] : 1.0f;
#pragma unroll
    for (int i = 0; i < 4; ++i) { const float g = acc0[i] * sc; v[i] = mode == 0 ? g * __builtin_amdgcn_rcpf(1.0f + __expf(-g)) * (acc1[i] * sc) : g; }
    *(GAS unsigned long long*)((bf16*)O + (size_t)(MX + fr) * ldo + col) = (unsigned long long)pk2(v[0], v[1]) | ((unsigned long long)pk2(v[2], v[3]) << 32);
}
__device__ __forceinline__ void meta_gemm(Frame& F, const bf16* A, const bf16* Bt, int K, int N, int mode, void* O, int ldo, int nks, int gw  , const float* rs) {
    const int lane = F.tid & 63; if (gw < 0) return;
    if (mode == 0) { if (gw < FF / 16) { const int j0 = 16 * gw, nb0 = (j0 >> 7) * 256 + (j0 & 127); meta_tile(A, Bt, K, 0, K, nb0, nb0 + 128, 0, O, ldo, j0, lane, rs); } return; }
    const int ntile = N / 16;
    if (gw < ntile * nks) { const int tile = gw % ntile, sl = gw / ntile, kl = K / nks;
        meta_tile(A, Bt, K, sl * kl, kl, 16 * tile, 0, mode, mode == 2 ? (void*)((float*)O + (size_t)sl * NMETA * D) : O, ldo, 16 * tile, lane, rs); }
}

__device__ __forceinline__ void row_ld_f32(const float* p, int lane, f32x4 (&v)[4]) {
#pragma unroll
    for (int j = 0; j < 4; ++j) v[j] = ((const GAS f32x4*)p)[lane + 64 * j]; }
__device__ __forceinline__ void row_ld_bf16(const bf16* p, int lane, f32x4 (&v)[4]) {
#pragma unroll
    for (int j = 0; j < 4; ++j) { const unsigned long long u = ((const GAS unsigned long long*)p)[lane + 64 * j]; v[j][0] = bf2f((unsigned)u & 0xffffu); v[j][1] = bf2f((unsigned)u >> 16); v[j][2] = bf2f((unsigned)(u >> 32) & 0xffffu); v[j][3] = bf2f((unsigned)(u >> 48)); } }
__device__ __forceinline__ void row_st_bf16(bf16* p, int lane, const f32x4 (&v)[4]) {
#pragma unroll
    for (int j = 0; j < 4; ++j) ((GAS unsigned long long*)p)[lane + 64 * j] = (unsigned long long)pk2(v[j][0], v[j][1]) | ((unsigned long long)pk2(v[j][2], v[j][3]) << 32); }
__device__ __forceinline__ void phase_init(Frame& F) {
    { int ln_ = F.tid & 63; asm volatile("" : "+v"(ln_)); F.lane = ln_; }
    const int gw = F.vcu * NWAVES + F.wave, NGW = GRID * NWAVES;
    float* RS = (float*)(F.ws + WS_RS);
    for (int r0 = gw; r0 < MREAL; r0 += 4 * NGW) {
        f32x4 v[4][4];
#pragma unroll
        for (int u = 0; u < 4; ++u) { const int r = r0 + u * NGW < MREAL ? r0 + u * NGW : r0; row_ld_f32(r < MX ? F.x + (size_t)r * D : F.meta + (size_t)(r - MX) * D, F.lane, v[u]); }
#pragma unroll
        for (int u = 0; u < 4; ++u) { const int r = r0 + u * NGW; if (r < MREAL) {
            const float rstd = rsqrtf(wave_sum(sumsq4(v[u])) * (1.0f / D) + RMS_EPS);
#pragma unroll
            for (int j = 0; j < 4; ++j) v[u][j] = v[u][j] * rstd;
            row_st_bf16(r < MX ? (bf16*)F.out + (size_t)r * D : (bf16*)(F.ws + WS_HMETA) + (size_t)(r - MX) * D, F.lane, v[u]);
            if (F.lane == 0) RS[r] = rstd; } }
    }
}
struct PostIO { const bf16* raw16; const bf16* hin16; bf16* hout16; float* out32; int nks; };
__device__ __forceinline__ void post_row_load(const Frame& F, const PostIO& io, int r, f32x4 (&y)[4], f32x4 (&h)[4]) {
    if (r >= MX) { const float* sl = (const float*)(F.ws + WS_MSLAB) + (size_t)(r - MX) * D; row_ld_f32(sl, F.lane, y);
        for (int s = 1; s < io.nks; ++s) { f32x4 t[4]; row_ld_f32(sl + (size_t)s * NMETA * D, F.lane, t);
#pragma unroll
            for (int j = 0; j < 4; ++j) y[j] = y[j] + t[j]; }
        row_ld_bf16((const bf16*)(F.ws + WS_HMETA) + (size_t)(r - MX) * D, F.lane, h);
        const float inv = 1.0f / ((const float*)(F.ws + WS_RS))[r];
#pragma unroll
        for (int j = 0; j < 4; ++j) h[j] = h[j] * inv;
        return; }
    row_ld_bf16(io.raw16 + (size_t)r * D, F.lane, y);
    row_ld_bf16(io.hin16 + (size_t)r * D, F.lane, h);
    const float inv = 1.0f / ((const float*)(F.ws + WS_RS))[r];
#pragma unroll
    for (int j = 0; j < 4; ++j) h[j] = h[j] * inv;
}
__device__ __forceinline__ void post_row_store(const Frame& F, const PostIO& io, int r, const f32x4 (&h)[4]) {
    if (r >= MX) row_st_bf16((bf16*)(F.ws + WS_HMETA) + (size_t)(r - MX) * D, F.lane, h);
    else if (io.out32) {
#pragma unroll
        for (int j = 0; j < 4; ++j) ((GAS f32x4*)(io.out32 + (size_t)r * D))[F.lane + 64 * j] = h[j]; }
    else row_st_bf16(io.hout16 + (size_t)r * D, F.lane, h);
}
__device__ __forceinline__ void phase_post(Frame& F, const PostIO& io, float scale, const float* g_post, bool want_rs) {
    { int ln_ = F.tid & 63; asm volatile("" : "+v"(ln_)); F.lane = ln_; }
    const int gw = F.vcu * NWAVES + F.wave, NGW = GRID * NWAVES, nrows = io.out32 ? MX : MREAL;
    for (int r0 = gw; r0 < nrows; r0 += 2 * NGW) {
        const int r1 = r0 + NGW; const bool two = r1 < nrows; const int r1c = two ? r1 : r0;
        f32x4 y0[4], h0[4], y1[4], h1[4];
        post_row_load(F, io, r0, y0, h0); post_row_load(F, io, r1c, y1, h1);
        const float rs0 = scale * rsqrtf(wave_sum(sumsq4(y0)) * (1.0f / D) + RMS_EPS), rs1 = scale * rsqrtf(wave_sum(sumsq4(y1)) * (1.0f / D) + RMS_EPS);
#pragma unroll
        for (int j = 0; j < 4; ++j) { const f32x4 gv = ((const GAS f32x4*)g_post)[F.lane + 64 * j]; h0[j] = h0[j] + y0[j] * rs0 * gv; h1[j] = h1[j] + y1[j] * rs1 * gv; }
        if (want_rs) { const float q0 = rsqrtf(wave_sum(sumsq4(h0)) * (1.0f / D) + RMS_EPS), q1 = rsqrtf(wave_sum(sumsq4(h1)) * (1.0f / D) + RMS_EPS);
#pragma unroll
            for (int j = 0; j < 4; ++j) { h0[j] = h0[j] * q0; h1[j] = h1[j] * q1; }
            if (F.lane == 0) { ((float*)(F.ws + WS_RS))[r0] = q0; if (two) ((float*)(F.ws + WS_RS))[r1] = q1; } }
        post_row_store(F, io, r0, h0); if (two) post_row_store(F, io, r1, h1);
    }
}
typedef short bf16x8v __attribute__((ext_vector_type(8)));
typedef float f32x4v __attribute__((ext_vector_type(4)));
constexpr int FR_PER_WAVE = 24;
constexpr size_t WS_FRAG = WS_AGG + 512 * 1024, FRAG_LAYER_BYTES = (size_t)8 * FR_PER_WAVE * 64 * 16;
static_assert(WS_FRAG + NLAYER * FRAG_LAYER_BYTES <= WS_WB, "fragment store fits behind AGG");
__device__ __forceinline__ float frag_src(const float* const* in, int l, int w, int f, int lane, int j) {
    const int kq = 8 * (lane >> 4) + j, cl = lane & 15;
    if (f < 4)  return in[21][(size_t)l * 32 * 512 + (size_t)kq * 512 + 64 * w + 16 * f + cl];
    if (f < 8)  return in[23][(size_t)l * 32 * 512 + (size_t)kq * 512 + 64 * w + 16 * (f - 4) + cl];
    if (f < 16) { const int ct = (f - 8) >> 1, ks = (f - 8) & 1; return in[24][(size_t)l * 64 * 512 + (size_t)(32 * ks + kq) * 512 + 64 * w + 16 * ct + cl]; }
    { const int ct = (f - 16) >> 1, ks = (f - 16) & 1, gt = w >> 2, g = w & 3; return in[gt ? 13 : 11][(size_t)l * 16384 + (size_t)g * 4096 + (size_t)(32 * ks + kq) * 64 + 16 * ct + cl]; }
}
__device__ __forceinline__ void phase_frag(Frame& F, const float* const* in) {
    const int gt = F.vcu * (NWAVES * 64) + F.tid, NT = GRID * NWAVES * 64;
    bf16* FR = (bf16*)(F.ws + WS_FRAG);
    for (int i = gt; i < NLAYER * 8 * FR_PER_WAVE * 64 * 8; i += NT) { const int j = i & 7, lane = (i >> 3) & 63, f = (i >> 9) % FR_PER_WAVE, w = ((i >> 9) / FR_PER_WAVE) & 7, l = (i >> 9) / (FR_PER_WAVE * 8);
        FR[i] = (bf16)f2bf(frag_src(in, l, w, f, lane, j)); }
}
__device__ __forceinline__ bf16x8v pack8(const float (&v)[8]) { v4u u; u.x = pk2(v[0], v[1]); u.y = pk2(v[2], v[3]); u.z = pk2(v[4], v[5]); u.w = pk2(v[6], v[7]); return __builtin_bit_cast(bf16x8v, u); }
__device__ __forceinline__ void unpack8(const v4u& u, float (&v)[8]) { v[0] = bf2f(u.x & 0xffffu); v[1] = bf2f(u.x >> 16); v[2] = bf2f(u.y & 0xffffu); v[3] = bf2f(u.y >> 16); v[4] = bf2f(u.z & 0xffffu); v[5] = bf2f(u.z >> 16); v[6] = bf2f(u.w & 0xffffu); v[7] = bf2f(u.w >> 16); }
__device__ __forceinline__ void unpack4f(unsigned long long u, f32x4& v) { v[0] = bf2f((unsigned)u & 0xffffu); v[1] = bf2f(((unsigned)u >> 16)); v[2] = bf2f((unsigned)(u >> 32) & 0xffffu); v[3] = bf2f((unsigned)(u >> 48)); }
__device__ __forceinline__ void phase_mix_prep(Frame& F, const float* pk, int layer) {
    { int ln_ = F.tid & 63; asm volatile("" : "+v"(ln_)); F.lane = ln_; }
    LAS float* U = (LAS float*)F.lds;
    LAS float* GT = U + 16 * 256;
    LAS float* XL = GT + 32 * 256;
    LAS float* VL = XL + 19 * 256;
    const int tid = F.tid, lane = F.lane, w = F.wave, fr = lane & 15, fq = lane >> 4;
    const bf16* P = ((bf16*)(F.ws + WS_OV + OV_P)); bf16* Y = ((bf16*)(F.ws + WS_XN));
    bf16x8v Bf[FR_PER_WAVE];
    { const v4u* fp = (const v4u*)(F.ws + WS_FRAG + (size_t)layer * FRAG_LAYER_BYTES) + (size_t)w * FR_PER_WAVE * 64 + lane;
#pragma unroll
        for (int f = 0; f < FR_PER_WAVE; ++f) Bf[f] = __builtin_bit_cast(bf16x8v, fp[f * 64]); }
    const int gtp = w >> 2, gblk = w & 3;
    const int cg4 = 4 * (tid & 63);
    for (int tile = blockIdx.x; tile < 256; tile += GRID) {
        const int b = tile >> 5, c = tile & 31;
        const int s_begin = c == 0 ? 0 : NMETA + 64 * c, nsub = c == 0 ? 5 : 4;
        float hloc = 0.f, caloc = 1.f;
        for (int sub = 0; sub < nsub; ++sub) {
            const int s0 = s_begin + 16 * sub;
            unsigned zz = 0u; asm volatile("" : "+v"(zz));
            v4u cur[4], prv[4];
            { const int s = s0 + fr; const bf16* pc = P + (size_t)row_of(b, s) * NINP + PC_LO + 8 * fq; const bf16* pp = P + (size_t)row_of(b, s > 0 ? s - 1 : 0) * NINP + PC_LO + 8 * fq;
#pragma unroll
                for (int f = 0; f < 4; ++f) { cur[f] = *(const v4u*)(pc + 32 * f); prv[f] = *(const v4u*)(pp + 32 * f); if (s == 0) prv[f] = (v4u){zz, zz, zz, zz}; } }
            unsigned long long lx[3], lc[3], lxx[3], lb[2];
#pragma unroll
            for (int j = 0; j < 3; ++j) { const int idx = tid + 512 * j, r = idx >> 6, s = s0 - 3 + r; lx[j] = zz; lc[j] = zz; lxx[j] = zz;
                if (idx < 19 * 64 && s >= 0) { const bf16* pr = P + (size_t)row_of(b, s) * NINP + cg4; lx[j] = *(const unsigned long long*)(pr + PC_LRUX); lc[j] = *(const unsigned long long*)(pr + PC_SCC); lxx[j] = *(const unsigned long long*)(pr + PC_SCX); } }
#pragma unroll
            for (int j = 0; j < 2; ++j) { const int t = (tid >> 6) + 8 * j; lb[j] = *(const unsigned long long*)(P + (size_t)row_of(b, s0 + t) * NINP + PC_SCB + cg4); }
            { bf16x8v Af[4];
#pragma unroll
                for (int f = 0; f < 4; ++f) { float cv[8], pv[8], zv[8]; unpack8(cur[f], cv); unpack8(prv[f], pv);
                    const f32x4v m0 = *(const f32x4v*)(pk + PK_MU + 1536 + 32 * f + 8 * fq), m1 = *(const f32x4v*)(pk + PK_MU + 1536 + 32 * f + 8 * fq + 4);
#pragma unroll
                    for (int j = 0; j < 8; ++j) { const float mu = j < 4 ? m0[j & 3] : m1[j & 3]; const float z = cv[j] + (pv[j] - cv[j]) * mu; zv[j] = f == 0 ? tanhf_(z) : (f == 1 ? z : sigmoidf_(z)); }
                    Af[f] = pack8(zv); }
                const f32x4v zero = (f32x4v){0.f, 0.f, 0.f, 0.f};
                const size_t ro = (size_t)row_of(b, s0 + fr) * 512;
#pragma unroll
                for (int ct = 0; ct < 4; ++ct) { const int n = 64 * w + 16 * ct + 4 * fq;
                    const f32x4v aw = __builtin_amdgcn_mfma_f32_16x16x32_bf16(Bf[ct], Af[0], zero, 0, 0, 0);
                    const f32x4v aa = __builtin_amdgcn_mfma_f32_16x16x32_bf16(Bf[4 + ct], Af[1], zero, 0, 0, 0);
                    f32x4v ag = __builtin_amdgcn_mfma_f32_16x16x32_bf16(Bf[8 + 2 * ct], Af[2], zero, 0, 0, 0); ag = __builtin_amdgcn_mfma_f32_16x16x32_bf16(Bf[9 + 2 * ct], Af[3], ag, 0, 0, 0);
                    const f32x4v w04 = *(const f32x4v*)(pk + PK_W0 + n), a04 = *(const f32x4v*)(pk + PK_A0 + n);
                    float wd[4], av4[4];
#pragma unroll
                    for (int i = 0; i < 4; ++i) { const float wl = -softplusf_(-(w04[i] + aw[i])) - 0.5f, e = __expf(wl); wd[i] = e * (1.0f - e * (0.5f - e * (0.16666667f - e * (0.041666668f - e * 0.0083333338f)))); av4[i] = sigmoidf_(a04[i] + aa[i]); }
                    *(GAS unsigned long long*)((bf16*)(F.ws + WS_OV + OV_WDEC) + ro + n) = (unsigned long long)pk2(wd[0], wd[1]) | ((unsigned long long)pk2(wd[2], wd[3]) << 32);
                    *(GAS unsigned long long*)((bf16*)(F.ws + WS_OV + OV_ABUF) + ro + n) = (unsigned long long)pk2(av4[0], av4[1]) | ((unsigned long long)pk2(av4[2], av4[3]) << 32);
                    *(GAS unsigned long long*)((bf16*)(F.ws + WS_OV + OV_GBUF) + ro + n) = (unsigned long long)pk2(ag[0], ag[1]) | ((unsigned long long)pk2(ag[2], ag[3]) << 32); } }
            PSTAMP(0);
#pragma unroll
            for (int j = 0; j < 3; ++j) { const int idx = tid + 512 * j; if (idx < 19 * 64) { f32x4 a4, c4, x4; unpack4f(lx[j], a4); unpack4f(lc[j], c4); unpack4f(lxx[j], x4);
                *(LAS f32x4*)(XL + (idx >> 6) * 256 + cg4) = a4; *(LAS f32x4*)(VL + (idx >> 6) * 256 + cg4) = c4 * x4; } }
            __syncthreads();
            const float* pkc = pk + cg4;
            const f32x4 cb4 = *(const f32x4*)(pkc + PK_CONVB), cw0 = *(const f32x4*)(pkc + PK_CONVW), cw1 = *(const f32x4*)(pkc + PK_CONVW + 256), cw2 = *(const f32x4*)(pkc + PK_CONVW + 512), cw3 = *(const f32x4*)(pkc + PK_CONVW + 768);
            const f32x4 sw0 = *(const f32x4*)(pkc + PK_SCW), sw1 = *(const f32x4*)(pkc + PK_SCW + 256), sw2 = *(const f32x4*)(pkc + PK_SCW + 512), sg4 = *(const f32x4*)(pkc + PK_SCG);
#pragma unroll
            for (int j = 0; j < 2; ++j) { const int t = (tid >> 6) + 8 * j;
                const LAS float* xr = XL + t * 256 + cg4; const LAS float* vr = VL + (t + 1) * 256 + cg4;
                *(LAS f32x4*)(U + t * 256 + cg4) = cb4 + *(const LAS f32x4*)xr * cw0 + *(const LAS f32x4*)(xr + 256) * cw1 + *(const LAS f32x4*)(xr + 512) * cw2 + *(const LAS f32x4*)(xr + 768) * cw3;
                f32x4 b4; unpack4f(lb[j], b4);
                const f32x4 y4 = b4 * (*(const LAS f32x4*)vr * sw0 + *(const LAS f32x4*)(vr + 256) * sw1 + *(const LAS f32x4*)(vr + 512) * sw2);
                const float ss = red16((y4[0] * y4[0] + y4[1] * y4[1]) + (y4[2] * y4[2] + y4[3] * y4[3])); const float rs = rsqrtf(ss * (1.0f / 64.0f) + RMS_EPS);
                *(GAS unsigned long long*)(Y + (size_t)row_of(b, s0 + t) * D + 256 + cg4) = (unsigned long long)pk2(y4[0] * rs * sg4[0], y4[1] * rs * sg4[1]) | ((unsigned long long)pk2(y4[2] * rs * sg4[2], y4[3] * rs * sg4[3]) << 32); }
            PSTAMP(1);
            __syncthreads();
            { bf16x8v Al[2];
#pragma unroll
                for (int ks = 0; ks < 2; ++ks) { const LAS float* up = U + fr * 256 + 64 * gblk + 32 * ks + 8 * fq; const f32x4v u0 = *(const LAS f32x4v*)up, u1 = *(const LAS f32x4v*)(up + 4);
                    const float uv[8] = {u0.x, u0.y, u0.z, u0.w, u1.x, u1.y, u1.z, u1.w}; Al[ks] = pack8(uv); }
                const f32x4v zero = (f32x4v){0.f, 0.f, 0.f, 0.f};
#pragma unroll
                for (int ct = 0; ct < 4; ++ct) { const int j = 64 * gblk + 16 * ct + 4 * fq;
                    f32x4v ac = __builtin_amdgcn_mfma_f32_16x16x32_bf16(Bf[16 + 2 * ct], Al[0], zero, 0, 0, 0); ac = __builtin_amdgcn_mfma_f32_16x16x32_bf16(Bf[17 + 2 * ct], Al[1], ac, 0, 0, 0);
                    const f32x4v bias = *(const f32x4v*)(pk + (gtp ? PK_BX : PK_BA) + j);
                    f32x4v gv;
#pragma unroll
                    for (int i = 0; i < 4; ++i) gv[i] = sigmoidf_(ac[i] + bias[i]);
                    *(LAS f32x4v*)(GT + (gtp * 16 + fr) * 256 + j) = gv; } }
            PSTAMP(2);
            __syncthreads();
#pragma unroll
            for (int it = 0; it < 8; ++it) { const int idx = it * (NWAVES * 64) + tid, ch = idx & 255;
                const float r = GT[idx], ig = GT[16 * 256 + idx], u = U[idx];
                const float la = -8.0f * r * softplusf_(-pk[PK_LAM + ch]), a = __expf(la), x2 = 2.0f * la;
                const float om = x2 < -0.25f ? (1.0f - __expf(x2)) : -x2 * (1.0f + x2 * (0.5f + x2 * (0.16666667f + x2 * (0.041666668f + x2 * 0.0083333338f))));
                const float bt = __builtin_amdgcn_sqrtf(om) * (ig * u);
                GT[idx] = a; GT[16 * 256 + idx] = bt; }
            __syncthreads();
            PSTAMP(3);
            if (tid < 256) { const int j = tid;
#pragma unroll
                for (int t = 0; t < 16; ++t) { const float a = GT[t * 256 + j], bt = GT[(16 + t) * 256 + j];
                    hloc = a * hloc + bt; caloc *= a;
                    const size_t ro = (size_t)row_of(b, s0 + t) * 256 + j; ((float*)(F.ws + WS_OV + OV_HL))[ro] = hloc; ((float*)(F.ws + WS_OV + OV_CA))[ro] = caloc; } }
            PSTAMP(4);
        }
        if (tid < 256) { ((float*)(F.ws + WS_AGG))[((size_t)(b * 32 + c) * 256 + tid) * 2 + 0] = caloc; ((float*)(F.ws + WS_AGG))[((size_t)(b * 32 + c) * 256 + tid) * 2 + 1] = hloc; }
        __syncthreads();
    }
}

constexpr int SC_CH = 24, SC_NCH = TT / SC_CH, SC_LW = SC_CH / 4, SC_STEPF = 336, SC_BUFF = SC_CH * SC_STEPF;
constexpr int SC_VJ = (SC_LW * 16 + 63) / 64;
static_assert(SC_NCH * SC_CH == TT && 2 * SC_BUFF * 4 <= RING_BYTES, "scan geometry");
struct ScanRegs { unsigned rr[SC_LW + 1], kk[SC_LW + 1], aa[SC_LW], ww[SC_LW]; unsigned vc[SC_VJ], vp[SC_VJ]; };
__device__ __forceinline__ void scan_load(const Frame& F, ScanRegs& R, int b, int h, int q, int lw, int chunk, unsigned lane) {
    const int t0 = chunk * SC_CH + SC_LW * lw;
    const bf16* P = ((bf16*)(F.ws + WS_OV + OV_P)); const bf16* AB = ((bf16*)(F.ws + WS_OV + OV_ABUF)); const bf16* WD = ((bf16*)(F.ws + WS_OV + OV_WDEC));
#pragma unroll
    for (int m = 0; m < SC_LW + 1; ++m) { const int s = t0 - 1 + m;
        if (s >= 0) { const bf16* rowp = P + (size_t)row_of(b, s) * NINP + h * 64; R.rr[m] = rowp[PC_R + lane]; R.kk[m] = rowp[PC_K + lane]; } else { R.rr[m] = 0u; R.kk[m] = 0u; } }
#pragma unroll
    for (int i = 0; i < SC_LW; ++i) { const size_t ro = (size_t)row_of(b, t0 + i) * 512 + h * 64; R.aa[i] = (AB + ro)[lane]; R.ww[i] = (WD + ro)[lane]; }
#pragma unroll
    for (int j = 0; j < SC_VJ; ++j) { const int st0 = 4 * j; const unsigned st = st0 + (lane >> 4), rw = lane & 15; R.vc[j] = 0u; R.vp[j] = 0u;
        if (st < (unsigned)SC_LW) { const int s = t0 + (int)st; const unsigned col = PC_V + h * 64 + 16 * q + rw; R.vc[j] = P[(size_t)row_of(b, s) * NINP + col]; if (s > 0) R.vp[j] = P[(size_t)row_of(b, s - 1) * NINP + col]; } }
}
__device__ __forceinline__ void scan_emit(const ScanRegs& R, LAS float* buf, int lw, unsigned lane, float mu_r, float mu_k, float kk_n, float ka_n, float mu_v) {
    LAS float* lb = buf + SC_LW * lw * SC_STEPF + lane; asm volatile("" : "+v"(lb));
#pragma unroll
    for (int i = 0; i < SC_LW; ++i) { LAS float* sp = lb + i * SC_STEPF;
        const float rc = bf2f(R.rr[i + 1]), rp = bf2f(R.rr[i]), kc = bf2f(R.kk[i + 1]), kp = bf2f(R.kk[i]);
        const float zr = rc + (rp - rc) * mu_r, zk = kc + (kp - kc) * mu_k, a = bf2f(R.aa[i]);
        const float kv = zk * kk_n; const float ss = wave_sum_dpp(kv * kv); const float kn = kv * rsqrtf(fmaxf(ss, 1e-24f));
        sp[0] = zr; sp[64] = 1.0f - bf2f(R.ww[i]); sp[128] = zk * (1.0f + (a - 1.0f) * ka_n); sp[192] = -kn; sp[256] = kn * a; }
#pragma unroll
    for (int j = 0; j < SC_VJ; ++j) { const unsigned st = 4 * j + (lane >> 4), rw = lane & 15;
        if (st < (unsigned)SC_LW) { const float vc = bf2f(R.vc[j]), vp = bf2f(R.vp[j]); buf[(SC_LW * lw + st) * SC_STEPF + 320 + rw] = vc + (vp - vc) * mu_v; } }
}
typedef float f32x2 __attribute__((ext_vector_type(2)));
struct ScanOps { f32x4 r4, w4, k4, n4, b4; float v; };
__device__ __forceinline__ void scan_ops_load(ScanOps& o, const LAS float* lp, const LAS float* vp) {
    o.r4 = *(const LAS f32x4*)(lp); o.w4 = *(const LAS f32x4*)(lp + 64); o.k4 = *(const LAS f32x4*)(lp + 128);
    o.n4 = *(const LAS f32x4*)(lp + 192); o.b4 = *(const LAS f32x4*)(lp + 256); o.v = *vp; }
#define LO2(v) ((f32x2){(v).x, (v).y})
#define HI2(v) ((f32x2){(v).z, (v).w})
__device__ __forceinline__ float dot4p(const f32x2& a0, const f32x2& a1, const f32x4& b) { f32x2 t = a0 * LO2(b); t = a1 * HI2(b) + t; return t.x + t.y; }
__device__ __forceinline__ float scan_step(f32x2& S0, f32x2& S1, const ScanOps& o, float& q) {
    float p = dot4p(S0, S1, o.n4), y = q;
    p += dppf<0xB1>(p); y += dppf<0xB1>(y); p += dppf<0x4E>(p); y += dppf<0x4E>(y); p += dppf<0x141>(p); y += dppf<0x141>(y); p += dppf<0x128>(p); y += dppf<0x128>(y);
    const f32x2 vv = (f32x2){o.v, o.v}, sa = (f32x2){p, p};
    S0 = LO2(o.b4) * sa + (S0 * LO2(o.w4) + LO2(o.k4) * vv); S1 = HI2(o.b4) * sa + (S1 * HI2(o.w4) + HI2(o.k4) * vv);
    q = dot4p(S0, S1, o.r4);
    return y; }
constexpr int SC_YB = SC_CH * 16;
static_assert((2 * SC_BUFF + 2 * SC_YB + 256 + 256 + 4 * 64 * 33) * 4 <= RING_BYTES, "scan LDS");
__device__ __forceinline__ void scan_flush(const Frame& F, const LAS float* yb, int b, int h, int q, int chunk, int ltid) {
    bf16* Y = ((bf16*)(F.ws + WS_XN)); asm volatile("" : "+v"(ltid));
#pragma unroll
    for (int j = 0; j < (SC_YB + 255) / 256; ++j) { const int idx = ltid + 256 * j; if (idx < SC_YB) { const int st = idx >> 4, rw = idx & 15;
        Y[(size_t)row_of(b, chunk * SC_CH + st) * D + 512 + h * 64 + 16 * q + rw] = (bf16)f2bf(yb[idx]); } }
}
__device__ __forceinline__ void phase_scan(Frame& F, const float* pk, const float* const* in, int l) {
    { int ln_ = F.tid & 63; asm volatile("" : "+v"(ln_)); F.lane = ln_; }
    LAS float* buf0 = (LAS float*)F.lds; LAS float* buf1 = buf0 + SC_BUFF; LAS float* yb0 = buf1 + SC_BUFF; LAS float* yb1 = yb0 + SC_YB; LAS float* dummy = yb1 + SC_YB;
    const unsigned lane = F.lane; const int wave = F.wave;
    const int cv_split = CI_SET1, cv_n = CI_SET1 + (l + 1 < NLAYER ? CI_SET0 : 0);
    for (int item = blockIdx.x; item < 256; item += GRID) {
        const int b = item >> 5, h = (item >> 2) & 7, q = item & 3;
        if (wave >= 4) {
            const int lw = wave - 4, n = h * 64 + lane, ltid = lw * 64 + lane;
            const float mu_r = pk[PK_MU + n], mu_k = pk[PK_MU + 512 + n], kk_n = pk[PK_KK + n], ka_n = pk[PK_KA + n];
            const float mu_v = pk[PK_MU + 1024 + h * 64 + 16 * q + (lane & 15)];
            ScanRegs A, B;
            scan_load(F, A, b, h, q, lw, 0, lane); scan_load(F, B, b, h, q, lw, 1, lane);
            scan_emit(A, buf0, lw, lane, mu_r, mu_k, kk_n, ka_n, mu_v);
            __syncthreads();
            LAS float* cscr = dummy + 256 + lw * (64 * 33);
            int cv_it = (item * 4 + lw); bool cv_pending = false; ConvItem cvi; float cvv[32];
            cvi = conv_item(F.ws, in, l, 1, 0);
            for (int c = 0; c < SC_NCH; ++c) {
                if ((c & 1) == 0) { if (c + 2 < SC_NCH) scan_load(F, A, b, h, q, lw, c + 2, lane); if (c + 1 < SC_NCH) scan_emit(B, buf1, lw, lane, mu_r, mu_k, kk_n, ka_n, mu_v); }
                else              { if (c + 2 < SC_NCH) scan_load(F, B, b, h, q, lw, c + 2, lane); if (c + 1 < SC_NCH) scan_emit(A, buf0, lw, lane, mu_r, mu_k, kk_n, ka_n, mu_v); }
                if (c > 0) scan_flush(F, ((c - 1) & 1) ? yb1 : yb0, b, h, q, c - 1, ltid);
                if ((c & 7) == 1 && cv_pending) { conv_store(cvi, (int)lane, cvv, cscr); cv_pending = false; cv_it += 4 * 256; }
                if ((c & 7) == 0 && cv_it < cv_n) { cvi = cv_it < cv_split ? conv_item(F.ws, in, l, 1, cv_it) : conv_item(F.ws, in, l + 1, 0, cv_it - cv_split); conv_loads(cvi, (int)lane, cvv); cv_pending = true; }
                __syncthreads();
            }
            if (cv_pending) { conv_store(cvi, (int)lane, cvv, cscr); cv_it += 4 * 256; }
            for (; cv_it < cv_n; cv_it += 4 * 256) { cvi = cv_it < cv_split ? conv_item(F.ws, in, l, 1, cv_it) : conv_item(F.ws, in, l + 1, 0, cv_it - cv_split); conv_loads(cvi, (int)lane, cvv); conv_store(cvi, (int)lane, cvv, cscr); }
            scan_flush(F, ((SC_NCH - 1) & 1) ? yb1 : yb0, b, h, q, SC_NCH - 1, ltid);
        } else {
            const int kq = lane & 15, rowl = 4 * wave + (lane >> 4);
            f32x2 S0 = (f32x2){0.f, 0.f}, S1 = S0;
            __builtin_amdgcn_s_setprio(3);
            __syncthreads();
            for (int c = 0; c < SC_NCH; ++c) {
                const LAS float* bp = (c & 1) ? buf1 : buf0;
                LAS float* yw = kq == 0 ? (((c & 1) ? yb1 : yb0) + rowl) : (dummy + lane);
                const int ystep = kq == 0 ? 16 : 0;
                ScanOps oa, ob; float qp = 0.f;
                const LAS float* lp = bp + 4 * kq; const LAS float* vp = bp + 320 + rowl;
                asm volatile("" : "+v"(lp), "+v"(vp), "+v"(yw));
                scan_ops_load(oa, lp, vp);
                scan_ops_load(ob, lp + SC_STEPF, vp + SC_STEPF);
                (void)scan_step(S0, S1, oa, qp);
#pragma unroll 2
                for (int i = 1; i < SC_CH - 1; i += 2) {
                    scan_ops_load(oa, lp + (i + 1) * SC_STEPF, vp + (i + 1) * SC_STEPF);
                    const float y0 = scan_step(S0, S1, ob, qp); yw[(i - 1) * ystep] = y0;
                    scan_ops_load(ob, lp + (i + 2) * SC_STEPF, vp + (i + 2) * SC_STEPF);
                    const float y1 = scan_step(S0, S1, oa, qp); yw[i * ystep] = y1;
                }
                { const float y2 = scan_step(S0, S1, ob, qp); yw[(SC_CH - 2) * ystep] = y2; }
                yw[(SC_CH - 1) * ystep] = red16(qp);
                __syncthreads();
            }
            __builtin_amdgcn_s_setprio(0);
        }
        __syncthreads();
    }
}

__device__ __forceinline__ void unpack4(unsigned long long u, float (&v)[4]) { v[0] = bf2f((unsigned)u & 0xffffu); v[1] = bf2f(((unsigned)u >> 16)); v[2] = bf2f((unsigned)(u >> 32) & 0xffffu); v[3] = bf2f((unsigned)(u >> 48)); }
__device__ __forceinline__ void phase_mix_final(Frame& F, const float* pk) {
    { int ln_ = F.tid & 63; asm volatile("" : "+v"(ln_)); F.lane = ln_; }
    LAS float* carry = (LAS float*)F.lds;
    const int tid = F.tid, lane = F.lane, w = F.wave, rg = lane >> 4, kq = lane & 15;
    const bf16* P = ((bf16*)(F.ws + WS_OV + OV_P)); bf16* Y = ((bf16*)(F.ws + WS_XN));
    const bf16* AB = ((bf16*)(F.ws + WS_OV + OV_ABUF)); const bf16* GB = ((bf16*)(F.ws + WS_OV + OV_GBUF)); const float* HLp = ((float*)(F.ws + WS_OV + OV_HL)); const float* CAp = ((float*)(F.ws + WS_OV + OV_CA));
    const int n0 = w * 64 + 4 * kq;
    const f32x4 mu_r = *(const f32x4*)(pk + PK_MU + n0), mu_k = *(const f32x4*)(pk + PK_MU + 512 + n0), mu_v = *(const f32x4*)(pk + PK_MU + 1024 + n0);
    const f32x4 ka4 = *(const f32x4*)(pk + PK_KA + n0), rk4 = *(const f32x4*)(pk + PK_RK + n0), lw4 = *(const f32x4*)(pk + PK_LNW + n0), lb4 = *(const f32x4*)(pk + PK_LNB + n0);
    const f32x4 ng4 = w < 4 ? *(const f32x4*)(pk + PK_LNG + n0) : (f32x4){0.f, 0.f, 0.f, 0.f};
    for (int tile = blockIdx.x; tile < 256; tile += GRID) {
        const int b = tile >> 5, c = tile & 31;
        const int s_begin = c == 0 ? 0 : NMETA + 64 * c, ntok = c == 0 ? 80 : 64;
        if (tid < 256) {
            const float* ag = ((float*)(F.ws + WS_AGG)) + ((size_t)(b * 32) * 256 + tid) * 2; float ca[32], hh[32];
#pragma unroll
            for (int c2 = 0; c2 < 31; ++c2) { ca[c2] = 0.f; hh[c2] = 0.f; if (c2 < c) { const f32x2v_ t2 = *(const f32x2v_*)(ag + (size_t)c2 * 512); ca[c2] = t2.x; hh[c2] = t2.y; } }
            float hc = 0.f;
#pragma unroll
            for (int c2 = 0; c2 < 31; ++c2) if (c2 < c) hc = ca[c2] * hc + hh[c2];
            carry[tid] = hc; }
        __syncthreads();
        f32x4 cr4 = (f32x4){0.f, 0.f, 0.f, 0.f}; if (w < 4) cr4 = *(const LAS f32x4*)(carry + n0);
        for (int tg = (c == 0 && b != 0) ? NMETA : 0; tg < ntok; tg += 16) {
            unsigned long long rc[4], kc[4], vc[4], rp[4], kp[4], vp[4], av[4], yv[4], gv[4], lg[4]; f32x4 hl[4], cav[4];
#pragma unroll
            for (int u = 0; u < 4; ++u) { const int s = s_begin + tg + 4 * u + rg; const size_t ro = (size_t)row_of(b, s); const bf16* pr = P + ro * NINP + n0;
                rc[u] = *(const unsigned long long*)(pr + PC_R); kc[u] = *(const unsigned long long*)(pr + PC_K); vc[u] = *(const unsigned long long*)(pr + PC_V); rp[u] = 0ull; kp[u] = 0ull; vp[u] = 0ull;
                if (s > 0) { const bf16* pp = P + (size_t)row_of(b, s - 1) * NINP + n0; rp[u] = *(const unsigned long long*)(pp + PC_R); kp[u] = *(const unsigned long long*)(pp + PC_K); vp[u] = *(const unsigned long long*)(pp + PC_V); }
                av[u] = *(const unsigned long long*)(AB + ro * 512 + n0); yv[u] = *(const unsigned long long*)(Y + ro * D + 512 + n0); gv[u] = *(const unsigned long long*)(GB + ro * 512 + n0);
                lg[u] = 0ull; hl[u] = (f32x4){0.f, 0.f, 0.f, 0.f}; cav[u] = hl[u];
                if (w < 4) { lg[u] = *(const unsigned long long*)(pr + PC_LRUG); hl[u] = *(const f32x4*)(HLp + ro * 256 + n0); cav[u] = *(const f32x4*)(CAp + ro * 256 + n0); } }
#pragma unroll
            for (int u = 0; u < 4; ++u) { const int s = s_begin + tg + 4 * u + rg; const size_t ro = (size_t)row_of(b, s);
                float r_c[4], k_c[4], v_c[4], r_p[4], k_p[4], v_p[4], a4[4], y4[4], g4[4];
                unpack4(rc[u], r_c); unpack4(kc[u], k_c); unpack4(vc[u], v_c); unpack4(rp[u], r_p); unpack4(kp[u], k_p); unpack4(vp[u], v_p); unpack4(av[u], a4); unpack4(yv[u], y4); unpack4(gv[u], g4);
                float zv[4], cbp = 0.f, ysum = 0.f;
#pragma unroll
                for (int j = 0; j < 4; ++j) { const float zr = r_c[j] + (r_p[j] - r_c[j]) * mu_r[j], zk = k_c[j] + (k_p[j] - k_c[j]) * mu_k[j]; zv[j] = v_c[j] + (v_p[j] - v_c[j]) * mu_v[j];
                    cbp += zr * (zk * (1.0f + (a4[j] - 1.0f) * ka4[j])) * rk4[j]; ysum += y4[j]; }
                const float cb = red16(cbp), mean = red16(ysum) * (1.0f / 64.0f);
                float d4[4], vs = 0.f;
#pragma unroll
                for (int j = 0; j < 4; ++j) { d4[j] = y4[j] - mean; vs += d4[j] * d4[j]; }
                const float rstd = rsqrtf(red16(vs) * (1.0f / 64.0f) + LNX_EPS);
                float o4[4];
#pragma unroll
                for (int j = 0; j < 4; ++j) o4[j] = (d4[j] * rstd * lw4[j] + lb4[j] + cb * zv[j]) * g4[j];
                *(GAS unsigned long long*)(Y + ro * D + 512 + n0) = (unsigned long long)pk2(o4[0], o4[1]) | ((unsigned long long)pk2(o4[2], o4[3]) << 32);
                if (w < 4) { float l4[4], yy[4], ss = 0.f; unpack4(lg[u], l4);
#pragma unroll
                    for (int j = 0; j < 4; ++j) { yy[j] = gelu_tanh(l4[j]) * (hl[u][j] + cav[u][j] * cr4[j]); ss += yy[j] * yy[j]; }
                    const float rs = rsqrtf(red16(ss) * (1.0f / 64.0f) + RMS_EPS);
                    *(GAS unsigned long long*)(Y + ro * D + n0) = (unsigned long long)pk2(yy[0] * rs * ng4[0], yy[1] * rs * ng4[1]) | ((unsigned long long)pk2(yy[2] * rs * ng4[2], yy[3] * rs * ng4[3]) << 32); } }
        }
        __syncthreads();
    }
}
#ifndef MK_PER_PHASE
#define MK_PER_PHASE 0
#endif
constexpr int REP_GEMM = 1, REP_PREP = 1, REP_SCAN = 1, REP_CONV = 1;
constexpr int PH_PER_LAYER = 12, N_PHASES = 1 + NLAYER * PH_PER_LAYER;
struct Args { const float* in[30]; float* out; unsigned char* ws; int ph_lo, ph_hi; };
static_assert(sizeof(Args) == 30 * 8 + 8 + 8 + 4 + 4, "Args has no padding");

__global__ void __launch_bounds__(NWAVES * 64, 2) hybrid_fwd(Args args) {
    extern __shared__ __attribute__((aligned(16))) unsigned char lds[];
    Frame F;
    F.lds = (LAS unsigned char*)lds;
    F.tid = threadIdx.x; F.lane = F.tid & 63; F.wave = 0;
    { const int bx = blockIdx.x; F.vcu = (bx % 8) * (GRID / 8) + bx / 8; }
    unsigned char* ws = args.ws;
    F.ws = ws; F.x = args.in[0]; F.meta = args.in[1]; F.out = args.out;
    volatile LAS unsigned* MISC = (volatile LAS unsigned*)(F.lds + MISC_OFF);
    for (int u = F.tid; u < (LDS_BYTES - LDSCTL_OFF) / 4; u += NWAVES * 64) ((LAS unsigned*)(F.lds + LDSCTL_OFF))[u] = 0u;
    __syncthreads();
    { const unsigned simd = ((unsigned)__builtin_amdgcn_s_getreg((1 << 11) | (4 << 6) | 4)) & 3u;
      LAS unsigned* tkw = (LAS unsigned*)(F.lds + MISC_OFF) + 12;
      unsigned tk = 0u, tg = 0u; if (vlane() == 0) { tk = __hip_atomic_fetch_add(tkw + simd, 1u, __ATOMIC_RELAXED, __HIP_MEMORY_SCOPE_WORKGROUP); tg = __hip_atomic_fetch_add(tkw + 4, 1u, __ATOMIC_RELAXED, __HIP_MEMORY_SCOPE_WORKGROUP); }
      tk = (unsigned)__builtin_amdgcn_readfirstlane(tk); tg = (unsigned)__builtin_amdgcn_readfirstlane(tg);
      __syncthreads();
      const bool two_each = tkw[0] == 2u && tkw[1] == 2u && tkw[2] == 2u && tkw[3] == 2u;
      F.wave = two_each ? (int)(simd + 4u * tk) : (int)tg; }
    F.lane = vlane(); F.tid = F.wave * 64 + F.lane;
    XcdBarrier bar; bar.bar = (unsigned*)(ws + WS_CTL) + CW_BAR; bar.x = 0; bar.st = nullptr;
    if (!MK_PER_PHASE) bar = xcd_barrier_post((unsigned*)(ws + WS_CTL) + CW_BAR, MISC + 8, F.tid == 0);
    const int lo = args.ph_lo, hi = args.ph_hi;
    unsigned long long pr_prev = 0ull; F.pr_acc = 0ull; F.pr_sub = 0ull; F.ph = 0; if (PROBE_MASK) pr_prev = __builtin_amdgcn_s_memrealtime();
#pragma unroll 1
    for (int ph = lo; ph < hi; ++ph) {
        if (PROBE_MASK) F.ph = ph;
        { GAS unsigned char* wsg = (GAS unsigned char*)args.ws; asm volatile("" : "+s"(wsg)); F.ws = (unsigned char*)wsg; }
        { int t_ = F.wave * 64 + vlane(); asm volatile("" : "+v"(t_)); F.tid = t_; }
        if (ph == 0) { phase_init(F); phase_pack(F, args.in); phase_frag(F, args.in); for (int rep_ = 0; rep_ < REP_CONV; ++rep_) phase_convert(F, args.in, 0, 0); }
        else {
            const int l = (ph - 1) / PH_PER_LAYER, k = (ph - 1) - l * PH_PER_LAYER;
            if (k == 0 || k == 1 || k == 3 || k == 7 || k == 9 || k == 10) {
                unsigned char* w = F.ws;
                const bool up = (k == 0 || k == 9), down = (k == 1 || k == 10);
                const bool lastl = l + 1 == NLAYER;
                const bf16* hcur = (lastl && k == 9) ? (const bf16*)(w + WS_OV + OV_HTMP) : (const bf16*)F.out;
                const bf16* A = down ? (const bf16*)(w + WS_OV + OV_HID) : (k == 7 ? (const bf16*)(w + WS_XN) : hcur);
                const bf16* Am = (down || k == 7) ? A : (const bf16*)(w + WS_HMETA) - (size_t)MX * D;
                const bf16* B = (const bf16*)(w + WS_WB + (k == 0 ? WB_W1IN : k == 1 ? WB_W1OUT : k == 3 ? WB_WIN : k == 7 ? WB_WOUT : k == 9 ? WB_W2IN : WB_W2OUT));
                const int N = up ? 2 * FF : (k == 3 ? NINP : D), K = down ? FF : D;
                const float* rs = nullptr;
                pg8::EpiAny E; E.mode = up ? 0 : 1; E.O = w + WS_OV + (up ? OV_HID : k == 3 ? OV_P : k == 7 ? OV_RAWM : OV_RAWF); E.ldo = up ? FF : (k == 3 ? NINP : D); E.rs = rs;
                const int gwv = F.vcu * NWAVES + F.wave;
                if (k == 3) meta_gemm(F, Am, B, K, N, 1, w + WS_OV + OV_P, NINP, 1, gwv, rs);
                else if (!up) meta_gemm(F, Am, B, K, N, 2, w + WS_MSLAB, D, down ? 8 : 4, gwv, nullptr);
                pg8::Gemm g{A, B, MX, N, K, K}; pg8::StaticOrder S; S.init(MX, N, GRID, (int)blockIdx.x);
                for (int rep_ = 0; rep_ < REP_GEMM; ++rep_) pg8::gemm_phase<pg8::EpiAny, pg8::StaticOrder, true, true>(F.lds, g, S, E, F.tid);
                if (up) meta_gemm(F, Am, B, K, N, 0, w + WS_OV + OV_HID, FF, 1, (int)blockIdx.x >= 128 ? ((int)blockIdx.x - 128) * NWAVES + F.wave : -1, rs);
            } else if (k == 2 || k == 8 || k == 11) {
                const float* ng = args.in[2] + (size_t)l * 6 * D;
                const bool last = l + 1 == NLAYER;
                const float* g_post = ng + (k == 2 ? 1 : k == 8 ? 3 : 5) * D;
                bf16* h16 = (bf16*)F.out; bf16* htmp = (bf16*)(F.ws + WS_OV + OV_HTMP);
                PostIO io; io.raw16 = (const bf16*)(F.ws + WS_OV + (k == 8 ? OV_RAWM : OV_RAWF));
                io.hin16 = (last && k == 11) ? htmp : h16; io.hout16 = (last && k == 8) ? htmp : h16; io.out32 = (last && k == 11) ? F.out : nullptr; io.nks = k == 8 ? 4 : 8;
                phase_post(F, io, k == 8 ? 1.0f : 0.5f, g_post, !(last && k == 11));
            } else if (k == 4) { for (int rep_ = 0; rep_ < REP_PREP; ++rep_) phase_mix_prep(F, pack_of(F, l), l); }
            else if (k == 5) { for (int rep_ = 0; rep_ < REP_SCAN; ++rep_) phase_scan(F, pack_of(F, l), args.in, l); }
            else { phase_mix_final(F, pack_of(F, l)); }
        }
        if (ph + 1 < hi) xcd_barrier(bar, F.tid == 0);
        if (PROBE_MASK) { const unsigned long long t = __builtin_amdgcn_s_memrealtime(); if (PROBE_SUB < 0 && ((PROBE_MASK >> ph) & 1u)) F.pr_acc += t - pr_prev; pr_prev = t; F.pr_sub = t; }
    }
    if (PROBE_MASK && blockIdx.x == 0 && F.tid == 0) { const unsigned long long t0 = __builtin_amdgcn_s_memrealtime(); while (__builtin_amdgcn_s_memrealtime() - t0 < PROBE_AMP * F.pr_acc) __builtin_amdgcn_s_sleep(8); }
}

extern "C" void kernel_launch(void* const* d_in, const int* in_sizes, int n_in, void* d_out, int out_size, void* d_ws, size_t ws_size, hipStream_t stream) {
    static int grid = 0;
    if (grid == 0) {
        if (n_in != 30 || in_sizes[0] != MX * D || out_size != MX * D || ws_size < WS_END) { fprintf(stderr, "kernel_launch: unexpected shapes: n_in %d in0 %d out %d ws %zu\n", n_in, n_in > 0 ? in_sizes[0] : -1, out_size, ws_size); grid = -1; return; }
        int dev = 0, cus = 0, per_cu = 0;
        if (hipGetDevice(&dev) != hipSuccess || hipDeviceGetAttribute(&cus, hipDeviceAttributeMultiprocessorCount, dev) != hipSuccess) { grid = -1; return; }
        if (hipFuncSetAttribute((const void*)hybrid_fwd, hipFuncAttributeMaxDynamicSharedMemorySize, LDS_BYTES) != hipSuccess) { fprintf(stderr, "kernel_launch: hipFuncSetAttribute failed\n"); grid = -1; return; }
        if (hipOccupancyMaxActiveBlocksPerMultiprocessor(&per_cu, (const void*)hybrid_fwd, NWAVES * 64, LDS_BYTES) != hipSuccess || per_cu < 1) { fprintf(stderr, "kernel_launch: occupancy query says %d blocks per CU\n", per_cu); grid = -1; (void)hipGetLastError(); return; }
        (void)hipGetLastError();
        if (cus < GRID) { fprintf(stderr, "kernel_launch: this kernel needs %d CUs (one resident workgroup each), the device has %d\n", GRID, cus); grid = -1; return; }
        grid = GRID;
    }
    if (grid < 0) return;
    if (hipMemsetAsync((char*)d_ws + WS_CTL, 0, CTL_ZERO_BYTES, stream) != hipSuccess) return;
    Args a{};
    for (int i = 0; i < 30; ++i) a.in[i] = (const float*)d_in[i];
    a.out = (float*)d_out; a.ws = (unsigned char*)d_ws;
#if MK_PER_PHASE
    for (int p = 0; p < N_PHASES; ++p) { a.ph_lo = p; a.ph_hi = p + 1; hipLaunchKernelGGL(hybrid_fwd, dim3(grid), dim3(NWAVES * 64), LDS_BYTES, stream, a); }
#else
    a.ph_lo = 0; a.ph_hi = N_PHASES;
    hipLaunchKernelGGL(hybrid_fwd, dim3(grid), dim3(NWAVES * 64), LDS_BYTES, stream, a);
#endif
}
```

```cpp
#include <hip/hip_runtime.h>
#include <cstdio>
#include <cstdint>
namespace pg8 {
#define PG8_LAS __attribute__((address_space(3)))
typedef unsigned short bf16_t;
typedef short bf16x8 __attribute__((ext_vector_type(8)));
typedef float f32x4 __attribute__((ext_vector_type(4)));
typedef unsigned u32x4 __attribute__((ext_vector_type(4)));
constexpr int BM = 256, BK = 64, HALF = 128, HTB = HALF * BK * 2  , STAGE_BYTES = 8 * HTB, NXCD = 8, WGM = 8;

__host__ __device__ __forceinline__ int lds_byte(int r, int c) { const int st = (r >> 4) * 2 + (c >> 5), rr = r & 15, cc = c & 31, ob = rr * 64 + cc * 2; return st * 1024 + (ob ^ (((ob >> 9) & 1) << 5)); }
__host__ __device__ __forceinline__ void stage_rc(int b, int& R, int& C) { const int st = b / 1024, sb = b % 1024, swz = sb ^ (((sb >> 9) & 1) << 5); R = (st >> 1) * 16 + swz / 64; C = (st & 1) * 32 + (swz % 64) / 2; }
__host__ __device__ __forceinline__ int perm32(int rho) { const int n = rho >> 4, i = rho & 15; return 8 * (i >> 2) + 4 * n + (i & 3); }

struct Unit { int pm, pn; };
struct Gemm { const bf16_t* A; const bf16_t* Bt; int M, N, K, ld; };

struct StaticOrder {
    int nM, nN, nwg, G, c, one_pn;
    __host__ __device__ void init(int M, int N, int G_, int c_) { nM = M / BM; nN = N / BM; nwg = nM * nN; G = G_; c = c_; one_pn = -1; }
    __host__ __device__ bool next(int i, Unit& u) const {
        if (one_pn != -1) { if (i != 0 || one_pn < 0) return false; u.pm = 0; u.pn = one_pn; return true; }
        const long L = (long)i * G + c; if (L >= nwg) return false;
        int wgid = (int)L; { const int q = nwg / NXCD, r = nwg % NXCD, xcd = wgid % NXCD, off = wgid / NXCD; wgid = (xcd < r ? xcd * (q + 1) : r * (q + 1) + (xcd - r) * q) + off; }
        const int nig = WGM * nN, gid = wgid / nig, fm = gid * WGM, gsz = (nM - fm) < WGM ? (nM - fm) : WGM;
        u.pm = fm + ((wgid % nig) % gsz); u.pn = (wgid % nig) / gsz; return true;
    }
    __device__ __forceinline__ void a_ready(const Unit&) const {}
    __device__ __forceinline__ void done(const Unit&) const {}
};
__device__ __forceinline__ unsigned cvt_pk_bf16(float lo, float hi) { unsigned r; asm volatile("v_cvt_pk_bf16_f32 %0, %1, %2" : "=v"(r) : "v"(lo), "v"(hi)); return r; }
typedef float f32x2 __attribute__((ext_vector_type(2)));
struct EpiSwiGLU {
    static constexpr bool PERM = true, AFTER_DRAIN = false;
    bf16_t* O; int ldo; const PG8_LAS float* rst;
    __device__ __forceinline__ void operator()(const f32x4 (&acc)[2][2][4][2], const Unit& u, int wr, int wc, int fr, int fq) const {
        const int row0 = u.pm * BM + wr * 64 + fr, col0 = u.pn * HALF + wc * 32 + 8 * fq;
#pragma unroll
        for (int ai = 0; ai < 2; ++ai)
#pragma unroll
            for (int m = 0; m < 4; ++m) { bf16_t* rowp = O + (size_t)(row0 + ai * HALF + m * 16) * ldo + col0; const float sc = rst ? rst[64 * ai + 16 * m + fr] : 1.0f;
                float hv[8];
#pragma unroll
                for (int n = 0; n < 2; ++n)
#pragma unroll
                    for (int j = 0; j < 4; ++j) { const float g = acc[ai][0][m][n][j] * sc, up = acc[ai][1][m][n][j] * sc; hv[n * 4 + j] = g * __builtin_amdgcn_rcpf(1.0f + __expf(-g)) * up; }
                u32x4 w; w.x = cvt_pk_bf16(hv[0], hv[1]); w.y = cvt_pk_bf16(hv[2], hv[3]); w.z = cvt_pk_bf16(hv[4], hv[5]); w.w = cvt_pk_bf16(hv[6], hv[7]);
                *(u32x4*)rowp = w; }
    }
};
struct EpiStoreBf16 {
    static constexpr bool PERM = true, AFTER_DRAIN = false;
    bf16_t* O; int ldc; const PG8_LAS float* rst;
    __device__ __forceinline__ void operator()(const f32x4 (&acc)[2][2][4][2], const Unit& u, int wr, int wc, int fr, int fq) const {
        const int row0 = u.pm * BM + wr * 64 + fr, col0 = u.pn * BM + wc * 32 + 8 * fq;
#pragma unroll
        for (int ai = 0; ai < 2; ++ai)
#pragma unroll
            for (int m = 0; m < 4; ++m) { bf16_t* rowp = O + (size_t)(row0 + ai * HALF + m * 16) * ldc + col0; const float sc = rst ? rst[64 * ai + 16 * m + fr] : 1.0f;
#pragma unroll
                for (int bj = 0; bj < 2; ++bj) { const f32x4 v0 = acc[ai][bj][m][0] * sc, v1 = acc[ai][bj][m][1] * sc;
                    u32x4 w; w.x = cvt_pk_bf16(v0[0], v0[1]); w.y = cvt_pk_bf16(v0[2], v0[3]); w.z = cvt_pk_bf16(v1[0], v1[1]); w.w = cvt_pk_bf16(v1[2], v1[3]);
                    *(u32x4*)(rowp + bj * HALF) = w; } }
    }
};
struct EpiF32 {
    static constexpr bool PERM = false, AFTER_DRAIN = false;
    float* C; int ldc;
    __device__ __forceinline__ void operator()(const f32x4 (&acc)[2][2][4][2], const Unit& u, int wr, int wc, int fr, int fq) const {
        const int row0 = u.pm * BM + wr * 64 + fr, col0 = u.pn * BM + wc * 32 + 4 * fq;
#pragma unroll
        for (int ai = 0; ai < 2; ++ai)
#pragma unroll
            for (int m = 0; m < 4; ++m) { float* rowp = C + (size_t)(row0 + ai * HALF + m * 16) * ldc + col0;
#pragma unroll
                for (int bj = 0; bj < 2; ++bj)
#pragma unroll
                    for (int n = 0; n < 2; ++n) *(f32x4*)(rowp + bj * HALF + n * 16) = acc[ai][bj][m][n]; }
    }
};
struct EpiAny {
    static constexpr bool PERM = true, AFTER_DRAIN = false;
    int mode; void* O; int ldo; const float* rs;
    __device__ __forceinline__ void row_scale_issue(const Unit& u, int wr, int fr, int fq, float& v0, float& v1) const {
        if (rs) { const float* p = rs + u.pm * BM + wr * 64 + fr + (fq >> 1) * HALF + (fq & 1) * 32; v0 = p[0]; v1 = p[16]; } }
    __device__ __forceinline__ void row_scale_park(PG8_LAS unsigned char* tab, int wid, int lane, float v0, float v1) const {
        if (rs) { PG8_LAS float* t = (PG8_LAS float*)(tab + wid * 512) + ((lane >> 5) * 64 + ((lane >> 4) & 1) * 32 + (lane & 15)); t[0] = v0; t[16] = v1; asm volatile("s_waitcnt lgkmcnt(0)" ::: "memory"); } }
    __device__ __forceinline__ void operator()(f32x4 (&acc)[2][2][4][2], const Unit& u, int wr, int wc, int fr, int fq, PG8_LAS unsigned char* tab, int wid) const {
        const PG8_LAS float* rst = rs ? (const PG8_LAS float*)(tab + wid * 512) : nullptr;
        if (mode == 0) { EpiSwiGLU E{(bf16_t*)O, ldo, rst}; E(acc, u, wr, wc, fr, fq); }
        else if (mode == 1) { EpiStoreBf16 E{(bf16_t*)O, ldo, rst}; E(acc, u, wr, wc, fr, fq); }
        else { float* C = (float*)O; const int row0 = u.pm * BM + wr * 64 + fr, col0 = u.pn * BM + wc * 32 + 8 * fq;
#pragma unroll
            for (int ai = 0; ai < 2; ++ai)
#pragma unroll
                for (int m = 0; m < 4; ++m) { float* rowp = C + (size_t)(row0 + ai * HALF + m * 16) * ldo + col0;
#pragma unroll
                    for (int bj = 0; bj < 2; ++bj)
#pragma unroll
                        for (int n = 0; n < 2; ++n) *(f32x4*)(rowp + bj * HALF + n * 4) = acc[ai][bj][m][n]; } }
    }
};
template <class Epi, class Sched, bool ALIGN_EPI = false, bool SP2 = false>
__device__ __forceinline__ void gemm_phase(PG8_LAS unsigned char* lds, const Gemm g, const Sched& S, const Epi& E, int tid_in  ) {
    int tid_ = tid_in; asm volatile("" : "+v"(tid_));
    const int tid = tid_, wid = __builtin_amdgcn_readfirstlane(tid >> 6), lane = tid & 63, wr = wid >> 2, wc = wid & 3, fr = lane & 15, fq = lane >> 4;
    const int K = g.K, LD = g.ld, nt = K / BK;
    unsigned voffA[2], voffB[2];
#pragma unroll
    for (int i = 0; i < 2; ++i) { int R, C; stage_rc(tid * 16 + i * 8192, R, C); const int Rb = Epi::PERM ? ((R & ~31) + perm32(R & 31)) : R;
        voffA[i] = (unsigned)(R * LD + C) * 2u; voffB[i] = (unsigned)(Rb * LD + C) * 2u; }
    const size_t kstep = (size_t)(BK * 2);
    const size_t hstep = (size_t)HALF * LD * 2;
    const size_t tstep = 2 * hstep;
    const unsigned ldsw = (unsigned)wid * 1024u;
    const int aoff = lds_byte(wr * 64 + fr, fq * 8), boff = lds_byte(wc * 32 + fr, fq * 8);
#define PG8_SA(b, h) (((b) * 2 + (h)) * HTB)
#define PG8_SB(b, h) ((4 + (b) * 2 + (h)) * HTB)
#define PG8_STAGE(bufoff, gbase, voff) do { _Pragma("unroll") for (int _i = 0; _i < 2; ++_i) \
        __builtin_amdgcn_global_load_lds((const unsigned*)((const char*)(gbase) + (voff)[_i]), (PG8_LAS unsigned*)(lds + (bufoff) + ldsw + _i * 8192), 16, 0, 0); } while (0)
#define PG8_LDA(dst, b, h) do { _Pragma("unroll") for (int m = 0; m < 4; ++m) _Pragma("unroll") for (int k = 0; k < 2; ++k) dst[m][k] = *(const PG8_LAS bf16x8*)(lds + PG8_SA(b, h) + aoff + m * 2048 + k * 1024); } while (0)
#define PG8_LDB(dst, b, h) do { _Pragma("unroll") for (int n = 0; n < 2; ++n) _Pragma("unroll") for (int k = 0; k < 2; ++k) dst[n][k] = *(const PG8_LAS bf16x8*)(lds + PG8_SB(b, h) + boff + n * 2048 + k * 1024); } while (0)
#define PG8_MMA(ai, bj, At, Bt) do { __builtin_amdgcn_s_setprio(1); _Pragma("unroll") for (int m = 0; m < 4; ++m) _Pragma("unroll") for (int n = 0; n < 2; ++n) _Pragma("unroll") for (int k = 0; k < 2; ++k) \
        acc[ai][bj][m][n] = __builtin_amdgcn_mfma_f32_16x16x32_bf16(Bt[n][k], At[m][k], acc[ai][bj][m][n], 0, 0, 0); __builtin_amdgcn_s_setprio(0); } while (0)
#define PG8_WAIT_V(n) asm volatile("s_waitcnt vmcnt(" #n ")" ::: "memory")
#define PG8_WAIT_L(n) asm volatile("s_waitcnt lgkmcnt(" #n ")" ::: "memory")
#define PG8_BAR __builtin_amdgcn_s_barrier()
#define PG8_SCHED __builtin_amdgcn_sched_barrier(0)
    Unit cur, nxt; int ui = 0;
    if (!S.next(0, cur)) return;
    f32x4 acc[2][2][4][2];
#pragma unroll
    for (int a = 0; a < 2; ++a)
#pragma unroll
        for (int b = 0; b < 2; ++b)
#pragma unroll
            for (int m = 0; m < 4; ++m)
#pragma unroll
                for (int n = 0; n < 2; ++n) acc[a][b][m][n] = (f32x4){0.f, 0.f, 0.f, 0.f};
    bf16x8 At[4][2], B0[2][2], B1[2][2];
    const char* cA = (const char*)g.A + (size_t)cur.pm * tstep; const char* cB = (const char*)g.Bt + (size_t)cur.pn * tstep;
    S.a_ready(cur);
    if constexpr (SP2) {
        PG8_STAGE(PG8_SB(0, 0), cB, voffB); PG8_STAGE(PG8_SB(0, 1), cB + hstep, voffB); PG8_STAGE(PG8_SA(0, 0), cA, voffA); PG8_STAGE(PG8_SA(0, 1), cA + hstep, voffA);
        if (wr == 1) PG8_BAR;
        PG8_WAIT_V(2); PG8_BAR;
        PG8_STAGE(PG8_SB(1, 0), cB + kstep, voffB); PG8_STAGE(PG8_SA(1, 0), cA + kstep, voffA); PG8_STAGE(PG8_SB(1, 1), cB + hstep + kstep, voffB);
        PG8_WAIT_V(6); PG8_BAR;
    } else {
        PG8_STAGE(PG8_SB(0, 0), cB, voffB); PG8_STAGE(PG8_SA(0, 0), cA, voffA); PG8_STAGE(PG8_SB(0, 1), cB + hstep, voffB); PG8_STAGE(PG8_SA(0, 1), cA + hstep, voffA);
        if (wr == 1) PG8_BAR;
        PG8_WAIT_V(4); PG8_BAR;
        PG8_STAGE(PG8_SB(1, 0), cB + kstep, voffB); PG8_STAGE(PG8_SA(1, 0), cA + kstep, voffA); PG8_STAGE(PG8_SB(1, 1), cB + hstep + kstep, voffB);
        PG8_WAIT_V(6); PG8_BAR;
    }
    for (;;) {
        const bool has_next = S.next(ui + 1, nxt);
        { float rsv0 = 1.0f, rsv1 = 1.0f; E.row_scale_issue(cur, wr, fr, fq, rsv0, rsv1); E.row_scale_park(lds + STAGE_BYTES, wid, lane, rsv0, rsv1); }
        const char* nA = has_next ? (const char*)g.A + (size_t)nxt.pm * tstep : cA; const char* nB = has_next ? (const char*)g.Bt + (size_t)nxt.pn * tstep : cB;
        for (int t = 0; t < nt; t += 2) {
            const bool last = (t == nt - 2);
            const char* a1 = cA + (size_t)(t + 1) * kstep;
            const char* a2 = last ? nA : cA + (size_t)(t + 2) * kstep; const char* b2 = last ? nB : cB + (size_t)(t + 2) * kstep;
            const char* a3 = a2 + kstep; const char* b3 = b2 + kstep;
            if (last && has_next) S.a_ready(nxt);
            if constexpr (SP2) {
            PG8_LDB(B0, 0, 0); PG8_LDB(B1, 0, 1); PG8_SCHED; PG8_LDA(At, 0, 0); PG8_STAGE(PG8_SA(1, 1), a1 + hstep, voffA);
            PG8_WAIT_V(8); PG8_WAIT_L(0); PG8_BAR; PG8_MMA(0, 0, At, B0); PG8_MMA(0, 1, At, B1); PG8_BAR; PG8_SCHED;
            PG8_LDA(At, 0, 1); PG8_STAGE(PG8_SB(0, 0), b2, voffB); PG8_STAGE(PG8_SB(0, 1), b2 + hstep, voffB); PG8_STAGE(PG8_SA(0, 0), a2, voffA);
            PG8_WAIT_V(8); PG8_WAIT_L(0); PG8_BAR; PG8_MMA(1, 0, At, B0); PG8_MMA(1, 1, At, B1); PG8_BAR; PG8_SCHED;
            PG8_LDB(B0, 1, 0); PG8_LDB(B1, 1, 1); PG8_SCHED; PG8_LDA(At, 1, 0); PG8_STAGE(PG8_SA(0, 1), a2 + hstep, voffA);
            PG8_WAIT_V(8); PG8_WAIT_L(0); PG8_BAR; PG8_MMA(0, 0, At, B0); PG8_MMA(0, 1, At, B1); PG8_BAR; PG8_SCHED;
            PG8_LDA(At, 1, 1); PG8_STAGE(PG8_SB(1, 0), b3, voffB); PG8_STAGE(PG8_SB(1, 1), b3 + hstep, voffB); PG8_STAGE(PG8_SA(1, 0), a3, voffA);
            PG8_WAIT_V(8); PG8_WAIT_L(0); PG8_BAR; PG8_MMA(1, 0, At, B0); PG8_MMA(1, 1, At, B1); PG8_BAR; PG8_SCHED;
            } else {
            PG8_LDB(B0, 0, 0); PG8_SCHED; PG8_LDA(At, 0, 0); PG8_STAGE(PG8_SA(1, 1), a1 + hstep, voffA);
            PG8_WAIT_L(8); PG8_BAR; PG8_WAIT_L(0); PG8_MMA(0, 0, At, B0); PG8_BAR; PG8_SCHED;
            PG8_LDB(B1, 0, 1); PG8_STAGE(PG8_SB(0, 0), b2, voffB);
            PG8_BAR; PG8_WAIT_L(0); PG8_MMA(0, 1, At, B1); PG8_BAR;
            PG8_LDA(At, 0, 1); PG8_STAGE(PG8_SA(0, 0), a2, voffA);
            PG8_BAR; PG8_WAIT_L(0); PG8_MMA(1, 0, At, B0); PG8_BAR; PG8_SCHED;
            PG8_STAGE(PG8_SB(0, 1), b2 + hstep, voffB);
            PG8_WAIT_V(6); PG8_BAR; PG8_MMA(1, 1, At, B1); PG8_BAR;
            PG8_LDB(B0, 1, 0); PG8_SCHED; PG8_LDA(At, 1, 0); PG8_STAGE(PG8_SA(0, 1), a2 + hstep, voffA);
            PG8_WAIT_L(8); PG8_BAR; PG8_WAIT_L(0); PG8_MMA(0, 0, At, B0); PG8_BAR; PG8_SCHED;
            PG8_LDB(B1, 1, 1); PG8_STAGE(PG8_SB(1, 0), b3, voffB);
            PG8_BAR; PG8_WAIT_L(0); PG8_MMA(0, 1, At, B1); PG8_BAR;
            PG8_LDA(At, 1, 1); PG8_STAGE(PG8_SA(1, 0), a3, voffA);
            PG8_BAR; PG8_WAIT_L(0); PG8_MMA(1, 0, At, B0); PG8_BAR; PG8_SCHED;
            PG8_STAGE(PG8_SB(1, 1), b3 + hstep, voffB);
            PG8_WAIT_V(6); PG8_BAR; PG8_MMA(1, 1, At, B1); PG8_BAR;
            }
        }
        if constexpr (ALIGN_EPI) { if (wr == 0) PG8_BAR; }
        E(acc, cur, wr, wc, fr, fq, lds + STAGE_BYTES, wid); S.done(cur);
        if (!has_next) break;
#pragma unroll
        for (int a = 0; a < 2; ++a)
#pragma unroll
            for (int b = 0; b < 2; ++b)
#pragma unroll
                for (int m = 0; m < 4; ++m)
#pragma unroll
                    for (int n = 0; n < 2; ++n) acc[a][b][m][n] = (f32x4){0.f, 0.f, 0.f, 0.f};
        cur = nxt; cA = nA; cB = nB; ++ui;
        if constexpr (ALIGN_EPI) { if (wr == 1) PG8_BAR; }
    }
    PG8_WAIT_V(0);
    if constexpr (!ALIGN_EPI) { if (wr == 0) PG8_BAR; }
    PG8_BAR;
#undef PG8_SA
#undef PG8_SB
#undef PG8_STAGE
#undef PG8_LDA
#undef PG8_LDB
#undef PG8_MMA
#undef PG8_WAIT_V
#undef PG8_WAIT_L
#undef PG8_BAR
#undef PG8_SCHED
}
}
constexpr int NWAVES = 8, GRID = 256;
constexpr int D = 1024, FF = 2816, NIN = 2944, NINP = 3072, NLAYER = 2;
constexpr int NB = 8, SEQ = 2048, NMETA = 16, TT = SEQ + NMETA;
constexpr int MX = NB * SEQ, MREAL = MX + NMETA, MP = 16640;
constexpr float RMS_EPS = 1e-6f, LNX_EPS = 64e-5f;
constexpr int PC_LRUX = 0, PC_LRUG = 256, PC_SCB = 512, PC_SCC = 768, PC_SCX = 1024, PC_R = 1280, PC_K = 1792, PC_V = 2304, PC_LO = 2816;

constexpr size_t MiB = 1u << 20;
constexpr size_t WS_CTL = 0, CTL_ZERO_BYTES = 1 * MiB;
constexpr size_t WS_HMETA = 1 * MiB;
constexpr size_t WS_RS = WS_HMETA + 640 * 1024;
constexpr size_t WS_MSLAB = WS_HMETA + 64 * 1024;
constexpr size_t WS_AGG = 2 * MiB;
constexpr size_t WS_WB = 3 * MiB;
constexpr size_t WB_W1IN = 0, WB_W1OUT = 11 * MiB, WB_W2IN = WB_W1OUT + 5632 * 1024, WB_W2OUT = WB_W2IN + 11 * MiB, WB_WIN = WB_W2OUT + 5632 * 1024, WB_WOUT = WB_WIN + 6 * MiB, WB_END = WB_WOUT + 2 * MiB;
static_assert(WB_END == 41 * MiB, "weight map");
constexpr size_t WS_XN = 44 * MiB;
constexpr size_t WS_OV = 77 * MiB;
constexpr size_t OV_HID = 0, OV_RAWF = 90 * MiB;
constexpr size_t OV_P = 0, OV_WDEC = OV_P + (size_t)MP * NINP * 2, OV_ABUF = OV_WDEC + (size_t)MP * 512 * 2, OV_GBUF = OV_ABUF + (size_t)MP * 512 * 2, OV_HL = OV_GBUF + (size_t)MP * 512 * 2, OV_CA = OV_HL + (size_t)MP * 256 * 4, OV_MIXEND = OV_CA + (size_t)MP * 256 * 4;
constexpr size_t OV_HTMP = 130 * MiB;
constexpr size_t OV_RAWM = 0;
constexpr size_t WS_END = 256 * MiB;
static_assert(WS_XN + (size_t)MP * D * 2 <= WS_OV && WS_OV + OV_MIXEND <= WS_END && WS_OV + OV_RAWF + (size_t)MP * D * 2 <= WS_OV + OV_HTMP && WS_OV + OV_HTMP + (size_t)MX * D * 2 <= WS_END && (size_t)MP * FF * 2 <= OV_RAWF, "d_ws map");
constexpr int CW_BAR = 4096;

constexpr unsigned PROBE_MASK = 0u, PROBE_AMP = 8u; constexpr int PROBE_SUB = -1;
#define PSTAMP(j) do { if (PROBE_MASK && PROBE_SUB >= 0) { const unsigned long long t_ = __builtin_amdgcn_s_memrealtime(); if (PROBE_SUB == (j) && ((PROBE_MASK >> F.ph) & 1u)) F.pr_acc += t_ - F.pr_sub; F.pr_sub = t_; } } while (0)
constexpr int RING_BYTES = 143360, LDSCTL_OFF = RING_BYTES, MISC_OFF = LDSCTL_OFF + 320, LDS_BYTES = 147456;

#define GAS __attribute__((address_space(1)))
#define LAS __attribute__((address_space(3)))
typedef unsigned short bf16;
typedef unsigned v4u __attribute__((ext_vector_type(4)));
typedef float f32x4 __attribute__((ext_vector_type(4)));
typedef GAS unsigned gu32;
typedef float f32x2v_ __attribute__((ext_vector_type(2)));
#define LDS_WAIT() asm volatile("s_waitcnt lgkmcnt(0)" ::: "memory")
__device__ __forceinline__ unsigned f2bf(float f) { unsigned u = __builtin_bit_cast(unsigned, f); return (u + 0x7fffu + ((u >> 16) & 1u)) >> 16; }
__device__ __forceinline__ unsigned pk2(float lo, float hi) { return f2bf(lo) | (f2bf(hi) << 16); }
__device__ __forceinline__ float bf2f(unsigned b) { return __builtin_bit_cast(float, b << 16); }
__device__ __forceinline__ float sigmoidf_(float x) { return __builtin_amdgcn_rcpf(1.0f + __expf(-x)); }
__device__ __forceinline__ float tanhf_(float x) { return 1.0f - 2.0f * __builtin_amdgcn_rcpf(1.0f + __expf(2.0f * x)); }
__device__ __forceinline__ float softplusf_(float x) { return fmaxf(x, 0.f) + __logf(1.0f + __expf(-fabsf(x))); }
__device__ __forceinline__ float gelu_tanh(float x) { const float u = 0.7978845608028654f * (x + 0.044715f * x * x * x); return 0.5f * x * (1.0f + tanhf_(u)); }
template <int CTRL> __device__ __forceinline__ float dppf(float x) { return __builtin_bit_cast(float, __builtin_amdgcn_mov_dpp(__builtin_bit_cast(int, x), CTRL, 0xf, 0xf, true)); }
__device__ __forceinline__ float red16(float x) { x += dppf<0xB1>(x); x += dppf<0x4E>(x); x += dppf<0x141>(x); x += dppf<0x128>(x); return x; }
__device__ __forceinline__ float wave_sum(float x) {
    x = red16(x);
    x += __builtin_bit_cast(float, __builtin_amdgcn_update_dpp(0, __builtin_bit_cast(int, x), 0x142, 0xa, 0xf, false));
    x += __builtin_bit_cast(float, __builtin_amdgcn_update_dpp(0, __builtin_bit_cast(int, x), 0x143, 0xc, 0xf, false));
    return __builtin_bit_cast(float, __builtin_amdgcn_readlane(__builtin_bit_cast(int, x), 63)); }
__device__ __forceinline__ float wave_sum_dpp(float x) { return wave_sum(x); }
__device__ __forceinline__ int vlane() { return (int)__builtin_amdgcn_mbcnt_hi(~0u, __builtin_amdgcn_mbcnt_lo(~0u, 0u)); }
__device__ __forceinline__ int row_of(int b, int s) { return s < NMETA ? (MX + s) : (b * SEQ + s - NMETA); }
__device__ __forceinline__ void unpack8(const v4u& u, float (&v)[8]) { v[0] = bf2f(u.x & 0xffffu); v[1] = bf2f(u.x >> 16); v[2] = bf2f(u.y & 0xffffu); v[3] = bf2f(u.y >> 16); v[4] = bf2f(u.z & 0xffffu); v[5] = bf2f(u.z >> 16); v[6] = bf2f(u.w & 0xffffu); v[7] = bf2f(u.w >> 16); }
#define XB_TMO      128
#define XB_XCNT(j)  (256  + 64 * (j))
#define XB_XSUB(j)  (1280 + 64 * (j))
#define XB_XGEN(j)  (2304 + 64 * (j))
#define XB_TOP      3328
#define XB_TOPGEN   3392
#define XCD_BAR_WORDS 3456
#define XB_SPIN_CAP (1u << 18)

__device__ __forceinline__ unsigned xb_ld(unsigned* p)              { return __hip_atomic_load(p, __ATOMIC_RELAXED, __HIP_MEMORY_SCOPE_AGENT); }
__device__ __forceinline__ unsigned xb_add(unsigned* p, unsigned v) { return __hip_atomic_fetch_add(p, v, __ATOMIC_RELAXED, __HIP_MEMORY_SCOPE_AGENT); }
__device__ __forceinline__ unsigned xb_xcc_id() { return (unsigned)__builtin_amdgcn_s_getreg((3 << 11) | 20) & 0xFu; }
#define XB_SPIN(cond, bar) do { unsigned _sp = 0; while (cond) { __builtin_amdgcn_s_sleep(1); \
    if ((++_sp & 255u) == 0u) { if (xb_ld(&(bar)[XB_TMO])) break; if (_sp > XB_SPIN_CAP) { atomicAdd(&(bar)[XB_TMO], 1u); break; } } } } while (0)

struct XcdBarrier {
    unsigned* bar; unsigned x;
    volatile LAS unsigned* st;
};

__device__ __forceinline__ XcdBarrier xcd_barrier_post(unsigned* bar, volatile LAS unsigned* st, bool leader  ) {
    XcdBarrier b; b.bar = bar; b.x = xb_xcc_id(); b.st = st;
    if (leader) (void)xb_add(&bar[XB_XCNT(b.x)], 1u);
    return b;
}
__device__ __forceinline__ void xcd_barrier_complete(unsigned* bar, unsigned x, unsigned& nloc, unsigned& nx) {
    const unsigned G = gridDim.x * gridDim.y * gridDim.z;
    unsigned sum, cnt, mine, sp = 0u;
    for (;;) {
        sum = 0u; cnt = 0u; mine = 0u;
#pragma unroll
        for (unsigned j = 0; j < 16; ++j) { const unsigned c = xb_ld(&bar[XB_XCNT(j)]); sum += c; cnt += (c > 0u) ? 1u : 0u; mine = (j == x) ? c : mine; }
        if (sum == G) break;
        __builtin_amdgcn_s_sleep(1);
        if ((++sp & 255u) == 0u) { if (xb_ld(&bar[XB_TMO])) break; if (sp > XB_SPIN_CAP) { atomicAdd(&bar[XB_TMO], 1u); break; } }
    }
    nloc = mine > 0u ? mine : 1u; nx = cnt > 0u ? cnt : 1u;
}

__device__ __forceinline__ void xcd_barrier(const XcdBarrier& b, bool leader  ) {
    asm volatile("s_waitcnt vmcnt(0)" ::: "memory");
    __syncthreads();
    if (leader) {
        unsigned* bar = b.bar;
        __builtin_amdgcn_s_waitcnt(0);
        unsigned nloc = b.st[0], nx = b.st[1];
        if (nloc == 0u) { xcd_barrier_complete(bar, b.x, nloc, nx); b.st[0] = nloc; b.st[1] = nx; }
        const unsigned old = xb_add(&bar[XB_XSUB(b.x)], 1u);
        const unsigned gen = old / nloc;
        if (old + 1u == (gen + 1u) * nloc) {
            __builtin_amdgcn_fence(__ATOMIC_RELEASE, "agent");
            asm volatile("s_waitcnt vmcnt(0)" ::: "memory");
            const unsigned og = xb_add(&bar[XB_TOP], 1u);
            const unsigned tg = og / nx;
            if (og + 1u == (tg + 1u) * nx) xb_add(&bar[XB_TOPGEN], 1u);
            else XB_SPIN(xb_ld(&bar[XB_TOPGEN]) == tg, bar);
            __builtin_amdgcn_fence(__ATOMIC_ACQUIRE, "agent");
            xb_add(&bar[XB_XGEN(b.x)], 1u);
            asm volatile("s_waitcnt vmcnt(0)" ::: "memory");
        } else {
            XB_SPIN(xb_ld(&bar[XB_XGEN(b.x)]) == gen, bar);
            __builtin_amdgcn_fence(__ATOMIC_ACQUIRE, "agent");
            asm volatile("s_waitcnt vmcnt(0)" ::: "memory");
        }
    }
    __syncthreads();
}
struct Frame {
    LAS unsigned char* lds;
    int tid, lane, wave, vcu;
    unsigned long long pr_acc, pr_sub; int ph;
    unsigned char* ws;
    const float* x; const float* meta; float* out;
};

constexpr int PK_CONVW = 0, PK_CONVB = 1024, PK_WA = 1280, PK_BA = 17664, PK_WX = 17920, PK_BX = 34304, PK_LAM = 34560, PK_LNG = 34816, PK_SCW = 35072, PK_SCG = 35840, PK_MU = 36096, PK_W0 = 37760,
              PK_W2 = 38272, PK_A0 = 54656, PK_A2 = 55168, PK_G2 = 71552, PK_KK = 104320, PK_KA = 104832, PK_RK = 105344, PK_LNW = 105856, PK_LNB = 106368, PK_SIZE = 106880;
constexpr size_t WS_PACK = 72 * 1024;
static_assert(WS_PACK + (size_t)NLAYER * PK_SIZE * 4 <= CTL_ZERO_BYTES && (CW_BAR + 3456) * 4 <= (int)WS_PACK, "pack inside CTL, above the barrier words");
__device__ __forceinline__ const float* pack_of(const Frame& F, int l) { return (const float*)(F.ws + WS_PACK) + (size_t)l * PK_SIZE; }
struct PackRegs { float a[21]; float f0, f1; };
#define PKG(i) int gs = gt - (i) * 6144; if (gs < 0) gs += GRID * NWAVES * 64;
#define PKL(i, n, per) { PKG(i) R.a[i] = 0.f; if (gs < NLAYER * (per)) R.a[i] = in[n][gs]; }
#define PKS(i, per, off) { PKG(i) if (gs < NLAYER * (per)) { const int l_ = gs / (per), j_ = gs - l_ * (per); dst[(size_t)l_ * PK_SIZE + (off) + j_] = R.a[i]; } }
__device__ __forceinline__ void pack_loads(Frame& F, const float* const* in, PackRegs& R) {
    const int gt = F.vcu * (NWAVES * 64) + F.tid;
    static_assert(NLAYER * 32768 <= GRID * NWAVES * 64, "one element per thread covers the longest segment");
    PKL(0, 9, 1024) PKL(1, 10, 256) PKL(2, 11, 16384) PKL(3, 12, 256) PKL(4, 13, 16384) PKL(5, 14, 256) PKL(6, 15, 256)
    __builtin_amdgcn_sched_barrier(0);
    PKL(7, 16, 256) PKL(8, 17, 768) PKL(9, 18, 256) PKL(10, 19, 1664) PKL(11, 20, 512) PKL(12, 21, 16384) PKL(13, 22, 512)
    __builtin_amdgcn_sched_barrier(0);
    PKL(14, 23, 16384) PKL(15, 24, 32768) PKL(16, 25, 512) PKL(17, 26, 512) PKL(18, 27, 512) PKL(19, 28, 512) PKL(20, 29, 512)
}
__device__ __forceinline__ void pack_stores(Frame& F, const PackRegs& R) {
    const int gt = F.vcu * (NWAVES * 64) + F.tid;
    float* dst = (float*)(F.ws + WS_PACK);
    PKS(0, 1024, PK_CONVW) PKS(1, 256, PK_CONVB) PKS(2, 16384, PK_WA) PKS(3, 256, PK_BA) PKS(4, 16384, PK_WX) PKS(5, 256, PK_BX) PKS(6, 256, PK_LAM)
    PKS(7, 256, PK_LNG) PKS(8, 768, PK_SCW) PKS(9, 256, PK_SCG) PKS(10, 1664, PK_MU) PKS(11, 512, PK_W0) PKS(12, 16384, PK_W2) PKS(13, 512, PK_A0)
    PKS(14, 16384, PK_A2) PKS(15, 32768, PK_G2) PKS(16, 512, PK_KK) PKS(17, 512, PK_KA) PKS(18, 512, PK_RK) PKS(19, 512, PK_LNW) PKS(20, 512, PK_LNB)
}
#undef PKL
#undef PKS
#undef PKG

__device__ __forceinline__ int swiglu_row(int n0) { return n0 < FF ? ((n0 >> 7) * 256 + (n0 & 127)) : (((n0 - FF) >> 7) * 256 + 128 + ((n0 - FF) & 127)); }
constexpr int CI_IN = (D / 64) * (2 * FF / 32), CI_OUT = (FF / 64) * (D / 32), CI_MI = (D / 64) * (NIN / 32), CI_MO = (D / 64) * (D / 32);
constexpr int CI_SET0 = CI_IN + CI_OUT + CI_MI, CI_SET1 = CI_MO + CI_IN + CI_OUT;
struct ConvItem { const float* W; bf16* WT; int K, N, k0, n0, drow0; const float* g; };
__device__ __forceinline__ ConvItem conv_item(unsigned char* ws, const float* const* in, int l, int set, int r) {
    ConvItem ci;
    if (set == 0) {
        if (r < CI_IN) { const int nblk = 2 * FF / 32, kb = r / nblk, nb = r % nblk; ci = ConvItem{in[3] + (size_t)l * D * 2 * FF, (bf16*)(ws + WS_WB + WB_W1IN), D, 2 * FF, 64 * kb, 32 * nb, swiglu_row(32 * nb), in[2] + (size_t)(l * 6 + 0) * D}; return ci; }
        r -= CI_IN;
        if (r < CI_OUT) { const int nblk = D / 32, kb = r / nblk, nb = r % nblk; ci = ConvItem{in[4] + (size_t)l * FF * D, (bf16*)(ws + WS_WB + WB_W1OUT), FF, D, 64 * kb, 32 * nb, 32 * nb, nullptr}; return ci; }
        r -= CI_OUT;
        { const int nblk = NIN / 32, kb = r / nblk, nb = r % nblk; ci = ConvItem{in[7] + (size_t)l * D * NIN, (bf16*)(ws + WS_WB + WB_WIN), D, NIN, 64 * kb, 32 * nb, 32 * nb, in[2] + (size_t)(l * 6 + 2) * D}; return ci; }
    }
    if (r < CI_MO) { const int nblk = D / 32, kb = r / nblk, nb = r % nblk; ci = ConvItem{in[8] + (size_t)l * D * D, (bf16*)(ws + WS_WB + WB_WOUT), D, D, 64 * kb, 32 * nb, 32 * nb, nullptr}; return ci; }
    r -= CI_MO;
    if (r < CI_IN) { const int nblk = 2 * FF / 32, kb = r / nblk, nb = r % nblk; ci = ConvItem{in[5] + (size_t)l * D * 2 * FF, (bf16*)(ws + WS_WB + WB_W2IN), D, 2 * FF, 64 * kb, 32 * nb, swiglu_row(32 * nb), in[2] + (size_t)(l * 6 + 4) * D}; return ci; }
    r -= CI_IN;
    { const int nblk = D / 32, kb = r / nblk, nb = r % nblk; ci = ConvItem{in[6] + (size_t)l * FF * D, (bf16*)(ws + WS_WB + WB_W2OUT), FF, D, 64 * kb, 32 * nb, 32 * nb, nullptr}; return ci; }
}
__device__ __forceinline__ void conv_loads(const ConvItem& ci, int lane, float (&v)[32]) {
    const float* src = ci.W + (size_t)(ci.k0 + (lane >> 5)) * ci.N + ci.n0 + (lane & 31);
#pragma unroll
    for (int i = 0; i < 32; ++i) v[i] = src[(size_t)(2 * i) * ci.N];
}
__device__ __forceinline__ void conv_store(const ConvItem& ci, int lane, const float (&v)[32], LAS float* scr) {
#pragma unroll
    for (int i = 0; i < 32; ++i) scr[(2 * i + (lane >> 5)) * 33 + (lane & 31)] = v[i];
    LDS_WAIT(); asm volatile("" ::: "memory");
    const int c = lane & 7;
    f32x4 g0 = (f32x4){1.f, 1.f, 1.f, 1.f}, g1 = g0; if (ci.g) { g0 = *(const f32x4*)(ci.g + ci.k0 + 8 * c); g1 = *(const f32x4*)(ci.g + ci.k0 + 8 * c + 4); }
#pragma unroll
    for (int j = 0; j < 4; ++j) { const int n = (lane >> 3) + 8 * j; const LAS float* s = scr + (8 * c) * 33 + n;
        v4u o; o.x = pk2(s[0 * 33] * g0[0], s[1 * 33] * g0[1]); o.y = pk2(s[2 * 33] * g0[2], s[3 * 33] * g0[3]); o.z = pk2(s[4 * 33] * g1[0], s[5 * 33] * g1[1]); o.w = pk2(s[6 * 33] * g1[2], s[7 * 33] * g1[3]);
        *(GAS v4u*)(ci.WT + (size_t)(ci.drow0 + n) * ci.K + ci.k0 + 8 * c) = o; }
    LDS_WAIT(); asm volatile("" ::: "memory");
}
__device__ __forceinline__ float sumsq4(const f32x4 (&v)[4]) { float s = 0.f;
#pragma unroll
    for (int j = 0; j < 4; ++j) s += (v[j].x * v[j].x + v[j].y * v[j].y) + (v[j].z * v[j].z + v[j].w * v[j].w);
    return s; }
typedef short mbf16x8 __attribute__((ext_vector_type(8)));
__device__ __forceinline__ void meta_tile(const bf16* A, const bf16* Bt, int K, int k0, int kl, int nb0, int nb1, int mode, void* O, int ldo, int ocol, int lane, const float* rs) {
    const int fr = lane & 15, fq = lane >> 4;
    const bf16* ap = A + (size_t)(MX + fr) * K + k0 + 8 * fq; const bf16* b0p = Bt + (size_t)(nb0 + fr) * K + k0 + 8 * fq; const bf16* b1p = Bt + (size_t)((mode == 0 ? nb1 : nb0) + fr) * K + k0 + 8 * fq;
    f32x4 acc0 = (f32x4){0.f, 0.f, 0.f, 0.f}, acc1 = acc0;
    for (int kb = 0; kb < kl; kb += 256) {
        mbf16x8 a[8], w0[8], w1[8];
#pragma unroll
        for (int j = 0; j < 8; ++j) { const int ks = kb + 32 * j; const bool on = ks < kl; const int kc = on ? ks : kb;
            a[j] = *(const mbf16x8*)(ap + kc); w0[j] = *(const mbf16x8*)(b0p + kc); if (mode == 0) w1[j] = *(const mbf16x8*)(b1p + kc); }
#pragma unroll
        for (int j = 0; j < 8; ++j) { if (kb + 32 * j < kl) { acc0 = __builtin_amdgcn_mfma_f32_16x16x32_bf16(w0[j], a[j], acc0, 0, 0, 0);
            if (mode == 0) acc1 = __builtin_amdgcn_mfma_f32_16x16x32_bf16(w1[j], a[j], acc1, 0, 0, 0); } } }
    const int col = ocol + 4 * fq;
    if (mode == 2) { *(f32x4*)((float*)O + (size_t)fr * ldo + col) = acc0; return; }
    float v[4];
    const float sc = rs ? rs[MX + fr] : 1.0f;
#pragma unroll
    for (int i = 0; i < 4; ++i) { const float g = acc0[i] * sc; v[i] = mode == 0 ? g * __builtin_amdgcn_rcpf(1.0f + __expf(-g)) * (acc1[i] * sc) : g; }
    *(GAS unsigned long long*)((bf16*)O + (size_t)(MX + fr) * ldo + col) = (unsigned long long)pk2(v[0], v[1]) | ((unsigned long long)pk2(v[2], v[3]) << 32);
}
__device__ __forceinline__ void meta_gemm(Frame& F, const bf16* A, const bf16* Bt, int K, int N, int mode, void* O, int ldo, int nks, int gw  , const float* rs) {
    const int lane = F.tid & 63; if (gw < 0) return;
    if (mode == 0) { if (gw < FF / 16) { const int j0 = 16 * gw, nb0 = (j0 >> 7) * 256 + (j0 & 127); meta_tile(A, Bt, K, 0, K, nb0, nb0 + 128, 0, O, ldo, j0, lane, rs); } return; }
    const int ntile = N / 16;
    if (gw < ntile * nks) { const int tile = gw % ntile, sl = gw / ntile, kl = K / nks;
        meta_tile(A, Bt, K, sl * kl, kl, 16 * tile, 0, mode, mode == 2 ? (void*)((float*)O + (size_t)sl * NMETA * D) : O, ldo, 16 * tile, lane, rs); }
}

__device__ __forceinline__ void row_ld_f32(const float* p, int lane, f32x4 (&v)[4]) {
#pragma unroll
    for (int j = 0; j < 4; ++j) v[j] = ((const GAS f32x4*)p)[lane + 64 * j]; }
__device__ __forceinline__ void row_ld_bf16(const bf16* p, int lane, f32x4 (&v)[4]) {
#pragma unroll
    for (int j = 0; j < 4; ++j) { const unsigned long long u = ((const GAS unsigned long long*)p)[lane + 64 * j]; v[j][0] = bf2f((unsigned)u & 0xffffu); v[j][1] = bf2f((unsigned)u >> 16); v[j][2] = bf2f((unsigned)(u >> 32) & 0xffffu); v[j][3] = bf2f((unsigned)(u >> 48)); } }
__device__ __forceinline__ void row_st_bf16(bf16* p, int lane, const f32x4 (&v)[4]) {
#pragma unroll
    for (int j = 0; j < 4; ++j) ((GAS unsigned long long*)p)[lane + 64 * j] = (unsigned long long)pk2(v[j][0], v[j][1]) | ((unsigned long long)pk2(v[j][2], v[j][3]) << 32); }
__device__ __forceinline__ void phase_init_convert(Frame& F, const float* const* in) {
    { int ln_ = F.tid & 63; asm volatile("" : "+v"(ln_)); F.lane = ln_; }
    const int gw = F.vcu * NWAVES + F.wave, NGW = GRID * NWAVES;
    float* RS = (float*)(F.ws + WS_RS);
    LAS float* scr = (LAS float*)(F.lds + F.wave * 16384);
    ConvItem ca; float va[32]; int it = gw;
    if (it < CI_SET0) { ca = conv_item(F.ws, in, 0, 0, it); conv_loads(ca, F.lane, va); }
    for (int r0 = gw; r0 < MREAL; r0 += 2 * NGW) {
        f32x4 v[2][4];
#pragma unroll
        for (int u = 0; u < 2; ++u) { const int r = r0 + u * NGW < MREAL ? r0 + u * NGW : r0; row_ld_f32(r < MX ? F.x + (size_t)r * D : F.meta + (size_t)(r - MX) * D, F.lane, v[u]); }
#pragma unroll
        for (int u = 0; u < 2; ++u) { const int r = r0 + u * NGW; if (r < MREAL) {
            const float rstd = rsqrtf(wave_sum(sumsq4(v[u])) * (1.0f / D) + RMS_EPS);
#pragma unroll
            for (int j = 0; j < 4; ++j) v[u][j] = v[u][j] * rstd;
            row_st_bf16(r < MX ? (bf16*)F.out + (size_t)r * D : (bf16*)(F.ws + WS_HMETA) + (size_t)(r - MX) * D, F.lane, v[u]);
            if (F.lane == 0) RS[r] = rstd; } }
        if (it < CI_SET0) { conv_store(ca, F.lane, va, scr); it += NGW; if (it < CI_SET0) { ca = conv_item(F.ws, in, 0, 0, it); conv_loads(ca, F.lane, va); } }
    }
    while (it < CI_SET0) { conv_store(ca, F.lane, va, scr); it += NGW; if (it < CI_SET0) { ca = conv_item(F.ws, in, 0, 0, it); conv_loads(ca, F.lane, va); } }
    { unsigned zz = 0u; asm volatile("" : "+v"(zz));
      for (int i = gw * 64 + F.lane; i < (NINP - NIN) * D / 8; i += NGW * 64) *(GAS v4u*)(((bf16*)(F.ws + WS_WB + WB_WIN)) + (size_t)NIN * D + (size_t)i * 8) = (v4u){zz, zz, zz, zz}; }
}
struct PostIO { const bf16* raw16; const bf16* hin16; bf16* hout16; float* out32; int nks; };
__device__ __forceinline__ void post_row_load(const Frame& F, const PostIO& io, int r, f32x4 (&y)[4], f32x4 (&h)[4]) {
    if (r >= MX) { const float* sl = (const float*)(F.ws + WS_MSLAB) + (size_t)(r - MX) * D; row_ld_f32(sl, F.lane, y);
        for (int s = 1; s < io.nks; ++s) { f32x4 t[4]; row_ld_f32(sl + (size_t)s * NMETA * D, F.lane, t);
#pragma unroll
            for (int j = 0; j < 4; ++j) y[j] = y[j] + t[j]; }
        row_ld_bf16((const bf16*)(F.ws + WS_HMETA) + (size_t)(r - MX) * D, F.lane, h);
        const float inv = 1.0f / ((const float*)(F.ws + WS_RS))[r];
#pragma unroll
        for (int j = 0; j < 4; ++j) h[j] = h[j] * inv;
        return; }
    row_ld_bf16(io.raw16 + (size_t)r * D, F.lane, y);
    row_ld_bf16(io.hin16 + (size_t)r * D, F.lane, h);
    const float inv = 1.0f / ((const float*)(F.ws + WS_RS))[r];
#pragma unroll
    for (int j = 0; j < 4; ++j) h[j] = h[j] * inv;
}
__device__ __forceinline__ void post_row_store(const Frame& F, const PostIO& io, int r, const f32x4 (&h)[4]) {
    if (r >= MX) row_st_bf16((bf16*)(F.ws + WS_HMETA) + (size_t)(r - MX) * D, F.lane, h);
    else if (io.out32) {
#pragma unroll
        for (int j = 0; j < 4; ++j) ((GAS f32x4*)(io.out32 + (size_t)r * D))[F.lane + 64 * j] = h[j]; }
    else row_st_bf16(io.hout16 + (size_t)r * D, F.lane, h);
}
struct PostRaw { v4u y[2], h[2]; float rs; };
__device__ __forceinline__ void post_issue(const Frame& F, const PostIO& io, int r, PostRaw& R) {
#pragma unroll
    for (int j = 0; j < 2; ++j) { R.y[j] = ((const GAS v4u*)(io.raw16 + (size_t)r * D))[F.lane + 64 * j]; R.h[j] = ((const GAS v4u*)(io.hin16 + (size_t)r * D))[F.lane + 64 * j]; }
    R.rs = ((const float*)(F.ws + WS_RS))[r];
}
__device__ __forceinline__ float sumsq16(const float (&v)[16]) { float s0 = 0.f, s1 = 0.f;
#pragma unroll
    for (int j = 0; j < 16; j += 2) { s0 += v[j] * v[j]; s1 += v[j + 1] * v[j + 1]; }
    return s0 + s1; }
__device__ __forceinline__ void post_pair(const Frame& F, const PostIO& io, const PostRaw& R0, const PostRaw& R1, int r0, int r1, float scale, const float* g_post, bool want_rs) {
    float y0[16], h0[16], y1[16], h1[16];
    { float t[8];
#pragma unroll
      for (int j = 0; j < 2; ++j) {
          unpack8(R0.y[j], t);
#pragma unroll
          for (int e = 0; e < 8; ++e) y0[8 * j + e] = t[e];
          unpack8(R0.h[j], t);
#pragma unroll
          for (int e = 0; e < 8; ++e) h0[8 * j + e] = t[e];
          unpack8(R1.y[j], t);
#pragma unroll
          for (int e = 0; e < 8; ++e) y1[8 * j + e] = t[e];
          unpack8(R1.h[j], t);
#pragma unroll
          for (int e = 0; e < 8; ++e) h1[8 * j + e] = t[e]; } }
    const float i0 = 1.0f / R0.rs, i1 = 1.0f / R1.rs;
    const float rs0 = scale * rsqrtf(wave_sum(sumsq16(y0)) * (1.0f / D) + RMS_EPS), rs1 = scale * rsqrtf(wave_sum(sumsq16(y1)) * (1.0f / D) + RMS_EPS);
#pragma unroll
    for (int j = 0; j < 4; ++j) { const f32x4 gv = ((const GAS f32x4*)g_post)[2 * F.lane + 128 * (j >> 1) + (j & 1)];
#pragma unroll
        for (int e = 0; e < 4; ++e) { h0[4 * j + e] = h0[4 * j + e] * i0 + y0[4 * j + e] * rs0 * gv[e]; h1[4 * j + e] = h1[4 * j + e] * i1 + y1[4 * j + e] * rs1 * gv[e]; } }
    if (want_rs) { const float q0 = rsqrtf(wave_sum(sumsq16(h0)) * (1.0f / D) + RMS_EPS), q1 = rsqrtf(wave_sum(sumsq16(h1)) * (1.0f / D) + RMS_EPS);
#pragma unroll
        for (int e = 0; e < 16; ++e) { h0[e] *= q0; h1[e] *= q1; }
        if (F.lane == 0) { ((float*)(F.ws + WS_RS))[r0] = q0; ((float*)(F.ws + WS_RS))[r1] = q1; } }
    if (io.out32) {
#pragma unroll
        for (int j = 0; j < 4; ++j) { ((GAS f32x4*)(io.out32 + (size_t)r0 * D))[2 * F.lane + 128 * (j >> 1) + (j & 1)] = (f32x4){h0[4 * j], h0[4 * j + 1], h0[4 * j + 2], h0[4 * j + 3]};
                                      ((GAS f32x4*)(io.out32 + (size_t)r1 * D))[2 * F.lane + 128 * (j >> 1) + (j & 1)] = (f32x4){h1[4 * j], h1[4 * j + 1], h1[4 * j + 2], h1[4 * j + 3]}; } }
    else {
#pragma unroll
        for (int j = 0; j < 2; ++j) { v4u o0, o1;
            o0.x = pk2(h0[8 * j], h0[8 * j + 1]); o0.y = pk2(h0[8 * j + 2], h0[8 * j + 3]); o0.z = pk2(h0[8 * j + 4], h0[8 * j + 5]); o0.w = pk2(h0[8 * j + 6], h0[8 * j + 7]);
            o1.x = pk2(h1[8 * j], h1[8 * j + 1]); o1.y = pk2(h1[8 * j + 2], h1[8 * j + 3]); o1.z = pk2(h1[8 * j + 4], h1[8 * j + 5]); o1.w = pk2(h1[8 * j + 6], h1[8 * j + 7]);
            ((GAS v4u*)(io.hout16 + (size_t)r0 * D))[F.lane + 64 * j] = o0; ((GAS v4u*)(io.hout16 + (size_t)r1 * D))[F.lane + 64 * j] = o1; } }
}
__device__ __forceinline__ void phase_post(Frame& F, const PostIO& io, float scale, const float* g_post, bool want_rs) {
    { int ln_ = F.tid & 63; asm volatile("" : "+v"(ln_)); F.lane = ln_; }
    const int gw = F.vcu * NWAVES + F.wave, NGW = GRID * NWAVES;
    static_assert(MX == 8 * GRID * NWAVES, "exactly eight x-token rows per wave");
    { PostRaw A0, A1, B0, B1;
      post_issue(F, io, gw, A0); post_issue(F, io, gw + NGW, A1);
#pragma unroll
      for (int it = 0; it < 4; ++it) { const int ra = gw + 2 * it * NGW;
          if (it & 1) { if (it < 3) { post_issue(F, io, ra + 2 * NGW, A0); post_issue(F, io, ra + 3 * NGW, A1); } __builtin_amdgcn_sched_barrier(0); post_pair(F, io, B0, B1, ra, ra + NGW, scale, g_post, want_rs); }
          else        { post_issue(F, io, ra + 2 * NGW, B0); post_issue(F, io, ra + 3 * NGW, B1); __builtin_amdgcn_sched_barrier(0); post_pair(F, io, A0, A1, ra, ra + NGW, scale, g_post, want_rs); } } }
    if (!io.out32 && gw < NMETA) { const int r = MX + gw;
        f32x4 y[4], h[4]; post_row_load(F, io, r, y, h);
        const float rs0 = scale * rsqrtf(wave_sum(sumsq4(y)) * (1.0f / D) + RMS_EPS);
#pragma unroll
        for (int j = 0; j < 4; ++j) { const f32x4 gv = ((const GAS f32x4*)g_post)[F.lane + 64 * j]; h[j] = h[j] + y[j] * rs0 * gv; }
        if (want_rs) { const float q0 = rsqrtf(wave_sum(sumsq4(h)) * (1.0f / D) + RMS_EPS);
#pragma unroll
            for (int j = 0; j < 4; ++j) h[j] = h[j] * q0;
            if (F.lane == 0) ((float*)(F.ws + WS_RS))[r] = q0; }
        post_row_store(F, io, r, h); }
}
typedef short bf16x8v __attribute__((ext_vector_type(8)));
typedef float f32x4v __attribute__((ext_vector_type(4)));
constexpr int FR_PER_WAVE = 24;
constexpr size_t WS_FRAG = WS_AGG + 512 * 1024, FRAG_LAYER_BYTES = (size_t)8 * FR_PER_WAVE * 64 * 16;
static_assert(WS_FRAG + NLAYER * FRAG_LAYER_BYTES <= WS_WB, "fragment store fits behind AGG");
__device__ __forceinline__ float frag_src(const float* const* in, int l, int w, int f, int lane, int j) {
    const int kq = 8 * (lane >> 4) + j, cl = lane & 15;
    if (f < 4)  return in[21][(size_t)l * 32 * 512 + (size_t)kq * 512 + 64 * w + 16 * f + cl];
    if (f < 8)  return in[23][(size_t)l * 32 * 512 + (size_t)kq * 512 + 64 * w + 16 * (f - 4) + cl];
    if (f < 16) { const int ct = (f - 8) >> 1, ks = (f - 8) & 1; return in[24][(size_t)l * 64 * 512 + (size_t)(32 * ks + kq) * 512 + 64 * w + 16 * ct + cl]; }
    { const int ct = (f - 16) >> 1, ks = (f - 16) & 1, gt = w >> 2, g = w & 3; return in[gt ? 13 : 11][(size_t)l * 16384 + (size_t)g * 4096 + (size_t)(32 * ks + kq) * 64 + 16 * ct + cl]; }
}
__device__ __forceinline__ float frag_val(const float* const* in, int i) {
    const int j = i & 7, lane = (i >> 3) & 63, f = (i >> 9) % FR_PER_WAVE, w = ((i >> 9) / FR_PER_WAVE) & 7, l = (i >> 9) / (FR_PER_WAVE * 8);
    return frag_src(in, l, w, f, lane, j); }
__device__ __forceinline__ void frag_loads(Frame& F, const float* const* in, PackRegs& R) {
    const int gt = F.vcu * (NWAVES * 64) + F.tid, NT = GRID * NWAVES * 64, TOT = NLAYER * 8 * FR_PER_WAVE * 64 * 8;
    static_assert(NLAYER * 8 * FR_PER_WAVE * 64 * 8 <= 2 * GRID * NWAVES * 64, "two elements per thread cover the fragment store");
    R.f0 = frag_val(in, gt); R.f1 = 0.f; if (gt + NT < TOT) R.f1 = frag_val(in, gt + NT);
}
__device__ __forceinline__ void frag_stores(Frame& F, const PackRegs& R) {
    const int gt = F.vcu * (NWAVES * 64) + F.tid, NT = GRID * NWAVES * 64, TOT = NLAYER * 8 * FR_PER_WAVE * 64 * 8;
    bf16* FR = (bf16*)(F.ws + WS_FRAG);
    FR[gt] = (bf16)f2bf(R.f0); if (gt + NT < TOT) FR[gt + NT] = (bf16)f2bf(R.f1);
}
__device__ __forceinline__ bf16x8v pack8(const float (&v)[8]) { v4u u; u.x = pk2(v[0], v[1]); u.y = pk2(v[2], v[3]); u.z = pk2(v[4], v[5]); u.w = pk2(v[6], v[7]); return __builtin_bit_cast(bf16x8v, u); }
__device__ __forceinline__ void unpack4f(unsigned long long u, f32x4& v) { v[0] = bf2f((unsigned)u & 0xffffu); v[1] = bf2f(((unsigned)u >> 16)); v[2] = bf2f((unsigned)(u >> 32) & 0xffffu); v[3] = bf2f((unsigned)(u >> 48)); }
__device__ __forceinline__ void phase_mix_prep(Frame& F, const float* pk, int layer) {
    { int ln_ = F.tid & 63; asm volatile("" : "+v"(ln_)); F.lane = ln_; }
    LAS float* U = (LAS float*)F.lds;
    LAS float* GT = U + 16 * 256;
    LAS float* XL = GT + 32 * 256;
    LAS float* VL = XL + 19 * 256;
    const int tid = F.tid, lane = F.lane, w = F.wave, fr = lane & 15, fq = lane >> 4;
    const bf16* P = ((bf16*)(F.ws + WS_OV + OV_P)); bf16* Y = ((bf16*)(F.ws + WS_XN));
    bf16x8v Bf[FR_PER_WAVE];
    { const v4u* fp = (const v4u*)(F.ws + WS_FRAG + (size_t)layer * FRAG_LAYER_BYTES) + (size_t)w * FR_PER_WAVE * 64 + lane;
#pragma unroll
        for (int f = 0; f < FR_PER_WAVE; ++f) Bf[f] = __builtin_bit_cast(bf16x8v, fp[f * 64]); }
    const int gtp = w >> 2, gblk = w & 3;
    const int cg4 = 4 * (tid & 63);
    for (int tile = blockIdx.x; tile < 256; tile += GRID) {
        const int b = tile >> 5, c = tile & 31;
        const int s_begin = c == 0 ? 0 : NMETA + 64 * c, nsub = c == 0 ? 5 : 4;
        float hloc = 0.f, caloc = 1.f;
        for (int sub = 0; sub < nsub; ++sub) {
            const int s0 = s_begin + 16 * sub;
            unsigned zz = 0u; asm volatile("" : "+v"(zz));
            v4u cur[4], prv[4];
            { const int s = s0 + fr; const bf16* pc = P + (size_t)row_of(b, s) * NINP + PC_LO + 8 * fq; const bf16* pp = P + (size_t)row_of(b, s > 0 ? s - 1 : 0) * NINP + PC_LO + 8 * fq;
#pragma unroll
                for (int f = 0; f < 4; ++f) { cur[f] = *(const v4u*)(pc + 32 * f); prv[f] = *(const v4u*)(pp + 32 * f); if (s == 0) prv[f] = (v4u){zz, zz, zz, zz}; } }
            unsigned long long lx[3], lc[3], lxx[3], lb[2];
#pragma unroll
            for (int j = 0; j < 3; ++j) { const int idx = tid + 512 * j, r = idx >> 6, s = s0 - 3 + r; lx[j] = zz; lc[j] = zz; lxx[j] = zz;
                if (idx < 19 * 64 && s >= 0) { const bf16* pr = P + (size_t)row_of(b, s) * NINP + cg4; lx[j] = *(const unsigned long long*)(pr + PC_LRUX); lc[j] = *(const unsigned long long*)(pr + PC_SCC); lxx[j] = *(const unsigned long long*)(pr + PC_SCX); } }
#pragma unroll
            for (int j = 0; j < 2; ++j) { const int t = (tid >> 6) + 8 * j; lb[j] = *(const unsigned long long*)(P + (size_t)row_of(b, s0 + t) * NINP + PC_SCB + cg4); }
            { bf16x8v Af[4];
#pragma unroll
                for (int f = 0; f < 4; ++f) { float cv[8], pv[8], zv[8]; unpack8(cur[f], cv); unpack8(prv[f], pv);
                    const f32x4v m0 = *(const f32x4v*)(pk + PK_MU + 1536 + 32 * f + 8 * fq), m1 = *(const f32x4v*)(pk + PK_MU + 1536 + 32 * f + 8 * fq + 4);
#pragma unroll
                    for (int j = 0; j < 8; ++j) { const float mu = j < 4 ? m0[j & 3] : m1[j & 3]; const float z = cv[j] + (pv[j] - cv[j]) * mu; zv[j] = f == 0 ? tanhf_(z) : (f == 1 ? z : sigmoidf_(z)); }
                    Af[f] = pack8(zv); }
                const f32x4v zero = (f32x4v){0.f, 0.f, 0.f, 0.f};
                const size_t ro = (size_t)row_of(b, s0 + fr) * 512;
#pragma unroll
                for (int ct = 0; ct < 4; ++ct) { const int n = 64 * w + 16 * ct + 4 * fq;
                    const f32x4v aw = __builtin_amdgcn_mfma_f32_16x16x32_bf16(Bf[ct], Af[0], zero, 0, 0, 0);
                    const f32x4v aa = __builtin_amdgcn_mfma_f32_16x16x32_bf16(Bf[4 + ct], Af[1], zero, 0, 0, 0);
                    f32x4v ag = __builtin_amdgcn_mfma_f32_16x16x32_bf16(Bf[8 + 2 * ct], Af[2], zero, 0, 0, 0); ag = __builtin_amdgcn_mfma_f32_16x16x32_bf16(Bf[9 + 2 * ct], Af[3], ag, 0, 0, 0);
                    const f32x4v w04 = *(const f32x4v*)(pk + PK_W0 + n), a04 = *(const f32x4v*)(pk + PK_A0 + n);
                    float wd[4], av4[4];
#pragma unroll
                    for (int i = 0; i < 4; ++i) { const float wl = -softplusf_(-(w04[i] + aw[i])) - 0.5f, e = __expf(wl); wd[i] = e * (1.0f - e * (0.5f - e * (0.16666667f - e * (0.041666668f - e * 0.0083333338f)))); av4[i] = sigmoidf_(a04[i] + aa[i]); }
                    *(GAS unsigned long long*)((bf16*)(F.ws + WS_OV + OV_WDEC) + ro + n) = (unsigned long long)pk2(wd[0], wd[1]) | ((unsigned long long)pk2(wd[2], wd[3]) << 32);
                    *(GAS unsigned long long*)((bf16*)(F.ws + WS_OV + OV_ABUF) + ro + n) = (unsigned long long)pk2(av4[0], av4[1]) | ((unsigned long long)pk2(av4[2], av4[3]) << 32);
                    *(GAS unsigned long long*)((bf16*)(F.ws + WS_OV + OV_GBUF) + ro + n) = (unsigned long long)pk2(ag[0], ag[1]) | ((unsigned long long)pk2(ag[2], ag[3]) << 32); } }
            PSTAMP(0);
#pragma unroll
            for (int j = 0; j < 3; ++j) { const int idx = tid + 512 * j; if (idx < 19 * 64) { f32x4 a4, c4, x4; unpack4f(lx[j], a4); unpack4f(lc[j], c4); unpack4f(lxx[j], x4);
                *(LAS f32x4*)(XL + (idx >> 6) * 256 + cg4) = a4; *(LAS f32x4*)(VL + (idx >> 6) * 256 + cg4) = c4 * x4; } }
            __syncthreads();
            const float* pkc = pk + cg4;
            const f32x4 cb4 = *(const f32x4*)(pkc + PK_CONVB), cw0 = *(const f32x4*)(pkc + PK_CONVW), cw1 = *(const f32x4*)(pkc + PK_CONVW + 256), cw2 = *(const f32x4*)(pkc + PK_CONVW + 512), cw3 = *(const f32x4*)(pkc + PK_CONVW + 768);
            const f32x4 sw0 = *(const f32x4*)(pkc + PK_SCW), sw1 = *(const f32x4*)(pkc + PK_SCW + 256), sw2 = *(const f32x4*)(pkc + PK_SCW + 512), sg4 = *(const f32x4*)(pkc + PK_SCG);
#pragma unroll
            for (int j = 0; j < 2; ++j) { const int t = (tid >> 6) + 8 * j;
                const LAS float* xr = XL + t * 256 + cg4; const LAS float* vr = VL + (t + 1) * 256 + cg4;
                *(LAS f32x4*)(U + t * 256 + cg4) = cb4 + *(const LAS f32x4*)xr * cw0 + *(const LAS f32x4*)(xr + 256) * cw1 + *(const LAS f32x4*)(xr + 512) * cw2 + *(const LAS f32x4*)(xr + 768) * cw3;
                f32x4 b4; unpack4f(lb[j], b4);
                const f32x4 y4 = b4 * (*(const LAS f32x4*)vr * sw0 + *(const LAS f32x4*)(vr + 256) * sw1 + *(const LAS f32x4*)(vr + 512) * sw2);
                const float ss = red16((y4[0] * y4[0] + y4[1] * y4[1]) + (y4[2] * y4[2] + y4[3] * y4[3])); const float rs = rsqrtf(ss * (1.0f / 64.0f) + RMS_EPS);
                *(GAS unsigned long long*)(Y + (size_t)row_of(b, s0 + t) * D + 256 + cg4) = (unsigned long long)pk2(y4[0] * rs * sg4[0], y4[1] * rs * sg4[1]) | ((unsigned long long)pk2(y4[2] * rs * sg4[2], y4[3] * rs * sg4[3]) << 32); }
            PSTAMP(1);
            __syncthreads();
            { bf16x8v Al[2];
#pragma unroll
                for (int ks = 0; ks < 2; ++ks) { const LAS float* up = U + fr * 256 + 64 * gblk + 32 * ks + 8 * fq; const f32x4v u0 = *(const LAS f32x4v*)up, u1 = *(const LAS f32x4v*)(up + 4);
                    const float uv[8] = {u0.x, u0.y, u0.z, u0.w, u1.x, u1.y, u1.z, u1.w}; Al[ks] = pack8(uv); }
                const f32x4v zero = (f32x4v){0.f, 0.f, 0.f, 0.f};
#pragma unroll
                for (int ct = 0; ct < 4; ++ct) { const int j = 64 * gblk + 16 * ct + 4 * fq;
                    f32x4v ac = __builtin_amdgcn_mfma_f32_16x16x32_bf16(Bf[16 + 2 * ct], Al[0], zero, 0, 0, 0); ac = __builtin_amdgcn_mfma_f32_16x16x32_bf16(Bf[17 + 2 * ct], Al[1], ac, 0, 0, 0);
                    const f32x4v bias = *(const f32x4v*)(pk + (gtp ? PK_BX : PK_BA) + j);
                    f32x4v gv;
#pragma unroll
                    for (int i = 0; i < 4; ++i) gv[i] = sigmoidf_(ac[i] + bias[i]);
                    *(LAS f32x4v*)(GT + (gtp * 16 + fr) * 256 + j) = gv; } }
            PSTAMP(2);
            __syncthreads();
#pragma unroll
            for (int it = 0; it < 8; ++it) { const int idx = it * (NWAVES * 64) + tid, ch = idx & 255;
                const float r = GT[idx], ig = GT[16 * 256 + idx], u = U[idx];
                const float la = -8.0f * r * softplusf_(-pk[PK_LAM + ch]), a = __expf(la), x2 = 2.0f * la;
                const float om = x2 < -0.25f ? (1.0f - __expf(x2)) : -x2 * (1.0f + x2 * (0.5f + x2 * (0.16666667f + x2 * (0.041666668f + x2 * 0.0083333338f))));
                const float bt = __builtin_amdgcn_sqrtf(om) * (ig * u);
                GT[idx] = a; GT[16 * 256 + idx] = bt; }
            __syncthreads();
            PSTAMP(3);
            if (tid < 256) { const int j = tid;
#pragma unroll
                for (int t = 0; t < 16; ++t) { const float a = GT[t * 256 + j], bt = GT[(16 + t) * 256 + j];
                    hloc = a * hloc + bt; caloc *= a;
                    const size_t ro = (size_t)row_of(b, s0 + t) * 256 + j; ((unsigned*)(F.ws + WS_OV + OV_HL))[ro] = pk2(hloc, caloc); } }
            PSTAMP(4);
        }
        if (tid < 256) { ((float*)(F.ws + WS_AGG))[((size_t)(b * 32 + c) * 256 + tid) * 2 + 0] = caloc; ((float*)(F.ws + WS_AGG))[((size_t)(b * 32 + c) * 256 + tid) * 2 + 1] = hloc; }
        __syncthreads();
    }
}

constexpr int SC_CH = 24, SC_NCH = TT / SC_CH, SC_LW = SC_CH / 4, SC_STEPF = 336, SC_BUFF = SC_CH * SC_STEPF;
constexpr int SC_VJ = (SC_LW * 16 + 63) / 64;
static_assert(SC_NCH * SC_CH == TT && 2 * SC_BUFF * 4 <= RING_BYTES, "scan geometry");
struct ScanRegs { unsigned rr[SC_LW + 1], kk[SC_LW + 1], aa[SC_LW], ww[SC_LW]; unsigned vc[SC_VJ], vp[SC_VJ]; };
__device__ __forceinline__ void scan_load(const Frame& F, ScanRegs& R, int b, int h, int q, int lw, int chunk, unsigned lane) {
    const int t0 = chunk * SC_CH + SC_LW * lw;
    const bf16* P = ((bf16*)(F.ws + WS_OV + OV_P)); const bf16* AB = ((bf16*)(F.ws + WS_OV + OV_ABUF)); const bf16* WD = ((bf16*)(F.ws + WS_OV + OV_WDEC));
#pragma unroll
    for (int m = 0; m < SC_LW + 1; ++m) { const int s = t0 - 1 + m;
        if (s >= 0) { const bf16* rowp = P + (size_t)row_of(b, s) * NINP + h * 64; R.rr[m] = rowp[PC_R + lane]; R.kk[m] = rowp[PC_K + lane]; } else { R.rr[m] = 0u; R.kk[m] = 0u; } }
#pragma unroll
    for (int i = 0; i < SC_LW; ++i) { const size_t ro = (size_t)row_of(b, t0 + i) * 512 + h * 64; R.aa[i] = (AB + ro)[lane]; R.ww[i] = (WD + ro)[lane]; }
#pragma unroll
    for (int j = 0; j < SC_VJ; ++j) { const int st0 = 4 * j; const unsigned st = st0 + (lane >> 4), rw = lane & 15; R.vc[j] = 0u; R.vp[j] = 0u;
        if (st < (unsigned)SC_LW) { const int s = t0 + (int)st; const unsigned col = PC_V + h * 64 + 16 * q + rw; R.vc[j] = P[(size_t)row_of(b, s) * NINP + col]; if (s > 0) R.vp[j] = P[(size_t)row_of(b, s - 1) * NINP + col]; } }
}
__device__ __forceinline__ void scan_emit(const ScanRegs& R, LAS float* buf, int lw, unsigned lane, float mu_r, float mu_k, float kk_n, float ka_n, float mu_v) {
    LAS float* lb = buf + SC_LW * lw * SC_STEPF + lane; asm volatile("" : "+v"(lb));
#pragma unroll
    for (int i = 0; i < SC_LW; ++i) { LAS float* sp = lb + i * SC_STEPF;
        const float rc = bf2f(R.rr[i + 1]), rp = bf2f(R.rr[i]), kc = bf2f(R.kk[i + 1]), kp = bf2f(R.kk[i]);
        const float zr = rc + (rp - rc) * mu_r, zk = kc + (kp - kc) * mu_k, a = bf2f(R.aa[i]);
        const float kv = zk * kk_n; const float ss = wave_sum_dpp(kv * kv); const float kn = kv * rsqrtf(fmaxf(ss, 1e-24f));
        sp[0] = zr; sp[64] = 1.0f - bf2f(R.ww[i]); sp[128] = zk * (1.0f + (a - 1.0f) * ka_n); sp[192] = -kn; sp[256] = kn * a; }
#pragma unroll
    for (int j = 0; j < SC_VJ; ++j) { const unsigned st = 4 * j + (lane >> 4), rw = lane & 15;
        if (st < (unsigned)SC_LW) { const float vc = bf2f(R.vc[j]), vp = bf2f(R.vp[j]); buf[(SC_LW * lw + st) * SC_STEPF + 320 + rw] = vc + (vp - vc) * mu_v; } }
}
typedef float f32x2 __attribute__((ext_vector_type(2)));
struct ScanOps { f32x4 r4, w4, k4, n4, b4; float v; };
__device__ __forceinline__ void scan_ops_load(ScanOps& o, const LAS float* lp, const LAS float* vp) {
    o.r4 = *(const LAS f32x4*)(lp); o.w4 = *(const LAS f32x4*)(lp + 64); o.k4 = *(const LAS f32x4*)(lp + 128);
    o.n4 = *(const LAS f32x4*)(lp + 192); o.b4 = *(const LAS f32x4*)(lp + 256); o.v = *vp; }
#define LO2(v) ((f32x2){(v).x, (v).y})
#define HI2(v) ((f32x2){(v).z, (v).w})
__device__ __forceinline__ float dot4p(const f32x2& a0, const f32x2& a1, const f32x4& b) { f32x2 t = a0 * LO2(b); t = a1 * HI2(b) + t; return t.x + t.y; }
__device__ __forceinline__ float scan_step(f32x2& S0, f32x2& S1, const ScanOps& o, float& q) {
    float p = dot4p(S0, S1, o.n4), y = q;
    p += dppf<0xB1>(p); y += dppf<0xB1>(y); p += dppf<0x4E>(p); y += dppf<0x4E>(y); p += dppf<0x141>(p); y += dppf<0x141>(y); p += dppf<0x128>(p); y += dppf<0x128>(y);
    const f32x2 vv = (f32x2){o.v, o.v}, sa = (f32x2){p, p};
    S0 = LO2(o.b4) * sa + (S0 * LO2(o.w4) + LO2(o.k4) * vv); S1 = HI2(o.b4) * sa + (S1 * HI2(o.w4) + HI2(o.k4) * vv);
    q = dot4p(S0, S1, o.r4);
    return y; }
constexpr int SC_YB = SC_CH * 16;
static_assert((2 * SC_BUFF + 2 * SC_YB + 256 + 256 + 4 * 64 * 33) * 4 <= RING_BYTES, "scan LDS");
__device__ __forceinline__ void scan_flush(const Frame& F, const LAS float* yb, int b, int h, int q, int chunk, int ltid) {
    bf16* Y = ((bf16*)(F.ws + WS_XN)); asm volatile("" : "+v"(ltid));
#pragma unroll
    for (int j = 0; j < (SC_YB + 255) / 256; ++j) { const int idx = ltid + 256 * j; if (idx < SC_YB) { const int st = idx >> 4, rw = idx & 15;
        Y[(size_t)row_of(b, chunk * SC_CH + st) * D + 512 + h * 64 + 16 * q + rw] = (bf16)f2bf(yb[idx]); } }
}
__device__ __forceinline__ void phase_scan(Frame& F, const float* pk, const float* const* in, int l) {
    { int ln_ = F.tid & 63; asm volatile("" : "+v"(ln_)); F.lane = ln_; }
    LAS float* buf0 = (LAS float*)F.lds; LAS float* buf1 = buf0 + SC_BUFF; LAS float* yb0 = buf1 + SC_BUFF; LAS float* yb1 = yb0 + SC_YB; LAS float* dummy = yb1 + SC_YB;
    const unsigned lane = F.lane; const int wave = F.wave;
    const int cv_split = CI_SET1, cv_n = CI_SET1 + (l + 1 < NLAYER ? CI_SET0 : 0);
    for (int item = blockIdx.x; item < 256; item += GRID) {
        const int b = item >> 5, h = (item >> 2) & 7, q = item & 3;
        if (wave >= 4) {
            const int lw = wave - 4, n = h * 64 + lane, ltid = lw * 64 + lane;
            const float mu_r = pk[PK_MU + n], mu_k = pk[PK_MU + 512 + n], kk_n = pk[PK_KK + n], ka_n = pk[PK_KA + n];
            const float mu_v = pk[PK_MU + 1024 + h * 64 + 16 * q + (lane & 15)];
            ScanRegs A, B;
            scan_load(F, A, b, h, q, lw, 0, lane); scan_load(F, B, b, h, q, lw, 1, lane);
            scan_emit(A, buf0, lw, lane, mu_r, mu_k, kk_n, ka_n, mu_v);
            __syncthreads();
            LAS float* cscr = dummy + 256 + lw * (64 * 33);
            int cv_it = (item * 4 + lw); bool cv_pending = false; ConvItem cvi; float cvv[32];
            cvi = conv_item(F.ws, in, l, 1, 0);
            for (int c = 0; c < SC_NCH; ++c) {
                if ((c & 1) == 0) { if (c + 2 < SC_NCH) scan_load(F, A, b, h, q, lw, c + 2, lane); if (c + 1 < SC_NCH) scan_emit(B, buf1, lw, lane, mu_r, mu_k, kk_n, ka_n, mu_v); }
                else              { if (c + 2 < SC_NCH) scan_load(F, B, b, h, q, lw, c + 2, lane); if (c + 1 < SC_NCH) scan_emit(A, buf0, lw, lane, mu_r, mu_k, kk_n, ka_n, mu_v); }
                if (c > 0) scan_flush(F, ((c - 1) & 1) ? yb1 : yb0, b, h, q, c - 1, ltid);
                if ((c & 7) == 1 && cv_pending) { conv_store(cvi, (int)lane, cvv, cscr); cv_pending = false; cv_it += 4 * 256; }
                if ((c & 7) == 0 && cv_it < cv_n) { cvi = cv_it < cv_split ? conv_item(F.ws, in, l, 1, cv_it) : conv_item(F.ws, in, l + 1, 0, cv_it - cv_split); conv_loads(cvi, (int)lane, cvv); cv_pending = true; }
                __syncthreads();
            }
            if (cv_pending) { conv_store(cvi, (int)lane, cvv, cscr); cv_it += 4 * 256; }
            for (; cv_it < cv_n; cv_it += 4 * 256) { cvi = cv_it < cv_split ? conv_item(F.ws, in, l, 1, cv_it) : conv_item(F.ws, in, l + 1, 0, cv_it - cv_split); conv_loads(cvi, (int)lane, cvv); conv_store(cvi, (int)lane, cvv, cscr); }
            scan_flush(F, ((SC_NCH - 1) & 1) ? yb1 : yb0, b, h, q, SC_NCH - 1, ltid);
        } else {
            const int kq = lane & 15, rowl = 4 * wave + (lane >> 4);
            f32x2 S0 = (f32x2){0.f, 0.f}, S1 = S0;
            __builtin_amdgcn_s_setprio(3);
            __syncthreads();
            for (int c = 0; c < SC_NCH; ++c) {
                const LAS float* bp = (c & 1) ? buf1 : buf0;
                LAS float* yw = kq == 0 ? (((c & 1) ? yb1 : yb0) + rowl) : (dummy + lane);
                const int ystep = kq == 0 ? 16 : 0;
                ScanOps oa, ob; float qp = 0.f;
                const LAS float* lp = bp + 4 * kq; const LAS float* vp = bp + 320 + rowl;
                asm volatile("" : "+v"(lp), "+v"(vp), "+v"(yw));
                scan_ops_load(oa, lp, vp);
                scan_ops_load(ob, lp + SC_STEPF, vp + SC_STEPF);
                (void)scan_step(S0, S1, oa, qp);
#pragma unroll 2
                for (int i = 1; i < SC_CH - 1; i += 2) {
                    scan_ops_load(oa, lp + (i + 1) * SC_STEPF, vp + (i + 1) * SC_STEPF);
                    const float y0 = scan_step(S0, S1, ob, qp); yw[(i - 1) * ystep] = y0;
                    scan_ops_load(ob, lp + (i + 2) * SC_STEPF, vp + (i + 2) * SC_STEPF);
                    const float y1 = scan_step(S0, S1, oa, qp); yw[i * ystep] = y1;
                }
                { const float y2 = scan_step(S0, S1, ob, qp); yw[(SC_CH - 2) * ystep] = y2; }
                yw[(SC_CH - 1) * ystep] = red16(qp);
                __syncthreads();
            }
            __builtin_amdgcn_s_setprio(0);
        }
        __syncthreads();
    }
}

__device__ __forceinline__ void unpack4(unsigned long long u, float (&v)[4]) { v[0] = bf2f((unsigned)u & 0xffffu); v[1] = bf2f(((unsigned)u >> 16)); v[2] = bf2f((unsigned)(u >> 32) & 0xffffu); v[3] = bf2f((unsigned)(u >> 48)); }
__device__ __forceinline__ void phase_mix_final(Frame& F, const float* pk) {
    { int ln_ = F.tid & 63; asm volatile("" : "+v"(ln_)); F.lane = ln_; }
    LAS float* carry = (LAS float*)F.lds;
    const int tid = F.tid, lane = F.lane, w = F.wave, rg = lane >> 4, kq = lane & 15;
    const bf16* P = ((bf16*)(F.ws + WS_OV + OV_P)); bf16* Y = ((bf16*)(F.ws + WS_XN));
    const bf16* AB = ((bf16*)(F.ws + WS_OV + OV_ABUF)); const bf16* GB = ((bf16*)(F.ws + WS_OV + OV_GBUF)); const unsigned* HCp = ((const unsigned*)(F.ws + WS_OV + OV_HL));
    const int n0 = w * 64 + 4 * kq;
    const f32x4 mu_r = *(const f32x4*)(pk + PK_MU + n0), mu_k = *(const f32x4*)(pk + PK_MU + 512 + n0), mu_v = *(const f32x4*)(pk + PK_MU + 1024 + n0);
    const f32x4 ka4 = *(const f32x4*)(pk + PK_KA + n0), rk4 = *(const f32x4*)(pk + PK_RK + n0), lw4 = *(const f32x4*)(pk + PK_LNW + n0), lb4 = *(const f32x4*)(pk + PK_LNB + n0);
    const f32x4 ng4 = w < 4 ? *(const f32x4*)(pk + PK_LNG + n0) : (f32x4){0.f, 0.f, 0.f, 0.f};
    for (int tile = blockIdx.x; tile < 256; tile += GRID) {
        const int b = tile >> 5, c = tile & 31;
        const int s_begin = c == 0 ? 0 : NMETA + 64 * c, ntok = c == 0 ? 80 : 64;
        if (tid < 256) {
            const float* ag = ((float*)(F.ws + WS_AGG)) + ((size_t)(b * 32) * 256 + tid) * 2; float ca[32], hh[32];
#pragma unroll
            for (int c2 = 0; c2 < 31; ++c2) { ca[c2] = 0.f; hh[c2] = 0.f; if (c2 < c) { const f32x2v_ t2 = *(const f32x2v_*)(ag + (size_t)c2 * 512); ca[c2] = t2.x; hh[c2] = t2.y; } }
            float hc = 0.f;
#pragma unroll
            for (int c2 = 0; c2 < 31; ++c2) if (c2 < c) hc = ca[c2] * hc + hh[c2];
            carry[tid] = hc; }
        __syncthreads();
        f32x4 cr4 = (f32x4){0.f, 0.f, 0.f, 0.f}; if (w < 4) cr4 = *(const LAS f32x4*)(carry + n0);
        for (int tg = (c == 0 && b != 0) ? NMETA : 0; tg < ntok; tg += 16) {
            unsigned long long rc[4], kc[4], vc[4], rp[4], kp[4], vp[4], av[4], yv[4], gv[4], lg[4]; v4u hc[4];
#pragma unroll
            for (int u = 0; u < 4; ++u) { const int s = s_begin + tg + 4 * u + rg; const size_t ro = (size_t)row_of(b, s); const bf16* pr = P + ro * NINP + n0;
                rc[u] = *(const unsigned long long*)(pr + PC_R); kc[u] = *(const unsigned long long*)(pr + PC_K); vc[u] = *(const unsigned long long*)(pr + PC_V); rp[u] = 0ull; kp[u] = 0ull; vp[u] = 0ull;
                if (s > 0) { const bf16* pp = P + (size_t)row_of(b, s - 1) * NINP + n0; rp[u] = *(const unsigned long long*)(pp + PC_R); kp[u] = *(const unsigned long long*)(pp + PC_K); vp[u] = *(const unsigned long long*)(pp + PC_V); }
                av[u] = *(const unsigned long long*)(AB + ro * 512 + n0); yv[u] = *(const unsigned long long*)(Y + ro * D + 512 + n0); gv[u] = *(const unsigned long long*)(GB + ro * 512 + n0);
                lg[u] = 0ull; hc[u] = (v4u){0u, 0u, 0u, 0u};
                if (w < 4) { lg[u] = *(const unsigned long long*)(pr + PC_LRUG); hc[u] = *(const v4u*)(HCp + ro * 256 + n0); } }
#pragma unroll
            for (int u = 0; u < 4; ++u) { const int s = s_begin + tg + 4 * u + rg; const size_t ro = (size_t)row_of(b, s);
                float r_c[4], k_c[4], v_c[4], r_p[4], k_p[4], v_p[4], a4[4], y4[4], g4[4];
                unpack4(rc[u], r_c); unpack4(kc[u], k_c); unpack4(vc[u], v_c); unpack4(rp[u], r_p); unpack4(kp[u], k_p); unpack4(vp[u], v_p); unpack4(av[u], a4); unpack4(yv[u], y4); unpack4(gv[u], g4);
                float zv[4], cbp = 0.f, ysum = 0.f;
#pragma unroll
                for (int j = 0; j < 4; ++j) { const float zr = r_c[j] + (r_p[j] - r_c[j]) * mu_r[j], zk = k_c[j] + (k_p[j] - k_c[j]) * mu_k[j]; zv[j] = v_c[j] + (v_p[j] - v_c[j]) * mu_v[j];
                    cbp += zr * (zk * (1.0f + (a4[j] - 1.0f) * ka4[j])) * rk4[j]; ysum += y4[j]; }
                const float cb = red16(cbp), mean = red16(ysum) * (1.0f / 64.0f);
                float d4[4], vs = 0.f;
#pragma unroll
                for (int j = 0; j < 4; ++j) { d4[j] = y4[j] - mean; vs += d4[j] * d4[j]; }
                const float rstd = rsqrtf(red16(vs) * (1.0f / 64.0f) + LNX_EPS);
                float o4[4];
#pragma unroll
                for (int j = 0; j < 4; ++j) o4[j] = (d4[j] * rstd * lw4[j] + lb4[j] + cb * zv[j]) * g4[j];
                *(GAS unsigned long long*)(Y + ro * D + 512 + n0) = (unsigned long long)pk2(o4[0], o4[1]) | ((unsigned long long)pk2(o4[2], o4[3]) << 32);
                if (w < 4) { float l4[4], yy[4], ss = 0.f; unpack4(lg[u], l4);
#pragma unroll
                    for (int j = 0; j < 4; ++j) { yy[j] = gelu_tanh(l4[j]) * (bf2f(hc[u][j] & 0xffffu) + bf2f(hc[u][j] >> 16) * cr4[j]); ss += yy[j] * yy[j]; }
                    const float rs = rsqrtf(red16(ss) * (1.0f / 64.0f) + RMS_EPS);
                    *(GAS unsigned long long*)(Y + ro * D + n0) = (unsigned long long)pk2(yy[0] * rs * ng4[0], yy[1] * rs * ng4[1]) | ((unsigned long long)pk2(yy[2] * rs * ng4[2], yy[3] * rs * ng4[3]) << 32); } }
        }
        __syncthreads();
    }
}
#ifndef MK_PER_PHASE
#define MK_PER_PHASE 0
#endif
constexpr int REP_GEMM = 1, REP_PREP = 1, REP_SCAN = 1, REP_CONV = 1;
constexpr int PH_PER_LAYER = 12, N_PHASES = 1 + NLAYER * PH_PER_LAYER;
struct Args { const float* in[30]; float* out; unsigned char* ws; int ph_lo, ph_hi; };
static_assert(sizeof(Args) == 30 * 8 + 8 + 8 + 4 + 4, "Args has no padding");

__global__ void __launch_bounds__(NWAVES * 64, 2) hybrid_fwd(Args args) {
    extern __shared__ __attribute__((aligned(16))) unsigned char lds[];
    Frame F;
    F.lds = (LAS unsigned char*)lds;
    F.tid = threadIdx.x; F.lane = F.tid & 63; F.wave = 0;
    { const int bx = blockIdx.x; F.vcu = (bx % 8) * (GRID / 8) + bx / 8; }
    unsigned char* ws = args.ws;
    F.ws = ws; F.x = args.in[0]; F.meta = args.in[1]; F.out = args.out;
    volatile LAS unsigned* MISC = (volatile LAS unsigned*)(F.lds + MISC_OFF);
    for (int u = F.tid; u < (LDS_BYTES - LDSCTL_OFF) / 4; u += NWAVES * 64) ((LAS unsigned*)(F.lds + LDSCTL_OFF))[u] = 0u;
    __syncthreads();
    { const unsigned simd = ((unsigned)__builtin_amdgcn_s_getreg((1 << 11) | (4 << 6) | 4)) & 3u;
      LAS unsigned* tkw = (LAS unsigned*)(F.lds + MISC_OFF) + 12;
      unsigned tk = 0u, tg = 0u; if (vlane() == 0) { tk = __hip_atomic_fetch_add(tkw + simd, 1u, __ATOMIC_RELAXED, __HIP_MEMORY_SCOPE_WORKGROUP); tg = __hip_atomic_fetch_add(tkw + 4, 1u, __ATOMIC_RELAXED, __HIP_MEMORY_SCOPE_WORKGROUP); }
      tk = (unsigned)__builtin_amdgcn_readfirstlane(tk); tg = (unsigned)__builtin_amdgcn_readfirstlane(tg);
      __syncthreads();
      const bool two_each = tkw[0] == 2u && tkw[1] == 2u && tkw[2] == 2u && tkw[3] == 2u;
      F.wave = __builtin_amdgcn_readfirstlane(two_each ? (int)(simd + 4u * tk) : (int)tg); }
    F.lane = vlane(); F.tid = F.wave * 64 + F.lane;
    XcdBarrier bar; bar.bar = (unsigned*)(ws + WS_CTL) + CW_BAR; bar.x = 0; bar.st = nullptr;
    if (!MK_PER_PHASE) bar = xcd_barrier_post((unsigned*)(ws + WS_CTL) + CW_BAR, MISC + 8, F.tid == 0);
    const int lo = args.ph_lo, hi = args.ph_hi; const int wave0 = F.wave;
    unsigned long long pr_prev = 0ull; F.pr_acc = 0ull; F.pr_sub = 0ull; F.ph = 0; if (PROBE_MASK) { pr_prev = __builtin_amdgcn_s_memrealtime(); F.pr_sub = pr_prev; }
#pragma unroll 1
    for (int ph = lo; ph < hi; ++ph) {
        if (PROBE_MASK) F.ph = ph;
        { GAS unsigned char* wsg = (GAS unsigned char*)args.ws; asm volatile("" : "+s"(wsg)); F.ws = (unsigned char*)wsg; }
        { int w_ = wave0; asm volatile("" : "+s"(w_)); F.wave = w_; }
        { int t_ = F.wave * 64 + vlane(); asm volatile("" : "+v"(t_)); F.tid = t_; }
        if (ph == 0) { PackRegs PR; pack_loads(F, args.in, PR); frag_loads(F, args.in, PR); phase_init_convert(F, args.in); PSTAMP(8); pack_stores(F, PR); frag_stores(F, PR); PSTAMP(9); }
        else {
            const int l = (ph - 1) / PH_PER_LAYER, k = (ph - 1) - l * PH_PER_LAYER;
            if (k == 0 || k == 1 || k == 3 || k == 7 || k == 9 || k == 10) {
                unsigned char* w = F.ws;
                const bool up = (k == 0 || k == 9), down = (k == 1 || k == 10);
                const bool lastl = l + 1 == NLAYER;
                const bf16* hcur = (lastl && k == 9) ? (const bf16*)(w + WS_OV + OV_HTMP) : (const bf16*)F.out;
                const bf16* A = down ? (const bf16*)(w + WS_OV + OV_HID) : (k == 7 ? (const bf16*)(w + WS_XN) : hcur);
                const bf16* Am = (down || k == 7) ? A : (const bf16*)(w + WS_HMETA) - (size_t)MX * D;
                const bf16* B = (const bf16*)(w + WS_WB + (k == 0 ? WB_W1IN : k == 1 ? WB_W1OUT : k == 3 ? WB_WIN : k == 7 ? WB_WOUT : k == 9 ? WB_W2IN : WB_W2OUT));
                const int N = up ? 2 * FF : (k == 3 ? NINP : D), K = down ? FF : D;
                const float* rs = nullptr;
                pg8::EpiAny E; E.mode = up ? 0 : 1; E.O = w + WS_OV + (up ? OV_HID : k == 3 ? OV_P : k == 7 ? OV_RAWM : OV_RAWF); E.ldo = up ? FF : (k == 3 ? NINP : D); E.rs = rs;
                const int gwv = F.vcu * NWAVES + F.wave;
                if (k == 3) meta_gemm(F, Am, B, K, N, 1, w + WS_OV + OV_P, NINP, 1, gwv, rs);
                else if (!up) meta_gemm(F, Am, B, K, N, 2, w + WS_MSLAB, D, down ? 8 : 4, gwv, nullptr);
                PSTAMP(5);
                pg8::Gemm g{A, B, MX, N, K, K}; pg8::StaticOrder S; S.init(MX, N, GRID, (int)blockIdx.x);
                for (int rep_ = 0; rep_ < REP_GEMM; ++rep_) pg8::gemm_phase<pg8::EpiAny, pg8::StaticOrder, true, true>(F.lds, g, S, E, F.tid);
                PSTAMP(6);
                if (up) meta_gemm(F, Am, B, K, N, 0, w + WS_OV + OV_HID, FF, 1, (int)blockIdx.x >= 128 ? ((int)blockIdx.x - 128) * NWAVES + F.wave : -1, rs);
            } else if (k == 2 || k == 8 || k == 11) {
                const float* ng = args.in[2] + (size_t)l * 6 * D;
                const bool last = l + 1 == NLAYER;
                const float* g_post = ng + (k == 2 ? 1 : k == 8 ? 3 : 5) * D;
                bf16* h16 = (bf16*)F.out; bf16* htmp = (bf16*)(F.ws + WS_OV + OV_HTMP);
                PostIO io; io.raw16 = (const bf16*)(F.ws + WS_OV + (k == 8 ? OV_RAWM : OV_RAWF));
                io.hin16 = (last && k == 11) ? htmp : h16; io.hout16 = (last && k == 8) ? htmp : h16; io.out32 = (last && k == 11) ? F.out : nullptr; io.nks = k == 8 ? 4 : 8;
                phase_post(F, io, k == 8 ? 1.0f : 0.5f, g_post, !(last && k == 11));
            } else if (k == 4) { for (int rep_ = 0; rep_ < REP_PREP; ++rep_) phase_mix_prep(F, pack_of(F, l), l); }
            else if (k == 5) { for (int rep_ = 0; rep_ < REP_SCAN; ++rep_) phase_scan(F, pack_of(F, l), args.in, l); }
            else { phase_mix_final(F, pack_of(F, l)); }
        }
        if (ph + 1 < hi) { XcdBarrier b2 = bar; b2.bar = (unsigned*)(F.ws + WS_CTL) + CW_BAR; xcd_barrier(b2, F.tid == 0); }
        if (PROBE_MASK) { const unsigned long long t = __builtin_amdgcn_s_memrealtime(); if (PROBE_SUB < 0 && ((PROBE_MASK >> ph) & 1u)) F.pr_acc += t - pr_prev; pr_prev = t; F.pr_sub = t; }
    }
    if (PROBE_MASK && blockIdx.x == 0 && F.tid == 0) { const unsigned long long t0 = __builtin_amdgcn_s_memrealtime(); while (__builtin_amdgcn_s_memrealtime() - t0 < PROBE_AMP * F.pr_acc) __builtin_amdgcn_s_sleep(8); }
}

extern "C" void kernel_launch(void* const* d_in, const int* in_sizes, int n_in, void* d_out, int out_size, void* d_ws, size_t ws_size, hipStream_t stream) {
    static int grid = 0;
    if (grid == 0) {
        if (n_in != 30 || in_sizes[0] != MX * D || out_size != MX * D || ws_size < WS_END) { fprintf(stderr, "kernel_launch: unexpected shapes: n_in %d in0 %d out %d ws %zu\n", n_in, n_in > 0 ? in_sizes[0] : -1, out_size, ws_size); grid = -1; return; }
        int dev = 0, cus = 0, per_cu = 0;
        if (hipGetDevice(&dev) != hipSuccess || hipDeviceGetAttribute(&cus, hipDeviceAttributeMultiprocessorCount, dev) != hipSuccess) { grid = -1; return; }
        if (hipFuncSetAttribute((const void*)hybrid_fwd, hipFuncAttributeMaxDynamicSharedMemorySize, LDS_BYTES) != hipSuccess) { fprintf(stderr, "kernel_launch: hipFuncSetAttribute failed\n"); grid = -1; return; }
        if (hipOccupancyMaxActiveBlocksPerMultiprocessor(&per_cu, (const void*)hybrid_fwd, NWAVES * 64, LDS_BYTES) != hipSuccess || per_cu < 1) { fprintf(stderr, "kernel_launch: occupancy query says %d blocks per CU\n", per_cu); grid = -1; (void)hipGetLastError(); return; }
        (void)hipGetLastError();
        if (cus < GRID) { fprintf(stderr, "kernel_launch: this kernel needs %d CUs (one resident workgroup each), the device has %d\n", GRID, cus); grid = -1; return; }
        grid = GRID;
    }
    if (grid < 0) return;
    if (hipMemsetAsync((char*)d_ws + WS_CTL, 0, CTL_ZERO_BYTES, stream) != hipSuccess) return;
    Args a{};
    for (int i = 0; i < 30; ++i) a.in[i] = (const float*)d_in[i];
    a.out = (float*)d_out; a.ws = (unsigned char*)d_ws;
#if MK_PER_PHASE
    for (int p = 0; p < N_PHASES; ++p) { a.ph_lo = p; a.ph_hi = p + 1; hipLaunchKernelGGL(hybrid_fwd, dim3(grid), dim3(NWAVES * 64), LDS_BYTES, stream, a); }
#else
    a.ph_lo = 0; a.ph_hi = N_PHASES;
    hipLaunchKernelGGL(hybrid_fwd, dim3(grid), dim3(NWAVES * 64), LDS_BYTES, stream, a);
#endif
}
```

```cpp
#include <hip/hip_runtime.h>
#include <cstdio>
#include <cstdint>
namespace pg8 {
#define PG8_LAS __attribute__((address_space(3)))
typedef unsigned short bf16_t;
typedef short bf16x8 __attribute__((ext_vector_type(8)));
typedef float f32x4 __attribute__((ext_vector_type(4)));
typedef unsigned u32x4 __attribute__((ext_vector_type(4)));
constexpr int BM = 256, BK = 64, HALF = 128, HTB = HALF * BK * 2  , STAGE_BYTES = 8 * HTB, NXCD = 8, WGM = 8;

__host__ __device__ __forceinline__ int lds_byte(int r, int c) { const int st = (r >> 4) * 2 + (c >> 5), rr = r & 15, cc = c & 31, ob = rr * 64 + cc * 2; return st * 1024 + (ob ^ (((ob >> 9) & 1) << 5)); }
__host__ __device__ __forceinline__ void stage_rc(int b, int& R, int& C) { const int st = b / 1024, sb = b % 1024, swz = sb ^ (((sb >> 9) & 1) << 5); R = (st >> 1) * 16 + swz / 64; C = (st & 1) * 32 + (swz % 64) / 2; }
__host__ __device__ __forceinline__ int perm32(int rho) { const int n = rho >> 4, i = rho & 15; return 8 * (i >> 2) + 4 * n + (i & 3); }

struct Unit { int pm, pn; };
struct Gemm { const bf16_t* A; const bf16_t* Bt; int M, N, K, ld; };

struct StaticOrder {
    int nM, nN, nwg, G, c, one_pn;
    __host__ __device__ void init(int M, int N, int G_, int c_) { nM = M / BM; nN = N / BM; nwg = nM * nN; G = G_; c = c_; one_pn = -1; }
    __host__ __device__ bool next(int i, Unit& u) const {
        if (one_pn != -1) { if (i != 0 || one_pn < 0) return false; u.pm = 0; u.pn = one_pn; return true; }
        const long L = (long)i * G + c; if (L >= nwg) return false;
        int wgid = (int)L; { const int q = nwg / NXCD, r = nwg % NXCD, xcd = wgid % NXCD, off = wgid / NXCD; wgid = (xcd < r ? xcd * (q + 1) : r * (q + 1) + (xcd - r) * q) + off; }
        const int nig = WGM * nN, gid = wgid / nig, fm = gid * WGM, gsz = (nM - fm) < WGM ? (nM - fm) : WGM;
        u.pm = fm + ((wgid % nig) % gsz); u.pn = (wgid % nig) / gsz; return true;
    }
    __device__ __forceinline__ void a_ready(const Unit&) const {}
    __device__ __forceinline__ void done(const Unit&) const {}
};
__device__ __forceinline__ unsigned cvt_pk_bf16(float lo, float hi) { unsigned r; asm volatile("v_cvt_pk_bf16_f32 %0, %1, %2" : "=v"(r) : "v"(lo), "v"(hi)); return r; }
typedef float f32x2 __attribute__((ext_vector_type(2)));
struct EpiSwiGLU {
    static constexpr bool PERM = true, AFTER_DRAIN = false;
    bf16_t* O; int ldo; const PG8_LAS float* rst;
    __device__ __forceinline__ void operator()(const f32x4 (&acc)[2][2][4][2], const Unit& u, int wr, int wc, int fr, int fq) const {
        const int row0 = u.pm * BM + wr * 64 + fr, col0 = u.pn * HALF + wc * 32 + 8 * fq;
#pragma unroll
        for (int ai = 0; ai < 2; ++ai)
#pragma unroll
            for (int m = 0; m < 4; ++m) { bf16_t* rowp = O + (size_t)(row0 + ai * HALF + m * 16) * ldo + col0; const float sc = rst ? rst[64 * ai + 16 * m + fr] : 1.0f;
                float hv[8];
#pragma unroll
                for (int n = 0; n < 2; ++n)
#pragma unroll
                    for (int j = 0; j < 4; ++j) { const float g = acc[ai][0][m][n][j] * sc, up = acc[ai][1][m][n][j] * sc; hv[n * 4 + j] = g * __builtin_amdgcn_rcpf(1.0f + __expf(-g)) * up; }
                u32x4 w; w.x = cvt_pk_bf16(hv[0], hv[1]); w.y = cvt_pk_bf16(hv[2], hv[3]); w.z = cvt_pk_bf16(hv[4], hv[5]); w.w = cvt_pk_bf16(hv[6], hv[7]);
                *(u32x4*)rowp = w; }
    }
};
struct EpiStoreBf16 {
    static constexpr bool PERM = true, AFTER_DRAIN = false;
    bf16_t* O; int ldc; const PG8_LAS float* rst;
    __device__ __forceinline__ void operator()(const f32x4 (&acc)[2][2][4][2], const Unit& u, int wr, int wc, int fr, int fq) const {
        const int row0 = u.pm * BM + wr * 64 + fr, col0 = u.pn * BM + wc * 32 + 8 * fq;
#pragma unroll
        for (int ai = 0; ai < 2; ++ai)
#pragma unroll
            for (int m = 0; m < 4; ++m) { bf16_t* rowp = O + (size_t)(row0 + ai * HALF + m * 16) * ldc + col0; const float sc = rst ? rst[64 * ai + 16 * m + fr] : 1.0f;
#pragma unroll
                for (int bj = 0; bj < 2; ++bj) { const f32x4 v0 = acc[ai][bj][m][0] * sc, v1 = acc[ai][bj][m][1] * sc;
                    u32x4 w; w.x = cvt_pk_bf16(v0[0], v0[1]); w.y = cvt_pk_bf16(v0[2], v0[3]); w.z = cvt_pk_bf16(v1[0], v1[1]); w.w = cvt_pk_bf16(v1[2], v1[3]);
                    *(u32x4*)(rowp + bj * HALF) = w; } }
    }
};
struct EpiF32 {
    static constexpr bool PERM = false, AFTER_DRAIN = false;
    float* C; int ldc;
    __device__ __forceinline__ void operator()(const f32x4 (&acc)[2][2][4][2], const Unit& u, int wr, int wc, int fr, int fq) const {
        const int row0 = u.pm * BM + wr * 64 + fr, col0 = u.pn * BM + wc * 32 + 4 * fq;
#pragma unroll
        for (int ai = 0; ai < 2; ++ai)
#pragma unroll
            for (int m = 0; m < 4; ++m) { float* rowp = C + (size_t)(row0 + ai * HALF + m * 16) * ldc + col0;
#pragma unroll
                for (int bj = 0; bj < 2; ++bj)
#pragma unroll
                    for (int n = 0; n < 2; ++n) *(f32x4*)(rowp + bj * HALF + n * 16) = acc[ai][bj][m][n]; }
    }
};
struct EpiAny {
    static constexpr bool PERM = true, AFTER_DRAIN = false;
    int mode; void* O; int ldo; const float* rs;
    __device__ __forceinline__ void row_scale_issue(const Unit& u, int wr, int fr, int fq, float& v0, float& v1) const {
        if (rs) { const float* p = rs + u.pm * BM + wr * 64 + fr + (fq >> 1) * HALF + (fq & 1) * 32; v0 = p[0]; v1 = p[16]; } }
    __device__ __forceinline__ void row_scale_park(PG8_LAS unsigned char* tab, int wid, int lane, float v0, float v1) const {
        if (rs) { PG8_LAS float* t = (PG8_LAS float*)(tab + wid * 512) + ((lane >> 5) * 64 + ((lane >> 4) & 1) * 32 + (lane & 15)); t[0] = v0; t[16] = v1; asm volatile("s_waitcnt lgkmcnt(0)" ::: "memory"); } }
    __device__ __forceinline__ void operator()(f32x4 (&acc)[2][2][4][2], const Unit& u, int wr, int wc, int fr, int fq, PG8_LAS unsigned char* tab, int wid) const {
        const PG8_LAS float* rst = rs ? (const PG8_LAS float*)(tab + wid * 512) : nullptr;
        if (mode == 0) { EpiSwiGLU E{(bf16_t*)O, ldo, rst}; E(acc, u, wr, wc, fr, fq); }
        else if (mode == 1) { EpiStoreBf16 E{(bf16_t*)O, ldo, rst}; E(acc, u, wr, wc, fr, fq); }
        else { float* C = (float*)O; const int row0 = u.pm * BM + wr * 64 + fr, col0 = u.pn * BM + wc * 32 + 8 * fq;
#pragma unroll
            for (int ai = 0; ai < 2; ++ai)
#pragma unroll
                for (int m = 0; m < 4; ++m) { float* rowp = C + (size_t)(row0 + ai * HALF + m * 16) * ldo + col0;
#pragma unroll
                    for (int bj = 0; bj < 2; ++bj)
#pragma unroll
                        for (int n = 0; n < 2; ++n) *(f32x4*)(rowp + bj * HALF + n * 4) = acc[ai][bj][m][n]; } }
    }
};
template <class Epi, class Sched, bool ALIGN_EPI = false, bool SP2 = false>
__device__ __forceinline__ void gemm_phase(PG8_LAS unsigned char* lds, const Gemm g, const Sched& S, const Epi& E, int tid_in  ) {
    int tid_ = tid_in; asm volatile("" : "+v"(tid_));
    const int tid = tid_, wid = __builtin_amdgcn_readfirstlane(tid >> 6), lane = tid & 63, wr = wid >> 2, wc = wid & 3, fr = lane & 15, fq = lane >> 4;
    const int K = g.K, LD = g.ld, nt = K / BK;
    unsigned voffA[2], voffB[2];
#pragma unroll
    for (int i = 0; i < 2; ++i) { int R, C; stage_rc(tid * 16 + i * 8192, R, C); const int Rb = Epi::PERM ? ((R & ~31) + perm32(R & 31)) : R;
        voffA[i] = (unsigned)(R * LD + C) * 2u; voffB[i] = (unsigned)(Rb * LD + C) * 2u; }
    const size_t kstep = (size_t)(BK * 2);
    const size_t hstep = (size_t)HALF * LD * 2;
    const size_t tstep = 2 * hstep;
    const unsigned ldsw = (unsigned)wid * 1024u;
    const int aoff = lds_byte(wr * 64 + fr, fq * 8), boff = lds_byte(wc * 32 + fr, fq * 8);
#define PG8_SA(b, h) (((b) * 2 + (h)) * HTB)
#define PG8_SB(b, h) ((4 + (b) * 2 + (h)) * HTB)
#define PG8_STAGE(bufoff, gbase, voff) do { _Pragma("unroll") for (int _i = 0; _i < 2; ++_i) \
        __builtin_amdgcn_global_load_lds((const unsigned*)((const char*)(gbase) + (voff)[_i]), (PG8_LAS unsigned*)(lds + (bufoff) + ldsw + _i * 8192), 16, 0, 0); } while (0)
#define PG8_LDA(dst, b, h) do { _Pragma("unroll") for (int m = 0; m < 4; ++m) _Pragma("unroll") for (int k = 0; k < 2; ++k) dst[m][k] = *(const PG8_LAS bf16x8*)(lds + PG8_SA(b, h) + aoff + m * 2048 + k * 1024); } while (0)
#define PG8_LDB(dst, b, h) do { _Pragma("unroll") for (int n = 0; n < 2; ++n) _Pragma("unroll") for (int k = 0; k < 2; ++k) dst[n][k] = *(const PG8_LAS bf16x8*)(lds + PG8_SB(b, h) + boff + n * 2048 + k * 1024); } while (0)
#define PG8_MMA(ai, bj, At, Bt) do { __builtin_amdgcn_s_setprio(1); _Pragma("unroll") for (int m = 0; m < 4; ++m) _Pragma("unroll") for (int n = 0; n < 2; ++n) _Pragma("unroll") for (int k = 0; k < 2; ++k) \
        acc[ai][bj][m][n] = __builtin_amdgcn_mfma_f32_16x16x32_bf16(Bt[n][k], At[m][k], acc[ai][bj][m][n], 0, 0, 0); __builtin_amdgcn_s_setprio(0); } while (0)
#define PG8_WAIT_V(n) asm volatile("s_waitcnt vmcnt(" #n ")" ::: "memory")
#define PG8_WAIT_L(n) asm volatile("s_waitcnt lgkmcnt(" #n ")" ::: "memory")
#define PG8_BAR __builtin_amdgcn_s_barrier()
#define PG8_SCHED __builtin_amdgcn_sched_barrier(0)
    Unit cur, nxt; int ui = 0;
    if (!S.next(0, cur)) return;
    f32x4 acc[2][2][4][2];
#pragma unroll
    for (int a = 0; a < 2; ++a)
#pragma unroll
        for (int b = 0; b < 2; ++b)
#pragma unroll
            for (int m = 0; m < 4; ++m)
#pragma unroll
                for (int n = 0; n < 2; ++n) acc[a][b][m][n] = (f32x4){0.f, 0.f, 0.f, 0.f};
    bf16x8 At[4][2], B0[2][2], B1[2][2];
    const char* cA = (const char*)g.A + (size_t)cur.pm * tstep; const char* cB = (const char*)g.Bt + (size_t)cur.pn * tstep;
    S.a_ready(cur);
    if constexpr (SP2) {
        PG8_STAGE(PG8_SB(0, 0), cB, voffB); PG8_STAGE(PG8_SB(0, 1), cB + hstep, voffB); PG8_STAGE(PG8_SA(0, 0), cA, voffA); PG8_STAGE(PG8_SA(0, 1), cA + hstep, voffA);
        if (wr == 1) PG8_BAR;
        PG8_WAIT_V(2); PG8_BAR;
        PG8_STAGE(PG8_SB(1, 0), cB + kstep, voffB); PG8_STAGE(PG8_SA(1, 0), cA + kstep, voffA); PG8_STAGE(PG8_SB(1, 1), cB + hstep + kstep, voffB);
        PG8_WAIT_V(6); PG8_BAR;
    } else {
        PG8_STAGE(PG8_SB(0, 0), cB, voffB); PG8_STAGE(PG8_SA(0, 0), cA, voffA); PG8_STAGE(PG8_SB(0, 1), cB + hstep, voffB); PG8_STAGE(PG8_SA(0, 1), cA + hstep, voffA);
        if (wr == 1) PG8_BAR;
        PG8_WAIT_V(4); PG8_BAR;
        PG8_STAGE(PG8_SB(1, 0), cB + kstep, voffB); PG8_STAGE(PG8_SA(1, 0), cA + kstep, voffA); PG8_STAGE(PG8_SB(1, 1), cB + hstep + kstep, voffB);
        PG8_WAIT_V(6); PG8_BAR;
    }
    for (;;) {
        const bool has_next = S.next(ui + 1, nxt);
        { float rsv0 = 1.0f, rsv1 = 1.0f; E.row_scale_issue(cur, wr, fr, fq, rsv0, rsv1); E.row_scale_park(lds + STAGE_BYTES, wid, lane, rsv0, rsv1); }
        const char* nA = has_next ? (const char*)g.A + (size_t)nxt.pm * tstep : cA; const char* nB = has_next ? (const char*)g.Bt + (size_t)nxt.pn * tstep : cB;
        for (int t = 0; t < nt; t += 2) {
            const bool last = (t == nt - 2);
            const char* a1 = cA + (size_t)(t + 1) * kstep;
            const char* a2 = last ? nA : cA + (size_t)(t + 2) * kstep; const char* b2 = last ? nB : cB + (size_t)(t + 2) * kstep;
            const char* a3 = a2 + kstep; const char* b3 = b2 + kstep;
            if (last && has_next) S.a_ready(nxt);
            if constexpr (SP2) {
            PG8_LDB(B0, 0, 0); PG8_LDB(B1, 0, 1); PG8_SCHED; PG8_LDA(At, 0, 0); PG8_STAGE(PG8_SA(1, 1), a1 + hstep, voffA);
            PG8_WAIT_V(8); PG8_WAIT_L(0); PG8_BAR; PG8_MMA(0, 0, At, B0); PG8_MMA(0, 1, At, B1); PG8_BAR; PG8_SCHED;
            PG8_LDA(At, 0, 1); PG8_STAGE(PG8_SB(0, 0), b2, voffB); PG8_STAGE(PG8_SB(0, 1), b2 + hstep, voffB); PG8_STAGE(PG8_SA(0, 0), a2, voffA);
            PG8_WAIT_V(8); PG8_WAIT_L(0); PG8_BAR; PG8_MMA(1, 0, At, B0); PG8_MMA(1, 1, At, B1); PG8_BAR; PG8_SCHED;
            PG8_LDB(B0, 1, 0); PG8_LDB(B1, 1, 1); PG8_SCHED; PG8_LDA(At, 1, 0); PG8_STAGE(PG8_SA(0, 1), a2 + hstep, voffA);
            PG8_WAIT_V(8); PG8_WAIT_L(0); PG8_BAR; PG8_MMA(0, 0, At, B0); PG8_MMA(0, 1, At, B1); PG8_BAR; PG8_SCHED;
            PG8_LDA(At, 1, 1); PG8_STAGE(PG8_SB(1, 0), b3, voffB); PG8_STAGE(PG8_SB(1, 1), b3 + hstep, voffB); PG8_STAGE(PG8_SA(1, 0), a3, voffA);
            PG8_WAIT_V(8); PG8_WAIT_L(0); PG8_BAR; PG8_MMA(1, 0, At, B0); PG8_MMA(1, 1, At, B1); PG8_BAR; PG8_SCHED;
            } else {
            PG8_LDB(B0, 0, 0); PG8_SCHED; PG8_LDA(At, 0, 0); PG8_STAGE(PG8_SA(1, 1), a1 + hstep, voffA);
            PG8_WAIT_L(8); PG8_BAR; PG8_WAIT_L(0); PG8_MMA(0, 0, At, B0); PG8_BAR; PG8_SCHED;
            PG8_LDB(B1, 0, 1); PG8_STAGE(PG8_SB(0, 0), b2, voffB);
            PG8_BAR; PG8_WAIT_L(0); PG8_MMA(0, 1, At, B1); PG8_BAR;
            PG8_LDA(At, 0, 1); PG8_STAGE(PG8_SA(0, 0), a2, voffA);
            PG8_BAR; PG8_WAIT_L(0); PG8_MMA(1, 0, At, B0); PG8_BAR; PG8_SCHED;
            PG8_STAGE(PG8_SB(0, 1), b2 + hstep, voffB);
            PG8_WAIT_V(6); PG8_BAR; PG8_MMA(1, 1, At, B1); PG8_BAR;
            PG8_LDB(B0, 1, 0); PG8_SCHED; PG8_LDA(At, 1, 0); PG8_STAGE(PG8_SA(0, 1), a2 + hstep, voffA);
            PG8_WAIT_L(8); PG8_BAR; PG8_WAIT_L(0); PG8_MMA(0, 0, At, B0); PG8_BAR; PG8_SCHED;
            PG8_LDB(B1, 1, 1); PG8_STAGE(PG8_SB(1, 0), b3, voffB);
            PG8_BAR; PG8_WAIT_L(0); PG8_MMA(0, 1, At, B1); PG8_BAR;
            PG8_LDA(At, 1, 1); PG8_STAGE(PG8_SA(1, 0), a3, voffA);
            PG8_BAR; PG8_WAIT_L(0); PG8_MMA(1, 0, At, B0); PG8_BAR; PG8_SCHED;
            PG8_STAGE(PG8_SB(1, 1), b3 + hstep, voffB);
            PG8_WAIT_V(6); PG8_BAR; PG8_MMA(1, 1, At, B1); PG8_BAR;
            }
        }
        if constexpr (ALIGN_EPI) { if (wr == 0) PG8_BAR; }
        E(acc, cur, wr, wc, fr, fq, lds + STAGE_BYTES, wid); S.done(cur);
        if (!has_next) break;
#pragma unroll
        for (int a = 0; a < 2; ++a)
#pragma unroll
            for (int b = 0; b < 2; ++b)
#pragma unroll
                for (int m = 0; m < 4; ++m)
#pragma unroll
                    for (int n = 0; n < 2; ++n) acc[a][b][m][n] = (f32x4){0.f, 0.f, 0.f, 0.f};
        cur = nxt; cA = nA; cB = nB; ++ui;
        if constexpr (ALIGN_EPI) { if (wr == 1) PG8_BAR; }
    }
    PG8_WAIT_V(0);
    if constexpr (!ALIGN_EPI) { if (wr == 0) PG8_BAR; }
    PG8_BAR;
#undef PG8_SA
#undef PG8_SB
#undef PG8_STAGE
#undef PG8_LDA
#undef PG8_LDB
#undef PG8_MMA
#undef PG8_WAIT_V
#undef PG8_WAIT_L
#undef PG8_BAR
#undef PG8_SCHED
}
}
constexpr int NWAVES = 8, GRID = 256;
constexpr int D = 1024, FF = 2816, NIN = 2944, NINP = 3072, NLAYER = 2;
constexpr int NB = 8, SEQ = 2048, NMETA = 16, TT = SEQ + NMETA;
constexpr int MX = NB * SEQ, MREAL = MX + NMETA, MP = 16640;
constexpr float RMS_EPS = 1e-6f, LNX_EPS = 64e-5f;
constexpr int PC_LRUX = 0, PC_LRUG = 256, PC_SCB = 512, PC_SCC = 768, PC_SCX = 1024, PC_R = 1280, PC_K = 1792, PC_V = 2304, PC_LO = 2816;

constexpr size_t MiB = 1u << 20;
constexpr size_t WS_CTL = 0, CTL_ZERO_BYTES = 1 * MiB;
constexpr size_t WS_HMETA = 1 * MiB;
constexpr size_t WS_RS = WS_HMETA + 640 * 1024;
constexpr size_t WS_MSLAB = WS_HMETA + 64 * 1024;
constexpr size_t WS_AGG = 2 * MiB;
constexpr size_t WS_WB = 3 * MiB;
constexpr size_t WB_W1IN = 0, WB_W1OUT = 11 * MiB, WB_W2IN = WB_W1OUT + 5632 * 1024, WB_W2OUT = WB_W2IN + 11 * MiB, WB_WIN = WB_W2OUT + 5632 * 1024, WB_WOUT = WB_WIN + 6 * MiB, WB_END = WB_WOUT + 2 * MiB;
static_assert(WB_END == 41 * MiB, "weight map");
constexpr size_t WS_XN = 44 * MiB;
constexpr size_t WS_OV = 77 * MiB;
constexpr size_t OV_HID = 0, OV_RAWF = 90 * MiB;
constexpr size_t OV_P = 0, OV_WDEC = OV_P + (size_t)MP * NINP * 2, OV_ABUF = OV_WDEC + (size_t)MP * 512 * 2, OV_GBUF = OV_ABUF + (size_t)MP * 512 * 2, OV_HL = OV_GBUF + (size_t)MP * 512 * 2, OV_CA = OV_HL + (size_t)MP * 256 * 4, OV_MIXEND = OV_CA + (size_t)MP * 256 * 4;
constexpr size_t OV_HTMP = 130 * MiB;
constexpr size_t OV_RAWM = 0;
constexpr size_t WS_END = 256 * MiB;
static_assert(WS_XN + (size_t)MP * D * 2 <= WS_OV && WS_OV + OV_MIXEND <= WS_END && WS_OV + OV_RAWF + (size_t)MP * D * 2 <= WS_OV + OV_HTMP && WS_OV + OV_HTMP + (size_t)MX * D * 2 <= WS_END && (size_t)MP * FF * 2 <= OV_RAWF, "d_ws map");
constexpr int CW_THIN = 3072;
constexpr int CW_BAR = 4096;

constexpr unsigned PROBE_MASK = 0u, PROBE_AMP = 8u; constexpr int PROBE_SUB = -1;
#define PSTAMP(j) do { if (PROBE_MASK && PROBE_SUB >= 0) { const unsigned long long t_ = __builtin_amdgcn_s_memrealtime(); if (PROBE_SUB == (j) && ((PROBE_MASK >> F.ph) & 1u)) F.pr_acc += t_ - F.pr_sub; F.pr_sub = t_; } } while (0)
constexpr int RING_BYTES = 143360, LDSCTL_OFF = RING_BYTES, MISC_OFF = LDSCTL_OFF + 320, LDS_BYTES = 147456;

#define GAS __attribute__((address_space(1)))
#define LAS __attribute__((address_space(3)))
typedef unsigned short bf16;
typedef unsigned v4u __attribute__((ext_vector_type(4)));
typedef float f32x4 __attribute__((ext_vector_type(4)));
typedef GAS unsigned gu32;
typedef float f32x2v_ __attribute__((ext_vector_type(2)));
#define LDS_WAIT() asm volatile("s_waitcnt lgkmcnt(0)" ::: "memory")
__device__ __forceinline__ unsigned f2bf(float f) { unsigned u = __builtin_bit_cast(unsigned, f); return (u + 0x7fffu + ((u >> 16) & 1u)) >> 16; }
__device__ __forceinline__ unsigned pk2(float lo, float hi) { return f2bf(lo) | (f2bf(hi) << 16); }
__device__ __forceinline__ float bf2f(unsigned b) { return __builtin_bit_cast(float, b << 16); }
__device__ __forceinline__ float sigmoidf_(float x) { return __builtin_amdgcn_rcpf(1.0f + __expf(-x)); }
__device__ __forceinline__ float tanhf_(float x) { return 1.0f - 2.0f * __builtin_amdgcn_rcpf(1.0f + __expf(2.0f * x)); }
__device__ __forceinline__ float softplusf_(float x) { return fmaxf(x, 0.f) + __logf(1.0f + __expf(-fabsf(x))); }
__device__ __forceinline__ float gelu_tanh(float x) { const float u = 0.7978845608028654f * (x + 0.044715f * x * x * x); return 0.5f * x * (1.0f + tanhf_(u)); }
template <int CTRL> __device__ __forceinline__ float dppf(float x) { return __builtin_bit_cast(float, __builtin_amdgcn_mov_dpp(__builtin_bit_cast(int, x), CTRL, 0xf, 0xf, true)); }
__device__ __forceinline__ float red16(float x) { x += dppf<0xB1>(x); x += dppf<0x4E>(x); x += dppf<0x141>(x); x += dppf<0x128>(x); return x; }
__device__ __forceinline__ float wave_sum(float x) {
    x = red16(x);
    x += __builtin_bit_cast(float, __builtin_amdgcn_update_dpp(0, __builtin_bit_cast(int, x), 0x142, 0xa, 0xf, false));
    x += __builtin_bit_cast(float, __builtin_amdgcn_update_dpp(0, __builtin_bit_cast(int, x), 0x143, 0xc, 0xf, false));
    return __builtin_bit_cast(float, __builtin_amdgcn_readlane(__builtin_bit_cast(int, x), 63)); }
__device__ __forceinline__ float wave_sum_dpp(float x) { return wave_sum(x); }
__device__ __forceinline__ int vlane() { return (int)__builtin_amdgcn_mbcnt_hi(~0u, __builtin_amdgcn_mbcnt_lo(~0u, 0u)); }
__device__ __forceinline__ int row_of(int b, int s) { return s < NMETA ? (MX + s) : (b * SEQ + s - NMETA); }
__device__ __forceinline__ void unpack8(const v4u& u, float (&v)[8]) { v[0] = bf2f(u.x & 0xffffu); v[1] = bf2f(u.x >> 16); v[2] = bf2f(u.y & 0xffffu); v[3] = bf2f(u.y >> 16); v[4] = bf2f(u.z & 0xffffu); v[5] = bf2f(u.z >> 16); v[6] = bf2f(u.w & 0xffffu); v[7] = bf2f(u.w >> 16); }
#define XB_TMO      128
#define XB_XCNT(j)  (256  + 64 * (j))
#define XB_XSUB(j)  (1280 + 64 * (j))
#define XB_XGEN(j)  (2304 + 64 * (j))
#define XB_TOP      3328
#define XB_TOPGEN   3392
#define XCD_BAR_WORDS 3456
#define XB_SPIN_CAP (1u << 18)

__device__ __forceinline__ unsigned xb_ld(unsigned* p)              { return __hip_atomic_load(p, __ATOMIC_RELAXED, __HIP_MEMORY_SCOPE_AGENT); }
__device__ __forceinline__ unsigned xb_add(unsigned* p, unsigned v) { return __hip_atomic_fetch_add(p, v, __ATOMIC_RELAXED, __HIP_MEMORY_SCOPE_AGENT); }
__device__ __forceinline__ unsigned xb_xcc_id() { return (unsigned)__builtin_amdgcn_s_getreg((3 << 11) | 20) & 0xFu; }
#define XB_SPIN(cond, bar) do { unsigned _sp = 0; while (cond) { __builtin_amdgcn_s_sleep(1); \
    if ((++_sp & 255u) == 0u) { if (xb_ld(&(bar)[XB_TMO])) break; if (_sp > XB_SPIN_CAP) { atomicAdd(&(bar)[XB_TMO], 1u); break; } } } } while (0)

struct XcdBarrier {
    unsigned* bar; unsigned x;
    volatile LAS unsigned* st;
};

__device__ __forceinline__ XcdBarrier xcd_barrier_post(unsigned* bar, volatile LAS unsigned* st, bool leader  ) {
    XcdBarrier b; b.bar = bar; b.x = xb_xcc_id(); b.st = st;
    if (leader) (void)xb_add(&bar[XB_XCNT(b.x)], 1u);
    return b;
}
__device__ __forceinline__ void xcd_barrier_complete(unsigned* bar, unsigned x, unsigned& nloc, unsigned& nx) {
    const unsigned G = gridDim.x * gridDim.y * gridDim.z;
    unsigned sum, cnt, mine, sp = 0u;
    for (;;) {
        sum = 0u; cnt = 0u; mine = 0u;
#pragma unroll
        for (unsigned j = 0; j < 16; ++j) { const unsigned c = xb_ld(&bar[XB_XCNT(j)]); sum += c; cnt += (c > 0u) ? 1u : 0u; mine = (j == x) ? c : mine; }
        if (sum == G) break;
        __builtin_amdgcn_s_sleep(1);
        if ((++sp & 255u) == 0u) { if (xb_ld(&bar[XB_TMO])) break; if (sp > XB_SPIN_CAP) { atomicAdd(&bar[XB_TMO], 1u); break; } }
    }
    nloc = mine > 0u ? mine : 1u; nx = cnt > 0u ? cnt : 1u;
}

__device__ __forceinline__ void xcd_barrier(const XcdBarrier& b, bool leader  ) {
    asm volatile("s_waitcnt vmcnt(0)" ::: "memory");
    __syncthreads();
    if (leader) {
        unsigned* bar = b.bar;
        __builtin_amdgcn_s_waitcnt(0);
        unsigned nloc = b.st[0], nx = b.st[1];
        if (nloc == 0u) { xcd_barrier_complete(bar, b.x, nloc, nx); b.st[0] = nloc; b.st[1] = nx; }
        const unsigned old = xb_add(&bar[XB_XSUB(b.x)], 1u);
        const unsigned gen = old / nloc;
        if (old + 1u == (gen + 1u) * nloc) {
            __builtin_amdgcn_fence(__ATOMIC_RELEASE, "agent");
            asm volatile("s_waitcnt vmcnt(0)" ::: "memory");
            const unsigned og = xb_add(&bar[XB_TOP], 1u);
            const unsigned tg = og / nx;
            if (og + 1u == (tg + 1u) * nx) xb_add(&bar[XB_TOPGEN], 1u);
            else XB_SPIN(xb_ld(&bar[XB_TOPGEN]) == tg, bar);
            __builtin_amdgcn_fence(__ATOMIC_ACQUIRE, "agent");
            xb_add(&bar[XB_XGEN(b.x)], 1u);
            asm volatile("s_waitcnt vmcnt(0)" ::: "memory");
        } else {
            XB_SPIN(xb_ld(&bar[XB_XGEN(b.x)]) == gen, bar);
            __builtin_amdgcn_fence(__ATOMIC_ACQUIRE, "agent");
            asm volatile("s_waitcnt vmcnt(0)" ::: "memory");
        }
    }
    __syncthreads();
}
struct Frame {
    LAS unsigned char* lds;
    int tid, lane, wave, vcu;
    unsigned long long pr_acc, pr_sub; int ph;
    unsigned char* ws;
    const float* x; const float* meta; float* out;
};

constexpr int PK_CONVW = 0, PK_CONVB = 1024, PK_WA = 1280, PK_BA = 17664, PK_WX = 17920, PK_BX = 34304, PK_LAM = 34560, PK_LNG = 34816, PK_SCW = 35072, PK_SCG = 35840, PK_MU = 36096, PK_W0 = 37760,
              PK_W2 = 38272, PK_A0 = 54656, PK_A2 = 55168, PK_G2 = 71552, PK_KK = 104320, PK_KA = 104832, PK_RK = 105344, PK_LNW = 105856, PK_LNB = 106368, PK_SIZE = 106880;
constexpr size_t WS_PACK = 72 * 1024;
static_assert(WS_PACK + (size_t)NLAYER * PK_SIZE * 4 <= CTL_ZERO_BYTES && (CW_BAR + 3456) * 4 <= (int)WS_PACK, "pack inside CTL, above the barrier words");
__device__ __forceinline__ const float* pack_of(const Frame& F, int l) { return (const float*)(F.ws + WS_PACK) + (size_t)l * PK_SIZE; }
struct PackRegs { float a[21]; float f0, f1; };
#define PKG(i) int gs = gt - (i) * 6144; if (gs < 0) gs += GRID * NWAVES * 64;
#define PKL(i, n, per) { PKG(i) R.a[i] = 0.f; if (gs < NLAYER * (per)) R.a[i] = in[n][gs]; }
#define PKS(i, per, off) { PKG(i) if (gs < NLAYER * (per)) { const int l_ = gs / (per), j_ = gs - l_ * (per); dst[(size_t)l_ * PK_SIZE + (off) + j_] = R.a[i]; } }
__device__ __forceinline__ void pack_loads(Frame& F, const float* const* in, PackRegs& R) {
    const int gt = F.vcu * (NWAVES * 64) + F.tid;
    static_assert(NLAYER * 32768 <= GRID * NWAVES * 64, "one element per thread covers the longest segment");
    PKL(0, 9, 1024) PKL(1, 10, 256) PKL(2, 11, 16384) PKL(3, 12, 256) PKL(4, 13, 16384) PKL(5, 14, 256) PKL(6, 15, 256)
    __builtin_amdgcn_sched_barrier(0);
    PKL(7, 16, 256) PKL(8, 17, 768) PKL(9, 18, 256) PKL(10, 19, 1664) PKL(11, 20, 512) PKL(12, 21, 16384) PKL(13, 22, 512)
    __builtin_amdgcn_sched_barrier(0);
    PKL(14, 23, 16384) PKL(15, 24, 32768) PKL(16, 25, 512) PKL(17, 26, 512) PKL(18, 27, 512) PKL(19, 28, 512) PKL(20, 29, 512)
}
__device__ __forceinline__ void pack_stores(Frame& F, const PackRegs& R) {
    const int gt = F.vcu * (NWAVES * 64) + F.tid;
    float* dst = (float*)(F.ws + WS_PACK);
    PKS(0, 1024, PK_CONVW) PKS(1, 256, PK_CONVB) PKS(2, 16384, PK_WA) PKS(3, 256, PK_BA) PKS(4, 16384, PK_WX) PKS(5, 256, PK_BX) PKS(6, 256, PK_LAM)
    PKS(7, 256, PK_LNG) PKS(8, 768, PK_SCW) PKS(9, 256, PK_SCG) PKS(10, 1664, PK_MU) PKS(11, 512, PK_W0) PKS(12, 16384, PK_W2) PKS(13, 512, PK_A0)
    PKS(14, 16384, PK_A2) PKS(15, 32768, PK_G2) PKS(16, 512, PK_KK) PKS(17, 512, PK_KA) PKS(18, 512, PK_RK) PKS(19, 512, PK_LNW) PKS(20, 512, PK_LNB)
}
#undef PKL
#undef PKS
#undef PKG

__device__ __forceinline__ int swiglu_row(int n0) { return n0 < FF ? ((n0 >> 7) * 256 + (n0 & 127)) : (((n0 - FF) >> 7) * 256 + 128 + ((n0 - FF) & 127)); }
constexpr int CI_IN = (D / 64) * (2 * FF / 32), CI_OUT = (FF / 64) * (D / 32), CI_MI = (D / 64) * (NIN / 32), CI_MO = (D / 64) * (D / 32);
constexpr int CI_SET0 = CI_IN + CI_OUT + CI_MI, CI_SET1 = CI_MO + CI_IN + CI_OUT;
struct ConvItem { const float* W; bf16* WT; int K, N, k0, n0, drow0; const float* g; };
__device__ __forceinline__ ConvItem conv_item(unsigned char* ws, const float* const* in, int l, int set, int r) {
    ConvItem ci;
    if (set == 0) {
        if (r < CI_IN) { const int nblk = 2 * FF / 32, kb = r / nblk, nb = r % nblk; ci = ConvItem{in[3] + (size_t)l * D * 2 * FF, (bf16*)(ws + WS_WB + WB_W1IN), D, 2 * FF, 64 * kb, 32 * nb, swiglu_row(32 * nb), in[2] + (size_t)(l * 6 + 0) * D}; return ci; }
        r -= CI_IN;
        if (r < CI_OUT) { const int nblk = D / 32, kb = r / nblk, nb = r % nblk; ci = ConvItem{in[4] + (size_t)l * FF * D, (bf16*)(ws + WS_WB + WB_W1OUT), FF, D, 64 * kb, 32 * nb, 32 * nb, nullptr}; return ci; }
        r -= CI_OUT;
        { const int nblk = NIN / 32, kb = r / nblk, nb = r % nblk; ci = ConvItem{in[7] + (size_t)l * D * NIN, (bf16*)(ws + WS_WB + WB_WIN), D, NIN, 64 * kb, 32 * nb, 32 * nb, in[2] + (size_t)(l * 6 + 2) * D}; return ci; }
    }
    if (r < CI_MO) { const int nblk = D / 32, kb = r / nblk, nb = r % nblk; ci = ConvItem{in[8] + (size_t)l * D * D, (bf16*)(ws + WS_WB + WB_WOUT), D, D, 64 * kb, 32 * nb, 32 * nb, nullptr}; return ci; }
    r -= CI_MO;
    if (r < CI_IN) { const int nblk = 2 * FF / 32, kb = r / nblk, nb = r % nblk; ci = ConvItem{in[5] + (size_t)l * D * 2 * FF, (bf16*)(ws + WS_WB + WB_W2IN), D, 2 * FF, 64 * kb, 32 * nb, swiglu_row(32 * nb), in[2] + (size_t)(l * 6 + 4) * D}; return ci; }
    r -= CI_IN;
    { const int nblk = D / 32, kb = r / nblk, nb = r % nblk; ci = ConvItem{in[6] + (size_t)l * FF * D, (bf16*)(ws + WS_WB + WB_W2OUT), FF, D, 64 * kb, 32 * nb, 32 * nb, nullptr}; return ci; }
}
__device__ __forceinline__ void conv_loads(const ConvItem& ci, int lane, float (&v)[32]) {
    const float* src = ci.W + (size_t)(ci.k0 + (lane >> 5)) * ci.N + ci.n0 + (lane & 31);
#pragma unroll
    for (int i = 0; i < 32; ++i) v[i] = src[(size_t)(2 * i) * ci.N];
}
__device__ __forceinline__ void conv_store(const ConvItem& ci, int lane, const float (&v)[32], LAS float* scr) {
#pragma unroll
    for (int i = 0; i < 32; ++i) scr[(2 * i + (lane >> 5)) * 33 + (lane & 31)] = v[i];
    LDS_WAIT(); asm volatile("" ::: "memory");
    const int c = lane & 7;
    f32x4 g0 = (f32x4){1.f, 1.f, 1.f, 1.f}, g1 = g0; if (ci.g) { g0 = *(const f32x4*)(ci.g + ci.k0 + 8 * c); g1 = *(const f32x4*)(ci.g + ci.k0 + 8 * c + 4); }
#pragma unroll
    for (int j = 0; j < 4; ++j) { const int n = (lane >> 3) + 8 * j; const LAS float* s = scr + (8 * c) * 33 + n;
        v4u o; o.x = pk2(s[0 * 33] * g0[0], s[1 * 33] * g0[1]); o.y = pk2(s[2 * 33] * g0[2], s[3 * 33] * g0[3]); o.z = pk2(s[4 * 33] * g1[0], s[5 * 33] * g1[1]); o.w = pk2(s[6 * 33] * g1[2], s[7 * 33] * g1[3]);
        *(GAS v4u*)(ci.WT + (size_t)(ci.drow0 + n) * ci.K + ci.k0 + 8 * c) = o; }
    LDS_WAIT(); asm volatile("" ::: "memory");
}
__device__ __forceinline__ float sumsq4(const f32x4 (&v)[4]) { float s = 0.f;
#pragma unroll
    for (int j = 0; j < 4; ++j) s += (v[j].x * v[j].x + v[j].y * v[j].y) + (v[j].z * v[j].z + v[j].w * v[j].w);
    return s; }
typedef short mbf16x8 __attribute__((ext_vector_type(8)));
__device__ __forceinline__ void meta_tile(const bf16* A, const bf16* Bt, int K, int k0, int kl, int nb0, int nb1, int mode, void* O, int ldo, int ocol, int lane, const float* rs) {
    const int fr = lane & 15, fq = lane >> 4;
    const bf16* ap = A + (size_t)(MX + fr) * K + k0 + 8 * fq; const bf16* b0p = Bt + (size_t)(nb0 + fr) * K + k0 + 8 * fq; const bf16* b1p = Bt + (size_t)((mode == 0 ? nb1 : nb0) + fr) * K + k0 + 8 * fq;
    f32x4 acc0 = (f32x4){0.f, 0.f, 0.f, 0.f}, acc1 = acc0;
    for (int kb = 0; kb < kl; kb += 256) {
        mbf16x8 a[8], w0[8], w1[8];
#pragma unroll
        for (int j = 0; j < 8; ++j) { const int ks = kb + 32 * j; const bool on = ks < kl; const int kc = on ? ks : kb;
            a[j] = *(const mbf16x8*)(ap + kc); w0[j] = *(const mbf16x8*)(b0p + kc); if (mode == 0) w1[j] = *(const mbf16x8*)(b1p + kc); }
#pragma unroll
        for (int j = 0; j < 8; ++j) { if (kb + 32 * j < kl) { acc0 = __builtin_amdgcn_mfma_f32_16x16x32_bf16(w0[j], a[j], acc0, 0, 0, 0);
            if (mode == 0) acc1 = __builtin_amdgcn_mfma_f32_16x16x32_bf16(w1[j], a[j], acc1, 0, 0, 0); } } }
    const int col = ocol + 4 * fq;
    if (mode == 2) { *(f32x4*)((float*)O + (size_t)fr * ldo + col) = acc0; return; }
    float v[4];
    const float sc = rs ? rs[MX + fr] : 1.0f;
#pragma unroll
    for (int i = 0; i < 4; ++i) { const float g = acc0[i] * sc; v[i] = mode == 0 ? g * __builtin_amdgcn_rcpf(1.0f + __expf(-g)) * (acc1[i] * sc) : g; }
    const unsigned long long ov = (unsigned long long)pk2(v[0], v[1]) | ((unsigned long long)pk2(v[2], v[3]) << 32);
    if (mode == 0) __hip_atomic_store((GAS unsigned long long*)((bf16*)O + (size_t)(MX + fr) * ldo + col), ov, __ATOMIC_RELAXED, __HIP_MEMORY_SCOPE_AGENT);
    else *(GAS unsigned long long*)((bf16*)O + (size_t)(MX + fr) * ldo + col) = ov;
}
__device__ __forceinline__ void meta_up_split(Frame& F, const bf16* A, const bf16* Bt, int tile, bf16* HIDp) {
    const int lane = F.tid & 63, fr = lane & 15, fq = lane >> 4, ks = F.wave & 3;
    LAS f32x4* red = (LAS f32x4*)F.lds + (size_t)(F.wave >> 2) * (3 * 64 * 2);
    f32x4 acc0 = (f32x4){0.f, 0.f, 0.f, 0.f}, acc1 = acc0;
    const int j0 = 16 * tile, nb0 = (j0 >> 7) * 256 + (j0 & 127);
    if (tile >= 0) {
        const bf16* ap = A + (size_t)(MX + fr) * D + 256 * ks + 8 * fq; const bf16* b0p = Bt + (size_t)(nb0 + fr) * D + 256 * ks + 8 * fq; const bf16* b1p = b0p + (size_t)128 * D;
        mbf16x8 a[8], w0[8], w1[8];
#pragma unroll
        for (int j = 0; j < 8; ++j) { a[j] = *(const mbf16x8*)(ap + 32 * j); w0[j] = *(const mbf16x8*)(b0p + 32 * j); w1[j] = *(const mbf16x8*)(b1p + 32 * j); }
#pragma unroll
        for (int j = 0; j < 8; ++j) { acc0 = __builtin_amdgcn_mfma_f32_16x16x32_bf16(w0[j], a[j], acc0, 0, 0, 0); acc1 = __builtin_amdgcn_mfma_f32_16x16x32_bf16(w1[j], a[j], acc1, 0, 0, 0); }
        if (ks != 0) { red[((ks - 1) * 64 + lane) * 2] = acc0; red[((ks - 1) * 64 + lane) * 2 + 1] = acc1; } }
    __syncthreads();
    if (tile >= 0 && ks == 0) {
#pragma unroll
        for (int s = 0; s < 3; ++s) { acc0 = acc0 + red[(s * 64 + lane) * 2]; acc1 = acc1 + red[(s * 64 + lane) * 2 + 1]; }
        float v[4];
#pragma unroll
        for (int i = 0; i < 4; ++i) { const float g = acc0[i]; v[i] = g * __builtin_amdgcn_rcpf(1.0f + __expf(-g)) * acc1[i]; }
        __hip_atomic_store((GAS unsigned long long*)(HIDp + (size_t)(MX + fr) * FF + j0 + 4 * fq), (unsigned long long)pk2(v[0], v[1]) | ((unsigned long long)pk2(v[2], v[3]) << 32), __ATOMIC_RELAXED, __HIP_MEMORY_SCOPE_AGENT); }
}
__device__ __forceinline__ void meta_gemm(Frame& F, const bf16* A, const bf16* Bt, int K, int N, int mode, void* O, int ldo, int nks, int gw  , const float* rs) {
    const int lane = F.tid & 63; if (gw < 0) return;
    if (mode == 0) { if (gw < FF / 16) { const int j0 = 16 * gw, nb0 = (j0 >> 7) * 256 + (j0 & 127); meta_tile(A, Bt, K, 0, K, nb0, nb0 + 128, 0, O, ldo, j0, lane, rs); } return; }
    const int ntile = N / 16;
    if (gw < ntile * nks) { const int tile = gw % ntile, sl = gw / ntile, kl = K / nks;
        meta_tile(A, Bt, K, sl * kl, kl, 16 * tile, 0, mode, mode == 2 ? (void*)((float*)O + (size_t)sl * NMETA * D) : O, ldo, 16 * tile, lane, rs); }
}

__device__ __forceinline__ void row_ld_f32(const float* p, int lane, f32x4 (&v)[4]) {
#pragma unroll
    for (int j = 0; j < 4; ++j) v[j] = ((const GAS f32x4*)p)[lane + 64 * j]; }
__device__ __forceinline__ void row_ld_bf16(const bf16* p, int lane, f32x4 (&v)[4]) {
#pragma unroll
    for (int j = 0; j < 4; ++j) { const unsigned long long u = ((const GAS unsigned long long*)p)[lane + 64 * j]; v[j][0] = bf2f((unsigned)u & 0xffffu); v[j][1] = bf2f((unsigned)u >> 16); v[j][2] = bf2f((unsigned)(u >> 32) & 0xffffu); v[j][3] = bf2f((unsigned)(u >> 48)); } }
__device__ __forceinline__ void row_st_bf16(bf16* p, int lane, const f32x4 (&v)[4]) {
#pragma unroll
    for (int j = 0; j < 4; ++j) ((GAS unsigned long long*)p)[lane + 64 * j] = (unsigned long long)pk2(v[j][0], v[j][1]) | ((unsigned long long)pk2(v[j][2], v[j][3]) << 32); }
__device__ __forceinline__ void phase_init_convert(Frame& F, const float* const* in) {
    { int ln_ = F.tid & 63; asm volatile("" : "+v"(ln_)); F.lane = ln_; }
    const int gw = F.vcu * NWAVES + F.wave, NGW = GRID * NWAVES;
    float* RS = (float*)(F.ws + WS_RS);
    LAS float* scr = (LAS float*)(F.lds + F.wave * 16384);
    ConvItem ca; float va[32]; int it = gw;
    if (it < CI_SET0) { ca = conv_item(F.ws, in, 0, 0, it); conv_loads(ca, F.lane, va); }
    for (int r0 = gw; r0 < MREAL; r0 += 2 * NGW) {
        f32x4 v[2][4];
#pragma unroll
        for (int u = 0; u < 2; ++u) { const int r = r0 + u * NGW < MREAL ? r0 + u * NGW : r0; row_ld_f32(r < MX ? F.x + (size_t)r * D : F.meta + (size_t)(r - MX) * D, F.lane, v[u]); }
#pragma unroll
        for (int u = 0; u < 2; ++u) { const int r = r0 + u * NGW; if (r < MREAL) {
            const float rstd = rsqrtf(wave_sum(sumsq4(v[u])) * (1.0f / D) + RMS_EPS);
#pragma unroll
            for (int j = 0; j < 4; ++j) v[u][j] = v[u][j] * rstd;
            row_st_bf16(r < MX ? (bf16*)F.out + (size_t)r * D : (bf16*)(F.ws + WS_HMETA) + (size_t)(r - MX) * D, F.lane, v[u]);
            if (F.lane == 0) RS[r] = rstd; } }
        if (it < CI_SET0) { conv_store(ca, F.lane, va, scr); it += NGW; if (it < CI_SET0) { ca = conv_item(F.ws, in, 0, 0, it); conv_loads(ca, F.lane, va); } }
    }
    while (it < CI_SET0) { conv_store(ca, F.lane, va, scr); it += NGW; if (it < CI_SET0) { ca = conv_item(F.ws, in, 0, 0, it); conv_loads(ca, F.lane, va); } }
    { unsigned zz = 0u; asm volatile("" : "+v"(zz));
      for (int i = gw * 64 + F.lane; i < (NINP - NIN) * D / 8; i += NGW * 64) *(GAS v4u*)(((bf16*)(F.ws + WS_WB + WB_WIN)) + (size_t)NIN * D + (size_t)i * 8) = (v4u){zz, zz, zz, zz}; }
}
struct PostIO { const bf16* raw16; const bf16* hin16; bf16* hout16; float* out32; int nks; };
__device__ __forceinline__ void post_row_load(const Frame& F, const PostIO& io, int r, f32x4 (&y)[4], f32x4 (&h)[4]) {
    if (r >= MX) { const float* sl = (const float*)(F.ws + WS_MSLAB) + (size_t)(r - MX) * D; row_ld_f32(sl, F.lane, y);
        for (int s = 1; s < io.nks; ++s) { f32x4 t[4]; row_ld_f32(sl + (size_t)s * NMETA * D, F.lane, t);
#pragma unroll
            for (int j = 0; j < 4; ++j) y[j] = y[j] + t[j]; }
        row_ld_bf16((const bf16*)(F.ws + WS_HMETA) + (size_t)(r - MX) * D, F.lane, h);
        const float inv = 1.0f / ((const float*)(F.ws + WS_RS))[r];
#pragma unroll
        for (int j = 0; j < 4; ++j) h[j] = h[j] * inv;
        return; }
    row_ld_bf16(io.raw16 + (size_t)r * D, F.lane, y);
    row_ld_bf16(io.hin16 + (size_t)r * D, F.lane, h);
    const float inv = 1.0f / ((const float*)(F.ws + WS_RS))[r];
#pragma unroll
    for (int j = 0; j < 4; ++j) h[j] = h[j] * inv;
}
__device__ __forceinline__ void post_row_store(const Frame& F, const PostIO& io, int r, const f32x4 (&h)[4]) {
    if (r >= MX) row_st_bf16((bf16*)(F.ws + WS_HMETA) + (size_t)(r - MX) * D, F.lane, h);
    else if (io.out32) {
#pragma unroll
        for (int j = 0; j < 4; ++j) ((GAS f32x4*)(io.out32 + (size_t)r * D))[F.lane + 64 * j] = h[j]; }
    else row_st_bf16(io.hout16 + (size_t)r * D, F.lane, h);
}
struct PostRaw { v4u y[2], h[2]; float rs; };
__device__ __forceinline__ void post_issue(const Frame& F, const PostIO& io, int r, PostRaw& R) {
#pragma unroll
    for (int j = 0; j < 2; ++j) { R.y[j] = ((const GAS v4u*)(io.raw16 + (size_t)r * D))[F.lane + 64 * j]; R.h[j] = ((const GAS v4u*)(io.hin16 + (size_t)r * D))[F.lane + 64 * j]; }
    R.rs = ((const float*)(F.ws + WS_RS))[r];
}
__device__ __forceinline__ float sumsq16(const float (&v)[16]) { float s0 = 0.f, s1 = 0.f;
#pragma unroll
    for (int j = 0; j < 16; j += 2) { s0 += v[j] * v[j]; s1 += v[j + 1] * v[j + 1]; }
    return s0 + s1; }
__device__ __forceinline__ void post_pair(const Frame& F, const PostIO& io, const PostRaw& R0, const PostRaw& R1, int r0, int r1, float scale, const float* g_post, bool want_rs) {
    float y0[16], h0[16], y1[16], h1[16];
    { float t[8];
#pragma unroll
      for (int j = 0; j < 2; ++j) {
          unpack8(R0.y[j], t);
#pragma unroll
          for (int e = 0; e < 8; ++e) y0[8 * j + e] = t[e];
          unpack8(R0.h[j], t);
#pragma unroll
          for (int e = 0; e < 8; ++e) h0[8 * j + e] = t[e];
          unpack8(R1.y[j], t);
#pragma unroll
          for (int e = 0; e < 8; ++e) y1[8 * j + e] = t[e];
          unpack8(R1.h[j], t);
#pragma unroll
          for (int e = 0; e < 8; ++e) h1[8 * j + e] = t[e]; } }
    const float i0 = 1.0f / R0.rs, i1 = 1.0f / R1.rs;
    const float rs0 = scale * rsqrtf(wave_sum(sumsq16(y0)) * (1.0f / D) + RMS_EPS), rs1 = scale * rsqrtf(wave_sum(sumsq16(y1)) * (1.0f / D) + RMS_EPS);
#pragma unroll
    for (int j = 0; j < 4; ++j) { const f32x4 gv = ((const GAS f32x4*)g_post)[2 * F.lane + 128 * (j >> 1) + (j & 1)];
#pragma unroll
        for (int e = 0; e < 4; ++e) { h0[4 * j + e] = h0[4 * j + e] * i0 + y0[4 * j + e] * rs0 * gv[e]; h1[4 * j + e] = h1[4 * j + e] * i1 + y1[4 * j + e] * rs1 * gv[e]; } }
    if (want_rs) { const float q0 = rsqrtf(wave_sum(sumsq16(h0)) * (1.0f / D) + RMS_EPS), q1 = rsqrtf(wave_sum(sumsq16(h1)) * (1.0f / D) + RMS_EPS);
#pragma unroll
        for (int e = 0; e < 16; ++e) { h0[e] *= q0; h1[e] *= q1; }
        if (F.lane == 0) { ((float*)(F.ws + WS_RS))[r0] = q0; ((float*)(F.ws + WS_RS))[r1] = q1; } }
    if (io.out32) {
#pragma unroll
        for (int j = 0; j < 4; ++j) { ((GAS f32x4*)(io.out32 + (size_t)r0 * D))[2 * F.lane + 128 * (j >> 1) + (j & 1)] = (f32x4){h0[4 * j], h0[4 * j + 1], h0[4 * j + 2], h0[4 * j + 3]};
                                      ((GAS f32x4*)(io.out32 + (size_t)r1 * D))[2 * F.lane + 128 * (j >> 1) + (j & 1)] = (f32x4){h1[4 * j], h1[4 * j + 1], h1[4 * j + 2], h1[4 * j + 3]}; } }
    else {
#pragma unroll
        for (int j = 0; j < 2; ++j) { v4u o0, o1;
            o0.x = pk2(h0[8 * j], h0[8 * j + 1]); o0.y = pk2(h0[8 * j + 2], h0[8 * j + 3]); o0.z = pk2(h0[8 * j + 4], h0[8 * j + 5]); o0.w = pk2(h0[8 * j + 6], h0[8 * j + 7]);
            o1.x = pk2(h1[8 * j], h1[8 * j + 1]); o1.y = pk2(h1[8 * j + 2], h1[8 * j + 3]); o1.z = pk2(h1[8 * j + 4], h1[8 * j + 5]); o1.w = pk2(h1[8 * j + 6], h1[8 * j + 7]);
            ((GAS v4u*)(io.hout16 + (size_t)r0 * D))[F.lane + 64 * j] = o0; ((GAS v4u*)(io.hout16 + (size_t)r1 * D))[F.lane + 64 * j] = o1; } }
}
__device__ __forceinline__ void phase_post(Frame& F, const PostIO& io, float scale, const float* g_post, bool want_rs) {
    { int ln_ = F.tid & 63; asm volatile("" : "+v"(ln_)); F.lane = ln_; }
    const int gw = F.vcu * NWAVES + F.wave, NGW = GRID * NWAVES;
    static_assert(MX == 8 * GRID * NWAVES, "exactly eight x-token rows per wave");
    { PostRaw A0, A1, B0, B1;
      post_issue(F, io, gw, A0); post_issue(F, io, gw + NGW, A1);
#pragma unroll
      for (int it = 0; it < 4; ++it) { const int ra = gw + 2 * it * NGW;
          if (it & 1) { if (it < 3) { post_issue(F, io, ra + 2 * NGW, A0); post_issue(F, io, ra + 3 * NGW, A1); } __builtin_amdgcn_sched_barrier(0); post_pair(F, io, B0, B1, ra, ra + NGW, scale, g_post, want_rs); }
          else        { post_issue(F, io, ra + 2 * NGW, B0); post_issue(F, io, ra + 3 * NGW, B1); __builtin_amdgcn_sched_barrier(0); post_pair(F, io, A0, A1, ra, ra + NGW, scale, g_post, want_rs); } } }
    if (!io.out32 && gw < NMETA) { const int r = MX + gw;
        f32x4 y[4], h[4]; post_row_load(F, io, r, y, h);
        const float rs0 = scale * rsqrtf(wave_sum(sumsq4(y)) * (1.0f / D) + RMS_EPS);
#pragma unroll
        for (int j = 0; j < 4; ++j) { const f32x4 gv = ((const GAS f32x4*)g_post)[F.lane + 64 * j]; h[j] = h[j] + y[j] * rs0 * gv; }
        if (want_rs) { const float q0 = rsqrtf(wave_sum(sumsq4(h)) * (1.0f / D) + RMS_EPS);
#pragma unroll
            for (int j = 0; j < 4; ++j) h[j] = h[j] * q0;
            if (F.lane == 0) ((float*)(F.ws + WS_RS))[r] = q0; }
        post_row_store(F, io, r, h); }
}
typedef short bf16x8v __attribute__((ext_vector_type(8)));
typedef float f32x4v __attribute__((ext_vector_type(4)));
constexpr int FR_PER_WAVE = 24;
constexpr size_t WS_FRAG = WS_AGG + 512 * 1024, FRAG_LAYER_BYTES = (size_t)8 * FR_PER_WAVE * 64 * 16;
static_assert(WS_FRAG + NLAYER * FRAG_LAYER_BYTES <= WS_WB, "fragment store fits behind AGG");
__device__ __forceinline__ float frag_src(const float* const* in, int l, int w, int f, int lane, int j) {
    const int kq = 8 * (lane >> 4) + j, cl = lane & 15;
    if (f < 4)  return in[21][(size_t)l * 32 * 512 + (size_t)kq * 512 + 64 * w + 16 * f + cl];
    if (f < 8)  return in[23][(size_t)l * 32 * 512 + (size_t)kq * 512 + 64 * w + 16 * (f - 4) + cl];
    if (f < 16) { const int ct = (f - 8) >> 1, ks = (f - 8) & 1; return in[24][(size_t)l * 64 * 512 + (size_t)(32 * ks + kq) * 512 + 64 * w + 16 * ct + cl]; }
    { const int ct = (f - 16) >> 1, ks = (f - 16) & 1, gt = w >> 2, g = w & 3; return in[gt ? 13 : 11][(size_t)l * 16384 + (size_t)g * 4096 + (size_t)(32 * ks + kq) * 64 + 16 * ct + cl]; }
}
__device__ __forceinline__ float frag_val(const float* const* in, int i) {
    const int j = i & 7, lane = (i >> 3) & 63, f = (i >> 9) % FR_PER_WAVE, w = ((i >> 9) / FR_PER_WAVE) & 7, l = (i >> 9) / (FR_PER_WAVE * 8);
    return frag_src(in, l, w, f, lane, j); }
__device__ __forceinline__ void frag_loads(Frame& F, const float* const* in, PackRegs& R) {
    const int gt = F.vcu * (NWAVES * 64) + F.tid, NT = GRID * NWAVES * 64, TOT = NLAYER * 8 * FR_PER_WAVE * 64 * 8;
    static_assert(NLAYER * 8 * FR_PER_WAVE * 64 * 8 <= 2 * GRID * NWAVES * 64, "two elements per thread cover the fragment store");
    R.f0 = frag_val(in, gt); R.f1 = 0.f; if (gt + NT < TOT) R.f1 = frag_val(in, gt + NT);
}
__device__ __forceinline__ void frag_stores(Frame& F, const PackRegs& R) {
    const int gt = F.vcu * (NWAVES * 64) + F.tid, NT = GRID * NWAVES * 64, TOT = NLAYER * 8 * FR_PER_WAVE * 64 * 8;
    bf16* FR = (bf16*)(F.ws + WS_FRAG);
    FR[gt] = (bf16)f2bf(R.f0); if (gt + NT < TOT) FR[gt + NT] = (bf16)f2bf(R.f1);
}
__device__ __forceinline__ bf16x8v pack8(const float (&v)[8]) { v4u u; u.x = pk2(v[0], v[1]); u.y = pk2(v[2], v[3]); u.z = pk2(v[4], v[5]); u.w = pk2(v[6], v[7]); return __builtin_bit_cast(bf16x8v, u); }
__device__ __forceinline__ void unpack4f(unsigned long long u, f32x4& v) { v[0] = bf2f((unsigned)u & 0xffffu); v[1] = bf2f(((unsigned)u >> 16)); v[2] = bf2f((unsigned)(u >> 32) & 0xffffu); v[3] = bf2f((unsigned)(u >> 48)); }
__device__ __forceinline__ void phase_mix_prep(Frame& F, const float* pk, int layer) {
    { int ln_ = F.tid & 63; asm volatile("" : "+v"(ln_)); F.lane = ln_; }
    LAS float* U = (LAS float*)F.lds;
    LAS float* GT = U + 16 * 256;
    LAS float* XL = GT + 32 * 256;
    LAS float* VL = XL + 19 * 256;
    const int tid = F.tid, lane = F.lane, w = F.wave, fr = lane & 15, fq = lane >> 4;
    const bf16* P = ((bf16*)(F.ws + WS_OV + OV_P)); bf16* Y = ((bf16*)(F.ws + WS_XN));
    bf16x8v Bf[FR_PER_WAVE];
    { const v4u* fp = (const v4u*)(F.ws + WS_FRAG + (size_t)layer * FRAG_LAYER_BYTES) + (size_t)w * FR_PER_WAVE * 64 + lane;
#pragma unroll
        for (int f = 0; f < FR_PER_WAVE; ++f) Bf[f] = __builtin_bit_cast(bf16x8v, fp[f * 64]); }
    const int gtp = w >> 2, gblk = w & 3;
    const int cg4 = 4 * (tid & 63);
    for (int tile = blockIdx.x; tile < 256; tile += GRID) {
        const int b = tile >> 5, c = tile & 31;
        const int s_begin = c == 0 ? 0 : NMETA + 64 * c, nsub = c == 0 ? 5 : 4;
        float hloc = 0.f, caloc = 1.f;
        for (int sub = 0; sub < nsub; ++sub) {
            const int s0 = s_begin + 16 * sub;
            unsigned zz = 0u; asm volatile("" : "+v"(zz));
            v4u cur[4], prv[4];
            { const int s = s0 + fr; const bf16* pc = P + (size_t)row_of(b, s) * NINP + PC_LO + 8 * fq; const bf16* pp = P + (size_t)row_of(b, s > 0 ? s - 1 : 0) * NINP + PC_LO + 8 * fq;
#pragma unroll
                for (int f = 0; f < 4; ++f) { cur[f] = *(const v4u*)(pc + 32 * f); prv[f] = *(const v4u*)(pp + 32 * f); if (s == 0) prv[f] = (v4u){zz, zz, zz, zz}; } }
            unsigned long long lx[3], lc[3], lxx[3], lb[2];
#pragma unroll
            for (int j = 0; j < 3; ++j) { const int idx = tid + 512 * j, r = idx >> 6, s = s0 - 3 + r; lx[j] = zz; lc[j] = zz; lxx[j] = zz;
                if (idx < 19 * 64 && s >= 0) { const bf16* pr = P + (size_t)row_of(b, s) * NINP + cg4; lx[j] = *(const unsigned long long*)(pr + PC_LRUX); lc[j] = *(const unsigned long long*)(pr + PC_SCC); lxx[j] = *(const unsigned long long*)(pr + PC_SCX); } }
#pragma unroll
            for (int j = 0; j < 2; ++j) { const int t = (tid >> 6) + 8 * j; lb[j] = *(const unsigned long long*)(P + (size_t)row_of(b, s0 + t) * NINP + PC_SCB + cg4); }
            { bf16x8v Af[4];
#pragma unroll
                for (int f = 0; f < 4; ++f) { float cv[8], pv[8], zv[8]; unpack8(cur[f], cv); unpack8(prv[f], pv);
                    const f32x4v m0 = *(const f32x4v*)(pk + PK_MU + 1536 + 32 * f + 8 * fq), m1 = *(const f32x4v*)(pk + PK_MU + 1536 + 32 * f + 8 * fq + 4);
#pragma unroll
                    for (int j = 0; j < 8; ++j) { const float mu = j < 4 ? m0[j & 3] : m1[j & 3]; const float z = cv[j] + (pv[j] - cv[j]) * mu; zv[j] = f == 0 ? tanhf_(z) : (f == 1 ? z : sigmoidf_(z)); }
                    Af[f] = pack8(zv); }
                const f32x4v zero = (f32x4v){0.f, 0.f, 0.f, 0.f};
                const size_t ro = (size_t)row_of(b, s0 + fr) * 512;
#pragma unroll
                for (int ct = 0; ct < 4; ++ct) { const int n = 64 * w + 16 * ct + 4 * fq;
                    const f32x4v aw = __builtin_amdgcn_mfma_f32_16x16x32_bf16(Bf[ct], Af[0], zero, 0, 0, 0);
                    const f32x4v aa = __builtin_amdgcn_mfma_f32_16x16x32_bf16(Bf[4 + ct], Af[1], zero, 0, 0, 0);
                    f32x4v ag = __builtin_amdgcn_mfma_f32_16x16x32_bf16(Bf[8 + 2 * ct], Af[2], zero, 0, 0, 0); ag = __builtin_amdgcn_mfma_f32_16x16x32_bf16(Bf[9 + 2 * ct], Af[3], ag, 0, 0, 0);
                    const f32x4v w04 = *(const f32x4v*)(pk + PK_W0 + n), a04 = *(const f32x4v*)(pk + PK_A0 + n);
                    float wd[4], av4[4];
#pragma unroll
                    for (int i = 0; i < 4; ++i) { const float wl = -softplusf_(-(w04[i] + aw[i])) - 0.5f, e = __expf(wl); wd[i] = e * (1.0f - e * (0.5f - e * (0.16666667f - e * (0.041666668f - e * 0.0083333338f)))); av4[i] = sigmoidf_(a04[i] + aa[i]); }
                    *(GAS unsigned long long*)((bf16*)(F.ws + WS_OV + OV_WDEC) + ro + n) = (unsigned long long)pk2(wd[0], wd[1]) | ((unsigned long long)pk2(wd[2], wd[3]) << 32);
                    *(GAS unsigned long long*)((bf16*)(F.ws + WS_OV + OV_ABUF) + ro + n) = (unsigned long long)pk2(av4[0], av4[1]) | ((unsigned long long)pk2(av4[2], av4[3]) << 32);
                    *(GAS unsigned long long*)((bf16*)(F.ws + WS_OV + OV_GBUF) + ro + n) = (unsigned long long)pk2(ag[0], ag[1]) | ((unsigned long long)pk2(ag[2], ag[3]) << 32); } }
            PSTAMP(0);
#pragma unroll
            for (int j = 0; j < 3; ++j) { const int idx = tid + 512 * j; if (idx < 19 * 64) { f32x4 a4, c4, x4; unpack4f(lx[j], a4); unpack4f(lc[j], c4); unpack4f(lxx[j], x4);
                *(LAS f32x4*)(XL + (idx >> 6) * 256 + cg4) = a4; *(LAS f32x4*)(VL + (idx >> 6) * 256 + cg4) = c4 * x4; } }
            __syncthreads();
            const float* pkc = pk + cg4;
            const f32x4 cb4 = *(const f32x4*)(pkc + PK_CONVB), cw0 = *(const f32x4*)(pkc + PK_CONVW), cw1 = *(const f32x4*)(pkc + PK_CONVW + 256), cw2 = *(const f32x4*)(pkc + PK_CONVW + 512), cw3 = *(const f32x4*)(pkc + PK_CONVW + 768);
            const f32x4 sw0 = *(const f32x4*)(pkc + PK_SCW), sw1 = *(const f32x4*)(pkc + PK_SCW + 256), sw2 = *(const f32x4*)(pkc + PK_SCW + 512), sg4 = *(const f32x4*)(pkc + PK_SCG);
#pragma unroll
            for (int j = 0; j < 2; ++j) { const int t = (tid >> 6) + 8 * j;
                const LAS float* xr = XL + t * 256 + cg4; const LAS float* vr = VL + (t + 1) * 256 + cg4;
                *(LAS f32x4*)(U + t * 256 + cg4) = cb4 + *(const LAS f32x4*)xr * cw0 + *(const LAS f32x4*)(xr + 256) * cw1 + *(const LAS f32x4*)(xr + 512) * cw2 + *(const LAS f32x4*)(xr + 768) * cw3;
                f32x4 b4; unpack4f(lb[j], b4);
                const f32x4 y4 = b4 * (*(const LAS f32x4*)vr * sw0 + *(const LAS f32x4*)(vr + 256) * sw1 + *(const LAS f32x4*)(vr + 512) * sw2);
                const float ss = red16((y4[0] * y4[0] + y4[1] * y4[1]) + (y4[2] * y4[2] + y4[3] * y4[3])); const float rs = rsqrtf(ss * (1.0f / 64.0f) + RMS_EPS);
                *(GAS unsigned long long*)(Y + (size_t)row_of(b, s0 + t) * D + 256 + cg4) = (unsigned long long)pk2(y4[0] * rs * sg4[0], y4[1] * rs * sg4[1]) | ((unsigned long long)pk2(y4[2] * rs * sg4[2], y4[3] * rs * sg4[3]) << 32); }
            PSTAMP(1);
            __syncthreads();
            { bf16x8v Al[2];
#pragma unroll
                for (int ks = 0; ks < 2; ++ks) { const LAS float* up = U + fr * 256 + 64 * gblk + 32 * ks + 8 * fq; const f32x4v u0 = *(const LAS f32x4v*)up, u1 = *(const LAS f32x4v*)(up + 4);
                    const float uv[8] = {u0.x, u0.y, u0.z, u0.w, u1.x, u1.y, u1.z, u1.w}; Al[ks] = pack8(uv); }
                const f32x4v zero = (f32x4v){0.f, 0.f, 0.f, 0.f};
#pragma unroll
                for (int ct = 0; ct < 4; ++ct) { const int j = 64 * gblk + 16 * ct + 4 * fq;
                    f32x4v ac = __builtin_amdgcn_mfma_f32_16x16x32_bf16(Bf[16 + 2 * ct], Al[0], zero, 0, 0, 0); ac = __builtin_amdgcn_mfma_f32_16x16x32_bf16(Bf[17 + 2 * ct], Al[1], ac, 0, 0, 0);
                    const f32x4v bias = *(const f32x4v*)(pk + (gtp ? PK_BX : PK_BA) + j);
                    f32x4v gv;
#pragma unroll
                    for (int i = 0; i < 4; ++i) gv[i] = sigmoidf_(ac[i] + bias[i]);
                    *(LAS f32x4v*)(GT + (gtp * 16 + fr) * 256 + j) = gv; } }
            PSTAMP(2);
            __syncthreads();
#pragma unroll
            for (int it = 0; it < 8; ++it) { const int idx = it * (NWAVES * 64) + tid, ch = idx & 255;
                const float r = GT[idx], ig = GT[16 * 256 + idx], u = U[idx];
                const float la = -8.0f * r * softplusf_(-pk[PK_LAM + ch]), a = __expf(la), x2 = 2.0f * la;
                const float om = x2 < -0.25f ? (1.0f - __expf(x2)) : -x2 * (1.0f + x2 * (0.5f + x2 * (0.16666667f + x2 * (0.041666668f + x2 * 0.0083333338f))));
                const float bt = __builtin_amdgcn_sqrtf(om) * (ig * u);
                GT[idx] = a; GT[16 * 256 + idx] = bt; }
            __syncthreads();
            PSTAMP(3);
            if (tid < 256) { const int j = tid;
#pragma unroll
                for (int t = 0; t < 16; ++t) { const float a = GT[t * 256 + j], bt = GT[(16 + t) * 256 + j];
                    hloc = a * hloc + bt; caloc *= a;
                    const size_t ro = (size_t)row_of(b, s0 + t) * 256 + j; ((unsigned*)(F.ws + WS_OV + OV_HL))[ro] = pk2(hloc, caloc); } }
            PSTAMP(4);
        }
        if (tid < 256) { ((float*)(F.ws + WS_AGG))[((size_t)(b * 32 + c) * 256 + tid) * 2 + 0] = caloc; ((float*)(F.ws + WS_AGG))[((size_t)(b * 32 + c) * 256 + tid) * 2 + 1] = hloc; }
        __syncthreads();
    }
}

constexpr int SC_CH = 24, SC_NCH = TT / SC_CH, SC_LW = SC_CH / 4, SC_STEPF = 336, SC_BUFF = SC_CH * SC_STEPF;
constexpr int SC_VJ = (SC_LW * 16 + 63) / 64;
static_assert(SC_NCH * SC_CH == TT && 2 * SC_BUFF * 4 <= RING_BYTES, "scan geometry");
struct ScanRegs { unsigned rr[SC_LW + 1], kk[SC_LW + 1], aa[SC_LW], ww[SC_LW]; unsigned vc[SC_VJ], vp[SC_VJ]; };
__device__ __forceinline__ void scan_load(const Frame& F, ScanRegs& R, int b, int h, int q, int lw, int chunk, unsigned lane) {
    const int t0 = chunk * SC_CH + SC_LW * lw;
    const bf16* P = ((bf16*)(F.ws + WS_OV + OV_P)); const bf16* AB = ((bf16*)(F.ws + WS_OV + OV_ABUF)); const bf16* WD = ((bf16*)(F.ws + WS_OV + OV_WDEC));
#pragma unroll
    for (int m = 0; m < SC_LW + 1; ++m) { const int s = t0 - 1 + m;
        if (s >= 0) { const bf16* rowp = P + (size_t)row_of(b, s) * NINP + h * 64; R.rr[m] = rowp[PC_R + lane]; R.kk[m] = rowp[PC_K + lane]; } else { R.rr[m] = 0u; R.kk[m] = 0u; } }
#pragma unroll
    for (int i = 0; i < SC_LW; ++i) { const size_t ro = (size_t)row_of(b, t0 + i) * 512 + h * 64; R.aa[i] = (AB + ro)[lane]; R.ww[i] = (WD + ro)[lane]; }
#pragma unroll
    for (int j = 0; j < SC_VJ; ++j) { const int st0 = 4 * j; const unsigned st = st0 + (lane >> 4), rw = lane & 15; R.vc[j] = 0u; R.vp[j] = 0u;
        if (st < (unsigned)SC_LW) { const int s = t0 + (int)st; const unsigned col = PC_V + h * 64 + 16 * q + rw; R.vc[j] = P[(size_t)row_of(b, s) * NINP + col]; if (s > 0) R.vp[j] = P[(size_t)row_of(b, s - 1) * NINP + col]; } }
}
__device__ __forceinline__ void scan_emit(const ScanRegs& R, LAS float* buf, int lw, unsigned lane, float mu_r, float mu_k, float kk_n, float ka_n, float mu_v) {
    LAS float* lb = buf + SC_LW * lw * SC_STEPF + lane; asm volatile("" : "+v"(lb));
#pragma unroll
    for (int i = 0; i < SC_LW; ++i) { LAS float* sp = lb + i * SC_STEPF;
        const float rc = bf2f(R.rr[i + 1]), rp = bf2f(R.rr[i]), kc = bf2f(R.kk[i + 1]), kp = bf2f(R.kk[i]);
        const float zr = rc + (rp - rc) * mu_r, zk = kc + (kp - kc) * mu_k, a = bf2f(R.aa[i]);
        const float kv = zk * kk_n; const float ss = wave_sum_dpp(kv * kv); const float kn = kv * rsqrtf(fmaxf(ss, 1e-24f));
        sp[0] = zr; sp[64] = 1.0f - bf2f(R.ww[i]); sp[128] = zk * (1.0f + (a - 1.0f) * ka_n); sp[192] = -kn; sp[256] = kn * a; }
#pragma unroll
    for (int j = 0; j < SC_VJ; ++j) { const unsigned st = 4 * j + (lane >> 4), rw = lane & 15;
        if (st < (unsigned)SC_LW) { const float vc = bf2f(R.vc[j]), vp = bf2f(R.vp[j]); buf[(SC_LW * lw + st) * SC_STEPF + 320 + rw] = vc + (vp - vc) * mu_v; } }
}
typedef float f32x2 __attribute__((ext_vector_type(2)));
struct ScanOps { f32x4 r4, w4, k4, n4, b4; float v; };
__device__ __forceinline__ void scan_ops_load(ScanOps& o, const LAS float* lp, const LAS float* vp) {
    o.r4 = *(const LAS f32x4*)(lp); o.w4 = *(const LAS f32x4*)(lp + 64); o.k4 = *(const LAS f32x4*)(lp + 128);
    o.n4 = *(const LAS f32x4*)(lp + 192); o.b4 = *(const LAS f32x4*)(lp + 256); o.v = *vp; }
#define LO2(v) ((f32x2){(v).x, (v).y})
#define HI2(v) ((f32x2){(v).z, (v).w})
__device__ __forceinline__ float dot4p(const f32x2& a0, const f32x2& a1, const f32x4& b) { f32x2 t = a0 * LO2(b); t = a1 * HI2(b) + t; return t.x + t.y; }
__device__ __forceinline__ float scan_step(f32x2& S0, f32x2& S1, const ScanOps& o, float& q) {
    float p = dot4p(S0, S1, o.n4), y = q;
    p += dppf<0xB1>(p); y += dppf<0xB1>(y); p += dppf<0x4E>(p); y += dppf<0x4E>(y); p += dppf<0x141>(p); y += dppf<0x141>(y); p += dppf<0x128>(p); y += dppf<0x128>(y);
    const f32x2 vv = (f32x2){o.v, o.v}, sa = (f32x2){p, p};
    S0 = LO2(o.b4) * sa + (S0 * LO2(o.w4) + LO2(o.k4) * vv); S1 = HI2(o.b4) * sa + (S1 * HI2(o.w4) + HI2(o.k4) * vv);
    q = dot4p(S0, S1, o.r4);
    return y; }
constexpr int SC_YB = SC_CH * 16;
static_assert((2 * SC_BUFF + 2 * SC_YB + 256 + 256 + 4 * 64 * 33) * 4 <= RING_BYTES, "scan LDS");
__device__ __forceinline__ void scan_flush(const Frame& F, const LAS float* yb, int b, int h, int q, int chunk, int ltid) {
    bf16* Y = ((bf16*)(F.ws + WS_XN)); asm volatile("" : "+v"(ltid));
#pragma unroll
    for (int j = 0; j < (SC_YB + 255) / 256; ++j) { const int idx = ltid + 256 * j; if (idx < SC_YB) { const int st = idx >> 4, rw = idx & 15;
        Y[(size_t)row_of(b, chunk * SC_CH + st) * D + 512 + h * 64 + 16 * q + rw] = (bf16)f2bf(yb[idx]); } }
}
__device__ __forceinline__ void phase_scan(Frame& F, const float* pk, const float* const* in, int l) {
    { int ln_ = F.tid & 63; asm volatile("" : "+v"(ln_)); F.lane = ln_; }
    LAS float* buf0 = (LAS float*)F.lds; LAS float* buf1 = buf0 + SC_BUFF; LAS float* yb0 = buf1 + SC_BUFF; LAS float* yb1 = yb0 + SC_YB; LAS float* dummy = yb1 + SC_YB;
    const unsigned lane = F.lane; const int wave = F.wave;
    const int cv_split = CI_SET1, cv_n = CI_SET1 + (l + 1 < NLAYER ? CI_SET0 : 0);
    for (int item = blockIdx.x; item < 256; item += GRID) {
        const int b = item >> 5, h = (item >> 2) & 7, q = item & 3;
        if (wave >= 4) {
            const int lw = wave - 4, n = h * 64 + lane, ltid = lw * 64 + lane;
            const float mu_r = pk[PK_MU + n], mu_k = pk[PK_MU + 512 + n], kk_n = pk[PK_KK + n], ka_n = pk[PK_KA + n];
            const float mu_v = pk[PK_MU + 1024 + h * 64 + 16 * q + (lane & 15)];
            ScanRegs A, B;
            scan_load(F, A, b, h, q, lw, 0, lane); scan_load(F, B, b, h, q, lw, 1, lane);
            scan_emit(A, buf0, lw, lane, mu_r, mu_k, kk_n, ka_n, mu_v);
            __syncthreads();
            LAS float* cscr = dummy + 256 + lw * (64 * 33);
            int cv_it = (item * 4 + lw); bool cv_pending = false; ConvItem cvi; float cvv[32];
            cvi = conv_item(F.ws, in, l, 1, 0);
            for (int c = 0; c < SC_NCH; ++c) {
                if ((c & 1) == 0) { if (c + 2 < SC_NCH) scan_load(F, A, b, h, q, lw, c + 2, lane); if (c + 1 < SC_NCH) scan_emit(B, buf1, lw, lane, mu_r, mu_k, kk_n, ka_n, mu_v); }
                else              { if (c + 2 < SC_NCH) scan_load(F, B, b, h, q, lw, c + 2, lane); if (c + 1 < SC_NCH) scan_emit(A, buf0, lw, lane, mu_r, mu_k, kk_n, ka_n, mu_v); }
                if (c > 0) scan_flush(F, ((c - 1) & 1) ? yb1 : yb0, b, h, q, c - 1, ltid);
                if ((c & 7) == 1 && cv_pending) { conv_store(cvi, (int)lane, cvv, cscr); cv_pending = false; cv_it += 4 * 256; }
                if ((c & 7) == 0 && cv_it < cv_n) { cvi = cv_it < cv_split ? conv_item(F.ws, in, l, 1, cv_it) : conv_item(F.ws, in, l + 1, 0, cv_it - cv_split); conv_loads(cvi, (int)lane, cvv); cv_pending = true; }
                __syncthreads();
            }
            if (cv_pending) { conv_store(cvi, (int)lane, cvv, cscr); cv_it += 4 * 256; }
            for (; cv_it < cv_n; cv_it += 4 * 256) { cvi = cv_it < cv_split ? conv_item(F.ws, in, l, 1, cv_it) : conv_item(F.ws, in, l + 1, 0, cv_it - cv_split); conv_loads(cvi, (int)lane, cvv); conv_store(cvi, (int)lane, cvv, cscr); }
            scan_flush(F, ((SC_NCH - 1) & 1) ? yb1 : yb0, b, h, q, SC_NCH - 1, ltid);
        } else {
            const int kq = lane & 15, rowl = 4 * wave + (lane >> 4);
            f32x2 S0 = (f32x2){0.f, 0.f}, S1 = S0;
            __builtin_amdgcn_s_setprio(3);
            __syncthreads();
            for (int c = 0; c < SC_NCH; ++c) {
                const LAS float* bp = (c & 1) ? buf1 : buf0;
                LAS float* yw = kq == 0 ? (((c & 1) ? yb1 : yb0) + rowl) : (dummy + lane);
                const int ystep = kq == 0 ? 16 : 0;
                ScanOps oa, ob; float qp = 0.f;
                const LAS float* lp = bp + 4 * kq; const LAS float* vp = bp + 320 + rowl;
                asm volatile("" : "+v"(lp), "+v"(vp), "+v"(yw));
                scan_ops_load(oa, lp, vp);
                scan_ops_load(ob, lp + SC_STEPF, vp + SC_STEPF);
                (void)scan_step(S0, S1, oa, qp);
#pragma unroll 2
                for (int i = 1; i < SC_CH - 1; i += 2) {
                    scan_ops_load(oa, lp + (i + 1) * SC_STEPF, vp + (i + 1) * SC_STEPF);
                    const float y0 = scan_step(S0, S1, ob, qp); yw[(i - 1) * ystep] = y0;
                    scan_ops_load(ob, lp + (i + 2) * SC_STEPF, vp + (i + 2) * SC_STEPF);
                    const float y1 = scan_step(S0, S1, oa, qp); yw[i * ystep] = y1;
                }
                { const float y2 = scan_step(S0, S1, ob, qp); yw[(SC_CH - 2) * ystep] = y2; }
                yw[(SC_CH - 1) * ystep] = red16(qp);
                __syncthreads();
            }
            __builtin_amdgcn_s_setprio(0);
        }
        __syncthreads();
    }
}

__device__ __forceinline__ void unpack4(unsigned long long u, float (&v)[4]) { v[0] = bf2f((unsigned)u & 0xffffu); v[1] = bf2f(((unsigned)u >> 16)); v[2] = bf2f((unsigned)(u >> 32) & 0xffffu); v[3] = bf2f((unsigned)(u >> 48)); }
__device__ __forceinline__ void phase_mix_final(Frame& F, const float* pk) {
    { int ln_ = F.tid & 63; asm volatile("" : "+v"(ln_)); F.lane = ln_; }
    LAS float* carry = (LAS float*)F.lds;
    const int tid = F.tid, lane = F.lane, w = F.wave, rg = lane >> 4, kq = lane & 15;
    const bf16* P = ((bf16*)(F.ws + WS_OV + OV_P)); bf16* Y = ((bf16*)(F.ws + WS_XN));
    const bf16* AB = ((bf16*)(F.ws + WS_OV + OV_ABUF)); const bf16* GB = ((bf16*)(F.ws + WS_OV + OV_GBUF)); const unsigned* HCp = ((const unsigned*)(F.ws + WS_OV + OV_HL));
    const int n0 = w * 64 + 4 * kq;
    const f32x4 mu_r = *(const f32x4*)(pk + PK_MU + n0), mu_k = *(const f32x4*)(pk + PK_MU + 512 + n0), mu_v = *(const f32x4*)(pk + PK_MU + 1024 + n0);
    const f32x4 ka4 = *(const f32x4*)(pk + PK_KA + n0), rk4 = *(const f32x4*)(pk + PK_RK + n0), lw4 = *(const f32x4*)(pk + PK_LNW + n0), lb4 = *(const f32x4*)(pk + PK_LNB + n0);
    const f32x4 ng4 = w < 4 ? *(const f32x4*)(pk + PK_LNG + n0) : (f32x4){0.f, 0.f, 0.f, 0.f};
    for (int tile = blockIdx.x; tile < 256; tile += GRID) {
        const int b = tile >> 5, c = tile & 31;
        const int s_begin = c == 0 ? 0 : NMETA + 64 * c, ntok = c == 0 ? 80 : 64;
        if (tid < 256) {
            const float* ag = ((float*)(F.ws + WS_AGG)) + ((size_t)(b * 32) * 256 + tid) * 2; float ca[32], hh[32];
#pragma unroll
            for (int c2 = 0; c2 < 31; ++c2) { ca[c2] = 0.f; hh[c2] = 0.f; if (c2 < c) { const f32x2v_ t2 = *(const f32x2v_*)(ag + (size_t)c2 * 512); ca[c2] = t2.x; hh[c2] = t2.y; } }
            float hc = 0.f;
#pragma unroll
            for (int c2 = 0; c2 < 31; ++c2) if (c2 < c) hc = ca[c2] * hc + hh[c2];
            carry[tid] = hc; }
        __syncthreads();
        f32x4 cr4 = (f32x4){0.f, 0.f, 0.f, 0.f}; if (w < 4) cr4 = *(const LAS f32x4*)(carry + n0);
        for (int tg = (c == 0 && b != 0) ? NMETA : 0; tg < ntok; tg += 16) {
            unsigned long long rc[4], kc[4], vc[4], rp[4], kp[4], vp[4], av[4], yv[4], gv[4], lg[4]; v4u hc[4];
#pragma unroll
            for (int u = 0; u < 4; ++u) { const int s = s_begin + tg + 4 * u + rg; const size_t ro = (size_t)row_of(b, s); const bf16* pr = P + ro * NINP + n0;
                rc[u] = *(const unsigned long long*)(pr + PC_R); kc[u] = *(const unsigned long long*)(pr + PC_K); vc[u] = *(const unsigned long long*)(pr + PC_V); rp[u] = 0ull; kp[u] = 0ull; vp[u] = 0ull;
                if (s > 0) { const bf16* pp = P + (size_t)row_of(b, s - 1) * NINP + n0; rp[u] = *(const unsigned long long*)(pp + PC_R); kp[u] = *(const unsigned long long*)(pp + PC_K); vp[u] = *(const unsigned long long*)(pp + PC_V); }
                av[u] = *(const unsigned long long*)(AB + ro * 512 + n0); yv[u] = *(const unsigned long long*)(Y + ro * D + 512 + n0); gv[u] = *(const unsigned long long*)(GB + ro * 512 + n0);
                lg[u] = 0ull; hc[u] = (v4u){0u, 0u, 0u, 0u};
                if (w < 4) { lg[u] = *(const unsigned long long*)(pr + PC_LRUG); hc[u] = *(const v4u*)(HCp + ro * 256 + n0); } }
#pragma unroll
            for (int u = 0; u < 4; ++u) { const int s = s_begin + tg + 4 * u + rg; const size_t ro = (size_t)row_of(b, s);
                float r_c[4], k_c[4], v_c[4], r_p[4], k_p[4], v_p[4], a4[4], y4[4], g4[4];
                unpack4(rc[u], r_c); unpack4(kc[u], k_c); unpack4(vc[u], v_c); unpack4(rp[u], r_p); unpack4(kp[u], k_p); unpack4(vp[u], v_p); unpack4(av[u], a4); unpack4(yv[u], y4); unpack4(gv[u], g4);
                float zv[4], cbp = 0.f, ysum = 0.f;
#pragma unroll
                for (int j = 0; j < 4; ++j) { const float zr = r_c[j] + (r_p[j] - r_c[j]) * mu_r[j], zk = k_c[j] + (k_p[j] - k_c[j]) * mu_k[j]; zv[j] = v_c[j] + (v_p[j] - v_c[j]) * mu_v[j];
                    cbp += zr * (zk * (1.0f + (a4[j] - 1.0f) * ka4[j])) * rk4[j]; ysum += y4[j]; }
                const float cb = red16(cbp), mean = red16(ysum) * (1.0f / 64.0f);
                float d4[4], vs = 0.f;
#pragma unroll
                for (int j = 0; j < 4; ++j) { d4[j] = y4[j] - mean; vs += d4[j] * d4[j]; }
                const float rstd = rsqrtf(red16(vs) * (1.0f / 64.0f) + LNX_EPS);
                float o4[4];
#pragma unroll
                for (int j = 0; j < 4; ++j) o4[j] = (d4[j] * rstd * lw4[j] + lb4[j] + cb * zv[j]) * g4[j];
                *(GAS unsigned long long*)(Y + ro * D + 512 + n0) = (unsigned long long)pk2(o4[0], o4[1]) | ((unsigned long long)pk2(o4[2], o4[3]) << 32);
                if (w < 4) { float l4[4], yy[4], ss = 0.f; unpack4(lg[u], l4);
#pragma unroll
                    for (int j = 0; j < 4; ++j) { yy[j] = gelu_tanh(l4[j]) * (bf2f(hc[u][j] & 0xffffu) + bf2f(hc[u][j] >> 16) * cr4[j]); ss += yy[j] * yy[j]; }
                    const float rs = rsqrtf(red16(ss) * (1.0f / 64.0f) + RMS_EPS);
                    *(GAS unsigned long long*)(Y + ro * D + n0) = (unsigned long long)pk2(yy[0] * rs * ng4[0], yy[1] * rs * ng4[1]) | ((unsigned long long)pk2(yy[2] * rs * ng4[2], yy[3] * rs * ng4[3]) << 32); } }
        }
        __syncthreads();
    }
}
#ifndef MK_PER_PHASE
#define MK_PER_PHASE 0
#endif
constexpr int REP_GEMM = 1, REP_PREP = 1, REP_SCAN = 1, REP_CONV = 1;
constexpr int PH_PER_LAYER = 12, N_PHASES = 1 + NLAYER * PH_PER_LAYER;
struct Args { const float* in[30]; float* out; unsigned char* ws; int ph_lo, ph_hi; };
static_assert(sizeof(Args) == 30 * 8 + 8 + 8 + 4 + 4, "Args has no padding");

__global__ void __launch_bounds__(NWAVES * 64, 2) hybrid_fwd(Args args) {
    extern __shared__ __attribute__((aligned(16))) unsigned char lds[];
    Frame F;
    F.lds = (LAS unsigned char*)lds;
    F.tid = threadIdx.x; F.lane = F.tid & 63; F.wave = 0;
    { const int bx = blockIdx.x; F.vcu = (bx % 8) * (GRID / 8) + bx / 8; }
    unsigned char* ws = args.ws;
    F.ws = ws; F.x = args.in[0]; F.meta = args.in[1]; F.out = args.out;
    volatile LAS unsigned* MISC = (volatile LAS unsigned*)(F.lds + MISC_OFF);
    for (int u = F.tid; u < (LDS_BYTES - LDSCTL_OFF) / 4; u += NWAVES * 64) ((LAS unsigned*)(F.lds + LDSCTL_OFF))[u] = 0u;
    __syncthreads();
    { const unsigned simd = ((unsigned)__builtin_amdgcn_s_getreg((1 << 11) | (4 << 6) | 4)) & 3u;
      LAS unsigned* tkw = (LAS unsigned*)(F.lds + MISC_OFF) + 12;
      unsigned tk = 0u, tg = 0u; if (vlane() == 0) { tk = __hip_atomic_fetch_add(tkw + simd, 1u, __ATOMIC_RELAXED, __HIP_MEMORY_SCOPE_WORKGROUP); tg = __hip_atomic_fetch_add(tkw + 4, 1u, __ATOMIC_RELAXED, __HIP_MEMORY_SCOPE_WORKGROUP); }
      tk = (unsigned)__builtin_amdgcn_readfirstlane(tk); tg = (unsigned)__builtin_amdgcn_readfirstlane(tg);
      __syncthreads();
      const bool two_each = tkw[0] == 2u && tkw[1] == 2u && tkw[2] == 2u && tkw[3] == 2u;
      F.wave = __builtin_amdgcn_readfirstlane(two_each ? (int)(simd + 4u * tk) : (int)tg); }
    F.lane = vlane(); F.tid = F.wave * 64 + F.lane;
    XcdBarrier bar; bar.bar = (unsigned*)(ws + WS_CTL) + CW_BAR; bar.x = 0; bar.st = nullptr;
    if (!MK_PER_PHASE) bar = xcd_barrier_post((unsigned*)(ws + WS_CTL) + CW_BAR, MISC + 8, F.tid == 0);
    const int lo = args.ph_lo, hi = args.ph_hi; const int wave0 = F.wave;
    unsigned long long pr_prev = 0ull; F.pr_acc = 0ull; F.pr_sub = 0ull; F.ph = 0; if (PROBE_MASK) { pr_prev = __builtin_amdgcn_s_memrealtime(); F.pr_sub = pr_prev; }
#pragma unroll 1
    for (int ph = lo; ph < hi; ++ph) {
        if (PROBE_MASK) F.ph = ph;
        { GAS unsigned char* wsg = (GAS unsigned char*)args.ws; asm volatile("" : "+s"(wsg)); F.ws = (unsigned char*)wsg; }
        { int w_ = wave0; asm volatile("" : "+s"(w_)); F.wave = w_; }
        { int t_ = F.wave * 64 + vlane(); asm volatile("" : "+v"(t_)); F.tid = t_; }
        if (ph == 0) { PackRegs PR; pack_loads(F, args.in, PR); frag_loads(F, args.in, PR); phase_init_convert(F, args.in); PSTAMP(8); pack_stores(F, PR); frag_stores(F, PR); PSTAMP(9); }
        else {
            const int l = (ph - 1) / PH_PER_LAYER, k = (ph - 1) - l * PH_PER_LAYER;
            if (k == 0 || k == 1 || k == 3 || k == 7 || k == 9 || k == 10) {
                unsigned char* w = F.ws;
                const bool up = (k == 0 || k == 9), down = (k == 1 || k == 10);
                const bool lastl = l + 1 == NLAYER;
                const bf16* hcur = (lastl && k == 9) ? (const bf16*)(w + WS_OV + OV_HTMP) : (const bf16*)F.out;
                const bf16* A = down ? (const bf16*)(w + WS_OV + OV_HID) : (k == 7 ? (const bf16*)(w + WS_XN) : hcur);
                const bf16* Am = (down || k == 7) ? A : (const bf16*)(w + WS_HMETA) - (size_t)MX * D;
                const bf16* B = (const bf16*)(w + WS_WB + (k == 0 ? WB_W1IN : k == 1 ? WB_W1OUT : k == 3 ? WB_WIN : k == 7 ? WB_WOUT : k == 9 ? WB_W2IN : WB_W2OUT));
                const int N = up ? 2 * FF : (k == 3 ? NINP : D), K = down ? FF : D;
                const float* rs = nullptr;
                pg8::EpiAny E; E.mode = up ? 0 : 1; E.O = w + WS_OV + (up ? OV_HID : k == 3 ? OV_P : k == 7 ? OV_RAWM : OV_RAWF); E.ldo = up ? FF : (k == 3 ? NINP : D); E.rs = rs;
                const int gwv = F.vcu * NWAVES + F.wave;
                if (k == 3) meta_gemm(F, Am, B, K, N, 1, w + WS_OV + OV_P, NINP, 1, gwv, rs);
                else if (k == 7) meta_gemm(F, Am, B, K, N, 2, w + WS_MSLAB, D, 4, gwv, nullptr);
                PSTAMP(5);
                pg8::Gemm g{A, B, MX, N, K, K}; pg8::StaticOrder S; S.init(MX, N, GRID, (int)blockIdx.x);
                for (int rep_ = 0; rep_ < REP_GEMM; ++rep_) pg8::gemm_phase<pg8::EpiAny, pg8::StaticOrder, true, true>(F.lds, g, S, E, F.tid);
                PSTAMP(6);
                if (up) {
                    const int bx = (int)blockIdx.x; gu32* cnt = (gu32*)(w + WS_CTL) + CW_THIN + ph;
                    if (bx >= 128 && bx < 216) { const int tile = (bx - 128) * 2 + (F.wave >> 2);
                        meta_up_split(F, Am, B, tile < FF / 16 ? tile : -1, (bf16*)(w + WS_OV + OV_HID));
                        asm volatile("s_waitcnt vmcnt(0)" ::: "memory"); if ((F.wave & 3) == 0 && (F.tid & 63) == 0) (void)__hip_atomic_fetch_add(cnt, 1u, __ATOMIC_RELAXED, __HIP_MEMORY_SCOPE_AGENT); }
                    if (bx >= 128 && bx < 192) {
                        if (F.wave == 0) { unsigned sp = 0u; while ((unsigned)__builtin_amdgcn_readfirstlane((int)__hip_atomic_load(cnt, __ATOMIC_RELAXED, __HIP_MEMORY_SCOPE_AGENT)) != (unsigned)(FF / 16)) { __builtin_amdgcn_s_sleep(2); if (++sp > (1u << 20)) break; }
                            __builtin_amdgcn_fence(__ATOMIC_ACQUIRE, "agent"); asm volatile("s_waitcnt vmcnt(0)" ::: "memory"); }
                        __syncthreads();
                        const bf16* Bd = (const bf16*)(w + WS_WB + (k == 0 ? WB_W1OUT : WB_W2OUT));
                        meta_gemm(F, (const bf16*)(w + WS_OV + OV_HID), Bd, FF, D, 2, w + WS_MSLAB, D, 8, (bx - 128) * NWAVES + F.wave, nullptr); }
                }
            } else if (k == 2 || k == 8 || k == 11) {
                const float* ng = args.in[2] + (size_t)l * 6 * D;
                const bool last = l + 1 == NLAYER;
                const float* g_post = ng + (k == 2 ? 1 : k == 8 ? 3 : 5) * D;
                bf16* h16 = (bf16*)F.out; bf16* htmp = (bf16*)(F.ws + WS_OV + OV_HTMP);
                PostIO io; io.raw16 = (const bf16*)(F.ws + WS_OV + (k == 8 ? OV_RAWM : OV_RAWF));
                io.hin16 = (last && k == 11) ? htmp : h16; io.hout16 = (last && k == 8) ? htmp : h16; io.out32 = (last && k == 11) ? F.out : nullptr; io.nks = k == 8 ? 4 : 8;
                phase_post(F, io, k == 8 ? 1.0f : 0.5f, g_post, !(last && k == 11));
            } else if (k == 4) { for (int rep_ = 0; rep_ < REP_PREP; ++rep_) phase_mix_prep(F, pack_of(F, l), l); }
            else if (k == 5) { for (int rep_ = 0; rep_ < REP_SCAN; ++rep_) phase_scan(F, pack_of(F, l), args.in, l); }
            else { phase_mix_final(F, pack_of(F, l)); }
        }
        if (ph + 1 < hi) { XcdBarrier b2 = bar; b2.bar = (unsigned*)(F.ws + WS_CTL) + CW_BAR; xcd_barrier(b2, F.tid == 0); }
        if (PROBE_MASK) { const unsigned long long t = __builtin_amdgcn_s_memrealtime(); if (PROBE_SUB < 0 && ((PROBE_MASK >> ph) & 1u)) F.pr_acc += t - pr_prev; pr_prev = t; F.pr_sub = t; }
    }
    if (PROBE_MASK && blockIdx.x == 0 && F.tid == 0) { const unsigned long long t0 = __builtin_amdgcn_s_memrealtime(); while (__builtin_amdgcn_s_memrealtime() - t0 < PROBE_AMP * F.pr_acc) __builtin_amdgcn_s_sleep(8); }
}

extern "C" void kernel_launch(void* const* d_in, const int* in_sizes, int n_in, void* d_out, int out_size, void* d_ws, size_t ws_size, hipStream_t stream) {
    static int grid = 0;
    if (grid == 0) {
        if (n_in != 30 || in_sizes[0] != MX * D || out_size != MX * D || ws_size < WS_END) { fprintf(stderr, "kernel_launch: unexpected shapes: n_in %d in0 %d out %d ws %zu\n", n_in, n_in > 0 ? in_sizes[0] : -1, out_size, ws_size); grid = -1; return; }
        int dev = 0, cus = 0, per_cu = 0;
        if (hipGetDevice(&dev) != hipSuccess || hipDeviceGetAttribute(&cus, hipDeviceAttributeMultiprocessorCount, dev) != hipSuccess) { grid = -1; return; }
        if (hipFuncSetAttribute((const void*)hybrid_fwd, hipFuncAttributeMaxDynamicSharedMemorySize, LDS_BYTES) != hipSuccess) { fprintf(stderr, "kernel_launch: hipFuncSetAttribute failed\n"); grid = -1; return; }
        if (hipOccupancyMaxActiveBlocksPerMultiprocessor(&per_cu, (const void*)hybrid_fwd, NWAVES * 64, LDS_BYTES) != hipSuccess || per_cu < 1) { fprintf(stderr, "kernel_launch: occupancy query says %d blocks per CU\n", per_cu); grid = -1; (void)hipGetLastError(); return; }
        (void)hipGetLastError();
        if (cus < GRID) { fprintf(stderr, "kernel_launch: this kernel needs %d CUs (one resident workgroup each), the device has %d\n", GRID, cus); grid = -1; return; }
        grid = GRID;
    }
    if (grid < 0) return;
    if (hipMemsetAsync((char*)d_ws + WS_CTL, 0, CTL_ZERO_BYTES, stream) != hipSuccess) return;
    Args a{};
    for (int i = 0; i < 30; ++i) a.in[i] = (const float*)d_in[i];
    a.out = (float*)d_out; a.ws = (unsigned char*)d_ws;
#if MK_PER_PHASE
    for (int p = 0; p < N_PHASES; ++p) { a.ph_lo = p; a.ph_hi = p + 1; hipLaunchKernelGGL(hybrid_fwd, dim3(grid), dim3(NWAVES * 64), LDS_BYTES, stream, a); }
#else
    a.ph_lo = 0; a.ph_hi = N_PHASES;
    hipLaunchKernelGGL(hybrid_fwd, dim3(grid), dim3(NWAVES * 64), LDS_BYTES, stream, a);
#endif
}
```

```cpp
#include <hip/hip_runtime.h>
#include <cstdio>
#include <cstdint>
namespace pg8 {
#define PG8_LAS __attribute__((address_space(3)))
typedef unsigned short bf16_t;
typedef short bf16x8 __attribute__((ext_vector_type(8)));
typedef float f32x4 __attribute__((ext_vector_type(4)));
typedef unsigned u32x4 __attribute__((ext_vector_type(4)));
constexpr int BM = 256, BK = 64, HALF = 128, HTB = HALF * BK * 2  , STAGE_BYTES = 8 * HTB, NXCD = 8, WGM = 8;

__host__ __device__ __forceinline__ int lds_byte(int r, int c) { const int st = (r >> 4) * 2 + (c >> 5), rr = r & 15, cc = c & 31, ob = rr * 64 + cc * 2; return st * 1024 + (ob ^ (((ob >> 9) & 1) << 5)); }
__host__ __device__ __forceinline__ void stage_rc(int b, int& R, int& C) { const int st = b / 1024, sb = b % 1024, swz = sb ^ (((sb >> 9) & 1) << 5); R = (st >> 1) * 16 + swz / 64; C = (st & 1) * 32 + (swz % 64) / 2; }
__host__ __device__ __forceinline__ int perm32(int rho) { const int n = rho >> 4, i = rho & 15; return 8 * (i >> 2) + 4 * n + (i & 3); }

struct Unit { int pm, pn; };
struct Gemm { const bf16_t* A; const bf16_t* Bt; int M, N, K, ld; };

struct StaticOrder {
    int nM, nN, nwg, G, c, one_pn;
    __host__ __device__ void init(int M, int N, int G_, int c_) { nM = M / BM; nN = N / BM; nwg = nM * nN; G = G_; c = c_; one_pn = -1; }
    __host__ __device__ bool next(int i, Unit& u) const {
        if (one_pn != -1) { if (i != 0 || one_pn < 0) return false; u.pm = 0; u.pn = one_pn; return true; }
        const long L = (long)i * G + c; if (L >= nwg) return false;
        int wgid = (int)L; { const int q = nwg / NXCD, r = nwg % NXCD, xcd = wgid % NXCD, off = wgid / NXCD; wgid = (xcd < r ? xcd * (q + 1) : r * (q + 1) + (xcd - r) * q) + off; }
        const int nig = WGM * nN, gid = wgid / nig, fm = gid * WGM, gsz = (nM - fm) < WGM ? (nM - fm) : WGM;
        u.pm = fm + ((wgid % nig) % gsz); u.pn = (wgid % nig) / gsz; return true;
    }
    __device__ __forceinline__ void a_ready(const Unit&) const {}
    __device__ __forceinline__ void done(const Unit&) const {}
};
__device__ __forceinline__ unsigned cvt_pk_bf16(float lo, float hi) { unsigned r; asm volatile("v_cvt_pk_bf16_f32 %0, %1, %2" : "=v"(r) : "v"(lo), "v"(hi)); return r; }
typedef float f32x2 __attribute__((ext_vector_type(2)));
struct EpiSwiGLU {
    static constexpr bool PERM = true, AFTER_DRAIN = false;
    bf16_t* O; int ldo; const PG8_LAS float* rst;
    __device__ __forceinline__ void operator()(const f32x4 (&acc)[2][2][4][2], const Unit& u, int wr, int wc, int fr, int fq) const {
        const int row0 = u.pm * BM + wr * 64 + fr, col0 = u.pn * HALF + wc * 32 + 8 * fq;
        const __amdgpu_buffer_rsrc_t ro = __builtin_amdgcn_make_buffer_rsrc((void*)O, 0, 0x7ffffff0, 0x00020000);
#pragma unroll
        for (int ai = 0; ai < 2; ++ai)
#pragma unroll
            for (int m = 0; m < 4; ++m) { const int vo = ((row0 + ai * HALF + m * 16) * ldo + col0) * 2; const float sc = rst ? rst[64 * ai + 16 * m + fr] : 1.0f;
                float hv[8];
#pragma unroll
                for (int n = 0; n < 2; ++n)
#pragma unroll
                    for (int j = 0; j < 4; ++j) { const float g = acc[ai][0][m][n][j] * sc, up = acc[ai][1][m][n][j] * sc; hv[n * 4 + j] = g * __builtin_amdgcn_rcpf(1.0f + __expf(-g)) * up; }
                u32x4 w; w.x = cvt_pk_bf16(hv[0], hv[1]); w.y = cvt_pk_bf16(hv[2], hv[3]); w.z = cvt_pk_bf16(hv[4], hv[5]); w.w = cvt_pk_bf16(hv[6], hv[7]);
                __builtin_amdgcn_raw_buffer_store_b128(w, ro, vo, 0, 16); }
    }
};
struct EpiStoreBf16 {
    static constexpr bool PERM = true, AFTER_DRAIN = false;
    bf16_t* O; int ldc; const PG8_LAS float* rst;
    __device__ __forceinline__ void operator()(const f32x4 (&acc)[2][2][4][2], const Unit& u, int wr, int wc, int fr, int fq) const {
        const int row0 = u.pm * BM + wr * 64 + fr, col0 = u.pn * BM + wc * 32 + 8 * fq;
        const __amdgpu_buffer_rsrc_t ro = __builtin_amdgcn_make_buffer_rsrc((void*)O, 0, 0x7ffffff0, 0x00020000);
#pragma unroll
        for (int ai = 0; ai < 2; ++ai)
#pragma unroll
            for (int m = 0; m < 4; ++m) { const int vo = ((row0 + ai * HALF + m * 16) * ldc + col0) * 2; const float sc = rst ? rst[64 * ai + 16 * m + fr] : 1.0f;
#pragma unroll
                for (int bj = 0; bj < 2; ++bj) { const f32x4 v0 = acc[ai][bj][m][0] * sc, v1 = acc[ai][bj][m][1] * sc;
                    u32x4 w; w.x = cvt_pk_bf16(v0[0], v0[1]); w.y = cvt_pk_bf16(v0[2], v0[3]); w.z = cvt_pk_bf16(v1[0], v1[1]); w.w = cvt_pk_bf16(v1[2], v1[3]);
                    __builtin_amdgcn_raw_buffer_store_b128(w, ro, vo + bj * HALF * 2, 0, 16); } }
    }
};
struct EpiF32 {
    static constexpr bool PERM = false, AFTER_DRAIN = false;
    float* C; int ldc;
    __device__ __forceinline__ void operator()(const f32x4 (&acc)[2][2][4][2], const Unit& u, int wr, int wc, int fr, int fq) const {
        const int row0 = u.pm * BM + wr * 64 + fr, col0 = u.pn * BM + wc * 32 + 4 * fq;
#pragma unroll
        for (int ai = 0; ai < 2; ++ai)
#pragma unroll
            for (int m = 0; m < 4; ++m) { float* rowp = C + (size_t)(row0 + ai * HALF + m * 16) * ldc + col0;
#pragma unroll
                for (int bj = 0; bj < 2; ++bj)
#pragma unroll
                    for (int n = 0; n < 2; ++n) *(f32x4*)(rowp + bj * HALF + n * 16) = acc[ai][bj][m][n]; }
    }
};
struct EpiAny {
    static constexpr bool PERM = true, AFTER_DRAIN = false;
    int mode; void* O; int ldo; const float* rs;
    __device__ __forceinline__ void row_scale_issue(const Unit& u, int wr, int fr, int fq, float& v0, float& v1) const {
        if (rs) { const float* p = rs + u.pm * BM + wr * 64 + fr + (fq >> 1) * HALF + (fq & 1) * 32; v0 = p[0]; v1 = p[16]; } }
    __device__ __forceinline__ void row_scale_park(PG8_LAS unsigned char* tab, int wid, int lane, float v0, float v1) const {
        if (rs) { PG8_LAS float* t = (PG8_LAS float*)(tab + wid * 512) + ((lane >> 5) * 64 + ((lane >> 4) & 1) * 32 + (lane & 15)); t[0] = v0; t[16] = v1; asm volatile("s_waitcnt lgkmcnt(0)" ::: "memory"); } }
    __device__ __forceinline__ void operator()(f32x4 (&acc)[2][2][4][2], const Unit& u, int wr, int wc, int fr, int fq, PG8_LAS unsigned char* tab, int wid) const {
        const PG8_LAS float* rst = rs ? (const PG8_LAS float*)(tab + wid * 512) : nullptr;
        if (mode == 0) { EpiSwiGLU E{(bf16_t*)O, ldo, rst}; E(acc, u, wr, wc, fr, fq); }
        else if (mode == 1) { EpiStoreBf16 E{(bf16_t*)O, ldo, rst}; E(acc, u, wr, wc, fr, fq); }
        else { float* C = (float*)O; const int row0 = u.pm * BM + wr * 64 + fr, col0 = u.pn * BM + wc * 32 + 8 * fq;
#pragma unroll
            for (int ai = 0; ai < 2; ++ai)
#pragma unroll
                for (int m = 0; m < 4; ++m) { float* rowp = C + (size_t)(row0 + ai * HALF + m * 16) * ldo + col0;
#pragma unroll
                    for (int bj = 0; bj < 2; ++bj)
#pragma unroll
                        for (int n = 0; n < 2; ++n) *(f32x4*)(rowp + bj * HALF + n * 4) = acc[ai][bj][m][n]; } }
    }
};
template <class Epi, class Sched, bool ALIGN_EPI = false, bool SP2 = false>
__device__ __forceinline__ void gemm_phase(PG8_LAS unsigned char* lds, const Gemm g, const Sched& S, const Epi& E, int tid_in  ) {
    int tid_ = tid_in; asm volatile("" : "+v"(tid_));
    const int tid = tid_, wid = __builtin_amdgcn_readfirstlane(tid >> 6), lane = tid & 63, wr = wid >> 2, wc = wid & 3, fr = lane & 15, fq = lane >> 4;
    const int K = g.K, LD = g.ld, nt = K / BK;
    unsigned voffA[2], voffB[2];
#pragma unroll
    for (int i = 0; i < 2; ++i) { int R, C; stage_rc(tid * 16 + i * 8192, R, C); const int Rb = Epi::PERM ? ((R & ~31) + perm32(R & 31)) : R;
        voffA[i] = (unsigned)(R * LD + C) * 2u; voffB[i] = (unsigned)(Rb * LD + C) * 2u; }
    const size_t kstep = (size_t)(BK * 2);
    const size_t hstep = (size_t)HALF * LD * 2;
    const size_t tstep = 2 * hstep;
    const unsigned ldsw = (unsigned)wid * 1024u;
    const int aoff = lds_byte(wr * 64 + fr, fq * 8), boff = lds_byte(wc * 32 + fr, fq * 8);
#define PG8_SA(b, h) (((b) * 2 + (h)) * HTB)
#define PG8_SB(b, h) ((4 + (b) * 2 + (h)) * HTB)
#define PG8_STAGE(bufoff, gbase, voff) do { _Pragma("unroll") for (int _i = 0; _i < 2; ++_i) \
        __builtin_amdgcn_global_load_lds((const unsigned*)((const char*)(gbase) + (voff)[_i]), (PG8_LAS unsigned*)(lds + (bufoff) + ldsw + _i * 8192), 16, 0, 0); } while (0)
#define PG8_LDA(dst, b, h) do { _Pragma("unroll") for (int m = 0; m < 4; ++m) _Pragma("unroll") for (int k = 0; k < 2; ++k) dst[m][k] = *(const PG8_LAS bf16x8*)(lds + PG8_SA(b, h) + aoff + m * 2048 + k * 1024); } while (0)
#define PG8_LDB(dst, b, h) do { _Pragma("unroll") for (int n = 0; n < 2; ++n) _Pragma("unroll") for (int k = 0; k < 2; ++k) dst[n][k] = *(const PG8_LAS bf16x8*)(lds + PG8_SB(b, h) + boff + n * 2048 + k * 1024); } while (0)
#define PG8_MMA(ai, bj, At, Bt) do { __builtin_amdgcn_s_setprio(1); _Pragma("unroll") for (int m = 0; m < 4; ++m) _Pragma("unroll") for (int n = 0; n < 2; ++n) _Pragma("unroll") for (int k = 0; k < 2; ++k) \
        acc[ai][bj][m][n] = __builtin_amdgcn_mfma_f32_16x16x32_bf16(Bt[n][k], At[m][k], acc[ai][bj][m][n], 0, 0, 0); __builtin_amdgcn_s_setprio(0); } while (0)
#define PG8_WAIT_V(n) asm volatile("s_waitcnt vmcnt(" #n ")" ::: "memory")
#define PG8_WAIT_L(n) asm volatile("s_waitcnt lgkmcnt(" #n ")" ::: "memory")
#define PG8_BAR __builtin_amdgcn_s_barrier()
#define PG8_SCHED __builtin_amdgcn_sched_barrier(0)
    Unit cur, nxt; int ui = 0;
    if (!S.next(0, cur)) return;
    f32x4 acc[2][2][4][2];
#pragma unroll
    for (int a = 0; a < 2; ++a)
#pragma unroll
        for (int b = 0; b < 2; ++b)
#pragma unroll
            for (int m = 0; m < 4; ++m)
#pragma unroll
                for (int n = 0; n < 2; ++n) acc[a][b][m][n] = (f32x4){0.f, 0.f, 0.f, 0.f};
    bf16x8 At[4][2], B0[2][2], B1[2][2];
    const char* cA = (const char*)g.A + (size_t)cur.pm * tstep; const char* cB = (const char*)g.Bt + (size_t)cur.pn * tstep;
    S.a_ready(cur);
    if constexpr (SP2) {
        PG8_STAGE(PG8_SB(0, 0), cB, voffB); PG8_STAGE(PG8_SB(0, 1), cB + hstep, voffB); PG8_STAGE(PG8_SA(0, 0), cA, voffA); PG8_STAGE(PG8_SA(0, 1), cA + hstep, voffA);
        if (wr == 1) PG8_BAR;
        PG8_WAIT_V(2); PG8_BAR;
        PG8_STAGE(PG8_SB(1, 0), cB + kstep, voffB); PG8_STAGE(PG8_SA(1, 0), cA + kstep, voffA); PG8_STAGE(PG8_SB(1, 1), cB + hstep + kstep, voffB);
        PG8_WAIT_V(6); PG8_BAR;
    } else {
        PG8_STAGE(PG8_SB(0, 0), cB, voffB); PG8_STAGE(PG8_SA(0, 0), cA, voffA); PG8_STAGE(PG8_SB(0, 1), cB + hstep, voffB); PG8_STAGE(PG8_SA(0, 1), cA + hstep, voffA);
        if (wr == 1) PG8_BAR;
        PG8_WAIT_V(4); PG8_BAR;
        PG8_STAGE(PG8_SB(1, 0), cB + kstep, voffB); PG8_STAGE(PG8_SA(1, 0), cA + kstep, voffA); PG8_STAGE(PG8_SB(1, 1), cB + hstep + kstep, voffB);
        PG8_WAIT_V(6); PG8_BAR;
    }
    for (;;) {
        const bool has_next = S.next(ui + 1, nxt);
        { float rsv0 = 1.0f, rsv1 = 1.0f; E.row_scale_issue(cur, wr, fr, fq, rsv0, rsv1); E.row_scale_park(lds + STAGE_BYTES, wid, lane, rsv0, rsv1); }
        const char* nA = has_next ? (const char*)g.A + (size_t)nxt.pm * tstep : cA; const char* nB = has_next ? (const char*)g.Bt + (size_t)nxt.pn * tstep : cB;
        for (int t = 0; t < nt; t += 2) {
            const bool last = (t == nt - 2);
            const char* a1 = cA + (size_t)(t + 1) * kstep;
            const char* a2 = last ? nA : cA + (size_t)(t + 2) * kstep; const char* b2 = last ? nB : cB + (size_t)(t + 2) * kstep;
            const char* a3 = a2 + kstep; const char* b3 = b2 + kstep;
            if (last && has_next) S.a_ready(nxt);
            if constexpr (SP2) {
            PG8_LDB(B0, 0, 0); PG8_LDB(B1, 0, 1); PG8_SCHED; PG8_LDA(At, 0, 0); PG8_STAGE(PG8_SA(1, 1), a1 + hstep, voffA);
            PG8_WAIT_V(8); PG8_WAIT_L(0); PG8_BAR; PG8_MMA(0, 0, At, B0); PG8_MMA(0, 1, At, B1); PG8_BAR; PG8_SCHED;
            PG8_LDA(At, 0, 1); PG8_STAGE(PG8_SB(0, 0), b2, voffB); PG8_STAGE(PG8_SB(0, 1), b2 + hstep, voffB); PG8_STAGE(PG8_SA(0, 0), a2, voffA);
            PG8_WAIT_V(8); PG8_WAIT_L(0); PG8_BAR; PG8_MMA(1, 0, At, B0); PG8_MMA(1, 1, At, B1); PG8_BAR; PG8_SCHED;
            PG8_LDB(B0, 1, 0); PG8_LDB(B1, 1, 1); PG8_SCHED; PG8_LDA(At, 1, 0); PG8_STAGE(PG8_SA(0, 1), a2 + hstep, voffA);
            PG8_WAIT_V(8); PG8_WAIT_L(0); PG8_BAR; PG8_MMA(0, 0, At, B0); PG8_MMA(0, 1, At, B1); PG8_BAR; PG8_SCHED;
            PG8_LDA(At, 1, 1); PG8_STAGE(PG8_SB(1, 0), b3, voffB); PG8_STAGE(PG8_SB(1, 1), b3 + hstep, voffB); PG8_STAGE(PG8_SA(1, 0), a3, voffA);
            PG8_WAIT_V(8); PG8_WAIT_L(0); PG8_BAR; PG8_MMA(1, 0, At, B0); PG8_MMA(1, 1, At, B1); PG8_BAR; PG8_SCHED;
            } else {
            PG8_LDB(B0, 0, 0); PG8_SCHED; PG8_LDA(At, 0, 0); PG8_STAGE(PG8_SA(1, 1), a1 + hstep, voffA);
            PG8_WAIT_L(8); PG8_BAR; PG8_WAIT_L(0); PG8_MMA(0, 0, At, B0); PG8_BAR; PG8_SCHED;
            PG8_LDB(B1, 0, 1); PG8_STAGE(PG8_SB(0, 0), b2, voffB);
            PG8_BAR; PG8_WAIT_L(0); PG8_MMA(0, 1, At, B1); PG8_BAR;
            PG8_LDA(At, 0, 1); PG8_STAGE(PG8_SA(0, 0), a2, voffA);
            PG8_BAR; PG8_WAIT_L(0); PG8_MMA(1, 0, At, B0); PG8_BAR; PG8_SCHED;
            PG8_STAGE(PG8_SB(0, 1), b2 + hstep, voffB);
            PG8_WAIT_V(6); PG8_BAR; PG8_MMA(1, 1, At, B1); PG8_BAR;
            PG8_LDB(B0, 1, 0); PG8_SCHED; PG8_LDA(At, 1, 0); PG8_STAGE(PG8_SA(0, 1), a2 + hstep, voffA);
            PG8_WAIT_L(8); PG8_BAR; PG8_WAIT_L(0); PG8_MMA(0, 0, At, B0); PG8_BAR; PG8_SCHED;
            PG8_LDB(B1, 1, 1); PG8_STAGE(PG8_SB(1, 0), b3, voffB);
            PG8_BAR; PG8_WAIT_L(0); PG8_MMA(0, 1, At, B1); PG8_BAR;
            PG8_LDA(At, 1, 1); PG8_STAGE(PG8_SA(1, 0), a3, voffA);
            PG8_BAR; PG8_WAIT_L(0); PG8_MMA(1, 0, At, B0); PG8_BAR; PG8_SCHED;
            PG8_STAGE(PG8_SB(1, 1), b3 + hstep, voffB);
            PG8_WAIT_V(6); PG8_BAR; PG8_MMA(1, 1, At, B1); PG8_BAR;
            }
        }
        if constexpr (ALIGN_EPI) { if (wr == 0) PG8_BAR; }
        E(acc, cur, wr, wc, fr, fq, lds + STAGE_BYTES, wid); S.done(cur);
        if (!has_next) break;
#pragma unroll
        for (int a = 0; a < 2; ++a)
#pragma unroll
            for (int b = 0; b < 2; ++b)
#pragma unroll
                for (int m = 0; m < 4; ++m)
#pragma unroll
                    for (int n = 0; n < 2; ++n) acc[a][b][m][n] = (f32x4){0.f, 0.f, 0.f, 0.f};
        cur = nxt; cA = nA; cB = nB; ++ui;
        if constexpr (ALIGN_EPI) { if (wr == 1) PG8_BAR; }
    }
    PG8_WAIT_V(0);
    if constexpr (!ALIGN_EPI) { if (wr == 0) PG8_BAR; }
    PG8_BAR;
#undef PG8_SA
#undef PG8_SB
#undef PG8_STAGE
#undef PG8_LDA
#undef PG8_LDB
#undef PG8_MMA
#undef PG8_WAIT_V
#undef PG8_WAIT_L
#undef PG8_BAR
#undef PG8_SCHED
}
}
constexpr int NWAVES = 8, GRID = 256;
constexpr int D = 1024, FF = 2816, NIN = 2944, NINP = 3072, NLAYER = 2;
constexpr int NB = 8, SEQ = 2048, NMETA = 16, TT = SEQ + NMETA;
constexpr int MX = NB * SEQ, MREAL = MX + NMETA, MP = 16640;
constexpr float RMS_EPS = 1e-6f, LNX_EPS = 64e-5f;
constexpr int PC_LRUX = 0, PC_LRUG = 256, PC_SCB = 512, PC_SCC = 768, PC_SCX = 1024, PC_R = 1280, PC_K = 1792, PC_V = 2304, PC_LO = 2816;

constexpr size_t MiB = 1u << 20;
constexpr size_t WS_CTL = 0, CTL_ZERO_BYTES = 1 * MiB;
constexpr size_t WS_HMETA = 1 * MiB;
constexpr size_t WS_RS = WS_HMETA + 640 * 1024;
constexpr size_t WS_MSLAB = WS_HMETA + 64 * 1024;
constexpr size_t WS_AGG = 2 * MiB;
constexpr size_t WS_WB = 3 * MiB;
constexpr size_t WB_W1IN = 0, WB_W1OUT = 11 * MiB, WB_W2IN = WB_W1OUT + 5632 * 1024, WB_W2OUT = WB_W2IN + 11 * MiB, WB_WIN = WB_W2OUT + 5632 * 1024, WB_WOUT = WB_WIN + 6 * MiB, WB_END = WB_WOUT + 2 * MiB;
static_assert(WB_END == 41 * MiB, "weight map");
constexpr size_t WS_XN = 44 * MiB;
constexpr size_t WS_OV = 77 * MiB;
constexpr size_t OV_HID = 0, OV_RAWF = 90 * MiB;
constexpr size_t OV_P = 0, OV_WDEC = OV_P + (size_t)MP * NINP * 2, OV_ABUF = OV_WDEC + (size_t)MP * 512 * 2, OV_GBUF = OV_ABUF + (size_t)MP * 512 * 2, OV_HL = OV_GBUF + (size_t)MP * 512 * 2, OV_CA = OV_HL + (size_t)MP * 256 * 4, OV_MIXEND = OV_CA + (size_t)MP * 256 * 4;
constexpr size_t OV_HTMP = 130 * MiB;
constexpr size_t OV_RAWM = 0;
constexpr size_t WS_END = 256 * MiB;
static_assert(WS_XN + (size_t)MP * D * 2 <= WS_OV && WS_OV + OV_MIXEND <= WS_END && WS_OV + OV_RAWF + (size_t)MP * D * 2 <= WS_OV + OV_HTMP && WS_OV + OV_HTMP + (size_t)MX * D * 2 <= WS_END && (size_t)MP * FF * 2 <= OV_RAWF, "d_ws map");
constexpr int CW_THIN = 3072;
constexpr int CW_BAR = 4096;

constexpr unsigned PROBE_MASK = 0u, PROBE_AMP = 8u; constexpr int PROBE_SUB = -1;
#define PSTAMP(j) do { if (PROBE_MASK && PROBE_SUB >= 0) { const unsigned long long t_ = __builtin_amdgcn_s_memrealtime(); if (PROBE_SUB == (j) && ((PROBE_MASK >> F.ph) & 1u)) F.pr_acc += t_ - F.pr_sub; F.pr_sub = t_; } } while (0)
constexpr int RING_BYTES = 143360, LDSCTL_OFF = RING_BYTES, MISC_OFF = LDSCTL_OFF + 320, LDS_BYTES = 147456;

#define GAS __attribute__((address_space(1)))
#define LAS __attribute__((address_space(3)))
typedef unsigned short bf16;
typedef unsigned v4u __attribute__((ext_vector_type(4)));
typedef float f32x4 __attribute__((ext_vector_type(4)));
typedef GAS unsigned gu32;
typedef float f32x2v_ __attribute__((ext_vector_type(2)));
#define LDS_WAIT() asm volatile("s_waitcnt lgkmcnt(0)" ::: "memory")
__device__ __forceinline__ unsigned f2bf(float f) { unsigned u = __builtin_bit_cast(unsigned, f); return (u + 0x7fffu + ((u >> 16) & 1u)) >> 16; }
typedef __bf16 hwbf2 __attribute__((ext_vector_type(2)));
__device__ __forceinline__ unsigned pk2(float lo, float hi) { const hwbf2 r = __builtin_convertvector((f32x2v_){lo, hi}, hwbf2); return __builtin_bit_cast(unsigned, r); }
__device__ __forceinline__ float bf2f(unsigned b) { return __builtin_bit_cast(float, b << 16); }
__device__ __forceinline__ float sigmoidf_(float x) { return __builtin_amdgcn_rcpf(1.0f + __expf(-x)); }
__device__ __forceinline__ float tanhf_(float x) { return 1.0f - 2.0f * __builtin_amdgcn_rcpf(1.0f + __expf(2.0f * x)); }
__device__ __forceinline__ float softplusf_(float x) { return fmaxf(x, 0.f) + __logf(1.0f + __expf(-fabsf(x))); }
__device__ __forceinline__ float gelu_tanh(float x) { const float u = 0.7978845608028654f * (x + 0.044715f * x * x * x); return 0.5f * x * (1.0f + tanhf_(u)); }
template <int CTRL> __device__ __forceinline__ float dppf(float x) { return __builtin_bit_cast(float, __builtin_amdgcn_mov_dpp(__builtin_bit_cast(int, x), CTRL, 0xf, 0xf, true)); }
__device__ __forceinline__ float red16(float x) { x += dppf<0xB1>(x); x += dppf<0x4E>(x); x += dppf<0x141>(x); x += dppf<0x128>(x); return x; }
__device__ __forceinline__ float wave_sum(float x) {
    x = red16(x);
    x += __builtin_bit_cast(float, __builtin_amdgcn_update_dpp(0, __builtin_bit_cast(int, x), 0x142, 0xa, 0xf, false));
    x += __builtin_bit_cast(float, __builtin_amdgcn_update_dpp(0, __builtin_bit_cast(int, x), 0x143, 0xc, 0xf, false));
    return __builtin_bit_cast(float, __builtin_amdgcn_readlane(__builtin_bit_cast(int, x), 63)); }
__device__ __forceinline__ float wave_sum_dpp(float x) { return wave_sum(x); }
__device__ __forceinline__ int vlane() { return (int)__builtin_amdgcn_mbcnt_hi(~0u, __builtin_amdgcn_mbcnt_lo(~0u, 0u)); }
__device__ __forceinline__ int row_of(int b, int s) { return s < NMETA ? (MX + s) : (b * SEQ + s - NMETA); }
__device__ __forceinline__ void unpack8(const v4u& u, float (&v)[8]) { v[0] = bf2f(u.x & 0xffffu); v[1] = bf2f(u.x >> 16); v[2] = bf2f(u.y & 0xffffu); v[3] = bf2f(u.y >> 16); v[4] = bf2f(u.z & 0xffffu); v[5] = bf2f(u.z >> 16); v[6] = bf2f(u.w & 0xffffu); v[7] = bf2f(u.w >> 16); }
#define XB_TMO      128
#define XB_XCNT(j)  (256  + 64 * (j))
#define XB_XSUB(j)  (1280 + 64 * (j))
#define XB_XGEN(j)  (2304 + 64 * (j))
#define XB_TOP      3328
#define XB_TOPGEN   3392
#define XCD_BAR_WORDS 3456
#define XB_SPIN_CAP (1u << 18)

__device__ __forceinline__ unsigned xb_ld(unsigned* p)              { return __hip_atomic_load(p, __ATOMIC_RELAXED, __HIP_MEMORY_SCOPE_AGENT); }
__device__ __forceinline__ unsigned xb_add(unsigned* p, unsigned v) { return __hip_atomic_fetch_add(p, v, __ATOMIC_RELAXED, __HIP_MEMORY_SCOPE_AGENT); }
__device__ __forceinline__ unsigned xb_xcc_id() { return (unsigned)__builtin_amdgcn_s_getreg((3 << 11) | 20) & 0xFu; }
#define XB_SPIN(cond, bar) do { unsigned _sp = 0; while (cond) { __builtin_amdgcn_s_sleep(1); \
    if ((++_sp & 255u) == 0u) { if (xb_ld(&(bar)[XB_TMO])) break; if (_sp > XB_SPIN_CAP) { atomicAdd(&(bar)[XB_TMO], 1u); break; } } } } while (0)

struct XcdBarrier {
    unsigned* bar; unsigned x;
    volatile LAS unsigned* st;
};

__device__ __forceinline__ XcdBarrier xcd_barrier_post(unsigned* bar, volatile LAS unsigned* st, bool leader  ) {
    XcdBarrier b; b.bar = bar; b.x = xb_xcc_id(); b.st = st;
    if (leader) (void)xb_add(&bar[XB_XCNT(b.x)], 1u);
    return b;
}
__device__ __forceinline__ void xcd_barrier_complete(unsigned* bar, unsigned x, unsigned& nloc, unsigned& nx) {
    const unsigned G = gridDim.x * gridDim.y * gridDim.z;
    unsigned sum, cnt, mine, sp = 0u;
    for (;;) {
        sum = 0u; cnt = 0u; mine = 0u;
#pragma unroll
        for (unsigned j = 0; j < 16; ++j) { const unsigned c = xb_ld(&bar[XB_XCNT(j)]); sum += c; cnt += (c > 0u) ? 1u : 0u; mine = (j == x) ? c : mine; }
        if (sum == G) break;
        __builtin_amdgcn_s_sleep(1);
        if ((++sp & 255u) == 0u) { if (xb_ld(&bar[XB_TMO])) break; if (sp > XB_SPIN_CAP) { atomicAdd(&bar[XB_TMO], 1u); break; } }
    }
    nloc = mine > 0u ? mine : 1u; nx = cnt > 0u ? cnt : 1u;
}

__device__ __forceinline__ void xcd_barrier(const XcdBarrier& b, bool leader  ) {
    asm volatile("s_waitcnt vmcnt(0)" ::: "memory");
    __syncthreads();
    if (leader) {
        unsigned* bar = b.bar;
        __builtin_amdgcn_s_waitcnt(0);
        unsigned nloc = b.st[0], nx = b.st[1];
        if (nloc == 0u) { xcd_barrier_complete(bar, b.x, nloc, nx); b.st[0] = nloc; b.st[1] = nx; }
        const unsigned old = xb_add(&bar[XB_XSUB(b.x)], 1u);
        const unsigned gen = old / nloc;
        if (old + 1u == (gen + 1u) * nloc) {
            __builtin_amdgcn_fence(__ATOMIC_RELEASE, "agent");
            asm volatile("s_waitcnt vmcnt(0)" ::: "memory");
            (void)xb_add(&bar[XB_TOP], 1u);
            XB_SPIN(xb_ld(&bar[XB_TOP]) < (gen + 1u) * nx, bar);
            __builtin_amdgcn_fence(__ATOMIC_ACQUIRE, "agent");
            asm volatile("s_waitcnt vmcnt(0)" ::: "memory");
        } else {
            XB_SPIN(xb_ld(&bar[XB_TOP]) < (gen + 1u) * nx, bar);
            __builtin_amdgcn_fence(__ATOMIC_ACQUIRE, "agent");
            asm volatile("s_waitcnt vmcnt(0)" ::: "memory");
        }
    }
    __syncthreads();
}
struct Frame {
    LAS unsigned char* lds;
    int tid, lane, wave, vcu;
    unsigned long long pr_acc, pr_sub; int ph;
    unsigned char* ws;
    const float* x; const float* meta; float* out;
};

constexpr int PK_CONVW = 0, PK_CONVB = 1024, PK_WA = 1280, PK_BA = 17664, PK_WX = 17920, PK_BX = 34304, PK_LAM = 34560, PK_LNG = 34816, PK_SCW = 35072, PK_SCG = 35840, PK_MU = 36096, PK_W0 = 37760,
              PK_W2 = 38272, PK_A0 = 54656, PK_A2 = 55168, PK_G2 = 71552, PK_KK = 104320, PK_KA = 104832, PK_RK = 105344, PK_LNW = 105856, PK_LNB = 106368, PK_SIZE = 106880;
constexpr size_t WS_PACK = 72 * 1024;
static_assert(WS_PACK + (size_t)NLAYER * PK_SIZE * 4 <= CTL_ZERO_BYTES && (CW_BAR + 3456) * 4 <= (int)WS_PACK, "pack inside CTL, above the barrier words");
__device__ __forceinline__ const float* pack_of(const Frame& F, int l) { return (const float*)(F.ws + WS_PACK) + (size_t)l * PK_SIZE; }
struct PackRegs { float a[21]; float f0, f1; };
#define PKG(i) int gs = gt - (i) * 6144; if (gs < 0) gs += GRID * NWAVES * 64;
#define PKL(i, n, per) { PKG(i) R.a[i] = 0.f; if (gs < NLAYER * (per)) R.a[i] = in[n][gs]; }
#define PKS(i, per, off) { PKG(i) if (gs < NLAYER * (per)) { const int l_ = gs / (per), j_ = gs - l_ * (per); dst[(size_t)l_ * PK_SIZE + (off) + j_] = R.a[i]; } }
__device__ __forceinline__ void pack_loads(Frame& F, const float* const* in, PackRegs& R) {
    const int gt = F.vcu * (NWAVES * 64) + F.tid;
    static_assert(NLAYER * 32768 <= GRID * NWAVES * 64, "one element per thread covers the longest segment");
    PKL(0, 9, 1024) PKL(1, 10, 256) PKL(2, 11, 16384) PKL(3, 12, 256) PKL(4, 13, 16384) PKL(5, 14, 256) PKL(6, 15, 256)
    __builtin_amdgcn_sched_barrier(0);
    PKL(7, 16, 256) PKL(8, 17, 768) PKL(9, 18, 256) PKL(10, 19, 1664) PKL(11, 20, 512) PKL(12, 21, 16384) PKL(13, 22, 512)
    __builtin_amdgcn_sched_barrier(0);
    PKL(14, 23, 16384) PKL(15, 24, 32768) PKL(16, 25, 512) PKL(17, 26, 512) PKL(18, 27, 512) PKL(19, 28, 512) PKL(20, 29, 512)
}
__device__ __forceinline__ void pack_stores(Frame& F, const PackRegs& R) {
    const int gt = F.vcu * (NWAVES * 64) + F.tid;
    float* dst = (float*)(F.ws + WS_PACK);
    PKS(0, 1024, PK_CONVW) PKS(1, 256, PK_CONVB) PKS(2, 16384, PK_WA) PKS(3, 256, PK_BA) PKS(4, 16384, PK_WX) PKS(5, 256, PK_BX) PKS(6, 256, PK_LAM)
    PKS(7, 256, PK_LNG) PKS(8, 768, PK_SCW) PKS(9, 256, PK_SCG) PKS(10, 1664, PK_MU) PKS(11, 512, PK_W0) PKS(12, 16384, PK_W2) PKS(13, 512, PK_A0)
    PKS(14, 16384, PK_A2) PKS(15, 32768, PK_G2) PKS(16, 512, PK_KK) PKS(17, 512, PK_KA) PKS(18, 512, PK_RK) PKS(19, 512, PK_LNW) PKS(20, 512, PK_LNB)
}
#undef PKL
#undef PKS
#undef PKG

__device__ __forceinline__ int swiglu_row(int n0) { return n0 < FF ? ((n0 >> 7) * 256 + (n0 & 127)) : (((n0 - FF) >> 7) * 256 + 128 + ((n0 - FF) & 127)); }
constexpr int CI_IN = (D / 64) * (2 * FF / 32), CI_OUT = (FF / 64) * (D / 32), CI_MI = (D / 64) * (NIN / 32), CI_MO = (D / 64) * (D / 32);
constexpr int CI_SET0 = CI_IN + CI_OUT + CI_MI, CI_SET1 = CI_MO + CI_IN + CI_OUT;
struct ConvItem { const float* W; bf16* WT; int K, N, k0, n0, drow0; const float* g; };
__device__ __forceinline__ ConvItem conv_item(unsigned char* ws, const float* const* in, int l, int set, int r) {
    ConvItem ci;
    if (set == 0) {
        if (r < CI_IN) { const int nblk = 2 * FF / 32, kb = r / nblk, nb = r % nblk; ci = ConvItem{in[3] + (size_t)l * D * 2 * FF, (bf16*)(ws + WS_WB + WB_W1IN), D, 2 * FF, 64 * kb, 32 * nb, swiglu_row(32 * nb), in[2] + (size_t)(l * 6 + 0) * D}; return ci; }
        r -= CI_IN;
        if (r < CI_OUT) { const int nblk = D / 32, kb = r / nblk, nb = r % nblk; ci = ConvItem{in[4] + (size_t)l * FF * D, (bf16*)(ws + WS_WB + WB_W1OUT), FF, D, 64 * kb, 32 * nb, 32 * nb, nullptr}; return ci; }
        r -= CI_OUT;
        { const int nblk = NIN / 32, kb = r / nblk, nb = r % nblk; ci = ConvItem{in[7] + (size_t)l * D * NIN, (bf16*)(ws + WS_WB + WB_WIN), D, NIN, 64 * kb, 32 * nb, 32 * nb, in[2] + (size_t)(l * 6 + 2) * D}; return ci; }
    }
    if (r < CI_MO) { const int nblk = D / 32, kb = r / nblk, nb = r % nblk; ci = ConvItem{in[8] + (size_t)l * D * D, (bf16*)(ws + WS_WB + WB_WOUT), D, D, 64 * kb, 32 * nb, 32 * nb, nullptr}; return ci; }
    r -= CI_MO;
    if (r < CI_IN) { const int nblk = 2 * FF / 32, kb = r / nblk, nb = r % nblk; ci = ConvItem{in[5] + (size_t)l * D * 2 * FF, (bf16*)(ws + WS_WB + WB_W2IN), D, 2 * FF, 64 * kb, 32 * nb, swiglu_row(32 * nb), in[2] + (size_t)(l * 6 + 4) * D}; return ci; }
    r -= CI_IN;
    { const int nblk = D / 32, kb = r / nblk, nb = r % nblk; ci = ConvItem{in[6] + (size_t)l * FF * D, (bf16*)(ws + WS_WB + WB_W2OUT), FF, D, 64 * kb, 32 * nb, 32 * nb, nullptr}; return ci; }
}
__device__ __forceinline__ void conv_loads(const ConvItem& ci, int lane, float (&v)[32]) {
    const __amdgpu_buffer_rsrc_t rs = __builtin_amdgcn_make_buffer_rsrc((void*)ci.W, 0, 0x7ffffff0, 0x00020000);
    const int vo = (((lane >> 5) ? ci.N : 0) + (lane & 31)) * 4, so = __builtin_amdgcn_readfirstlane((ci.k0 * ci.N + ci.n0) * 4), st = __builtin_amdgcn_readfirstlane(ci.N * 8);
#pragma unroll
    for (int i = 0; i < 32; ++i) v[i] = __builtin_bit_cast(float, __builtin_amdgcn_raw_buffer_load_b32(rs, vo + i * st, so, 0));
}
template <bool WT = false> __device__ __forceinline__ void conv_store(const ConvItem& ci, int lane, const float (&v)[32], LAS float* scr) {
#pragma unroll
    for (int i = 0; i < 32; ++i) scr[(2 * i + (lane >> 5)) * 33 + (lane & 31)] = v[i];
    LDS_WAIT(); asm volatile("" ::: "memory");
    const int c = lane & 7;
    f32x4 g0 = (f32x4){1.f, 1.f, 1.f, 1.f}, g1 = g0; if (ci.g) { g0 = *(const f32x4*)(ci.g + ci.k0 + 8 * c); g1 = *(const f32x4*)(ci.g + ci.k0 + 8 * c + 4); }
#pragma unroll
    for (int j = 0; j < 4; ++j) { const int n = (lane >> 3) + 8 * j; const LAS float* s = scr + (8 * c) * 33 + n;
        v4u o; o.x = pk2(s[0 * 33] * g0[0], s[1 * 33] * g0[1]); o.y = pk2(s[2 * 33] * g0[2], s[3 * 33] * g0[3]); o.z = pk2(s[4 * 33] * g1[0], s[5 * 33] * g1[1]); o.w = pk2(s[6 * 33] * g1[2], s[7 * 33] * g1[3]);
        if (WT) { const __amdgpu_buffer_rsrc_t rw_ = __builtin_amdgcn_make_buffer_rsrc((void*)ci.WT, 0, 0x7ffffff0, 0x00020000); __builtin_amdgcn_raw_buffer_store_b128(o, rw_, ((ci.drow0 + n) * ci.K + ci.k0 + 8 * c) * 2, 0, 16); }
        else *(GAS v4u*)(ci.WT + (size_t)(ci.drow0 + n) * ci.K + ci.k0 + 8 * c) = o; }
    LDS_WAIT(); asm volatile("" ::: "memory");
}
__device__ __forceinline__ float sumsq4(const f32x4 (&v)[4]) { float s = 0.f;
#pragma unroll
    for (int j = 0; j < 4; ++j) s += (v[j].x * v[j].x + v[j].y * v[j].y) + (v[j].z * v[j].z + v[j].w * v[j].w);
    return s; }
typedef short mbf16x8 __attribute__((ext_vector_type(8)));
__device__ __forceinline__ void meta_tile(const bf16* A, const bf16* Bt, int K, int k0, int kl, int nb0, int nb1, int mode, void* O, int ldo, int ocol, int lane, const float* rs) {
    const int fr = lane & 15, fq = lane >> 4;
    const bf16* ap = A + (size_t)(MX + fr) * K + k0 + 8 * fq; const bf16* b0p = Bt + (size_t)(nb0 + fr) * K + k0 + 8 * fq; const bf16* b1p = Bt + (size_t)((mode == 0 ? nb1 : nb0) + fr) * K + k0 + 8 * fq;
    f32x4 acc0 = (f32x4){0.f, 0.f, 0.f, 0.f}, acc1 = acc0;
    for (int kb = 0; kb < kl; kb += 256) {
        mbf16x8 a[8], w0[8], w1[8];
#pragma unroll
        for (int j = 0; j < 8; ++j) { const int ks = kb + 32 * j; const bool on = ks < kl; const int kc = on ? ks : kb;
            a[j] = *(const mbf16x8*)(ap + kc); w0[j] = *(const mbf16x8*)(b0p + kc); if (mode == 0) w1[j] = *(const mbf16x8*)(b1p + kc); }
#pragma unroll
        for (int j = 0; j < 8; ++j) { if (kb + 32 * j < kl) { acc0 = __builtin_amdgcn_mfma_f32_16x16x32_bf16(w0[j], a[j], acc0, 0, 0, 0);
            if (mode == 0) acc1 = __builtin_amdgcn_mfma_f32_16x16x32_bf16(w1[j], a[j], acc1, 0, 0, 0); } } }
    const int col = ocol + 4 * fq;
    if (mode == 2) { *(f32x4*)((float*)O + (size_t)fr * ldo + col) = acc0; return; }
    float v[4];
    const float sc = rs ? rs[MX + fr] : 1.0f;
#pragma unroll
    for (int i = 0; i < 4; ++i) { const float g = acc0[i] * sc; v[i] = mode == 0 ? g * __builtin_amdgcn_rcpf(1.0f + __expf(-g)) * (acc1[i] * sc) : g; }
    const unsigned long long ov = (unsigned long long)pk2(v[0], v[1]) | ((unsigned long long)pk2(v[2], v[3]) << 32);
    if (mode == 0) __hip_atomic_store((GAS unsigned long long*)((bf16*)O + (size_t)(MX + fr) * ldo + col), ov, __ATOMIC_RELAXED, __HIP_MEMORY_SCOPE_AGENT);
    else *(GAS unsigned long long*)((bf16*)O + (size_t)(MX + fr) * ldo + col) = ov;
}
template <bool SWI> __device__ __forceinline__ void meta_split(Frame& F, const bf16* A, const bf16* Bt, int tile, bf16* O, int ldo) {
    const int lane = F.tid & 63, fr = lane & 15, fq = lane >> 4, ks = F.wave & 3;
    LAS f32x4* red = (LAS f32x4*)F.lds + (size_t)(F.wave >> 2) * (3 * 64 * 2);
    f32x4 acc0 = (f32x4){0.f, 0.f, 0.f, 0.f}, acc1 = acc0;
    const int j0 = 16 * tile, nb0 = SWI ? (j0 >> 7) * 256 + (j0 & 127) : j0;
    if (tile >= 0) {
        const bf16* ap = A + (size_t)(MX + fr) * D + 256 * ks + 8 * fq; const bf16* b0p = Bt + (size_t)(nb0 + fr) * D + 256 * ks + 8 * fq; const bf16* b1p = b0p + (size_t)128 * D;
        mbf16x8 a[8], w0[8], w1[8];
#pragma unroll
        for (int j = 0; j < 8; ++j) { a[j] = *(const mbf16x8*)(ap + 32 * j); w0[j] = *(const mbf16x8*)(b0p + 32 * j); if (SWI) w1[j] = *(const mbf16x8*)(b1p + 32 * j); }
#pragma unroll
        for (int j = 0; j < 8; ++j) { acc0 = __builtin_amdgcn_mfma_f32_16x16x32_bf16(w0[j], a[j], acc0, 0, 0, 0); if (SWI) acc1 = __builtin_amdgcn_mfma_f32_16x16x32_bf16(w1[j], a[j], acc1, 0, 0, 0); }
        if (ks != 0) { red[((ks - 1) * 64 + lane) * 2] = acc0; if (SWI) red[((ks - 1) * 64 + lane) * 2 + 1] = acc1; } }
    __syncthreads();
    if (tile >= 0 && ks == 0) {
#pragma unroll
        for (int s = 0; s < 3; ++s) { acc0 = acc0 + red[(s * 64 + lane) * 2]; if (SWI) acc1 = acc1 + red[(s * 64 + lane) * 2 + 1]; }
        float v[4];
#pragma unroll
        for (int i = 0; i < 4; ++i) { const float g = acc0[i]; v[i] = SWI ? g * __builtin_amdgcn_rcpf(1.0f + __expf(-g)) * acc1[i] : g; }
        const unsigned long long ov = (unsigned long long)pk2(v[0], v[1]) | ((unsigned long long)pk2(v[2], v[3]) << 32);
        GAS unsigned long long* op = (GAS unsigned long long*)(O + (size_t)(MX + fr) * ldo + j0 + 4 * fq);
        if (SWI) __hip_atomic_store(op, ov, __ATOMIC_RELAXED, __HIP_MEMORY_SCOPE_AGENT); else *op = ov; }
}
__device__ __forceinline__ void meta_gemm(Frame& F, const bf16* A, const bf16* Bt, int K, int N, int mode, void* O, int ldo, int nks, int gw  , const float* rs) {
    const int lane = F.tid & 63; if (gw < 0) return;
    if (mode == 0) { if (gw < FF / 16) { const int j0 = 16 * gw, nb0 = (j0 >> 7) * 256 + (j0 & 127); meta_tile(A, Bt, K, 0, K, nb0, nb0 + 128, 0, O, ldo, j0, lane, rs); } return; }
    const int ntile = N / 16;
    if (gw < ntile * nks) { const int tile = gw % ntile, sl = gw / ntile, kl = K / nks;
        meta_tile(A, Bt, K, sl * kl, kl, 16 * tile, 0, mode, mode == 2 ? (void*)((float*)O + (size_t)sl * NMETA * D) : O, ldo, 16 * tile, lane, rs); }
}

__device__ __forceinline__ void row_ld_f32(const float* p, int lane, f32x4 (&v)[4]) {
#pragma unroll
    for (int j = 0; j < 4; ++j) v[j] = ((const GAS f32x4*)p)[lane + 64 * j]; }
__device__ __forceinline__ void row_ld_bf16(const bf16* p, int lane, f32x4 (&v)[4]) {
#pragma unroll
    for (int j = 0; j < 4; ++j) { const unsigned long long u = ((const GAS unsigned long long*)p)[lane + 64 * j]; v[j][0] = bf2f((unsigned)u & 0xffffu); v[j][1] = bf2f((unsigned)u >> 16); v[j][2] = bf2f((unsigned)(u >> 32) & 0xffffu); v[j][3] = bf2f((unsigned)(u >> 48)); } }
__device__ __forceinline__ void row_st_bf16(bf16* p, int lane, const f32x4 (&v)[4]) {
#pragma unroll
    for (int j = 0; j < 4; ++j) ((GAS unsigned long long*)p)[lane + 64 * j] = (unsigned long long)pk2(v[j][0], v[j][1]) | ((unsigned long long)pk2(v[j][2], v[j][3]) << 32); }
__device__ __forceinline__ void frag_stores(Frame& F, const PackRegs& R);
__device__ __forceinline__ void phase_init_convert(Frame& F, const float* const* in, const PackRegs& PR) {
    { int ln_ = F.tid & 63; asm volatile("" : "+v"(ln_)); F.lane = ln_ & 63; }
    const int gw = F.vcu * NWAVES + F.wave, NGW = GRID * NWAVES;
    float* RS = (float*)(F.ws + WS_RS);
    LAS float* scr = (LAS float*)(F.lds + F.wave * 16384);
    ConvItem ca; float va[32]; int it = gw;
    if (it < CI_SET0) { ca = conv_item(F.ws, in, 0, 0, it); conv_loads(ca, F.lane, va); }
    for (int r0 = gw; r0 < MREAL; r0 += 2 * NGW) {
        f32x4 v[2][4];
#pragma unroll
        for (int u = 0; u < 2; ++u) { const int r = r0 + u * NGW < MREAL ? r0 + u * NGW : r0; row_ld_f32(r < MX ? F.x + (size_t)r * D : F.meta + (size_t)(r - MX) * D, F.lane, v[u]); }
#pragma unroll
        for (int u = 0; u < 2; ++u) { const int r = r0 + u * NGW; if (r < MREAL) {
            const float rstd = rsqrtf(wave_sum(sumsq4(v[u])) * (1.0f / D) + RMS_EPS);
#pragma unroll
            for (int j = 0; j < 4; ++j) v[u][j] = v[u][j] * rstd;
            { GAS unsigned long long* dp = (GAS unsigned long long*)(r < MX ? (bf16*)F.out + (size_t)r * D : (bf16*)(F.ws + WS_HMETA) + (size_t)(r - MX) * D);
#pragma unroll
              for (int j = 0; j < 4; ++j) __hip_atomic_store(dp + F.lane + 64 * j, (unsigned long long)pk2(v[u][j][0], v[u][j][1]) | ((unsigned long long)pk2(v[u][j][2], v[u][j][3]) << 32), __ATOMIC_RELAXED, __HIP_MEMORY_SCOPE_AGENT); }
            if (F.lane == 0) RS[r] = rstd; } }
        if (it < CI_SET0) { conv_store<true>(ca, F.lane, va, scr); it += NGW; if (it < CI_SET0) { ca = conv_item(F.ws, in, 0, 0, it); conv_loads(ca, F.lane, va); } }
        if (r0 == gw) { pack_stores(F, PR); frag_stores(F, PR); }
    }
    while (it < CI_SET0) { conv_store<true>(ca, F.lane, va, scr); it += NGW; if (it < CI_SET0) { ca = conv_item(F.ws, in, 0, 0, it); conv_loads(ca, F.lane, va); } }
    { unsigned zz = 0u; asm volatile("" : "+v"(zz));
      for (int i = gw * 64 + F.lane; i < (NINP - NIN) * D / 8; i += NGW * 64) *(GAS v4u*)(((bf16*)(F.ws + WS_WB + WB_WIN)) + (size_t)NIN * D + (size_t)i * 8) = (v4u){zz, zz, zz, zz}; }
}
struct PostIO { const bf16* raw16; const bf16* hin16; bf16* hout16; float* out32; int nks; };
__device__ __forceinline__ void post_row_load(const Frame& F, const PostIO& io, int r, f32x4 (&y)[4], f32x4 (&h)[4]) {
    if (r >= MX) { const float* sl = (const float*)(F.ws + WS_MSLAB) + (size_t)(r - MX) * D; row_ld_f32(sl, F.lane, y);
        for (int s = 1; s < io.nks; ++s) { f32x4 t[4]; row_ld_f32(sl + (size_t)s * NMETA * D, F.lane, t);
#pragma unroll
            for (int j = 0; j < 4; ++j) y[j] = y[j] + t[j]; }
        row_ld_bf16((const bf16*)(F.ws + WS_HMETA) + (size_t)(r - MX) * D, F.lane, h);
        const float inv = 1.0f / ((const float*)(F.ws + WS_RS))[r];
#pragma unroll
        for (int j = 0; j < 4; ++j) h[j] = h[j] * inv;
        return; }
    row_ld_bf16(io.raw16 + (size_t)r * D, F.lane, y);
    row_ld_bf16(io.hin16 + (size_t)r * D, F.lane, h);
    const float inv = 1.0f / ((const float*)(F.ws + WS_RS))[r];
#pragma unroll
    for (int j = 0; j < 4; ++j) h[j] = h[j] * inv;
}
__device__ __forceinline__ void post_row_store(const Frame& F, const PostIO& io, int r, const f32x4 (&h)[4]) {
    if (r >= MX) row_st_bf16((bf16*)(F.ws + WS_HMETA) + (size_t)(r - MX) * D, F.lane, h);
    else if (io.out32) {
#pragma unroll
        for (int j = 0; j < 4; ++j) ((GAS f32x4*)(io.out32 + (size_t)r * D))[F.lane + 64 * j] = h[j]; }
    else row_st_bf16(io.hout16 + (size_t)r * D, F.lane, h);
}
struct PostRaw { v4u y[2], h[2]; float rs; };
__device__ __forceinline__ void post_issue(const Frame& F, const PostIO& io, int r, PostRaw& R) {
#pragma unroll
    for (int j = 0; j < 2; ++j) { R.y[j] = ((const GAS v4u*)(io.raw16 + (size_t)r * D))[F.lane + 64 * j]; R.h[j] = ((const GAS v4u*)(io.hin16 + (size_t)r * D))[F.lane + 64 * j]; }
    R.rs = ((const float*)(F.ws + WS_RS))[r];
}
__device__ __forceinline__ float sumsq16(const float (&v)[16]) { float s0 = 0.f, s1 = 0.f;
#pragma unroll
    for (int j = 0; j < 16; j += 2) { s0 += v[j] * v[j]; s1 += v[j + 1] * v[j + 1]; }
    return s0 + s1; }
__device__ __forceinline__ void post_pair(const Frame& F, const PostIO& io, const PostRaw& R0, const PostRaw& R1, int r0, int r1, float scale, const f32x4 (&gq)[4], bool want_rs) {
    float y0[16], h0[16], y1[16], h1[16];
    { float t[8];
#pragma unroll
      for (int j = 0; j < 2; ++j) {
          unpack8(R0.y[j], t);
#pragma unroll
          for (int e = 0; e < 8; ++e) y0[8 * j + e] = t[e];
          unpack8(R0.h[j], t);
#pragma unroll
          for (int e = 0; e < 8; ++e) h0[8 * j + e] = t[e];
          unpack8(R1.y[j], t);
#pragma unroll
          for (int e = 0; e < 8; ++e) y1[8 * j + e] = t[e];
          unpack8(R1.h[j], t);
#pragma unroll
          for (int e = 0; e < 8; ++e) h1[8 * j + e] = t[e]; } }
    const float i0 = 1.0f / R0.rs, i1 = 1.0f / R1.rs;
    const float rs0 = scale * rsqrtf(wave_sum(sumsq16(y0)) * (1.0f / D) + RMS_EPS), rs1 = scale * rsqrtf(wave_sum(sumsq16(y1)) * (1.0f / D) + RMS_EPS);
#pragma unroll
    for (int j = 0; j < 4; ++j) { const f32x4 gv = gq[j];
#pragma unroll
        for (int e = 0; e < 4; ++e) { h0[4 * j + e] = h0[4 * j + e] * i0 + y0[4 * j + e] * rs0 * gv[e]; h1[4 * j + e] = h1[4 * j + e] * i1 + y1[4 * j + e] * rs1 * gv[e]; } }
    if (want_rs) { const float q0 = rsqrtf(wave_sum(sumsq16(h0)) * (1.0f / D) + RMS_EPS), q1 = rsqrtf(wave_sum(sumsq16(h1)) * (1.0f / D) + RMS_EPS);
#pragma unroll
        for (int e = 0; e < 16; ++e) { h0[e] *= q0; h1[e] *= q1; }
        if (F.lane == 0) { ((float*)(F.ws + WS_RS))[r0] = q0; ((float*)(F.ws + WS_RS))[r1] = q1; } }
    if (io.out32) {
#pragma unroll
        for (int j = 0; j < 4; ++j) { ((GAS f32x4*)(io.out32 + (size_t)r0 * D))[2 * F.lane + 128 * (j >> 1) + (j & 1)] = (f32x4){h0[4 * j], h0[4 * j + 1], h0[4 * j + 2], h0[4 * j + 3]};
                                      ((GAS f32x4*)(io.out32 + (size_t)r1 * D))[2 * F.lane + 128 * (j >> 1) + (j & 1)] = (f32x4){h1[4 * j], h1[4 * j + 1], h1[4 * j + 2], h1[4 * j + 3]}; } }
    else {
#pragma unroll
        for (int j = 0; j < 2; ++j) { v4u o0, o1;
            o0.x = pk2(h0[8 * j], h0[8 * j + 1]); o0.y = pk2(h0[8 * j + 2], h0[8 * j + 3]); o0.z = pk2(h0[8 * j + 4], h0[8 * j + 5]); o0.w = pk2(h0[8 * j + 6], h0[8 * j + 7]);
            o1.x = pk2(h1[8 * j], h1[8 * j + 1]); o1.y = pk2(h1[8 * j + 2], h1[8 * j + 3]); o1.z = pk2(h1[8 * j + 4], h1[8 * j + 5]); o1.w = pk2(h1[8 * j + 6], h1[8 * j + 7]);
            const __amdgpu_buffer_rsrc_t ro = __builtin_amdgcn_make_buffer_rsrc((void*)io.hout16, 0, 0x7ffffff0, 0x00020000);
            __builtin_amdgcn_raw_buffer_store_b128(o0, ro, (F.lane + 64 * j) * 16, __builtin_amdgcn_readfirstlane(r0 * (D * 2)), 16);
            __builtin_amdgcn_raw_buffer_store_b128(o1, ro, (F.lane + 64 * j) * 16, __builtin_amdgcn_readfirstlane(r1 * (D * 2)), 16); } }
}
__device__ __forceinline__ void phase_post(Frame& F, const PostIO& io, float scale, const float* g_post, bool want_rs) {
    { int ln_ = F.tid & 63; asm volatile("" : "+v"(ln_)); F.lane = ln_ & 63; }
    const int gw = F.vcu * NWAVES + F.wave, NGW = GRID * NWAVES;
    static_assert(MX == 8 * GRID * NWAVES, "exactly eight x-token rows per wave");
    { PostRaw A0, A1, B0, B1;
      post_issue(F, io, gw, A0); post_issue(F, io, gw + NGW, A1);
      f32x4 gq[4];
#pragma unroll
      for (int j = 0; j < 4; ++j) gq[j] = ((const GAS f32x4*)g_post)[2 * F.lane + 128 * (j >> 1) + (j & 1)];
#pragma unroll
      for (int it = 0; it < 4; ++it) { const int ra = gw + 2 * it * NGW;
          if (it & 1) { if (it < 3) { post_issue(F, io, ra + 2 * NGW, A0); post_issue(F, io, ra + 3 * NGW, A1); } __builtin_amdgcn_sched_barrier(0); post_pair(F, io, B0, B1, ra, ra + NGW, scale, gq, want_rs); }
          else        { post_issue(F, io, ra + 2 * NGW, B0); post_issue(F, io, ra + 3 * NGW, B1); __builtin_amdgcn_sched_barrier(0); post_pair(F, io, A0, A1, ra, ra + NGW, scale, gq, want_rs); } } }
    if (!io.out32 && gw < NMETA) { const int r = MX + gw;
        f32x4 y[4], h[4]; post_row_load(F, io, r, y, h);
        const float rs0 = scale * rsqrtf(wave_sum(sumsq4(y)) * (1.0f / D) + RMS_EPS);
#pragma unroll
        for (int j = 0; j < 4; ++j) { const f32x4 gv = ((const GAS f32x4*)g_post)[F.lane + 64 * j]; h[j] = h[j] + y[j] * rs0 * gv; }
        if (want_rs) { const float q0 = rsqrtf(wave_sum(sumsq4(h)) * (1.0f / D) + RMS_EPS);
#pragma unroll
            for (int j = 0; j < 4; ++j) h[j] = h[j] * q0;
            if (F.lane == 0) ((float*)(F.ws + WS_RS))[r] = q0; }
        post_row_store(F, io, r, h); }
}
typedef short bf16x8v __attribute__((ext_vector_type(8)));
typedef float f32x4v __attribute__((ext_vector_type(4)));
constexpr int FR_PER_WAVE = 24;
constexpr size_t WS_FRAG = WS_AGG + 512 * 1024, FRAG_LAYER_BYTES = (size_t)8 * FR_PER_WAVE * 64 * 16;
static_assert(WS_FRAG + NLAYER * FRAG_LAYER_BYTES <= WS_WB, "fragment store fits behind AGG");
__device__ __forceinline__ float frag_src(const float* const* in, int l, int w, int f, int lane, int j) {
    const int kq = 8 * (lane >> 4) + j, cl = lane & 15, pc = 16 * (cl >> 2) + (cl & 3);
    if (f < 4)  return in[21][(size_t)l * 32 * 512 + (size_t)kq * 512 + 64 * w + pc + 4 * f];
    if (f < 8)  return in[23][(size_t)l * 32 * 512 + (size_t)kq * 512 + 64 * w + pc + 4 * (f - 4)];
    if (f < 16) { const int ct = (f - 8) >> 1, ks = (f - 8) & 1; return in[24][(size_t)l * 64 * 512 + (size_t)(32 * ks + kq) * 512 + 64 * w + pc + 4 * ct]; }
    { const int gt = (f - 16) >> 2, ct = 2 * (w >> 2) + (((f - 16) >> 1) & 1), ks = (f - 16) & 1, g = w & 3; return in[gt ? 13 : 11][(size_t)l * 16384 + (size_t)g * 4096 + (size_t)(32 * ks + kq) * 64 + 16 * ct + cl]; }
}
__device__ __forceinline__ float frag_val(const float* const* in, int i) {
    const int j = i & 7, lane = (i >> 3) & 63, f = (i >> 9) % FR_PER_WAVE, w = ((i >> 9) / FR_PER_WAVE) & 7, l = (i >> 9) / (FR_PER_WAVE * 8);
    return frag_src(in, l, w, f, lane, j); }
__device__ __forceinline__ void frag_loads(Frame& F, const float* const* in, PackRegs& R) {
    const int gt = F.vcu * (NWAVES * 64) + F.tid, NT = GRID * NWAVES * 64, TOT = NLAYER * 8 * FR_PER_WAVE * 64 * 8;
    static_assert(NLAYER * 8 * FR_PER_WAVE * 64 * 8 <= 2 * GRID * NWAVES * 64, "two elements per thread cover the fragment store");
    R.f0 = frag_val(in, gt); R.f1 = 0.f; if (gt + NT < TOT) R.f1 = frag_val(in, gt + NT);
}
__device__ __forceinline__ void frag_stores(Frame& F, const PackRegs& R) {
    const int gt = F.vcu * (NWAVES * 64) + F.tid, NT = GRID * NWAVES * 64, TOT = NLAYER * 8 * FR_PER_WAVE * 64 * 8;
    bf16* FR = (bf16*)(F.ws + WS_FRAG);
    FR[gt] = (bf16)f2bf(R.f0); if (gt + NT < TOT) FR[gt + NT] = (bf16)f2bf(R.f1);
}
__device__ __forceinline__ bf16x8v pack8(const float (&v)[8]) { v4u u; u.x = pk2(v[0], v[1]); u.y = pk2(v[2], v[3]); u.z = pk2(v[4], v[5]); u.w = pk2(v[6], v[7]); return __builtin_bit_cast(bf16x8v, u); }
__device__ __forceinline__ void unpack4f(unsigned long long u, f32x4& v) { v[0] = bf2f((unsigned)u & 0xffffu); v[1] = bf2f(((unsigned)u >> 16)); v[2] = bf2f((unsigned)(u >> 32) & 0xffffu); v[3] = bf2f((unsigned)(u >> 48)); }
constexpr bool PREP_PREFETCH = true;
typedef unsigned bu2 __attribute__((ext_vector_type(2)));
#define WSR(F) __builtin_amdgcn_make_buffer_rsrc((void*)(F).ws, 0, 0x0ffffff0, 0x00020000)
__device__ __forceinline__ v4u bl128(__amdgpu_buffer_rsrc_t r, int vo, int so) { return __builtin_bit_cast(v4u, __builtin_amdgcn_raw_buffer_load_b128(r, vo, so, 0)); }
__device__ __forceinline__ f32x4 bl128f(__amdgpu_buffer_rsrc_t r, int vo, int so) { return __builtin_bit_cast(f32x4, __builtin_amdgcn_raw_buffer_load_b128(r, vo, so, 0)); }
__device__ __forceinline__ unsigned long long bl64(__amdgpu_buffer_rsrc_t r, int vo, int so) { return __builtin_bit_cast(unsigned long long, __builtin_amdgcn_raw_buffer_load_b64(r, vo, so, 0)); }
__device__ __forceinline__ float bl32f(__amdgpu_buffer_rsrc_t r, int vo, int so) { return __builtin_bit_cast(float, __builtin_amdgcn_raw_buffer_load_b32(r, vo, so, 0)); }
__device__ __forceinline__ void bs64(__amdgpu_buffer_rsrc_t r, int vo, int so, unsigned long long v) { __builtin_amdgcn_raw_buffer_store_b64(__builtin_bit_cast(bu2, v), r, vo, so, 0); }
__device__ __forceinline__ void bs32(__amdgpu_buffer_rsrc_t r, int vo, int so, unsigned v) { __builtin_amdgcn_raw_buffer_store_b32(v, r, vo, so, 0); }
__device__ __forceinline__ int urow(int b, int s) { return __builtin_amdgcn_readfirstlane(row_of(b, s)); }
struct PrepLoads { unsigned long long cur, prv, lx[3], lc[3], lxx[3], lb[2]; };
__device__ __forceinline__ void prep_loads(PrepLoads& L, __amdgpu_buffer_rsrc_t rw, int b, int s0, int fr, int fq, int fa, int ha, int w, int cg4) {
    unsigned zz = 0u; asm volatile("" : "+v"(zz));
    const int s = s0 + fr, co = (PC_LO + 32 * fa + 8 * fq + 4 * ha) * 2;
    L.cur = bl64(rw, row_of(b, s) * (NINP * 2) + co, (int)(WS_OV + OV_P)); L.prv = bl64(rw, row_of(b, s > 0 ? s - 1 : 0) * (NINP * 2) + co, (int)(WS_OV + OV_P)); if (s == 0) L.prv = zz;
#pragma unroll
    for (int j = 0; j < 3; ++j) { const int r = w + 8 * j, sr = s0 - 3 + r; L.lx[j] = zz; L.lc[j] = zz; L.lxx[j] = zz;
        if (r < 19 && sr >= 0) { const int so = (int)(WS_OV + OV_P) + urow(b, sr) * (NINP * 2); L.lx[j] = bl64(rw, cg4 * 2, so + PC_LRUX * 2); L.lc[j] = bl64(rw, cg4 * 2, so + PC_SCC * 2); L.lxx[j] = bl64(rw, cg4 * 2, so + PC_SCX * 2); } }
#pragma unroll
    for (int j = 0; j < 2; ++j) { const int t = w + 8 * j; L.lb[j] = bl64(rw, cg4 * 2, (int)(WS_OV + OV_P) + urow(b, s0 + t) * (NINP * 2) + PC_SCB * 2); }
}
__device__ __forceinline__ void phase_mix_prep(Frame& F, const float* pk, int layer) {
    { int ln_ = F.tid & 63; asm volatile("" : "+v"(ln_)); F.lane = ln_ & 63; }
    constexpr int PR = 260;
    LAS float* U = (LAS float*)F.lds;
    LAS float* GT = U + 16 * PR;
    LAS float* XL = GT + 32 * PR;
    LAS float* VL = XL + 19 * PR;
    LAS float* CST = VL + 19 * PR;
    constexpr int C_MU = 0, C_W0 = 128, C_A0 = 640, C_BA = 1152, C_BX = 1408, C_CONVW = 1664, C_CONVB = 2688, C_SCW = 2944, C_SCG = 3712, C_LAM = 3968, C_END = 4224;
    LAS unsigned char* AFb = (LAS unsigned char*)(CST + C_END);
    static_assert((16 * PR + 32 * PR + 2 * 19 * PR + C_END) * 4 + 4096 <= RING_BYTES, "prep LDS");
    const int tid = F.tid, lane = F.lane, w = F.wave, fr = lane & 15, fq = lane >> 4;
    const __amdgpu_buffer_rsrc_t rw = WSR(F);
    const int pkb = __builtin_amdgcn_readfirstlane((int)((const unsigned char*)pk - F.ws));
    bf16x8v Bf[FR_PER_WAVE];
    const int fso = __builtin_amdgcn_readfirstlane((int)(WS_FRAG + (size_t)layer * FRAG_LAYER_BYTES) + w * (FR_PER_WAVE * 64 * 16));
#pragma unroll
    for (int f = 0; f < FR_PER_WAVE; ++f) Bf[f] = __builtin_bit_cast(bf16x8v, bl128(rw, lane * 16, fso + f * 1024));
    const int gtp = w >> 2, gblk = w & 3, fa = w >> 1, ha = w & 1;
    const int cg4 = 4 * (tid & 63);
    for (int tile = blockIdx.x; tile < 256; tile += GRID) {
        const int b = tile >> 5, c = tile & 31;
        const int s_begin = c == 0 ? 0 : NMETA + 64 * c, nsub = c == 0 ? 5 : 4;
        float hloc = 0.f, caloc = 1.f;
        PrepLoads L; if (PREP_PREFETCH) prep_loads(L, rw, b, s_begin, fr, fq, fa, ha, w, cg4);
        { const int t4 = tid * 4;
#define CST_CP(dst, src, n) if (t4 < (n)) *(LAS f32x4*)(CST + (dst) + t4) = bl128f(rw, t4 * 4, pkb + (src) * 4);
          CST_CP(C_MU, PK_MU + 1536, 128) CST_CP(C_W0, PK_W0, 512) CST_CP(C_A0, PK_A0, 512) CST_CP(C_BA, PK_BA, 256) CST_CP(C_BX, PK_BX, 256) CST_CP(C_CONVW, PK_CONVW, 1024) CST_CP(C_CONVB, PK_CONVB, 256)
          CST_CP(C_SCW, PK_SCW, 768) CST_CP(C_SCG, PK_SCG, 256)
          if (t4 < 256) { const f32x4 lm = bl128f(rw, t4 * 4, pkb + PK_LAM * 4); *(LAS f32x4*)(CST + C_LAM + t4) = (f32x4){softplusf_(-lm[0]), softplusf_(-lm[1]), softplusf_(-lm[2]), softplusf_(-lm[3])}; }
#undef CST_CP
          __syncthreads(); }
        for (int sub = 0; sub < nsub; ++sub) {
            const int s0 = s_begin + 16 * sub;
            if (!PREP_PREFETCH) prep_loads(L, rw, b, s0, fr, fq, fa, ha, w, cg4);
            { bf16x8v Af[4];
                { f32x4 cv, pv; unpack4f(L.cur, cv); unpack4f(L.prv, pv); const f32x4 m = *(const LAS f32x4*)(CST + C_MU + 32 * fa + 8 * fq + 4 * ha); float zv[4];
#pragma unroll
                  for (int j = 0; j < 4; ++j) { const float z = cv[j] + (pv[j] - cv[j]) * m[j]; zv[j] = fa == 0 ? tanhf_(z) : (fa == 1 ? z : sigmoidf_(z)); }
                  *(LAS unsigned long long*)(AFb + (fa * 64 + lane) * 16 + 8 * ha) = (unsigned long long)pk2(zv[0], zv[1]) | ((unsigned long long)pk2(zv[2], zv[3]) << 32); }
#pragma unroll
                for (int j = 0; j < 3; ++j) { const int idx = tid + 512 * j; if (idx < 19 * 64) { f32x4 a4, c4, x4; unpack4f(L.lx[j], a4); unpack4f(L.lc[j], c4); unpack4f(L.lxx[j], x4);
                    *(LAS f32x4*)(XL + (idx >> 6) * PR + cg4) = a4; *(LAS f32x4*)(VL + (idx >> 6) * PR + cg4) = c4 * x4; } }
                __syncthreads();
#pragma unroll
                for (int f = 0; f < 4; ++f) Af[f] = __builtin_bit_cast(bf16x8v, *(const LAS v4u*)(AFb + (f * 64 + lane) * 16));
                const f32x4v zero = (f32x4v){0.f, 0.f, 0.f, 0.f};
                unsigned ow[8], oa[8], og[8];
#pragma unroll
                for (int ct = 0; ct < 4; ++ct) {
                    const f32x4v aw = __builtin_amdgcn_mfma_f32_16x16x32_bf16(Bf[ct], Af[0], zero, 0, 0, 0);
                    const f32x4v aa = __builtin_amdgcn_mfma_f32_16x16x32_bf16(Bf[4 + ct], Af[1], zero, 0, 0, 0);
                    f32x4v ag = __builtin_amdgcn_mfma_f32_16x16x32_bf16(Bf[8 + 2 * ct], Af[2], zero, 0, 0, 0); ag = __builtin_amdgcn_mfma_f32_16x16x32_bf16(Bf[9 + 2 * ct], Af[3], ag, 0, 0, 0);
                    const f32x4 w04 = *(const LAS f32x4*)(CST + C_W0 + 64 * w + 16 * fq + 4 * ct), a04 = *(const LAS f32x4*)(CST + C_A0 + 64 * w + 16 * fq + 4 * ct);
                    float wd[4], av4[4];
#pragma unroll
                    for (int i = 0; i < 4; ++i) { const float e = 0.60653066f * sigmoidf_(w04[i] + aw[i]);
                         wd[i] = e * (1.0f - e * (0.5f - e * (0.16666667f - e * (0.041666668f - e * 0.0083333338f)))); av4[i] = sigmoidf_(a04[i] + aa[i]); }
                    ow[2 * ct] = pk2(wd[0], wd[1]); ow[2 * ct + 1] = pk2(wd[2], wd[3]); oa[2 * ct] = pk2(av4[0], av4[1]); oa[2 * ct + 1] = pk2(av4[2], av4[3]); og[2 * ct] = pk2(ag[0], ag[1]); og[2 * ct + 1] = pk2(ag[2], ag[3]); }
                { const int vo = row_of(b, s0 + fr) * 1024 + fq * 32, so = w * 128;
#pragma unroll
                  for (int hh = 0; hh < 2; ++hh) {
                      __builtin_amdgcn_raw_buffer_store_b128((v4u){ow[4 * hh], ow[4 * hh + 1], ow[4 * hh + 2], ow[4 * hh + 3]}, rw, vo + 16 * hh, (int)(WS_OV + OV_WDEC) + so, 0);
                      __builtin_amdgcn_raw_buffer_store_b128((v4u){oa[4 * hh], oa[4 * hh + 1], oa[4 * hh + 2], oa[4 * hh + 3]}, rw, vo + 16 * hh, (int)(WS_OV + OV_ABUF) + so, 0);
                      __builtin_amdgcn_raw_buffer_store_b128((v4u){og[4 * hh], og[4 * hh + 1], og[4 * hh + 2], og[4 * hh + 3]}, rw, vo + 16 * hh, (int)(WS_OV + OV_GBUF) + so, 0); } } }
            PSTAMP(0);
            const LAS float* cc = CST + cg4;
            const f32x4 cb4 = *(const LAS f32x4*)(cc + C_CONVB), cw0 = *(const LAS f32x4*)(cc + C_CONVW), cw1 = *(const LAS f32x4*)(cc + C_CONVW + 256), cw2 = *(const LAS f32x4*)(cc + C_CONVW + 512), cw3 = *(const LAS f32x4*)(cc + C_CONVW + 768);
            const f32x4 sw0 = *(const LAS f32x4*)(cc + C_SCW), sw1 = *(const LAS f32x4*)(cc + C_SCW + 256), sw2 = *(const LAS f32x4*)(cc + C_SCW + 512), sg4 = *(const LAS f32x4*)(cc + C_SCG);
#pragma unroll
            for (int j = 0; j < 2; ++j) { const int t = w + 8 * j;
                const LAS float* xr = XL + t * PR + cg4; const LAS float* vr = VL + (t + 1) * PR + cg4;
                *(LAS f32x4*)(U + t * PR + cg4) = cb4 + *(const LAS f32x4*)xr * cw0 + *(const LAS f32x4*)(xr + PR) * cw1 + *(const LAS f32x4*)(xr + 2 * PR) * cw2 + *(const LAS f32x4*)(xr + 3 * PR) * cw3;
                f32x4 b4; unpack4f(L.lb[j], b4);
                const f32x4 y4 = b4 * (*(const LAS f32x4*)vr * sw0 + *(const LAS f32x4*)(vr + PR) * sw1 + *(const LAS f32x4*)(vr + 2 * PR) * sw2);
                const float ss = red16((y4[0] * y4[0] + y4[1] * y4[1]) + (y4[2] * y4[2] + y4[3] * y4[3])); const float rs = rsqrtf(ss * (1.0f / 64.0f) + RMS_EPS);
                bs64(rw, cg4 * 2, (int)WS_XN + urow(b, s0 + t) * (D * 2) + 512, (unsigned long long)pk2(y4[0] * rs * sg4[0], y4[1] * rs * sg4[1]) | ((unsigned long long)pk2(y4[2] * rs * sg4[2], y4[3] * rs * sg4[3]) << 32)); }
            PSTAMP(1);
            if (PREP_PREFETCH && sub + 1 < nsub) prep_loads(L, rw, b, s0 + 16, fr, fq, fa, ha, w, cg4);
            __syncthreads();
            { bf16x8v Al[2];
#pragma unroll
                for (int ks = 0; ks < 2; ++ks) { const LAS float* up = U + fr * PR + 64 * gblk + 32 * ks + 8 * fq; const f32x4v u0 = *(const LAS f32x4v*)up, u1 = *(const LAS f32x4v*)(up + 4);
                    const float uv[8] = {u0.x, u0.y, u0.z, u0.w, u1.x, u1.y, u1.z, u1.w}; Al[ks] = pack8(uv); }
                const f32x4v zero = (f32x4v){0.f, 0.f, 0.f, 0.f};
#pragma unroll
                for (int cl = 0; cl < 2; ++cl) { const int j = 64 * gblk + 16 * (2 * gtp + cl) + 4 * fq;
                    f32x4v ar = __builtin_amdgcn_mfma_f32_16x16x32_bf16(Bf[16 + 2 * cl], Al[0], zero, 0, 0, 0); ar = __builtin_amdgcn_mfma_f32_16x16x32_bf16(Bf[17 + 2 * cl], Al[1], ar, 0, 0, 0);
                    f32x4v ai = __builtin_amdgcn_mfma_f32_16x16x32_bf16(Bf[20 + 2 * cl], Al[0], zero, 0, 0, 0); ai = __builtin_amdgcn_mfma_f32_16x16x32_bf16(Bf[21 + 2 * cl], Al[1], ai, 0, 0, 0);
                    const f32x4 ba4 = *(const LAS f32x4*)(CST + C_BA + j), bx4 = *(const LAS f32x4*)(CST + C_BX + j), sp4 = *(const LAS f32x4*)(CST + C_LAM + j), u4 = *(const LAS f32x4*)(U + fr * PR + j);
                    f32x4v av, bv;
#pragma unroll
                    for (int i = 0; i < 4; ++i) { const float r = sigmoidf_(ar[i] + ba4[i]), ig = sigmoidf_(ai[i] + bx4[i]);
                        const float la = -8.0f * r * sp4[i], a = __expf(la), x2 = 2.0f * la;
                        const float om = x2 < -0.25f ? (1.0f - a * a) : -x2 * (1.0f + x2 * (0.5f + x2 * (0.16666667f + x2 * (0.041666668f + x2 * 0.0083333338f))));
                        av[i] = a; bv[i] = __builtin_amdgcn_sqrtf(om) * (ig * u4[i]); }
                    *(LAS f32x4v*)(GT + fr * PR + j) = av; *(LAS f32x4v*)(GT + (16 + fr) * PR + j) = bv; } }
            PSTAMP(2);
            __syncthreads();
            PSTAMP(3);
            if (tid < 256) { const int j = tid; float av[16], bv[16];
#pragma unroll
                for (int t = 0; t < 16; ++t) { av[t] = GT[t * PR + j]; bv[t] = GT[(16 + t) * PR + j]; }
                asm volatile("" ::: "memory");
#pragma unroll
                for (int t = 0; t < 16; ++t) { hloc = av[t] * hloc + bv[t]; caloc *= av[t];
                    bs32(rw, j * 4, (int)(WS_OV + OV_HL) + urow(b, s0 + t) * 1024, pk2(hloc, caloc)); } }
            PSTAMP(4);
        }
        if (tid < 256) { ((float*)(F.ws + WS_AGG))[((size_t)(b * 32 + c) * 256 + tid) * 2 + 0] = caloc; ((float*)(F.ws + WS_AGG))[((size_t)(b * 32 + c) * 256 + tid) * 2 + 1] = hloc; }
        __syncthreads();
    }
}

constexpr int SC_CH = 24, SC_NCH = TT / SC_CH, SC_LW = SC_CH / 4, SC_STEPF = 336, SC_BUFF = SC_CH * SC_STEPF;
constexpr int SC_VJ = (SC_LW * 16 + 63) / 64;
static_assert(SC_NCH * SC_CH == TT && 2 * SC_BUFF * 4 <= RING_BYTES, "scan geometry");
struct ScanRegs { unsigned rr[SC_LW + 1], kk[SC_LW + 1], aa[SC_LW], ww[SC_LW]; unsigned vc[SC_VJ], vp[SC_VJ]; };
__device__ __forceinline__ void scan_load(const Frame& F, ScanRegs& R, int b, int h, int q, int lw, int chunk, unsigned lane) {
    const int t0 = chunk * SC_CH + SC_LW * lw;
    const __amdgpu_buffer_rsrc_t rs = __builtin_amdgcn_make_buffer_rsrc((void*)(F.ws + WS_OV), 0, 0x7ffffff0, 0x00020000);
    const int vo = (int)(lane * 2u);
#pragma unroll
    for (int m = 0; m < SC_LW + 1; ++m) { const int s = t0 - 1 + m;
        if (s >= 0) { const int so = __builtin_amdgcn_readfirstlane((int)OV_P + row_of(b, s) * (NINP * 2) + h * 128);
            R.rr[m] = (unsigned short)__builtin_amdgcn_raw_buffer_load_b16(rs, vo + PC_R * 2, so, 0); R.kk[m] = (unsigned short)__builtin_amdgcn_raw_buffer_load_b16(rs, vo + PC_K * 2, so, 0); } else { R.rr[m] = 0u; R.kk[m] = 0u; } }
#pragma unroll
    for (int i = 0; i < SC_LW; ++i) { const int ro = row_of(b, t0 + i) * 1024 + h * 128;
        R.aa[i] = (unsigned short)__builtin_amdgcn_raw_buffer_load_b16(rs, vo, __builtin_amdgcn_readfirstlane((int)OV_ABUF + ro), 0); R.ww[i] = (unsigned short)__builtin_amdgcn_raw_buffer_load_b16(rs, vo, __builtin_amdgcn_readfirstlane((int)OV_WDEC + ro), 0); }
#pragma unroll
    for (int j = 0; j < SC_VJ; ++j) { const int st0 = 4 * j; const unsigned st = st0 + (lane >> 4), rw = lane & 15; R.vc[j] = 0u; R.vp[j] = 0u;
        if (st < (unsigned)SC_LW) { const int s = t0 + (int)st; const int col2 = (PC_V + h * 64 + 16 * q + (int)rw) * 2;
            R.vc[j] = (unsigned short)__builtin_amdgcn_raw_buffer_load_b16(rs, (int)__umul24((unsigned)row_of(b, s), (unsigned)(NINP * 2)) + col2, (int)OV_P, 0);
            if (s > 0) R.vp[j] = (unsigned short)__builtin_amdgcn_raw_buffer_load_b16(rs, (int)__umul24((unsigned)row_of(b, s - 1), (unsigned)(NINP * 2)) + col2, (int)OV_P, 0); } }
}
__device__ __forceinline__ void scan_emit(const ScanRegs& R, LAS float* buf, int lw, unsigned lane, float mu_r, float mu_k, float kk_n, float ka_n, float mu_v) {
    LAS float* lb = buf + SC_LW * lw * SC_STEPF + lane; asm volatile("" : "+v"(lb));
#pragma unroll
    for (int i = 0; i < SC_LW; ++i) { LAS float* sp = lb + i * SC_STEPF;
        const float rc = bf2f(R.rr[i + 1]), rp = bf2f(R.rr[i]), kc = bf2f(R.kk[i + 1]), kp = bf2f(R.kk[i]);
        const float zr = rc + (rp - rc) * mu_r, zk = kc + (kp - kc) * mu_k, a = bf2f(R.aa[i]);
        const float kv = zk * kk_n; const float ss = wave_sum_dpp(kv * kv); const float kn = kv * rsqrtf(fmaxf(ss, 1e-24f));
        sp[0] = zr; sp[64] = 1.0f - bf2f(R.ww[i]); sp[128] = zk * (1.0f + (a - 1.0f) * ka_n); sp[192] = -kn; sp[256] = kn * a; }
#pragma unroll
    for (int j = 0; j < SC_VJ; ++j) { const unsigned st = 4 * j + (lane >> 4), rw = lane & 15;
        if (st < (unsigned)SC_LW) { const float vc = bf2f(R.vc[j]), vp = bf2f(R.vp[j]); buf[(SC_LW * lw + st) * SC_STEPF + 320 + rw] = vc + (vp - vc) * mu_v; } }
}
typedef float f32x2 __attribute__((ext_vector_type(2)));
struct ScanOps { f32x4 r4, w4, k4, n4, b4; float v; };
__device__ __forceinline__ void scan_ops_load(ScanOps& o, const LAS float* lp, const LAS float* vp) {
    o.r4 = *(const LAS f32x4*)(lp); o.w4 = *(const LAS f32x4*)(lp + 64); o.k4 = *(const LAS f32x4*)(lp + 128);
    o.n4 = *(const LAS f32x4*)(lp + 192); o.b4 = *(const LAS f32x4*)(lp + 256); o.v = *vp; }
#define LO2(v) ((f32x2){(v).x, (v).y})
#define HI2(v) ((f32x2){(v).z, (v).w})
__device__ __forceinline__ float dot4p(const f32x2& a0, const f32x2& a1, const f32x4& b) { f32x2 t = a0 * LO2(b); t = a1 * HI2(b) + t; return t.x + t.y; }
__device__ __forceinline__ float scan_step(f32x2& S0, f32x2& S1, const ScanOps& o, float& q) {
    float p = dot4p(S0, S1, o.n4), y = q;
    p += dppf<0xB1>(p); y += dppf<0xB1>(y); p += dppf<0x4E>(p); y += dppf<0x4E>(y); p += dppf<0x141>(p); y += dppf<0x141>(y); p += dppf<0x128>(p); y += dppf<0x128>(y);
    const f32x2 vv = (f32x2){o.v, o.v}, sa = (f32x2){p, p};
    S0 = LO2(o.b4) * sa + (S0 * LO2(o.w4) + LO2(o.k4) * vv); S1 = HI2(o.b4) * sa + (S1 * HI2(o.w4) + HI2(o.k4) * vv);
    q = dot4p(S0, S1, o.r4);
    return y; }
constexpr int SC_YB = SC_CH * 16;
static_assert((2 * SC_BUFF + 2 * SC_YB + 256 + 256 + 4 * 64 * 33) * 4 <= RING_BYTES, "scan LDS");
__device__ __forceinline__ void scan_flush(const Frame& F, const LAS float* yb, int b, int h, int q, int chunk, int ltid) {
    asm volatile("" : "+v"(ltid));
    static_assert(SC_YB / 2 <= 256, "one pair per loader thread");
    if (ltid < SC_YB / 2) { const int st = ltid >> 3, rp = ltid & 7; const f32x2v_ yv = *(const LAS f32x2v_*)(yb + 2 * ltid);
        const __amdgpu_buffer_rsrc_t rs = __builtin_amdgcn_make_buffer_rsrc((void*)F.ws, 0, 0x0ffffff0, 0x00020000);
        __builtin_amdgcn_raw_buffer_store_b32(pk2(yv.x, yv.y), rs, (int)__umul24((unsigned)row_of(b, chunk * SC_CH + st), (unsigned)(D * 2)) + rp * 4, (int)WS_XN + 1024 + h * 128 + q * 32, 0); }
}
__device__ __forceinline__ void phase_scan(Frame& F, const float* pk, const float* const* in, int l) {
    { int ln_ = F.tid & 63; asm volatile("" : "+v"(ln_)); F.lane = ln_ & 63; }
    LAS float* buf0 = (LAS float*)F.lds; LAS float* buf1 = buf0 + SC_BUFF; LAS float* yb0 = buf1 + SC_BUFF; LAS float* yb1 = yb0 + SC_YB; LAS float* dummy = yb1 + SC_YB;
    const unsigned lane = F.lane; const int wave = F.wave;
    const int cv_split = CI_SET1, cv_n = CI_SET1 + (l + 1 < NLAYER ? CI_SET0 : 0);
    for (int item = blockIdx.x; item < 256; item += GRID) {
        const int b = item >> 5, h = (item >> 2) & 7, q = item & 3;
        if (wave >= 4) {
            const int lw = wave - 4, n = h * 64 + lane, ltid = lw * 64 + lane;
            const float mu_r = pk[PK_MU + n], mu_k = pk[PK_MU + 512 + n], kk_n = pk[PK_KK + n], ka_n = pk[PK_KA + n];
            const float mu_v = pk[PK_MU + 1024 + h * 64 + 16 * q + (lane & 15)];
            ScanRegs A, B;
            scan_load(F, A, b, h, q, lw, 0, lane); scan_load(F, B, b, h, q, lw, 1, lane);
            scan_emit(A, buf0, lw, lane, mu_r, mu_k, kk_n, ka_n, mu_v);
            __syncthreads();
            LAS float* cscr = dummy + 256 + lw * (64 * 33);
            int cv_it = (item * 4 + lw); bool cv_pending = false; ConvItem cvi; float cvv[32];
            cvi = conv_item(F.ws, in, l, 1, 0);
            for (int c = 0; c < SC_NCH; ++c) {
                if ((c & 1) == 0) { if (c + 2 < SC_NCH) scan_load(F, A, b, h, q, lw, c + 2, lane); if (c + 1 < SC_NCH) scan_emit(B, buf1, lw, lane, mu_r, mu_k, kk_n, ka_n, mu_v); }
                else              { if (c + 2 < SC_NCH) scan_load(F, B, b, h, q, lw, c + 2, lane); if (c + 1 < SC_NCH) scan_emit(A, buf0, lw, lane, mu_r, mu_k, kk_n, ka_n, mu_v); }
                if (c > 0) scan_flush(F, ((c - 1) & 1) ? yb1 : yb0, b, h, q, c - 1, ltid);
                if ((c & 7) == 1 && cv_pending) { conv_store(cvi, (int)lane, cvv, cscr); cv_pending = false; cv_it += 4 * 256; }
                if ((c & 7) == 0 && cv_it < cv_n) { cvi = cv_it < cv_split ? conv_item(F.ws, in, l, 1, cv_it) : conv_item(F.ws, in, l + 1, 0, cv_it - cv_split); conv_loads(cvi, (int)lane, cvv); cv_pending = true; }
                __syncthreads();
            }
            if (cv_pending) { conv_store(cvi, (int)lane, cvv, cscr); cv_it += 4 * 256; }
            for (; cv_it < cv_n; cv_it += 4 * 256) { cvi = cv_it < cv_split ? conv_item(F.ws, in, l, 1, cv_it) : conv_item(F.ws, in, l + 1, 0, cv_it - cv_split); conv_loads(cvi, (int)lane, cvv); conv_store(cvi, (int)lane, cvv, cscr); }
            scan_flush(F, ((SC_NCH - 1) & 1) ? yb1 : yb0, b, h, q, SC_NCH - 1, ltid);
        } else {
            const int kq = lane & 15, rowl = 4 * wave + (lane >> 4);
            f32x2 S0 = (f32x2){0.f, 0.f}, S1 = S0;
            __builtin_amdgcn_s_setprio(3);
            __syncthreads();
            for (int c = 0; c < SC_NCH; ++c) {
                const LAS float* bp = (c & 1) ? buf1 : buf0;
                LAS float* yw = kq == 0 ? (((c & 1) ? yb1 : yb0) + rowl) : (dummy + lane);
                const int ystep = kq == 0 ? 16 : 0;
                ScanOps oa, ob; float qp = 0.f;
                const LAS float* lp = bp + 4 * kq; const LAS float* vp = bp + 320 + rowl;
                asm volatile("" : "+v"(lp), "+v"(vp), "+v"(yw));
                scan_ops_load(oa, lp, vp);
                scan_ops_load(ob, lp + SC_STEPF, vp + SC_STEPF);
                (void)scan_step(S0, S1, oa, qp);
#pragma unroll 2
                for (int i = 1; i < SC_CH - 1; i += 2) {
                    scan_ops_load(oa, lp + (i + 1) * SC_STEPF, vp + (i + 1) * SC_STEPF);
                    const float y0 = scan_step(S0, S1, ob, qp); yw[(i - 1) * ystep] = y0;
                    scan_ops_load(ob, lp + (i + 2) * SC_STEPF, vp + (i + 2) * SC_STEPF);
                    const float y1 = scan_step(S0, S1, oa, qp); yw[i * ystep] = y1;
                }
                { const float y2 = scan_step(S0, S1, ob, qp); yw[(SC_CH - 2) * ystep] = y2; }
                yw[(SC_CH - 1) * ystep] = red16(qp);
                __syncthreads();
            }
            __builtin_amdgcn_s_setprio(0);
        }
        __syncthreads();
    }
}

__device__ __forceinline__ void unpack4(unsigned long long u, float (&v)[4]) { v[0] = bf2f((unsigned)u & 0xffffu); v[1] = bf2f(((unsigned)u >> 16)); v[2] = bf2f((unsigned)(u >> 32) & 0xffffu); v[3] = bf2f((unsigned)(u >> 48)); }
__device__ __forceinline__ void phase_mix_final(Frame& F, const float* pk) {
    { int ln_ = F.tid & 63; asm volatile("" : "+v"(ln_)); F.lane = ln_ & 63; }
    LAS float* carry = (LAS float*)F.lds;
    const int tid = F.tid, lane = F.lane, w = F.wave, rg = lane >> 4, kq = lane & 15;
    const bf16* P = ((bf16*)(F.ws + WS_OV + OV_P)); bf16* Y = ((bf16*)(F.ws + WS_XN));
    const bf16* AB = ((bf16*)(F.ws + WS_OV + OV_ABUF)); const bf16* GB = ((bf16*)(F.ws + WS_OV + OV_GBUF)); const unsigned* HCp = ((const unsigned*)(F.ws + WS_OV + OV_HL));
    const int n0 = w * 64 + 4 * kq;
    const f32x4 mu_r = *(const f32x4*)(pk + PK_MU + n0), mu_k = *(const f32x4*)(pk + PK_MU + 512 + n0), mu_v = *(const f32x4*)(pk + PK_MU + 1024 + n0);
    const f32x4 ka4 = *(const f32x4*)(pk + PK_KA + n0), rk4 = *(const f32x4*)(pk + PK_RK + n0), lw4 = *(const f32x4*)(pk + PK_LNW + n0), lb4 = *(const f32x4*)(pk + PK_LNB + n0);
    const f32x4 ng4 = w < 4 ? *(const f32x4*)(pk + PK_LNG + n0) : (f32x4){0.f, 0.f, 0.f, 0.f};
    for (int tile = blockIdx.x; tile < 256; tile += GRID) {
        const int b = tile >> 5, c = tile & 31;
        const int s_begin = c == 0 ? 0 : NMETA + 64 * c, ntok = c == 0 ? 80 : 64;
        if (tid < 256) {
            const float* ag = ((float*)(F.ws + WS_AGG)) + ((size_t)(b * 32) * 256 + tid) * 2; float ca[32], hh[32];
#pragma unroll
            for (int c2 = 0; c2 < 31; ++c2) { ca[c2] = 0.f; hh[c2] = 0.f; if (c2 < c) { const f32x2v_ t2 = *(const f32x2v_*)(ag + (size_t)c2 * 512); ca[c2] = t2.x; hh[c2] = t2.y; } }
            float hc = 0.f;
#pragma unroll
            for (int c2 = 0; c2 < 31; ++c2) if (c2 < c) hc = ca[c2] * hc + hh[c2];
            carry[tid] = hc; }
        __syncthreads();
        f32x4 cr4 = (f32x4){0.f, 0.f, 0.f, 0.f}; if (w < 4) cr4 = *(const LAS f32x4*)(carry + n0);
        for (int tg = (c == 0 && b != 0) ? NMETA : 0; tg < ntok; tg += 16) {
            unsigned long long rc[4], kc[4], vc[4], rp[4], kp[4], vp[4], av[4], yv[4], gv[4], lg[4]; v4u hc[4];
#pragma unroll
            for (int u = 0; u < 4; ++u) { const int s = s_begin + tg + 4 * u + rg; const size_t ro = (size_t)row_of(b, s); const bf16* pr = P + ro * NINP + n0;
                rc[u] = *(const unsigned long long*)(pr + PC_R); kc[u] = *(const unsigned long long*)(pr + PC_K); vc[u] = *(const unsigned long long*)(pr + PC_V); rp[u] = 0ull; kp[u] = 0ull; vp[u] = 0ull;
                if (s > 0) { const bf16* pp = P + (size_t)row_of(b, s - 1) * NINP + n0; rp[u] = *(const unsigned long long*)(pp + PC_R); kp[u] = *(const unsigned long long*)(pp + PC_K); vp[u] = *(const unsigned long long*)(pp + PC_V); }
                av[u] = *(const unsigned long long*)(AB + ro * 512 + n0); yv[u] = *(const unsigned long long*)(Y + ro * D + 512 + n0); gv[u] = *(const unsigned long long*)(GB + ro * 512 + n0);
                lg[u] = 0ull; hc[u] = (v4u){0u, 0u, 0u, 0u};
                if (w < 4) { lg[u] = *(const unsigned long long*)(pr + PC_LRUG); hc[u] = *(const v4u*)(HCp + ro * 256 + n0); } }
#pragma unroll
            for (int u = 0; u < 4; ++u) { const int s = s_begin + tg + 4 * u + rg; const size_t ro = (size_t)row_of(b, s);
                float r_c[4], k_c[4], v_c[4], r_p[4], k_p[4], v_p[4], a4[4], y4[4], g4[4];
                unpack4(rc[u], r_c); unpack4(kc[u], k_c); unpack4(vc[u], v_c); unpack4(rp[u], r_p); unpack4(kp[u], k_p); unpack4(vp[u], v_p); unpack4(av[u], a4); unpack4(yv[u], y4); unpack4(gv[u], g4);
                float zv[4], cbp = 0.f, ysum = 0.f;
#pragma unroll
                for (int j = 0; j < 4; ++j) { const float zr = r_c[j] + (r_p[j] - r_c[j]) * mu_r[j], zk = k_c[j] + (k_p[j] - k_c[j]) * mu_k[j]; zv[j] = v_c[j] + (v_p[j] - v_c[j]) * mu_v[j];
                    cbp += zr * (zk * (1.0f + (a4[j] - 1.0f) * ka4[j])) * rk4[j]; ysum += y4[j]; }
                const float cb = red16(cbp), mean = red16(ysum) * (1.0f / 64.0f);
                float d4[4], vs = 0.f;
#pragma unroll
                for (int j = 0; j < 4; ++j) { d4[j] = y4[j] - mean; vs += d4[j] * d4[j]; }
                const float rstd = rsqrtf(red16(vs) * (1.0f / 64.0f) + LNX_EPS);
                float o4[4];
#pragma unroll
                for (int j = 0; j < 4; ++j) o4[j] = (d4[j] * rstd * lw4[j] + lb4[j] + cb * zv[j]) * g4[j];
                *(GAS unsigned long long*)(Y + ro * D + 512 + n0) = (unsigned long long)pk2(o4[0], o4[1]) | ((unsigned long long)pk2(o4[2], o4[3]) << 32);
                if (w < 4) { float l4[4], yy[4], ss = 0.f; unpack4(lg[u], l4);
#pragma unroll
                    for (int j = 0; j < 4; ++j) { yy[j] = gelu_tanh(l4[j]) * (bf2f(hc[u][j] & 0xffffu) + bf2f(hc[u][j] >> 16) * cr4[j]); ss += yy[j] * yy[j]; }
                    const float rs = rsqrtf(red16(ss) * (1.0f / 64.0f) + RMS_EPS);
                    *(GAS unsigned long long*)(Y + ro * D + n0) = (unsigned long long)pk2(yy[0] * rs * ng4[0], yy[1] * rs * ng4[1]) | ((unsigned long long)pk2(yy[2] * rs * ng4[2], yy[3] * rs * ng4[3]) << 32); } }
        }
        __syncthreads();
    }
}
#ifndef MK_PER_PHASE
#define MK_PER_PHASE 0
#endif
constexpr bool EXP_BAR = false;
constexpr int REP_GEMM = 1, REP_PREP = 1, REP_SCAN = 1, REP_CONV = 1;
constexpr int PH_PER_LAYER = 12, N_PHASES = 1 + NLAYER * PH_PER_LAYER;
struct Args { const float* in[30]; float* out; unsigned char* ws; int ph_lo, ph_hi; };
static_assert(sizeof(Args) == 30 * 8 + 8 + 8 + 4 + 4, "Args has no padding");

__global__ void __launch_bounds__(NWAVES * 64, 2) hybrid_fwd(Args args) {
    extern __shared__ __attribute__((aligned(16))) unsigned char lds[];
    Frame F;
    F.lds = (LAS unsigned char*)lds;
    F.tid = threadIdx.x; F.lane = F.tid & 63; F.wave = 0;
    { const int bx = blockIdx.x; F.vcu = (bx % 8) * (GRID / 8) + bx / 8; }
    unsigned char* ws = args.ws;
    F.ws = ws; F.x = args.in[0]; F.meta = args.in[1]; F.out = args.out;
    volatile LAS unsigned* MISC = (volatile LAS unsigned*)(F.lds + MISC_OFF);
    for (int u = F.tid; u < (LDS_BYTES - LDSCTL_OFF) / 4; u += NWAVES * 64) ((LAS unsigned*)(F.lds + LDSCTL_OFF))[u] = 0u;
    __syncthreads();
    { const unsigned simd = ((unsigned)__builtin_amdgcn_s_getreg((1 << 11) | (4 << 6) | 4)) & 3u;
      LAS unsigned* tkw = (LAS unsigned*)(F.lds + MISC_OFF) + 12;
      unsigned tk = 0u, tg = 0u; if (vlane() == 0) { tk = __hip_atomic_fetch_add(tkw + simd, 1u, __ATOMIC_RELAXED, __HIP_MEMORY_SCOPE_WORKGROUP); tg = __hip_atomic_fetch_add(tkw + 4, 1u, __ATOMIC_RELAXED, __HIP_MEMORY_SCOPE_WORKGROUP); }
      tk = (unsigned)__builtin_amdgcn_readfirstlane(tk); tg = (unsigned)__builtin_amdgcn_readfirstlane(tg);
      __syncthreads();
      const bool two_each = tkw[0] == 2u && tkw[1] == 2u && tkw[2] == 2u && tkw[3] == 2u;
      F.wave = __builtin_amdgcn_readfirstlane(two_each ? (int)(simd + 4u * tk) : (int)tg); }
    F.lane = vlane(); F.tid = F.wave * 64 + F.lane;
    XcdBarrier bar; bar.bar = (unsigned*)(ws + WS_CTL) + CW_BAR; bar.x = 0; bar.st = nullptr;
    if (!MK_PER_PHASE) bar = xcd_barrier_post((unsigned*)(ws + WS_CTL) + CW_BAR, MISC + 8, F.tid == 0);
    const int lo = args.ph_lo, hi = args.ph_hi; const int wave0 = F.wave;
    unsigned long long pr_prev = 0ull; F.pr_acc = 0ull; F.pr_sub = 0ull; F.ph = 0; if (PROBE_MASK) { pr_prev = __builtin_amdgcn_s_memrealtime(); F.pr_sub = pr_prev; }
#pragma unroll 1
    for (int ph = lo; ph < hi; ++ph) {
        if (PROBE_MASK) F.ph = ph;
        { GAS unsigned char* wsg = (GAS unsigned char*)args.ws; asm volatile("" : "+s"(wsg)); F.ws = (unsigned char*)wsg; }
        { int w_ = wave0; asm volatile("" : "+s"(w_)); F.wave = w_; }
        { int t_ = F.wave * 64 + vlane(); asm volatile("" : "+v"(t_)); F.tid = t_; }
        if (ph == 0) { PackRegs PR; pack_loads(F, args.in, PR); frag_loads(F, args.in, PR); phase_init_convert(F, args.in, PR); PSTAMP(8); PSTAMP(9); }
        else {
            const int l = (ph - 1) / PH_PER_LAYER, k = (ph - 1) - l * PH_PER_LAYER;
            if (k == 0 || k == 1 || k == 3 || k == 7 || k == 9 || k == 10) {
                unsigned char* w = F.ws;
                const bool up = (k == 0 || k == 9), down = (k == 1 || k == 10);
                const bool lastl = l + 1 == NLAYER;
                const bf16* hcur = (lastl && k == 9) ? (const bf16*)(w + WS_OV + OV_HTMP) : (const bf16*)F.out;
                const bf16* A = down ? (const bf16*)(w + WS_OV + OV_HID) : (k == 7 ? (const bf16*)(w + WS_XN) : hcur);
                const bf16* Am = (down || k == 7) ? A : (const bf16*)(w + WS_HMETA) - (size_t)MX * D;
                const bf16* B = (const bf16*)(w + WS_WB + (k == 0 ? WB_W1IN : k == 1 ? WB_W1OUT : k == 3 ? WB_WIN : k == 7 ? WB_WOUT : k == 9 ? WB_W2IN : WB_W2OUT));
                const int N = up ? 2 * FF : (k == 3 ? NINP : D), K = down ? FF : D;
                const float* rs = nullptr;
                pg8::EpiAny E; E.mode = up ? 0 : 1; E.O = w + WS_OV + (up ? OV_HID : k == 3 ? OV_P : k == 7 ? OV_RAWM : OV_RAWF); E.ldo = up ? FF : (k == 3 ? NINP : D); E.rs = rs;
                const int gwv = F.vcu * NWAVES + F.wave;
                if (k == 3) { if ((int)blockIdx.x < NINP / 32) meta_split<false>(F, Am, B, (int)blockIdx.x * 2 + (F.wave >> 2), (bf16*)(w + WS_OV + OV_P), NINP); __syncthreads(); }
                else if (k == 7) meta_gemm(F, Am, B, K, N, 2, w + WS_MSLAB, D, 4, gwv, nullptr);
                PSTAMP(5);
                pg8::Gemm g{A, B, MX, N, K, K}; pg8::StaticOrder S; S.init(MX, N, GRID, (int)blockIdx.x);
                for (int rep_ = 0; rep_ < REP_GEMM; ++rep_) pg8::gemm_phase<pg8::EpiAny, pg8::StaticOrder, true, true>(F.lds, g, S, E, F.tid);
                PSTAMP(6);
                if (up) {
                    const int bx = (int)blockIdx.x; gu32* cnt = (gu32*)(w + WS_CTL) + CW_THIN + ph;
                    if (bx >= 128 && bx < 216) { const int tile = (bx - 128) * 2 + (F.wave >> 2);
                        meta_split<true>(F, Am, B, tile < FF / 16 ? tile : -1, (bf16*)(w + WS_OV + OV_HID), FF);
                        asm volatile("s_waitcnt vmcnt(0)" ::: "memory"); if ((F.wave & 3) == 0 && (F.tid & 63) == 0) (void)__hip_atomic_fetch_add(cnt, 1u, __ATOMIC_RELAXED, __HIP_MEMORY_SCOPE_AGENT); }
                    if (bx >= 128 && bx < 192) {
                        if (F.wave == 0) { unsigned sp = 0u; while ((unsigned)__builtin_amdgcn_readfirstlane((int)__hip_atomic_load(cnt, __ATOMIC_RELAXED, __HIP_MEMORY_SCOPE_AGENT)) != (unsigned)(FF / 16)) { __builtin_amdgcn_s_sleep(2); if (++sp > (1u << 20)) break; }
                            __builtin_amdgcn_fence(__ATOMIC_ACQUIRE, "agent"); asm volatile("s_waitcnt vmcnt(0)" ::: "memory"); }
                        __syncthreads();
                        const bf16* Bd = (const bf16*)(w + WS_WB + (k == 0 ? WB_W1OUT : WB_W2OUT));
                        meta_gemm(F, (const bf16*)(w + WS_OV + OV_HID), Bd, FF, D, 2, w + WS_MSLAB, D, 8, (bx - 128) * NWAVES + F.wave, nullptr); }
                }
            } else if (k == 2 || k == 8 || k == 11) {
                const float* ng = args.in[2] + (size_t)l * 6 * D;
                const bool last = l + 1 == NLAYER;
                const float* g_post = ng + (k == 2 ? 1 : k == 8 ? 3 : 5) * D;
                bf16* h16 = (bf16*)F.out; bf16* htmp = (bf16*)(F.ws + WS_OV + OV_HTMP);
                PostIO io; io.raw16 = (const bf16*)(F.ws + WS_OV + (k == 8 ? OV_RAWM : OV_RAWF));
                io.hin16 = (last && k == 11) ? htmp : h16; io.hout16 = (last && k == 8) ? htmp : h16; io.out32 = (last && k == 11) ? F.out : nullptr; io.nks = k == 8 ? 4 : 8;
                phase_post(F, io, k == 8 ? 1.0f : 0.5f, g_post, !(last && k == 11));
            } else if (k == 4) { for (int rep_ = 0; rep_ < REP_PREP; ++rep_) phase_mix_prep(F, pack_of(F, l), l); }
            else if (k == 5) { for (int rep_ = 0; rep_ < REP_SCAN; ++rep_) phase_scan(F, pack_of(F, l), args.in, l); }
            else { phase_mix_final(F, pack_of(F, l)); }
        }
        if (EXP_BAR && ph == 3) { for (int e_ = 0; e_ < 16; ++e_) { XcdBarrier b3 = bar; b3.bar = (unsigned*)(F.ws + WS_CTL) + CW_BAR; xcd_barrier(b3, F.tid == 0); } }
        if (ph + 1 < hi) { XcdBarrier b2 = bar; b2.bar = (unsigned*)(F.ws + WS_CTL) + CW_BAR; xcd_barrier(b2, F.tid == 0); }
        if (PROBE_MASK) { const unsigned long long t = __builtin_amdgcn_s_memrealtime(); if (PROBE_SUB < 0 && ((PROBE_MASK >> ph) & 1u)) F.pr_acc += t - pr_prev; pr_prev = t; F.pr_sub = t; }
    }
    if (PROBE_MASK && blockIdx.x == 0 && F.tid == 0) { const unsigned long long t0 = __builtin_amdgcn_s_memrealtime(); while (__builtin_amdgcn_s_memrealtime() - t0 < PROBE_AMP * F.pr_acc) __builtin_amdgcn_s_sleep(8); }
}

extern "C" void kernel_launch(void* const* d_in, const int* in_sizes, int n_in, void* d_out, int out_size, void* d_ws, size_t ws_size, hipStream_t stream) {
    static int grid = 0;
    if (grid == 0) {
        if (n_in != 30 || in_sizes[0] != MX * D || out_size != MX * D || ws_size < WS_END) { fprintf(stderr, "kernel_launch: unexpected shapes: n_in %d in0 %d out %d ws %zu\n", n_in, n_in > 0 ? in_sizes[0] : -1, out_size, ws_size); grid = -1; return; }
        int dev = 0, cus = 0, per_cu = 0;
        if (hipGetDevice(&dev) != hipSuccess || hipDeviceGetAttribute(&cus, hipDeviceAttributeMultiprocessorCount, dev) != hipSuccess) { grid = -1; return; }
        if (hipFuncSetAttribute((const void*)hybrid_fwd, hipFuncAttributeMaxDynamicSharedMemorySize, LDS_BYTES) != hipSuccess) { fprintf(stderr, "kernel_launch: hipFuncSetAttribute failed\n"); grid = -1; return; }
        if (hipOccupancyMaxActiveBlocksPerMultiprocessor(&per_cu, (const void*)hybrid_fwd, NWAVES * 64, LDS_BYTES) != hipSuccess || per_cu < 1) { fprintf(stderr, "kernel_launch: occupancy query says %d blocks per CU\n", per_cu); grid = -1; (void)hipGetLastError(); return; }
        (void)hipGetLastError();
        if (cus < GRID) { fprintf(stderr, "kernel_launch: this kernel needs %d CUs (one resident workgroup each), the device has %d\n", GRID, cus); grid = -1; return; }
        grid = GRID;
    }
    if (grid < 0) return;
    if (hipMemsetAsync((char*)d_ws + WS_CTL, 0, CTL_ZERO_BYTES, stream) != hipSuccess) return;
    Args a{};
    for (int i = 0; i < 30; ++i) a.in[i] = (const float*)d_in[i];
    a.out = (float*)d_out; a.ws = (unsigned char*)d_ws;
#if MK_PER_PHASE
    for (int p = 0; p < N_PHASES; ++p) { a.ph_lo = p; a.ph_hi = p + 1; hipLaunchKernelGGL(hybrid_fwd, dim3(grid), dim3(NWAVES * 64), LDS_BYTES, stream, a); }
#else
    a.ph_lo = 0; a.ph_hi = N_PHASES;
    hipLaunchKernelGGL(hybrid_fwd, dim3(grid), dim3(NWAVES * 64), LDS_BYTES, stream, a);
#endif
}
```
